# Optimizing an MI355X kernel written in HIP

```python
import jax, jax.numpy as jnp
from jax import lax
import numpy as np

D_MODEL = 1024
BATCH = 8
SEQ = 2048
DEPTH = 1
DEC_BATCH = 128
DEC_SEQ = 1
PAST_LEN = 16384
PAGE_SIZE = 128

R_HEADS = 8
R_HEAD_DIM = 64
R_WIDTH = R_HEADS * R_HEAD_DIM
W_LORA = 64
A_LORA = 64
G_LORA = 128
R_GN_EPS = 64e-5
M_HEADS = 4
M_HEAD_DIM = 128
M_WIDTH = M_HEADS * M_HEAD_DIM
CONV_W = 4
MLSTM_CHUNK = 64
M_GN_EPS = 1e-5
D_FF = 4 * D_MODEL
RMS_EPS = 1e-6
R_SHIFT_COLS = 3 * R_WIDTH + W_LORA + A_LORA + G_LORA
M_COLS = 3 * M_WIDTH + 2 * M_HEADS
GATE_COLS = 2 * D_MODEL
IN_COLS = R_SHIFT_COLS + M_COLS + GATE_COLS

F32 = jnp.float32

kernel_name = 'rwkv7_mlstm_gated_hybrid_step'


def _rmsnorm(x, g):
    xf = x.astype(F32)
    y = xf * lax.rsqrt(jnp.mean(xf * xf, axis=-1, keepdims=True) + RMS_EPS)
    return (y * g.astype(F32)).astype(x.dtype)


def _head_norm(y, eps):
    yf = y.astype(F32)
    mu = jnp.mean(yf, axis=-1, keepdims=True)
    var = jnp.mean(jnp.square(yf - mu), axis=-1, keepdims=True)
    return (yf - mu) * lax.rsqrt(var + eps)


def _rwkv7_recurrence(r, log_w, k, v, kk, a, S0):
    def step(S, inp):
        r_t, lw_t, k_t, v_t, kk_t, a_t = inp
        s_kk = jnp.einsum('bhvk,bhk->bhv', S, kk_t)
        S = (S * jnp.exp(lw_t)[:, :, None, :]
             - s_kk[..., None] * (kk_t * a_t)[:, :, None, :]
             + v_t[..., None] * k_t[:, :, None, :])
        return S, jnp.einsum('bhvk,bhk->bhv', S, r_t)
    xs = tuple(jnp.swapaxes(t.astype(F32), 0, 1) for t in (r, log_w, k, v, kk, a))
    S, ys = lax.scan(step, S0.astype(F32), xs)
    return jnp.swapaxes(ys, 0, 1), S


def _rwkv7_branch(pr, pr_prev, S0, p):
    B, T, _ = pr.shape
    mixed = pr + (pr_prev - pr) * p['r_mu']
    r, k, v, xw, xa, xg = jnp.split(
        mixed, [R_WIDTH, 2 * R_WIDTH, 3 * R_WIDTH, 3 * R_WIDTH + W_LORA, 3 * R_WIDTH + W_LORA + A_LORA], axis=-1)
    w = (p['r_w0'] + jnp.tanh(xw) @ p['r_w2']).astype(F32)
    log_decay = -jnp.exp(-jax.nn.softplus(-w) - 0.5)
    a = jax.nn.sigmoid(p['r_a0'] + xa @ p['r_a2'])
    g = jax.nn.sigmoid(xg) @ p['r_g2']
    hs = lambda t: t.reshape(B, T, R_HEADS, R_HEAD_DIM)
    kk = hs((k * p['r_kk']).astype(F32))
    kk = kk / jnp.maximum(jnp.sqrt(jnp.sum(kk * kk, axis=-1, keepdims=True)), 1e-12)
    k = k * (1.0 + (a - 1.0) * p['r_ka'])
    r_h, k_h, v_h, a_h = hs(r), hs(k), hs(v), hs(a)
    y, S_new = _rwkv7_recurrence(r_h, hs(log_decay), k_h, v_h, kk, a_h, S0)
    y = _head_norm(y, R_GN_EPS) * p['r_gn_w'].reshape(R_HEADS, R_HEAD_DIM) + p['r_gn_b'].reshape(R_HEADS, R_HEAD_DIM)
    y = y + jnp.sum(r_h * k_h * p['r_rk'], axis=-1, keepdims=True) * v_h
    y = (y.reshape(B, T, R_WIDTH) * g).astype(pr.dtype)
    return y, S_new


def _mlstm_chunked(q, k, v, logi, logf, C0, n0, m0, chunk):
    B, T, H, Dh = q.shape
    nc = T // chunk
    c4 = lambda t: t.astype(F32).reshape(B, nc, chunk, H, Dh).transpose(1, 0, 3, 2, 4)
    c3 = lambda t: t.astype(F32).reshape(B, nc, chunk, H).transpose(1, 0, 3, 2)
    causal = jnp.tril(jnp.ones((chunk, chunk), dtype=bool))

    def step(carry, inp):
        C, n, m = carry
        qb, kb, vb, li, lf = inp
        bcum = jnp.cumsum(lf, axis=-1)
        dmat = bcum[..., :, None] - bcum[..., None, :] + li[..., None, :]
        dmat = jnp.where(causal, dmat, -jnp.inf)
        g = bcum + m[..., None]
        m_t = jnp.maximum(g, jnp.max(dmat, axis=-1))
        w_in = jnp.exp(dmat - m_t[..., None])
        w_st = jnp.exp(g - m_t)
        s = jnp.einsum('bhtd,bhsd->bhts', qb, kb) * w_in
        num = w_st[..., None] * jnp.einsum('bhtd,bhde->bhte', qb, C) + jnp.einsum('bhts,bhse->bhte', s, vb)
        den = w_st * jnp.einsum('bhtd,bhd->bht', qb, n) + jnp.sum(s, axis=-1)
        h = num / jnp.maximum(jnp.abs(den), jnp.exp(-m_t))[..., None]
        b_last = bcum[..., -1]
        lw_end = b_last[..., None] - bcum + li
        g_end = b_last + m
        m_new = jnp.maximum(g_end, jnp.max(lw_end, axis=-1))
        we = jnp.exp(lw_end - m_new[..., None])
        ge = jnp.exp(g_end - m_new)
        C_new = ge[..., None, None] * C + jnp.einsum('bhs,bhsd,bhse->bhde', we, kb, vb)
        n_new = ge[..., None] * n + jnp.einsum('bhs,bhsd->bhd', we, kb)
        return (C_new, n_new, m_new), h

    carry0 = (C0.astype(F32), n0.astype(F32), m0.astype(F32))
    (C, n, m), hs = lax.scan(step, carry0, (c4(q), c4(k), c4(v), c3(logi), c3(logf)))
    h = hs.transpose(1, 0, 3, 2, 4).reshape(B, T, H, Dh)
    return h, C, n, m


def _mlstm_branch(pm, C0, n0, m0, conv0, p):
    B, T, _ = pm.shape
    xm, v, o, ig, fg = jnp.split(pm, [M_WIDTH, 2 * M_WIDTH, 3 * M_WIDTH, 3 * M_WIDTH + M_HEADS], axis=-1)
    xp = jnp.concatenate([conv0.astype(xm.dtype), xm], axis=1)
    xc = p['m_conv_b'] + sum(xp[:, j:j + T] * p['m_conv_w'][j] for j in range(CONV_W))
    xc = jax.nn.silu(xc)
    conv_new = xp[:, xp.shape[1] - (CONV_W - 1):]
    xc_h = xc.reshape(B, T, M_HEADS, M_HEAD_DIM)
    q = jnp.einsum('bthd,hde->bthe', xc_h, p['m_wq']) * (M_HEAD_DIM ** -0.5)
    k = jnp.einsum('bthd,hde->bthe', xc_h, p['m_wk'])
    v_h = v.reshape(B, T, M_HEADS, M_HEAD_DIM)
    logi = (ig + p['m_i_b']).astype(F32)
    logf = jax.nn.log_sigmoid((fg + p['m_f_b']).astype(F32))
    chunk = MLSTM_CHUNK if T % MLSTM_CHUNK == 0 else T
    h, C, n, m = _mlstm_chunked(q, k, v_h, logi, logf, C0, n0, m0, chunk)
    h = (_head_norm(h, M_GN_EPS) * p['m_gn_w'].reshape(M_HEADS, M_HEAD_DIM)
         + p['m_skip'].reshape(M_HEADS, M_HEAD_DIM) * xc_h)
    y = (jax.nn.sigmoid(o) * h.reshape(B, T, M_WIDTH)).astype(pm.dtype)
    return y, C, n, m, conv_new


def _layer(x, st, p):
    shift0, S0, C0, n0, m0, conv0 = st
    dt = x.dtype
    xn = _rmsnorm(x, p['norm_mix_g'])
    proj = xn @ p['w_in']
    pr = proj[..., :R_SHIFT_COLS]
    pm = proj[..., R_SHIFT_COLS:R_SHIFT_COLS + M_COLS]
    pg = proj[..., R_SHIFT_COLS + M_COLS:] + p['gate_b']
    pr_first = shift0.astype(dt) @ p['w_in'][:, :R_SHIFT_COLS]
    pr_prev = jnp.concatenate([pr_first[:, None], pr[:, :-1]], axis=1)
    y_r, S_new = _rwkv7_branch(pr, pr_prev, S0, p)
    y_m, C_new, n_new, m_new, conv_new = _mlstm_branch(pm, C0, n0, m0, conv0, p)
    g_r, g_m = jnp.split(pg, 2, axis=-1)
    merged = jax.nn.sigmoid(g_r) * (y_r @ p['r_up']) + jax.nn.sigmoid(g_m) * (y_m @ p['m_up'])
    x = x + merged @ p['w_out']
    hn = _rmsnorm(x, p['norm_ffn_g'])
    x = x + jnp.square(jax.nn.relu(hn @ p['ffn_w1'])) @ p['ffn_w2']
    new = (xn[:, -1], S_new.astype(dt), C_new.astype(dt), n_new.astype(dt), m_new.astype(dt), conv_new.astype(dt))
    return x, new


def _trunk(x, states, layers, norm_final_g):
    acc = [[] for _ in states]
    for l in range(DEPTH):
        x, new = _layer(x, tuple(s[l] for s in states), layers[l])
        for a_list, s in zip(acc, new):
            a_list.append(s)
    y = _rmsnorm(x, norm_final_g)
    return y, [jnp.stack(a_list) for a_list in acc]


def setup_inputs(seed: int = 0) -> dict:
    key = jax.random.key(seed)
    ks = iter(jax.random.split(key, 64))
    nrm = lambda shape, scale: scale * jax.random.normal(next(ks), shape, F32)
    uni = lambda shape, lo, hi: jax.random.uniform(next(ks), shape, F32, lo, hi)
    L = DEPTH
    d = {}
    d['x_prompt'] = nrm((BATCH, SEQ, D_MODEL), 1.0)
    d['x_sample'] = nrm((DEC_BATCH, DEC_SEQ, D_MODEL), 1.0)
    d['state_rwkv_shift'] = nrm((L, DEC_BATCH, D_MODEL), 1.0)
    d['state_rwkv_wkv'] = nrm((L, DEC_BATCH, R_HEADS, R_HEAD_DIM, R_HEAD_DIM), 0.1)
    d['state_mlstm_C'] = nrm((L, DEC_BATCH, M_HEADS, M_HEAD_DIM, M_HEAD_DIM), 0.1)
    d['state_mlstm_n'] = nrm((L, DEC_BATCH, M_HEADS, M_HEAD_DIM), 0.1)
    d['state_mlstm_m'] = nrm((L, DEC_BATCH, M_HEADS), 1.0)
    d['state_mlstm_conv'] = nrm((L, DEC_BATCH, CONV_W - 1, M_WIDTH), 1.0)
    d['norm_mix_g'] = 1.0 + nrm((L, D_MODEL), 0.02)
    d['w_in'] = nrm((L, D_MODEL, IN_COLS), D_MODEL ** -0.5)
    d['r_mu'] = uni((L, R_SHIFT_COLS), 0.0, 1.0)
    d['r_w0'] = uni((L, R_WIDTH), -6.0, 2.0)
    d['r_w2'] = nrm((L, W_LORA, R_WIDTH), 0.1)
    d['r_a0'] = nrm((L, R_WIDTH), 0.1)
    d['r_a2'] = nrm((L, A_LORA, R_WIDTH), 0.1)
    d['r_g2'] = nrm((L, G_LORA, R_WIDTH), G_LORA ** -0.5)
    d['r_kk'] = 0.85 + nrm((L, R_WIDTH), 0.02)
    d['r_ka'] = 1.0 + nrm((L, R_WIDTH), 0.02)
    d['r_rk'] = nrm((L, R_HEADS, R_HEAD_DIM), 0.1)
    d['r_gn_w'] = 1.0 + nrm((L, R_WIDTH), 0.02)
    d['r_gn_b'] = nrm((L, R_WIDTH), 0.02)
    d['r_up'] = nrm((L, R_WIDTH, D_MODEL), R_WIDTH ** -0.5)
    d['m_conv_w'] = nrm((L, CONV_W, M_WIDTH), CONV_W ** -0.5)
    d['m_conv_b'] = nrm((L, M_WIDTH), 0.02)
    d['m_wq'] = nrm((L, M_HEADS, M_HEAD_DIM, M_HEAD_DIM), M_HEAD_DIM ** -0.5)
    d['m_wk'] = nrm((L, M_HEADS, M_HEAD_DIM, M_HEAD_DIM), M_HEAD_DIM ** -0.5)
    d['m_i_b'] = nrm((L, M_HEADS), 0.1)
    d['m_f_b'] = jnp.linspace(3.0, 6.0, M_HEADS, dtype=F32)[None, :] + nrm((L, M_HEADS), 0.1)
    d['m_gn_w'] = 1.0 + nrm((L, M_WIDTH), 0.02)
    d['m_skip'] = 1.0 + nrm((L, M_WIDTH), 0.02)
    d['m_up'] = nrm((L, M_WIDTH, D_MODEL), M_WIDTH ** -0.5)
    d['gate_b'] = nrm((L, GATE_COLS), 0.02)
    d['w_out'] = nrm((L, D_MODEL, D_MODEL), D_MODEL ** -0.5)
    d['norm_ffn_g'] = 1.0 + nrm((L, D_MODEL), 0.02)
    d['ffn_w1'] = nrm((L, D_MODEL, D_FF), D_MODEL ** -0.5)
    d['ffn_w2'] = nrm((L, D_FF, D_MODEL), D_FF ** -0.5)
    d['norm_final_g'] = 1.0 + nrm((D_MODEL,), 0.02)
    return d


def reference(x_prompt, x_sample, state_rwkv_shift, state_rwkv_wkv, state_mlstm_C, state_mlstm_n,
              state_mlstm_m, state_mlstm_conv, norm_mix_g, w_in, r_mu, r_w0, r_w2, r_a0, r_a2, r_g2,
              r_kk, r_ka, r_rk, r_gn_w, r_gn_b, r_up, m_conv_w, m_conv_b, m_wq, m_wk, m_i_b, m_f_b,
              m_gn_w, m_skip, m_up, gate_b, w_out, norm_ffn_g, ffn_w1, ffn_w2, norm_final_g):
    layers = [dict(norm_mix_g=norm_mix_g[l], w_in=w_in[l], r_mu=r_mu[l], r_w0=r_w0[l], r_w2=r_w2[l],
                   r_a0=r_a0[l], r_a2=r_a2[l], r_g2=r_g2[l], r_kk=r_kk[l], r_ka=r_ka[l], r_rk=r_rk[l],
                   r_gn_w=r_gn_w[l], r_gn_b=r_gn_b[l], r_up=r_up[l], m_conv_w=m_conv_w[l],
                   m_conv_b=m_conv_b[l], m_wq=m_wq[l], m_wk=m_wk[l], m_i_b=m_i_b[l], m_f_b=m_f_b[l],
                   m_gn_w=m_gn_w[l], m_skip=m_skip[l], m_up=m_up[l], gate_b=gate_b[l], w_out=w_out[l],
                   norm_ffn_g=norm_ffn_g[l], ffn_w1=ffn_w1[l], ffn_w2=ffn_w2[l])
              for l in range(DEPTH)]
    dt = x_prompt.dtype
    bp = x_prompt.shape[0]
    zero_states = (jnp.zeros((DEPTH, bp, D_MODEL), dt),
                   jnp.zeros((DEPTH, bp, R_HEADS, R_HEAD_DIM, R_HEAD_DIM), dt),
                   jnp.zeros((DEPTH, bp, M_HEADS, M_HEAD_DIM, M_HEAD_DIM), dt),
                   jnp.zeros((DEPTH, bp, M_HEADS, M_HEAD_DIM), dt),
                   jnp.zeros((DEPTH, bp, M_HEADS), dt),
                   jnp.zeros((DEPTH, bp, CONV_W - 1, M_WIDTH), dt))
    y_prompt, p_st = _trunk(x_prompt, zero_states, layers, norm_final_g)
    sample_states = (state_rwkv_shift, state_rwkv_wkv, state_mlstm_C, state_mlstm_n, state_mlstm_m, state_mlstm_conv)
    y_sample, s_st = _trunk(x_sample, sample_states, layers, norm_final_g)
    return (y_prompt, y_sample, p_st[0], p_st[1], p_st[2], p_st[3], p_st[4], p_st[5],
            s_st[0], s_st[1], s_st[2], s_st[3], s_st[4], s_st[5])
```

```cpp
#include <hip/hip_runtime.h>
#include <cstdio>
#include <cstdint>

constexpr int DM = 1024, MP = 16384, MS = 128, MTOK = MP + MS, MT = 16640;
constexpr int SEQ = 2048, NB = 8;
constexpr int NPR = 1792, NPM = 1536, NPG = 2048, NPROJ = NPR + NPM + NPG, INCOLS = 5384, GCOL0 = 3328;
constexpr int RH = 8, RN = 64, RW = 512, MH = 4, MD = 128, MW = 512, FF = 4096;
constexpr float RMS_EPS = 1e-6f, R_GN_EPS = 64e-5f, M_GN_EPS = 1e-5f;

constexpr size_t O_Y = 0;
constexpr size_t O_PSHIFT = (size_t)MTOK * DM;
constexpr size_t O_PWKV = O_PSHIFT + (size_t)NB * DM;
constexpr size_t O_PC = O_PWKV + (size_t)NB * RH * RN * RN;
constexpr size_t O_PN = O_PC + (size_t)NB * MH * MD * MD;
constexpr size_t O_PMM = O_PN + (size_t)NB * MH * MD;
constexpr size_t O_PCONV = O_PMM + (size_t)NB * MH;
constexpr size_t O_SSHIFT = O_PCONV + (size_t)NB * 3 * MW;
constexpr size_t O_SWKV = O_SSHIFT + (size_t)MS * DM;
constexpr size_t O_SC = O_SWKV + (size_t)MS * RH * RN * RN;
constexpr size_t O_SN = O_SC + (size_t)MS * MH * MD * MD;
constexpr size_t O_SMM = O_SN + (size_t)MS * MH * MD;
constexpr size_t O_SCONV = O_SMM + (size_t)MS * MH;
constexpr size_t O_END = O_SCONV + (size_t)MS * 3 * MW;
static_assert(O_END == 30695968, "output size");

constexpr size_t MiB = 1u << 20;
constexpr size_t WS_CTL = 0;
constexpr size_t WS_SSQ1 = 0, WS_SSQ2 = 128 * 1024;
constexpr size_t WS_WINT = 1 * MiB, WS_UPRT = 12 * MiB, WS_UPMT = 13 * MiB, WS_WOUTT = 14 * MiB, WS_W1T = 16 * MiB, WS_W2T = 24 * MiB;
constexpr size_t WS_GATES = 32 * MiB;
constexpr size_t WS_XN = 33 * MiB;
constexpr size_t WS_YM = 33 * MiB, WS_X2B = 33 * MiB;
constexpr size_t WS_PR = 66 * MiB;
constexpr size_t WS_PM = 123 * MiB;
constexpr size_t WS_PG = 172 * MiB;
constexpr size_t WS_YR = 237 * MiB;
constexpr size_t WS_MERGED = 66 * MiB;
constexpr size_t WS_UPSCR = 100 * MiB;
constexpr size_t WS_H = 66 * MiB;
constexpr size_t WS_NEED = 256 * MiB;
static_assert(WS_YR + (size_t)MT * 512 * 2 <= WS_NEED && WS_H + (size_t)MT * FF * 2 <= WS_NEED && WS_PG + (size_t)MT * NPG * 2 <= WS_YR && WS_UPSCR + (size_t)MT * DM * 4 <= WS_PG, "ws map");

#define GAS __attribute__((address_space(1)))
#define LAS __attribute__((address_space(3)))
typedef unsigned short bf16;
typedef unsigned v4u __attribute__((ext_vector_type(4)));
typedef unsigned v2u __attribute__((ext_vector_type(2)));
typedef float f32x4 __attribute__((ext_vector_type(4)));
typedef float f32x2 __attribute__((ext_vector_type(2)));
__device__ __forceinline__ unsigned f2bf(float f) { unsigned u = __builtin_bit_cast(unsigned, f); return (u + 0x7fffu + ((u >> 16) & 1u)) >> 16; }
__device__ __forceinline__ unsigned pk2(float lo, float hi) { return f2bf(lo) | (f2bf(hi) << 16); }
__device__ __forceinline__ float bf2f(unsigned b) { return __builtin_bit_cast(float, b << 16); }
__device__ __forceinline__ float bflo(unsigned w) { return __builtin_bit_cast(float, w << 16); }
__device__ __forceinline__ float bfhi(unsigned w) { return __builtin_bit_cast(float, w & 0xffff0000u); }
__device__ __forceinline__ float sigmoidf_(float x) { return 1.0f / (1.0f + __expf(-x)); }
__device__ __forceinline__ float wave_sum(float v) {
#pragma unroll
    for (int o = 1; o < 64; o <<= 1) v += __shfl_xor(v, o);
    return v;
}

namespace pg8 {
#define PG8_LAS __attribute__((address_space(3)))
typedef unsigned short bf16_t;
typedef short bf16x8 __attribute__((ext_vector_type(8)));
typedef float f32x4 __attribute__((ext_vector_type(4)));
typedef unsigned u32x4 __attribute__((ext_vector_type(4)));
constexpr int BM = 256, BK = 64, HALF = 128, HTB = HALF * BK * 2  , STAGE_BYTES = 8 * HTB, NXCD = 8, WGM = 8;

__host__ __device__ __forceinline__ int lds_byte(int r, int c) { const int st = (r >> 4) * 2 + (c >> 5), rr = r & 15, cc = c & 31, ob = rr * 64 + cc * 2; return st * 1024 + (ob ^ (((ob >> 9) & 1) << 5)); }
__host__ __device__ __forceinline__ void stage_rc(int b, int& R, int& C) { const int st = b / 1024, sb = b % 1024, swz = sb ^ (((sb >> 9) & 1) << 5); R = (st >> 1) * 16 + swz / 64; C = (st & 1) * 32 + (swz % 64) / 2; }
__host__ __device__ __forceinline__ int perm32(int rho) { const int n = rho >> 4, i = rho & 15; return 8 * (i >> 2) + 4 * n + (i & 3); }

struct Unit { int pm, pn; };
struct Gemm { const bf16_t* A; const bf16_t* Bt; int M, N, K; };

struct StaticOrder {
    int nM, nN, nwg, G, c;
    __host__ __device__ void init(int M, int N, int G_, int c_) { nM = M / BM; nN = N / BM; nwg = nM * nN; G = G_; c = c_; }
    __host__ __device__ bool next(int i, Unit& u) const {
        const long L = (long)i * G + c; if (L >= nwg) return false;
        int wgid = (int)L; { const int q = nwg / NXCD, r = nwg % NXCD, xcd = wgid % NXCD, off = wgid / NXCD; wgid = (xcd < r ? xcd * (q + 1) : r * (q + 1) + (xcd - r) * q) + off; }
        const int nig = WGM * nN, gid = wgid / nig, fm = gid * WGM, gsz = (nM - fm) < WGM ? (nM - fm) : WGM;
        u.pm = fm + ((wgid % nig) % gsz); u.pn = (wgid % nig) / gsz; return true;
    }
    __device__ __forceinline__ void a_ready(const Unit&) const {}
    __device__ __forceinline__ void done(const Unit&) const {}
};

__device__ __forceinline__ unsigned cvt_pk_bf16(float lo, float hi) { unsigned r; asm volatile("v_cvt_pk_bf16_f32 %0, %1, %2" : "=v"(r) : "v"(lo), "v"(hi)); return r; }
typedef unsigned u32x2 __attribute__((ext_vector_type(2)));
__device__ __forceinline__ float sigm(float x) { return 1.0f / (1.0f + __expf(-x)); }
__device__ __forceinline__ float bf_lo(unsigned w) { return __builtin_bit_cast(float, w << 16); }
__device__ __forceinline__ float bf_hi(unsigned w) { return __builtin_bit_cast(float, w & 0xffff0000u); }

struct EpiProj {
    static constexpr bool PERM = true, AFTER_DRAIN = false;
    bf16_t *PR, *PM, *PG; const float* gate_b;
    __device__ __forceinline__ void operator()(const f32x4 (&acc)[2][2][4][2], const Unit& u, int wr, int wc, int fr, int fq) const {
        int colt = u.pn * BM; bf16_t* base; int ldc; bool gate = false;
        if (colt < 1792) { base = PR; ldc = 1792; } else if (colt < 3328) { base = PM; ldc = 1536; colt -= 1792; } else { base = PG; ldc = 2048; colt -= 3328; gate = true; }
        const int row0 = u.pm * BM + wr * 64 + fr, col0 = colt + wc * 32 + 8 * fq;
        f32x4 bv[2][2];
#pragma unroll
        for (int bj = 0; bj < 2; ++bj)
#pragma unroll
            for (int n = 0; n < 2; ++n) bv[bj][n] = gate ? *(const f32x4*)(gate_b + col0 + bj * HALF + 4 * n) : (f32x4){0.f, 0.f, 0.f, 0.f};
#pragma unroll
        for (int ai = 0; ai < 2; ++ai)
#pragma unroll
            for (int m = 0; m < 4; ++m) { bf16_t* rowp = base + (size_t)(row0 + ai * HALF + m * 16) * ldc + col0;
#pragma unroll
                for (int bj = 0; bj < 2; ++bj) { f32x4 v0 = acc[ai][bj][m][0] + bv[bj][0], v1 = acc[ai][bj][m][1] + bv[bj][1];
                    if (gate) {
#pragma unroll
                        for (int j = 0; j < 4; ++j) { v0[j] = sigm(v0[j]); v1[j] = sigm(v1[j]); } }
                    u32x4 w; w.x = cvt_pk_bf16(v0[0], v0[1]); w.y = cvt_pk_bf16(v0[2], v0[3]); w.z = cvt_pk_bf16(v1[0], v1[1]); w.w = cvt_pk_bf16(v1[2], v1[3]);
                    *(u32x4*)(rowp + bj * HALF) = w; } }
    }
};
struct EpiUp1 {
    static constexpr bool PERM = false, AFTER_DRAIN = false;
    float* SCR; const bf16_t* PG;
    __device__ __forceinline__ void operator()(const f32x4 (&acc)[2][2][4][2], const Unit& u, int wr, int wc, int fr, int fq) const {
        const int row0 = u.pm * BM + wr * 64 + fr, col0 = u.pn * BM + wc * 32 + 4 * fq;
#pragma unroll
        for (int ai = 0; ai < 2; ++ai)
#pragma unroll
            for (int m = 0; m < 4; ++m) { const size_t row = (size_t)(row0 + ai * HALF + m * 16);
#pragma unroll
                for (int bj = 0; bj < 2; ++bj)
#pragma unroll
                    for (int n = 0; n < 2; ++n) { const int c = col0 + bj * HALF + n * 16; const u32x2 g = *(const u32x2*)(PG + row * 2048 + c);
                        f32x4 v = acc[ai][bj][m][n]; v[0] *= bf_lo(g.x); v[1] *= bf_hi(g.x); v[2] *= bf_lo(g.y); v[3] *= bf_hi(g.y);
                        *(f32x4*)(SCR + row * 1024 + c) = v; } }
    }
};
struct EpiUp2 {
    static constexpr bool PERM = false, AFTER_DRAIN = false;
    const float* SCR; const bf16_t* PG; bf16_t* MG;
    __device__ __forceinline__ void operator()(const f32x4 (&acc)[2][2][4][2], const Unit& u, int wr, int wc, int fr, int fq) const {
        const int row0 = u.pm * BM + wr * 64 + fr, col0 = u.pn * BM + wc * 32 + 4 * fq;
#pragma unroll
        for (int ai = 0; ai < 2; ++ai)
#pragma unroll
            for (int m = 0; m < 4; ++m) { const size_t row = (size_t)(row0 + ai * HALF + m * 16);
#pragma unroll
                for (int bj = 0; bj < 2; ++bj)
#pragma unroll
                    for (int n = 0; n < 2; ++n) { const int c = col0 + bj * HALF + n * 16; const u32x2 g = *(const u32x2*)(PG + row * 2048 + 1024 + c);
                        const f32x4 s = *(const f32x4*)(SCR + row * 1024 + c); f32x4 v = acc[ai][bj][m][n];
                        v[0] = s[0] + v[0] * bf_lo(g.x); v[1] = s[1] + v[1] * bf_hi(g.x); v[2] = s[2] + v[2] * bf_lo(g.y); v[3] = s[3] + v[3] * bf_hi(g.y);
                        u32x2 w; w.x = cvt_pk_bf16(v[0], v[1]); w.y = cvt_pk_bf16(v[2], v[3]); *(u32x2*)(MG + row * 1024 + c) = w; } }
    }
};
struct EpiOut {
    static constexpr bool PERM = false, AFTER_DRAIN = false;
    const float *xp, *xs; float* OUT; bf16_t* X2B; const float* gffn; float* ssq;
    __device__ __forceinline__ void operator()(const f32x4 (&acc)[2][2][4][2], const Unit& u, int wr, int wc, int fr, int fq) const {
        const int row0 = u.pm * BM + wr * 64 + fr, col0 = u.pn * BM + wc * 32 + 4 * fq;
        f32x4 gv[2][2];
#pragma unroll
        for (int bj = 0; bj < 2; ++bj)
#pragma unroll
            for (int n = 0; n < 2; ++n) gv[bj][n] = *(const f32x4*)(gffn + col0 + bj * HALF + n * 16);
#pragma unroll
        for (int ai = 0; ai < 2; ++ai) {
            if (u.pm * BM + ai * HALF >= 16512) continue;
#pragma unroll
            for (int m = 0; m < 4; ++m) { const int row = row0 + ai * HALF + m * 16;
                const float* xin = row < 16384 ? xp + (size_t)row * 1024 : xs + (size_t)(row - 16384) * 1024; float sq = 0.f;
#pragma unroll
                for (int bj = 0; bj < 2; ++bj)
#pragma unroll
                    for (int n = 0; n < 2; ++n) { const int c = col0 + bj * HALF + n * 16; const f32x4 v = *(const f32x4*)(xin + c) + acc[ai][bj][m][n];
                        *(f32x4*)(OUT + (size_t)row * 1024 + c) = v; sq += (v[0] * v[0] + v[1] * v[1]) + (v[2] * v[2] + v[3] * v[3]);
                        const f32x4 h = v * gv[bj][n]; u32x2 w; w.x = cvt_pk_bf16(h[0], h[1]); w.y = cvt_pk_bf16(h[2], h[3]); *(u32x2*)(X2B + (size_t)row * 1024 + c) = w; }
                sq += __shfl_xor(sq, 16); sq += __shfl_xor(sq, 32);
                if (fq == 0) atomicAdd(ssq + row, sq); }
        }
    }
};
struct EpiFfn1 {
    static constexpr bool PERM = true, AFTER_DRAIN = false;
    bf16_t* H; const float* ssq;
    __device__ __forceinline__ void operator()(const f32x4 (&acc)[2][2][4][2], const Unit& u, int wr, int wc, int fr, int fq) const {
        const int row0 = u.pm * BM + wr * 64 + fr, col0 = u.pn * BM + wc * 32 + 8 * fq;
#pragma unroll
        for (int ai = 0; ai < 2; ++ai)
#pragma unroll
            for (int m = 0; m < 4; ++m) { const int row = row0 + ai * HALF + m * 16; const float rs = rsqrtf(ssq[row] * (1.0f / 1024.0f) + 1e-6f);
                bf16_t* rowp = H + (size_t)row * 4096 + col0;
#pragma unroll
                for (int bj = 0; bj < 2; ++bj) { f32x4 v0 = acc[ai][bj][m][0] * rs, v1 = acc[ai][bj][m][1] * rs;
#pragma unroll
                    for (int j = 0; j < 4; ++j) { const float a = fmaxf(v0[j], 0.f), b = fmaxf(v1[j], 0.f); v0[j] = a * a; v1[j] = b * b; }
                    u32x4 w; w.x = cvt_pk_bf16(v0[0], v0[1]); w.y = cvt_pk_bf16(v0[2], v0[3]); w.z = cvt_pk_bf16(v1[0], v1[1]); w.w = cvt_pk_bf16(v1[2], v1[3]);
                    *(u32x4*)(rowp + bj * HALF) = w; } }
    }
};
struct EpiFfn2 {
    static constexpr bool PERM = false, AFTER_DRAIN = false;
    float* OUT; float* ssq;
    __device__ __forceinline__ void operator()(const f32x4 (&acc)[2][2][4][2], const Unit& u, int wr, int wc, int fr, int fq) const {
        const int row0 = u.pm * BM + wr * 64 + fr, col0 = u.pn * BM + wc * 32 + 4 * fq;
#pragma unroll
        for (int ai = 0; ai < 2; ++ai) {
            if (u.pm * BM + ai * HALF >= 16512) continue;
#pragma unroll
            for (int m = 0; m < 4; ++m) { const int row = row0 + ai * HALF + m * 16; float sq = 0.f;
#pragma unroll
                for (int bj = 0; bj < 2; ++bj)
#pragma unroll
                    for (int n = 0; n < 2; ++n) { float* p = OUT + (size_t)row * 1024 + col0 + bj * HALF + n * 16; const f32x4 v = *(const f32x4*)p + acc[ai][bj][m][n];
                        *(f32x4*)p = v; sq += (v[0] * v[0] + v[1] * v[1]) + (v[2] * v[2] + v[3] * v[3]); }
                sq += __shfl_xor(sq, 16); sq += __shfl_xor(sq, 32);
                if (fq == 0) atomicAdd(ssq + row, sq); }
        }
    }
};

template <class Epi, class Sched, bool ALIGN_EPI = false, bool SP2 = false>
__device__ __forceinline__ void gemm_phase(PG8_LAS unsigned char* lds, const Gemm g, const Sched& S, const Epi& E) {
    const int tid = threadIdx.x, wid = __builtin_amdgcn_readfirstlane(tid >> 6), lane = tid & 63, wr = wid >> 2, wc = wid & 3, fr = lane & 15, fq = lane >> 4;
    const int K = g.K, nt = K / BK;
    unsigned voffA[2], voffB[2];
#pragma unroll
    for (int i = 0; i < 2; ++i) { int R, C; stage_rc(tid * 16 + i * 8192, R, C); const int Rb = Epi::PERM ? ((R & ~31) + perm32(R & 31)) : R;
        voffA[i] = (unsigned)(R * K + C) * 2u; voffB[i] = (unsigned)(Rb * K + C) * 2u; }
    const size_t kstep = (size_t)(BK * 2);
    const size_t hstep = (size_t)HALF * K * 2;
    const size_t tstep = 2 * hstep;
    const unsigned ldsw = (unsigned)wid * 1024u;
    const int aoff = lds_byte(wr * 64 + fr, fq * 8), boff = lds_byte(wc * 32 + fr, fq * 8);
#define PG8_SA(b, h) (((b) * 2 + (h)) * HTB)
#define PG8_SB(b, h) ((4 + (b) * 2 + (h)) * HTB)
#define PG8_STAGE(bufoff, gbase, voff) do { _Pragma("unroll") for (int _i = 0; _i < 2; ++_i) \
        __builtin_amdgcn_global_load_lds((const unsigned*)((const char*)(gbase) + (voff)[_i]), (PG8_LAS unsigned*)(lds + (bufoff) + ldsw + _i * 8192), 16, 0, 0); } while (0)
#define PG8_LDA(dst, b, h) do { _Pragma("unroll") for (int m = 0; m < 4; ++m) _Pragma("unroll") for (int k = 0; k < 2; ++k) dst[m][k] = *(const PG8_LAS bf16x8*)(lds + PG8_SA(b, h) + aoff + m * 2048 + k * 1024); } while (0)
#define PG8_LDB(dst, b, h) do { _Pragma("unroll") for (int n = 0; n < 2; ++n) _Pragma("unroll") for (int k = 0; k < 2; ++k) dst[n][k] = *(const PG8_LAS bf16x8*)(lds + PG8_SB(b, h) + boff + n * 2048 + k * 1024); } while (0)
#define PG8_MMA(ai, bj, At, Bt) do { __builtin_amdgcn_s_setprio(1); _Pragma("unroll") for (int m = 0; m < 4; ++m) _Pragma("unroll") for (int n = 0; n < 2; ++n) _Pragma("unroll") for (int k = 0; k < 2; ++k) \
        acc[ai][bj][m][n] = __builtin_amdgcn_mfma_f32_16x16x32_bf16(Bt[n][k], At[m][k], acc[ai][bj][m][n], 0, 0, 0); __builtin_amdgcn_s_setprio(0); } while (0)
#define PG8_WAIT_V(n) asm volatile("s_waitcnt vmcnt(" #n ")" ::: "memory")
#define PG8_WAIT_L(n) asm volatile("s_waitcnt lgkmcnt(" #n ")" ::: "memory")
#define PG8_BAR __builtin_amdgcn_s_barrier()
#define PG8_SCHED __builtin_amdgcn_sched_barrier(0)
    Unit cur, nxt; int ui = 0;
    if (!S.next(0, cur)) return;
    f32x4 acc[2][2][4][2];
#pragma unroll
    for (int a = 0; a < 2; ++a)
#pragma unroll
        for (int b = 0; b < 2; ++b)
#pragma unroll
            for (int m = 0; m < 4; ++m)
#pragma unroll
                for (int n = 0; n < 2; ++n) acc[a][b][m][n] = (f32x4){0.f, 0.f, 0.f, 0.f};
    bf16x8 At[4][2], B0[2][2], B1[2][2];
    const char* cA = (const char*)g.A + (size_t)cur.pm * tstep; const char* cB = (const char*)g.Bt + (size_t)cur.pn * tstep;
    S.a_ready(cur);
    if constexpr (SP2) {
        PG8_STAGE(PG8_SB(0, 0), cB, voffB); PG8_STAGE(PG8_SB(0, 1), cB + hstep, voffB); PG8_STAGE(PG8_SA(0, 0), cA, voffA); PG8_STAGE(PG8_SA(0, 1), cA + hstep, voffA);
        if (wr == 1) PG8_BAR;
        PG8_WAIT_V(2); PG8_BAR;
        PG8_STAGE(PG8_SB(1, 0), cB + kstep, voffB); PG8_STAGE(PG8_SA(1, 0), cA + kstep, voffA); PG8_STAGE(PG8_SB(1, 1), cB + hstep + kstep, voffB);
        PG8_WAIT_V(6); PG8_BAR;
    } else {
        PG8_STAGE(PG8_SB(0, 0), cB, voffB); PG8_STAGE(PG8_SA(0, 0), cA, voffA); PG8_STAGE(PG8_SB(0, 1), cB + hstep, voffB); PG8_STAGE(PG8_SA(0, 1), cA + hstep, voffA);
        if (wr == 1) PG8_BAR;
        PG8_WAIT_V(4); PG8_BAR;
        PG8_STAGE(PG8_SB(1, 0), cB + kstep, voffB); PG8_STAGE(PG8_SA(1, 0), cA + kstep, voffA); PG8_STAGE(PG8_SB(1, 1), cB + hstep + kstep, voffB);
        PG8_WAIT_V(6); PG8_BAR;
    }
    for (;;) {
        const bool has_next = S.next(ui + 1, nxt);
        const char* nA = has_next ? (const char*)g.A + (size_t)nxt.pm * tstep : cA; const char* nB = has_next ? (const char*)g.Bt + (size_t)nxt.pn * tstep : cB;
        for (int t = 0; t < nt; t += 2) {
            const bool last = (t == nt - 2);
            const char* a1 = cA + (size_t)(t + 1) * kstep;
            const char* a2 = last ? nA : cA + (size_t)(t + 2) * kstep; const char* b2 = last ? nB : cB + (size_t)(t + 2) * kstep;
            const char* a3 = a2 + kstep; const char* b3 = b2 + kstep;
            if (last && has_next) S.a_ready(nxt);
            if constexpr (SP2) {
            PG8_LDB(B0, 0, 0); PG8_LDB(B1, 0, 1); PG8_SCHED; PG8_LDA(At, 0, 0); PG8_STAGE(PG8_SA(1, 1), a1 + hstep, voffA);
            PG8_WAIT_V(8); PG8_WAIT_L(0); PG8_BAR; PG8_MMA(0, 0, At, B0); PG8_MMA(0, 1, At, B1); PG8_BAR; PG8_SCHED;
            PG8_LDA(At, 0, 1); PG8_STAGE(PG8_SB(0, 0), b2, voffB); PG8_STAGE(PG8_SB(0, 1), b2 + hstep, voffB); PG8_STAGE(PG8_SA(0, 0), a2, voffA);
            PG8_WAIT_V(8); PG8_WAIT_L(0); PG8_BAR; PG8_MMA(1, 0, At, B0); PG8_MMA(1, 1, At, B1); PG8_BAR; PG8_SCHED;
            PG8_LDB(B0, 1, 0); PG8_LDB(B1, 1, 1); PG8_SCHED; PG8_LDA(At, 1, 0); PG8_STAGE(PG8_SA(0, 1), a2 + hstep, voffA);
            PG8_WAIT_V(8); PG8_WAIT_L(0); PG8_BAR; PG8_MMA(0, 0, At, B0); PG8_MMA(0, 1, At, B1); PG8_BAR; PG8_SCHED;
            PG8_LDA(At, 1, 1); PG8_STAGE(PG8_SB(1, 0), b3, voffB); PG8_STAGE(PG8_SB(1, 1), b3 + hstep, voffB); PG8_STAGE(PG8_SA(1, 0), a3, voffA);
            PG8_WAIT_V(8); PG8_WAIT_L(0); PG8_BAR; PG8_MMA(1, 0, At, B0); PG8_MMA(1, 1, At, B1); PG8_BAR; PG8_SCHED;
            } else {
            PG8_LDB(B0, 0, 0); PG8_SCHED; PG8_LDA(At, 0, 0); PG8_STAGE(PG8_SA(1, 1), a1 + hstep, voffA);
            PG8_WAIT_L(8); PG8_BAR; PG8_WAIT_L(0); PG8_MMA(0, 0, At, B0); PG8_BAR; PG8_SCHED;
            PG8_LDB(B1, 0, 1); PG8_STAGE(PG8_SB(0, 0), b2, voffB);
            PG8_BAR; PG8_WAIT_L(0); PG8_MMA(0, 1, At, B1); PG8_BAR;
            PG8_LDA(At, 0, 1); PG8_STAGE(PG8_SA(0, 0), a2, voffA);
            PG8_BAR; PG8_WAIT_L(0); PG8_MMA(1, 0, At, B0); PG8_BAR; PG8_SCHED;
            PG8_STAGE(PG8_SB(0, 1), b2 + hstep, voffB);
            PG8_WAIT_V(6); PG8_BAR; PG8_MMA(1, 1, At, B1); PG8_BAR;
            PG8_LDB(B0, 1, 0); PG8_SCHED; PG8_LDA(At, 1, 0); PG8_STAGE(PG8_SA(0, 1), a2 + hstep, voffA);
            PG8_WAIT_L(8); PG8_BAR; PG8_WAIT_L(0); PG8_MMA(0, 0, At, B0); PG8_BAR; PG8_SCHED;
            PG8_LDB(B1, 1, 1); PG8_STAGE(PG8_SB(1, 0), b3, voffB);
            PG8_BAR; PG8_WAIT_L(0); PG8_MMA(0, 1, At, B1); PG8_BAR;
            PG8_LDA(At, 1, 1); PG8_STAGE(PG8_SA(1, 0), a3, voffA);
            PG8_BAR; PG8_WAIT_L(0); PG8_MMA(1, 0, At, B0); PG8_BAR; PG8_SCHED;
            PG8_STAGE(PG8_SB(1, 1), b3 + hstep, voffB);
            PG8_WAIT_V(6); PG8_BAR; PG8_MMA(1, 1, At, B1); PG8_BAR;
            }
        }
        if constexpr (ALIGN_EPI) { if (wr == 0) PG8_BAR; }
        if constexpr (!Epi::AFTER_DRAIN) { E(acc, cur, wr, wc, fr, fq); S.done(cur); }
        if (!has_next) break;
#pragma unroll
        for (int a = 0; a < 2; ++a)
#pragma unroll
            for (int b = 0; b < 2; ++b)
#pragma unroll
                for (int m = 0; m < 4; ++m)
#pragma unroll
                    for (int n = 0; n < 2; ++n) acc[a][b][m][n] = (f32x4){0.f, 0.f, 0.f, 0.f};
        cur = nxt; cA = nA; cB = nB; ++ui;
        if constexpr (ALIGN_EPI) { if (wr == 1) PG8_BAR; }
    }
    PG8_WAIT_V(0);
    if constexpr (!ALIGN_EPI) { if (wr == 0) PG8_BAR; }
    PG8_BAR;
    if constexpr (Epi::AFTER_DRAIN) { E.fused(acc, cur, wr, wc, fr, fq, lds, wid, lane); S.done(cur); }
#undef PG8_SA
#undef PG8_SB
#undef PG8_STAGE
#undef PG8_LDA
#undef PG8_LDB
#undef PG8_MMA
#undef PG8_WAIT_V
#undef PG8_WAIT_L
#undef PG8_BAR
#undef PG8_SCHED
}
}

struct Args {
    const float* in[37];
    float* out; unsigned char* ws;
};
constexpr int NWAVES = 8, NTHR = 512;
constexpr int GEMM_LDS = 131072;

#define LDS_WAIT() asm volatile("s_waitcnt lgkmcnt(0)" ::: "memory")

__device__ __forceinline__ void transpose_item(const float* W, int ldw, int nblk, bf16* WT, int ldt, int item, LAS float* scr, int lane) {
    const int kb = item / nblk, nb = item % nblk, k0 = 64 * kb, n0 = 32 * nb;
#pragma unroll 8
    for (int i = 0; i < 32; ++i) { const int kk = 2 * i + (lane >> 5); scr[kk * 33 + (lane & 31)] = W[(size_t)(k0 + kk) * ldw + n0 + (lane & 31)]; }
    LDS_WAIT(); asm volatile("" ::: "memory");
    const int c = lane & 7;
#pragma unroll
    for (int j = 0; j < 4; ++j) { const int n = (lane >> 3) + 8 * j; const LAS float* s = scr + (8 * c) * 33 + n;
        v4u o; o.x = pk2(s[0 * 33], s[1 * 33]); o.y = pk2(s[2 * 33], s[3 * 33]); o.z = pk2(s[4 * 33], s[5 * 33]); o.w = pk2(s[6 * 33], s[7 * 33]);
        *(v4u*)(WT + (size_t)(n0 + n) * ldt + k0 + 8 * c) = o; }
    LDS_WAIT(); asm volatile("" ::: "memory");
}

constexpr int P0_LDS = 8 * 64 * 33 * 4 + 8 * 1024 * 4;
__device__ __forceinline__ void p0_prologue(const Args& a, LAS unsigned char* lds, int gw, int NGW, int lane, int wave) {
    unsigned char* ws = a.ws;
    LAS float* scr = (LAS float*)(lds) + wave * (64 * 33);
    LAS float* wg = (LAS float*)(lds + 8 * 64 * 33 * 4);
    const float* w_in = a.in[9];
    for (int i = threadIdx.x; i < 8 * 1024; i += NTHR) { const int k = i >> 3, c = i & 7; wg[c * 1024 + k] = w_in[(size_t)k * INCOLS + GCOL0 + c]; }
    { float* z = (float*)(ws + WS_CTL); for (int i = gw * 64 + lane; i < 65536; i += NGW * 64) z[i] = 0.f; }
    constexpr int I_IN1 = 16 * (3328 / 32), I_IN2 = 16 * (2048 / 32), I_UP = 8 * 32, I_OUT = 16 * 32, I_F1 = 16 * 128, I_F2 = 64 * 32;
    constexpr int NITEMS = I_IN1 + I_IN2 + 2 * I_UP + I_OUT + I_F1 + I_F2;
    for (int it = gw; it < NITEMS; it += NGW) {
        int r = it;
        if (r < I_IN1) { transpose_item(w_in, INCOLS, 3328 / 32, (bf16*)(ws + WS_WINT), 1024, r, scr, lane); continue; } r -= I_IN1;
        if (r < I_IN2) { transpose_item(w_in + 3336, INCOLS, 2048 / 32, (bf16*)(ws + WS_WINT) + (size_t)3328 * 1024, 1024, r, scr, lane); continue; } r -= I_IN2;
        if (r < I_UP) { transpose_item(a.in[21], 1024, 32, (bf16*)(ws + WS_UPRT), 512, r, scr, lane); continue; } r -= I_UP;
        if (r < I_UP) { transpose_item(a.in[30], 1024, 32, (bf16*)(ws + WS_UPMT), 512, r, scr, lane); continue; } r -= I_UP;
        if (r < I_OUT) { transpose_item(a.in[32], 1024, 32, (bf16*)(ws + WS_WOUTT), 1024, r, scr, lane); continue; } r -= I_OUT;
        if (r < I_F1) { transpose_item(a.in[34], 4096, 128, (bf16*)(ws + WS_W1T), 1024, r, scr, lane); continue; } r -= I_F1;
        transpose_item(a.in[35], 1024, 32, (bf16*)(ws + WS_W2T), 4096, r, scr, lane);
    }
    __syncthreads();
    const float* gmix = a.in[8];
    f32x4 gv[4];
#pragma unroll
    for (int j = 0; j < 4; ++j) gv[j] = ((const f32x4*)gmix)[lane + 64 * j];
    bf16* XN = (bf16*)(ws + WS_XN); float* GATES = (float*)(ws + WS_GATES);
    for (int row = gw; row < MT; row += NGW) {
        unsigned long long* o8 = (unsigned long long*)(XN + (size_t)row * 1024) + lane;
        if (row >= MTOK) {
            const f32x4* xr = (const f32x4*)(a.in[2] + (size_t)(row - MTOK) * 1024) + lane;
#pragma unroll
            for (int j = 0; j < 4; ++j) { const f32x4 v = xr[64 * j]; o8[64 * j] = (unsigned long long)pk2(v.x, v.y) | ((unsigned long long)pk2(v.z, v.w) << 32); }
            continue;
        }
        const f32x4* xr = (const f32x4*)(row < MP ? a.in[0] + (size_t)row * 1024 : a.in[1] + (size_t)(row - MP) * 1024) + lane;
        f32x4 v[4]; float s = 0.f;
#pragma unroll
        for (int j = 0; j < 4; ++j) { v[j] = xr[64 * j]; s += (v[j].x * v[j].x + v[j].y * v[j].y) + (v[j].z * v[j].z + v[j].w * v[j].w); }
        const float rstd = rsqrtf(wave_sum(s) * (1.f / 1024.f) + RMS_EPS);
#pragma unroll
        for (int j = 0; j < 4; ++j) { v[j] = v[j] * rstd * gv[j]; o8[64 * j] = (unsigned long long)pk2(v[j].x, v[j].y) | ((unsigned long long)pk2(v[j].z, v[j].w) << 32); }
        float gsum[8];
#pragma unroll
        for (int c = 0; c < 8; ++c) { float p = 0.f;
#pragma unroll
            for (int j = 0; j < 4; ++j) { const f32x4 w = *(const LAS f32x4*)(wg + c * 1024 + 4 * (lane + 64 * j)); p += (v[j].x * w.x + v[j].y * w.y) + (v[j].z * w.z + v[j].w * w.w); }
            gsum[c] = wave_sum(p); }
        if (lane < 8) { float g = gsum[0];
#pragma unroll
            for (int c = 1; c < 8; ++c) g = (lane == c) ? gsum[c] : g;
            GATES[(size_t)row * 8 + lane] = g; }
        float* so = nullptr;
        if (row >= MP) so = a.out + O_SSHIFT + (size_t)(row - MP) * 1024;
        else if ((row & (SEQ - 1)) == SEQ - 1) so = a.out + O_PSHIFT + (size_t)(row >> 11) * 1024;
        if (so) {
#pragma unroll
            for (int j = 0; j < 4; ++j) ((f32x4*)so)[lane + 64 * j] = v[j]; }
    }
}

constexpr int RCH = 32;
constexpr int RWKV_LDS = (RCH * 256 + 8 * RCH * 64 + RCH) * 4;
__device__ __forceinline__ void rwkv_seq_item(const Args& a, LAS unsigned char* ldsb, int item) {
    const int tid = threadIdx.x, lane = tid & 63, wv = tid >> 6;
    const bf16* PR = (const bf16*)(a.ws + WS_PR); bf16* YR = (bf16*)(a.ws + WS_YR);
    const float *mu = a.in[10], *w0 = a.in[11], *w2 = a.in[12], *a0 = a.in[13], *a2 = a.in[14], *g2 = a.in[15], *rkk = a.in[16], *rka = a.in[17], *rrk = a.in[18], *gnw = a.in[19], *gnb = a.in[20];
    int T, row0, h, prevrow0; const float* S0 = nullptr; float* Sout;
    if (item < 64) { const int b = item >> 3; h = item & 7; T = SEQ; row0 = b * SEQ; prevrow0 = -1; Sout = a.out + O_PWKV + (size_t)item * 4096; }
    else { const int sb = (item - 64) >> 3; h = (item - 64) & 7; T = 1; row0 = MP + sb; prevrow0 = MTOK + sb; S0 = a.in[3] + (size_t)(item - 64) * 4096; Sout = a.out + O_SWKV + (size_t)(item - 64) * 4096; }
    const int hc = h * 64;
    LAS float* MIXW = (LAS float*)ldsb;
    LAS float* MIXA = MIXW + RCH * 64;
    LAS float* MIXG = MIXA + RCH * 64;
    LAS float* Rb = MIXG + RCH * 128;
    LAS float* Kb = Rb + RCH * 64;
    LAS float* Vb = Kb + RCH * 64;
    LAS float* Wb = Vb + RCH * 64;
    LAS float* KKb = Wb + RCH * 64;
    LAS float* Bb = KKb + RCH * 64;
    LAS float* Gb = Bb + RCH * 64;
    LAS float* Yb = Gb + RCH * 64;
    LAS float* BON = Yb + RCH * 64;
    const int sv = tid >> 2, kq = tid & 3;
    float S[16];
    if (S0) {
#pragma unroll
        for (int i = 0; i < 4; ++i) { const f32x4 t = *(const f32x4*)(S0 + sv * 64 + 16 * kq + 4 * i); S[4 * i] = t.x; S[4 * i + 1] = t.y; S[4 * i + 2] = t.z; S[4 * i + 3] = t.w; }
    } else {
#pragma unroll
        for (int i = 0; i < 16; ++i) S[i] = 0.f;
    }
    const int j = lane;
    const float w0j = w0[hc + j], a0j = a0[hc + j], rkkj = rkk[hc + j], rkaj = rka[hc + j], rrkj = rrk[hc + j], gnwj = gnw[hc + j], gnbj = gnb[hc + j];
    for (int t0 = 0; t0 < T; t0 += RCH) {
        const int nt = (T - t0) < RCH ? (T - t0) : RCH;
        for (int it = tid; it < nt * 56; it += 256) {
            const int t = it / 56, g = it % 56;
            int col; LAS float* dst; int kind;
            if (g < 8) { col = hc + 8 * g; dst = Rb + t * 64 + 8 * g; kind = 0; }
            else if (g < 16) { col = 512 + hc + 8 * (g - 8); dst = Kb + t * 64 + 8 * (g - 8); kind = 0; }
            else if (g < 24) { col = 1024 + hc + 8 * (g - 16); dst = Vb + t * 64 + 8 * (g - 16); kind = 0; }
            else if (g < 32) { col = 1536 + 8 * (g - 24); dst = MIXW + t * 64 + 8 * (g - 24); kind = 1; }
            else if (g < 40) { col = 1600 + 8 * (g - 32); dst = MIXA + t * 64 + 8 * (g - 32); kind = 0; }
            else { col = 1664 + 8 * (g - 40); dst = MIXG + t * 128 + 8 * (g - 40); kind = 2; }
            const int tg = t0 + t;
            const v4u cur = *(const v4u*)(PR + (size_t)(row0 + tg) * NPR + col);
            v4u prv = (v4u){0u, 0u, 0u, 0u};
            if (tg > 0) prv = *(const v4u*)(PR + (size_t)(row0 + tg - 1) * NPR + col);
            else if (prevrow0 >= 0) prv = *(const v4u*)(PR + (size_t)prevrow0 * NPR + col);
            const f32x4 m0 = *(const f32x4*)(mu + col), m1 = *(const f32x4*)(mu + col + 4);
            float c[8], p[8], mm[8] = {m0.x, m0.y, m0.z, m0.w, m1.x, m1.y, m1.z, m1.w};
            c[0] = bflo(cur.x); c[1] = bfhi(cur.x); c[2] = bflo(cur.y); c[3] = bfhi(cur.y); c[4] = bflo(cur.z); c[5] = bfhi(cur.z); c[6] = bflo(cur.w); c[7] = bfhi(cur.w);
            p[0] = bflo(prv.x); p[1] = bfhi(prv.x); p[2] = bflo(prv.y); p[3] = bfhi(prv.y); p[4] = bflo(prv.z); p[5] = bfhi(prv.z); p[6] = bflo(prv.w); p[7] = bfhi(prv.w);
#pragma unroll
            for (int i = 0; i < 8; ++i) { float m = c[i] + (p[i] - c[i]) * mm[i]; if (kind == 1) m = tanhf(m); else if (kind == 2) m = sigmoidf_(m); dst[i] = m; }
        }
        __syncthreads();
        float accw[RCH / 4], acca[RCH / 4], accg[RCH / 4];
#pragma unroll
        for (int i = 0; i < RCH / 4; ++i) { accw[i] = 0.f; acca[i] = 0.f; accg[i] = 0.f; }
        for (int i4 = 0; i4 < 16; ++i4) {
            float wv4[4], av4[4];
#pragma unroll
            for (int q = 0; q < 4; ++q) { wv4[q] = w2[(size_t)(4 * i4 + q) * 512 + hc + j]; av4[q] = a2[(size_t)(4 * i4 + q) * 512 + hc + j]; }
#pragma unroll
            for (int tt = 0; tt < RCH / 4; ++tt) { const int t = wv + 4 * tt; if (t < nt) {
                const f32x4 xw = *(const LAS f32x4*)(MIXW + t * 64 + 4 * i4), xa = *(const LAS f32x4*)(MIXA + t * 64 + 4 * i4);
                accw[tt] += (xw.x * wv4[0] + xw.y * wv4[1]) + (xw.z * wv4[2] + xw.w * wv4[3]);
                acca[tt] += (xa.x * av4[0] + xa.y * av4[1]) + (xa.z * av4[2] + xa.w * av4[3]); } }
        }
        for (int i4 = 0; i4 < 32; ++i4) {
            float gv4[4];
#pragma unroll
            for (int q = 0; q < 4; ++q) gv4[q] = g2[(size_t)(4 * i4 + q) * 512 + hc + j];
#pragma unroll
            for (int tt = 0; tt < RCH / 4; ++tt) { const int t = wv + 4 * tt; if (t < nt) {
                const f32x4 xg = *(const LAS f32x4*)(MIXG + t * 128 + 4 * i4);
                accg[tt] += (xg.x * gv4[0] + xg.y * gv4[1]) + (xg.z * gv4[2] + xg.w * gv4[3]); } }
        }
#pragma unroll
        for (int tt = 0; tt < RCH / 4; ++tt) { const int t = wv + 4 * tt; if (t < nt) {
            const float wl = w0j + accw[tt]; const float sg = 1.0f / (1.0f + expf(-wl));
            const float dec = expf(-0.6065306597126334f * sg);
            const float aa = 1.0f / (1.0f + expf(-(a0j + acca[tt])));
            const float kraw = Kb[t * 64 + j]; const float kkr = kraw * rkkj;
            const float ss = wave_sum(kkr * kkr); const float kk = kkr / fmaxf(sqrtf(ss), 1e-12f);
            const float k2 = kraw * (1.0f + (aa - 1.0f) * rkaj);
            const float bon = wave_sum(Rb[t * 64 + j] * k2 * rrkj);
            Wb[t * 64 + j] = dec; KKb[t * 64 + j] = kk; Bb[t * 64 + j] = kk * aa; Kb[t * 64 + j] = k2; Gb[t * 64 + j] = accg[tt];
            if (j == 0) BON[t] = bon; } }
        __syncthreads();
        for (int t = 0; t < nt; ++t) {
            float kk[16], p = 0.f;
#pragma unroll
            for (int i = 0; i < 4; ++i) { const f32x4 x = *(const LAS f32x4*)(KKb + t * 64 + 16 * kq + 4 * i); kk[4 * i] = x.x; kk[4 * i + 1] = x.y; kk[4 * i + 2] = x.z; kk[4 * i + 3] = x.w; }
#pragma unroll
            for (int i = 0; i < 16; ++i) p += S[i] * kk[i];
            p += __shfl_xor(p, 1); p += __shfl_xor(p, 2);
            const float vv = Vb[t * 64 + sv]; float y = 0.f;
#pragma unroll
            for (int i = 0; i < 4; ++i) {
                const f32x4 w = *(const LAS f32x4*)(Wb + t * 64 + 16 * kq + 4 * i), bb = *(const LAS f32x4*)(Bb + t * 64 + 16 * kq + 4 * i), k2 = *(const LAS f32x4*)(Kb + t * 64 + 16 * kq + 4 * i), r = *(const LAS f32x4*)(Rb + t * 64 + 16 * kq + 4 * i);
                S[4 * i + 0] = S[4 * i + 0] * w.x - p * bb.x + vv * k2.x; y += S[4 * i + 0] * r.x;
                S[4 * i + 1] = S[4 * i + 1] * w.y - p * bb.y + vv * k2.y; y += S[4 * i + 1] * r.y;
                S[4 * i + 2] = S[4 * i + 2] * w.z - p * bb.z + vv * k2.z; y += S[4 * i + 2] * r.z;
                S[4 * i + 3] = S[4 * i + 3] * w.w - p * bb.w + vv * k2.w; y += S[4 * i + 3] * r.w;
            }
            y += __shfl_xor(y, 1); y += __shfl_xor(y, 2);
            if (kq == 0) Yb[t * 64 + sv] = y;
        }
        __syncthreads();
#pragma unroll
        for (int tt = 0; tt < RCH / 4; ++tt) { const int t = wv + 4 * tt; if (t < nt) {
            const float y = Yb[t * 64 + j]; const float mean = wave_sum(y) * (1.0f / 64.0f); const float d = y - mean; const float var = wave_sum(d * d) * (1.0f / 64.0f);
            float o = d * rsqrtf(var + R_GN_EPS) * gnwj + gnbj; o += BON[t] * Vb[t * 64 + j]; o *= Gb[t * 64 + j];
            YR[(size_t)(row0 + t0 + t) * 512 + hc + j] = (bf16)f2bf(o); } }
        __syncthreads();
    }
#pragma unroll
    for (int i = 0; i < 4; ++i) *(f32x4*)(Sout + sv * 64 + 16 * kq + 4 * i) = (f32x4){S[4 * i], S[4 * i + 1], S[4 * i + 2], S[4 * i + 3]};
}

constexpr int MCH = 16;
constexpr int MLSTM_LDS = ((MCH + 3) * 128 + 5 * MCH * 128 + MCH * 4 * 128 + 8 * MCH) * 4;
__device__ __forceinline__ void mlstm_seq_item(const Args& a, LAS unsigned char* ldsb, int item) {
    const int tid = threadIdx.x, lane = tid & 63, wv = tid >> 6;
    const bf16* PM = (const bf16*)(a.ws + WS_PM); bf16* YM = (bf16*)(a.ws + WS_YM); const float* GATES = (const float*)(a.ws + WS_GATES);
    const float *convw = a.in[22], *convb = a.in[23], *wq = a.in[24], *wk = a.in[25], *ib = a.in[26], *fb = a.in[27], *gnw = a.in[28], *skip = a.in[29];
    int T, row0, h, sb = -1; float *Cout, *nout, *mout, *convout;
    if (item < 32) { const int b = item >> 2; h = item & 3; T = SEQ; row0 = b * SEQ; Cout = a.out + O_PC + (size_t)item * 16384; nout = a.out + O_PN + (size_t)item * 128; mout = a.out + O_PMM + item; convout = a.out + O_PCONV + (size_t)b * 3 * 512 + h * 128; }
    else { const int it2 = item - 32; sb = it2 >> 2; h = it2 & 3; T = 1; row0 = MP + sb; Cout = a.out + O_SC + (size_t)it2 * 16384; nout = a.out + O_SN + (size_t)it2 * 128; mout = a.out + O_SMM + it2; convout = a.out + O_SCONV + (size_t)sb * 3 * 512 + h * 128; }
    const int hc = h * 128;
    LAS float* XMW = (LAS float*)ldsb;
    LAS float* XC = XMW + (MCH + 3) * 128;
    LAS float* Qb = XC + MCH * 128;
    LAS float* Kb = Qb + MCH * 128;
    LAS float* Vb = Kb + MCH * 128;
    LAS float* Ob = Vb + MCH * 128;
    LAS float* HP = Ob + MCH * 128;
    LAS float* FS = HP + MCH * 512;
    LAS float* IS = FS + MCH;
    LAS float* EM = IS + MCH;
    LAS float* DEN = EM + MCH;
    LAS float* MST = DEN + 2 * MCH;
    const int e = tid & 127, dq = tid >> 7;
    float C[32]; float nreg = 0.f;
    if (sb >= 0) {
        const float* C0 = a.in[4] + (size_t)(item - 32) * 16384;
#pragma unroll
        for (int i = 0; i < 32; ++i) C[i] = C0[(size_t)(32 * dq + i) * 128 + e];
        if (tid < 128) nreg = a.in[5][(size_t)(item - 32) * 128 + tid];
        if (tid == 0) MST[0] = a.in[6][item - 32];
        if (tid < 384) XMW[tid] = a.in[7][(size_t)sb * 3 * 512 + (tid >> 7) * 512 + hc + (tid & 127)];
    } else {
#pragma unroll
        for (int i = 0; i < 32; ++i) C[i] = 0.f;
        if (tid == 0) MST[0] = 0.f;
        if (tid < 384) XMW[tid] = 0.f;
    }
    const float cw0 = convw[0 * 512 + hc + e], cw1 = convw[1 * 512 + hc + e], cw2 = convw[2 * 512 + hc + e], cw3 = convw[3 * 512 + hc + e], cbe = convb[hc + e];
    const float ibh = ib[h], fbh = fb[h];
    __syncthreads();
    for (int t0 = 0; t0 < T; t0 += MCH) {
        const int nt = (T - t0) < MCH ? (T - t0) : MCH;
        for (int t = dq; t < nt; t += 4) { const size_t r = (size_t)(row0 + t0 + t) * NPM;
            XMW[(t + 3) * 128 + e] = bf2f(PM[r + hc + e]); Vb[t * 128 + e] = bf2f(PM[r + 512 + hc + e]); Ob[t * 128 + e] = sigmoidf_(bf2f(PM[r + 1024 + hc + e])); }
        __syncthreads();
        for (int t = dq; t < nt; t += 4) { const float x = cbe + XMW[t * 128 + e] * cw0 + XMW[(t + 1) * 128 + e] * cw1 + XMW[(t + 2) * 128 + e] * cw2 + XMW[(t + 3) * 128 + e] * cw3;
            XC[t * 128 + e] = x / (1.0f + expf(-x)); }
        if (tid == 0) { float m = MST[0];
            for (int t = 0; t < nt; ++t) { const float* g = GATES + (size_t)(row0 + t0 + t) * 8;
                const float li = g[h] + ibh, fr = g[4 + h] + fbh; const float lf = fminf(fr, 0.f) - log1pf(expf(-fabsf(fr)));
                const float mn = fmaxf(lf + m, li); FS[t] = expf(lf + m - mn); IS[t] = expf(li - mn); EM[t] = expf(-mn); m = mn; }
            MST[0] = m; }
        __syncthreads();
        { float aq[MCH / 4], ak[MCH / 4];
#pragma unroll
          for (int i = 0; i < MCH / 4; ++i) { aq[i] = 0.f; ak[i] = 0.f; }
          for (int d4 = 0; d4 < 32; ++d4) {
              float q4[4], k4[4];
#pragma unroll
              for (int q = 0; q < 4; ++q) { q4[q] = wq[(size_t)(hc + 4 * d4 + q) * 128 + e]; k4[q] = wk[(size_t)(hc + 4 * d4 + q) * 128 + e]; }
#pragma unroll
              for (int tt = 0; tt < MCH / 4; ++tt) { const int t = dq + 4 * tt; if (t < nt) { const f32x4 x = *(const LAS f32x4*)(XC + t * 128 + 4 * d4);
                  aq[tt] += (x.x * q4[0] + x.y * q4[1]) + (x.z * q4[2] + x.w * q4[3]); ak[tt] += (x.x * k4[0] + x.y * k4[1]) + (x.z * k4[2] + x.w * k4[3]); } }
          }
#pragma unroll
          for (int tt = 0; tt < MCH / 4; ++tt) { const int t = dq + 4 * tt; if (t < nt) { Qb[t * 128 + e] = aq[tt] * 0.08838834764831845f; Kb[t * 128 + e] = ak[tt]; } }
        }
        __syncthreads();
        for (int t = 0; t < nt; ++t) {
            const float fs = FS[t], is = IS[t]; const float ve = Vb[t * 128 + e] * is; float hp = 0.f;
#pragma unroll
            for (int i = 0; i < 8; ++i) { const f32x4 k = *(const LAS f32x4*)(Kb + t * 128 + 32 * dq + 4 * i), q = *(const LAS f32x4*)(Qb + t * 128 + 32 * dq + 4 * i);
                C[4 * i + 0] = fs * C[4 * i + 0] + k.x * ve; hp += q.x * C[4 * i + 0];
                C[4 * i + 1] = fs * C[4 * i + 1] + k.y * ve; hp += q.y * C[4 * i + 1];
                C[4 * i + 2] = fs * C[4 * i + 2] + k.z * ve; hp += q.z * C[4 * i + 2];
                C[4 * i + 3] = fs * C[4 * i + 3] + k.w * ve; hp += q.w * C[4 * i + 3]; }
            HP[t * 512 + dq * 128 + e] = hp;
            if (tid < 128) { nreg = fs * nreg + is * Kb[t * 128 + tid]; const float dn = wave_sum(Qb[t * 128 + tid] * nreg); if (lane == 0) DEN[t * 2 + wv] = dn; }
        }
        __syncthreads();
        for (int t = wv; t < nt; t += 8) {
            const float den = DEN[t * 2] + DEN[t * 2 + 1]; const float dd = fmaxf(fabsf(den), EM[t]);
            float hv[2];
#pragma unroll
            for (int q = 0; q < 2; ++q) { const int ee = lane + 64 * q; hv[q] = (HP[t * 512 + ee] + HP[t * 512 + 128 + ee] + HP[t * 512 + 256 + ee] + HP[t * 512 + 384 + ee]) / dd; }
            const float mean = wave_sum(hv[0] + hv[1]) * (1.0f / 128.0f); const float d0 = hv[0] - mean, d1 = hv[1] - mean;
            const float var = wave_sum(d0 * d0 + d1 * d1) * (1.0f / 128.0f); const float rs = rsqrtf(var + M_GN_EPS);
#pragma unroll
            for (int q = 0; q < 2; ++q) { const int ee = lane + 64 * q; float o = (q ? d1 : d0) * rs * gnw[hc + ee] + skip[hc + ee] * XC[t * 128 + ee]; o *= Ob[t * 128 + ee];
                YM[(size_t)(row0 + t0 + t) * 512 + hc + ee] = (bf16)f2bf(o); }
        }
        __syncthreads();
        float keep = 0.f; if (tid < 384) keep = XMW[(nt + (tid >> 7)) * 128 + (tid & 127)];
        __syncthreads();
        if (tid < 384) XMW[tid] = keep;
        __syncthreads();
    }
#pragma unroll
    for (int i = 0; i < 32; ++i) Cout[(size_t)(32 * dq + i) * 128 + e] = C[i];
    if (tid < 128) nout[tid] = nreg;
    if (tid == 0) mout[0] = MST[0];
    if (tid < 384) convout[(tid >> 7) * 512 + (tid & 127)] = XMW[tid];
}

__device__ __forceinline__ void final_norm_rows(const Args& a, int gw, int NGW, int lane) {
    const float* ssq = (const float*)(a.ws + WS_SSQ2); const float* gf = a.in[36];
    f32x4 gv[4];
#pragma unroll
    for (int j = 0; j < 4; ++j) gv[j] = ((const f32x4*)gf)[lane + 64 * j];
    for (int row = gw; row < MTOK; row += NGW) { const float rs = rsqrtf(ssq[row] * (1.0f / 1024.0f) + RMS_EPS); f32x4* p = (f32x4*)(a.out + (size_t)row * 1024) + lane;
#pragma unroll
        for (int j = 0; j < 4; ++j) p[64 * j] = p[64 * j] * rs * gv[j]; }
}

__global__ void __launch_bounds__(NTHR) k_prologue(Args a) {
    extern __shared__ __attribute__((aligned(16))) unsigned char lds[];
    const int wave = __builtin_amdgcn_readfirstlane(threadIdx.x >> 6), lane = threadIdx.x & 63;
    p0_prologue(a, (LAS unsigned char*)lds, blockIdx.x * NWAVES + wave, gridDim.x * NWAVES, lane, wave);
}
__global__ void __launch_bounds__(256) k_rwkv(Args a) {
    extern __shared__ __attribute__((aligned(16))) unsigned char lds[];
    rwkv_seq_item(a, (LAS unsigned char*)lds, blockIdx.x);
}
__global__ void __launch_bounds__(512) k_mlstm(Args a) {
    extern __shared__ __attribute__((aligned(16))) unsigned char lds[];
    mlstm_seq_item(a, (LAS unsigned char*)lds, blockIdx.x);
}
__global__ void __launch_bounds__(NTHR) k_final(Args a) {
    const int wave = __builtin_amdgcn_readfirstlane(threadIdx.x >> 6), lane = threadIdx.x & 63;
    final_norm_rows(a, blockIdx.x * NWAVES + wave, gridDim.x * NWAVES, lane);
}
template <int WHICH>
__global__ void __launch_bounds__(NTHR, 2) k_gemm(Args a) {
    extern __shared__ __attribute__((aligned(16))) unsigned char lds[];
    unsigned char* ws = a.ws; PG8_LAS unsigned char* l = (PG8_LAS unsigned char*)lds;
    pg8::StaticOrder S;
    if constexpr (WHICH == 1) { pg8::Gemm g{(const bf16*)(ws + WS_XN), (const bf16*)(ws + WS_WINT), MT, NPROJ, 1024}; S.init(MT, NPROJ, gridDim.x, blockIdx.x);
        pg8::EpiProj E{(bf16*)(ws + WS_PR), (bf16*)(ws + WS_PM), (bf16*)(ws + WS_PG), a.in[31]}; pg8::gemm_phase<pg8::EpiProj, pg8::StaticOrder, true, true>(l, g, S, E); }
    if constexpr (WHICH == 2) { pg8::Gemm g{(const bf16*)(ws + WS_YR), (const bf16*)(ws + WS_UPRT), MT, 1024, 512}; S.init(MT, 1024, gridDim.x, blockIdx.x);
        pg8::EpiUp1 E{(float*)(ws + WS_UPSCR), (const bf16*)(ws + WS_PG)}; pg8::gemm_phase<pg8::EpiUp1, pg8::StaticOrder, true, true>(l, g, S, E); }
    if constexpr (WHICH == 3) { pg8::Gemm g{(const bf16*)(ws + WS_YM), (const bf16*)(ws + WS_UPMT), MT, 1024, 512}; S.init(MT, 1024, gridDim.x, blockIdx.x);
        pg8::EpiUp2 E{(const float*)(ws + WS_UPSCR), (const bf16*)(ws + WS_PG), (bf16*)(ws + WS_MERGED)}; pg8::gemm_phase<pg8::EpiUp2, pg8::StaticOrder, true, true>(l, g, S, E); }
    if constexpr (WHICH == 4) { pg8::Gemm g{(const bf16*)(ws + WS_MERGED), (const bf16*)(ws + WS_WOUTT), MT, 1024, 1024}; S.init(MT, 1024, gridDim.x, blockIdx.x);
        pg8::EpiOut E{a.in[0], a.in[1], a.out, (bf16*)(ws + WS_X2B), a.in[33], (float*)(ws + WS_SSQ1)}; pg8::gemm_phase<pg8::EpiOut, pg8::StaticOrder, true, true>(l, g, S, E); }
    if constexpr (WHICH == 5) { pg8::Gemm g{(const bf16*)(ws + WS_X2B), (const bf16*)(ws + WS_W1T), MT, FF, 1024}; S.init(MT, FF, gridDim.x, blockIdx.x);
        pg8::EpiFfn1 E{(bf16*)(ws + WS_H), (const float*)(ws + WS_SSQ1)}; pg8::gemm_phase<pg8::EpiFfn1, pg8::StaticOrder, true, true>(l, g, S, E); }
    if constexpr (WHICH == 6) { pg8::Gemm g{(const bf16*)(ws + WS_H), (const bf16*)(ws + WS_W2T), MT, 1024, FF}; S.init(MT, 1024, gridDim.x, blockIdx.x);
        pg8::EpiFfn2 E{a.out, (float*)(ws + WS_SSQ2)}; pg8::gemm_phase<pg8::EpiFfn2, pg8::StaticOrder, true, true>(l, g, S, E); }
}

extern "C" void kernel_launch(void* const* d_in, const int* in_sizes, int n_in, void* d_out, int out_size, void* d_ws, size_t ws_size, hipStream_t stream) {
    static int ready = 0;
    if (ready == 0) {
        if (n_in != 37 || (size_t)out_size != O_END || ws_size < WS_NEED) { fprintf(stderr, "kernel_launch: unexpected problem: n_in %d out %d ws %zu\n", n_in, out_size, ws_size); ready = -1; return; }
        bool ok = true;
        ok &= hipFuncSetAttribute((const void*)k_prologue, hipFuncAttributeMaxDynamicSharedMemorySize, P0_LDS) == hipSuccess;
        ok &= hipFuncSetAttribute((const void*)k_rwkv, hipFuncAttributeMaxDynamicSharedMemorySize, RWKV_LDS) == hipSuccess;
        ok &= hipFuncSetAttribute((const void*)k_mlstm, hipFuncAttributeMaxDynamicSharedMemorySize, MLSTM_LDS) == hipSuccess;
        ok &= hipFuncSetAttribute((const void*)k_gemm<1>, hipFuncAttributeMaxDynamicSharedMemorySize, GEMM_LDS) == hipSuccess;
        ok &= hipFuncSetAttribute((const void*)k_gemm<2>, hipFuncAttributeMaxDynamicSharedMemorySize, GEMM_LDS) == hipSuccess;
        ok &= hipFuncSetAttribute((const void*)k_gemm<3>, hipFuncAttributeMaxDynamicSharedMemorySize, GEMM_LDS) == hipSuccess;
        ok &= hipFuncSetAttribute((const void*)k_gemm<4>, hipFuncAttributeMaxDynamicSharedMemorySize, GEMM_LDS) == hipSuccess;
        ok &= hipFuncSetAttribute((const void*)k_gemm<5>, hipFuncAttributeMaxDynamicSharedMemorySize, GEMM_LDS) == hipSuccess;
        ok &= hipFuncSetAttribute((const void*)k_gemm<6>, hipFuncAttributeMaxDynamicSharedMemorySize, GEMM_LDS) == hipSuccess;
        if (!ok) { fprintf(stderr, "kernel_launch: hipFuncSetAttribute failed\n"); ready = -1; return; }
        ready = 1;
    }
    if (ready < 0) return;
    Args a{};
    for (int i = 0; i < 37; ++i) a.in[i] = (const float*)d_in[i];
    a.out = (float*)d_out; a.ws = (unsigned char*)d_ws;
    const int G = 256;
    hipLaunchKernelGGL(k_prologue, dim3(G), dim3(NTHR), P0_LDS, stream, a);
    hipLaunchKernelGGL(k_gemm<1>, dim3(G), dim3(NTHR), GEMM_LDS, stream, a);
    hipLaunchKernelGGL(k_rwkv, dim3(64 + MS * RH), dim3(256), RWKV_LDS, stream, a);
    hipLaunchKernelGGL(k_mlstm, dim3(32 + MS * MH), dim3(512), MLSTM_LDS, stream, a);
    hipLaunchKernelGGL(k_gemm<2>, dim3(G), dim3(NTHR), GEMM_LDS, stream, a);
    hipLaunchKernelGGL(k_gemm<3>, dim3(G), dim3(NTHR), GEMM_LDS, stream, a);
    hipLaunchKernelGGL(k_gemm<4>, dim3(G), dim3(NTHR), GEMM_LDS, stream, a);
    hipLaunchKernelGGL(k_gemm<5>, dim3(G), dim3(NTHR), GEMM_LDS, stream, a);
    hipLaunchKernelGGL(k_gemm<6>, dim3(G), dim3(NTHR), GEMM_LDS, stream, a);
    hipLaunchKernelGGL(k_final, dim3(G), dim3(NTHR), 0, stream, a);
}
```

```cpp
#include <hip/hip_runtime.h>
#include <cstdio>
#include <cstdint>

constexpr int DM = 1024, MP = 16384, MS = 128, MTOK = MP + MS, MT = 16640;
constexpr int SEQ = 2048, NB = 8;
constexpr int NPR = 1792, NPM = 1536, NPG = 2048, NPROJ = NPR + NPM + NPG, INCOLS = 5384, GCOL0 = 3328;
constexpr int RH = 8, RN = 64, RW = 512, MH = 4, MD = 128, MW = 512, FF = 4096;
constexpr float RMS_EPS = 1e-6f, R_GN_EPS = 64e-5f, M_GN_EPS = 1e-5f;

constexpr size_t O_Y = 0;
constexpr size_t O_PSHIFT = (size_t)MTOK * DM;
constexpr size_t O_PWKV = O_PSHIFT + (size_t)NB * DM;
constexpr size_t O_PC = O_PWKV + (size_t)NB * RH * RN * RN;
constexpr size_t O_PN = O_PC + (size_t)NB * MH * MD * MD;
constexpr size_t O_PMM = O_PN + (size_t)NB * MH * MD;
constexpr size_t O_PCONV = O_PMM + (size_t)NB * MH;
constexpr size_t O_SSHIFT = O_PCONV + (size_t)NB * 3 * MW;
constexpr size_t O_SWKV = O_SSHIFT + (size_t)MS * DM;
constexpr size_t O_SC = O_SWKV + (size_t)MS * RH * RN * RN;
constexpr size_t O_SN = O_SC + (size_t)MS * MH * MD * MD;
constexpr size_t O_SMM = O_SN + (size_t)MS * MH * MD;
constexpr size_t O_SCONV = O_SMM + (size_t)MS * MH;
constexpr size_t O_END = O_SCONV + (size_t)MS * 3 * MW;
static_assert(O_END == 30695968, "output size");

constexpr size_t MiB = 1u << 20;
constexpr size_t WS_CTL = 0;
constexpr size_t WS_SSQ1 = 0, WS_SSQ2 = 128 * 1024;
constexpr size_t WS_WINT = 1 * MiB, WS_UPRT = 12 * MiB, WS_UPMT = 13 * MiB, WS_WOUTT = 14 * MiB, WS_W1T = 16 * MiB, WS_W2T = 24 * MiB;
constexpr size_t WS_GATES = 32 * MiB;
constexpr size_t WS_XN = 33 * MiB;
constexpr size_t WS_YM = 33 * MiB, WS_X2B = 33 * MiB;
constexpr size_t WS_PR = 66 * MiB;
constexpr size_t WS_PM = 123 * MiB;
constexpr size_t WS_PG = 172 * MiB;
constexpr size_t WS_YR = 237 * MiB;
constexpr size_t WS_MERGED = 66 * MiB;
constexpr size_t WS_UPSCR = 100 * MiB;
constexpr size_t WS_H = 66 * MiB;
constexpr size_t WS_NEED = 256 * MiB;
static_assert(WS_YR + (size_t)MT * 512 * 2 <= WS_NEED && WS_H + (size_t)MT * FF * 2 <= WS_NEED && WS_PG + (size_t)MT * NPG * 2 <= WS_YR && WS_UPSCR + (size_t)MT * DM * 4 <= WS_PG, "ws map");

#define GAS __attribute__((address_space(1)))
#define LAS __attribute__((address_space(3)))
typedef unsigned short bf16;
typedef unsigned v4u __attribute__((ext_vector_type(4)));
typedef unsigned v2u __attribute__((ext_vector_type(2)));
typedef float f32x4 __attribute__((ext_vector_type(4)));
typedef float f32x2 __attribute__((ext_vector_type(2)));
__device__ __forceinline__ unsigned f2bf(float f) { unsigned u = __builtin_bit_cast(unsigned, f); return (u + 0x7fffu + ((u >> 16) & 1u)) >> 16; }
__device__ __forceinline__ unsigned pk2(float lo, float hi) { return f2bf(lo) | (f2bf(hi) << 16); }
__device__ __forceinline__ float bf2f(unsigned b) { return __builtin_bit_cast(float, b << 16); }
__device__ __forceinline__ float bflo(unsigned w) { return __builtin_bit_cast(float, w << 16); }
__device__ __forceinline__ float bfhi(unsigned w) { return __builtin_bit_cast(float, w & 0xffff0000u); }
__device__ __forceinline__ float sigmoidf_(float x) { return 1.0f / (1.0f + __expf(-x)); }
__device__ __forceinline__ float wave_sum(float v) {
#pragma unroll
    for (int o = 1; o < 64; o <<= 1) v += __shfl_xor(v, o);
    return v;
}

namespace pg8 {
#define PG8_LAS __attribute__((address_space(3)))
typedef unsigned short bf16_t;
typedef short bf16x8 __attribute__((ext_vector_type(8)));
typedef float f32x4 __attribute__((ext_vector_type(4)));
typedef unsigned u32x4 __attribute__((ext_vector_type(4)));
constexpr int BM = 256, BK = 64, HALF = 128, HTB = HALF * BK * 2  , STAGE_BYTES = 8 * HTB, NXCD = 8, WGM = 8;

__host__ __device__ __forceinline__ int lds_byte(int r, int c) { const int st = (r >> 4) * 2 + (c >> 5), rr = r & 15, cc = c & 31, ob = rr * 64 + cc * 2; return st * 1024 + (ob ^ (((ob >> 9) & 1) << 5)); }
__host__ __device__ __forceinline__ void stage_rc(int b, int& R, int& C) { const int st = b / 1024, sb = b % 1024, swz = sb ^ (((sb >> 9) & 1) << 5); R = (st >> 1) * 16 + swz / 64; C = (st & 1) * 32 + (swz % 64) / 2; }
__host__ __device__ __forceinline__ int perm32(int rho) { const int n = rho >> 4, i = rho & 15; return 8 * (i >> 2) + 4 * n + (i & 3); }

struct Unit { int pm, pn; };
struct Gemm { const bf16_t* A; const bf16_t* Bt; int M, N, K; };

struct StaticOrder {
    int nM, nN, nwg, G, c;
    __host__ __device__ void init(int M, int N, int G_, int c_) { nM = M / BM; nN = N / BM; nwg = nM * nN; G = G_; c = c_; }
    __host__ __device__ bool next(int i, Unit& u) const {
        const long L = (long)i * G + c; if (L >= nwg) return false;
        int wgid = (int)L; { const int q = nwg / NXCD, r = nwg % NXCD, xcd = wgid % NXCD, off = wgid / NXCD; wgid = (xcd < r ? xcd * (q + 1) : r * (q + 1) + (xcd - r) * q) + off; }
        const int nig = WGM * nN, gid = wgid / nig, fm = gid * WGM, gsz = (nM - fm) < WGM ? (nM - fm) : WGM;
        u.pm = fm + ((wgid % nig) % gsz); u.pn = (wgid % nig) / gsz; return true;
    }
    __device__ __forceinline__ void a_ready(const Unit&) const {}
    __device__ __forceinline__ void done(const Unit&) const {}
};

__device__ __forceinline__ unsigned cvt_pk_bf16(float lo, float hi) { unsigned r; asm volatile("v_cvt_pk_bf16_f32 %0, %1, %2" : "=v"(r) : "v"(lo), "v"(hi)); return r; }
typedef unsigned u32x2 __attribute__((ext_vector_type(2)));
__device__ __forceinline__ float sigm(float x) { return 1.0f / (1.0f + __expf(-x)); }
__device__ __forceinline__ float bf_lo(unsigned w) { return __builtin_bit_cast(float, w << 16); }
__device__ __forceinline__ float bf_hi(unsigned w) { return __builtin_bit_cast(float, w & 0xffff0000u); }

struct EpiProj {
    static constexpr bool PERM = true, AFTER_DRAIN = false;
    bf16_t *PR, *PM, *PG; const float* gate_b;
    __device__ __forceinline__ void operator()(const f32x4 (&acc)[2][2][4][2], const Unit& u, int wr, int wc, int fr, int fq) const {
        int colt = u.pn * BM; bf16_t* base; int ldc; bool gate = false;
        if (colt < 1792) { base = PR; ldc = 1792; } else if (colt < 3328) { base = PM; ldc = 1536; colt -= 1792; } else { base = PG; ldc = 2048; colt -= 3328; gate = true; }
        const int row0 = u.pm * BM + wr * 64 + fr, col0 = colt + wc * 32 + 8 * fq;
        f32x4 bv[2][2];
#pragma unroll
        for (int bj = 0; bj < 2; ++bj)
#pragma unroll
            for (int n = 0; n < 2; ++n) bv[bj][n] = gate ? *(const f32x4*)(gate_b + col0 + bj * HALF + 4 * n) : (f32x4){0.f, 0.f, 0.f, 0.f};
#pragma unroll
        for (int ai = 0; ai < 2; ++ai)
#pragma unroll
            for (int m = 0; m < 4; ++m) { bf16_t* rowp = base + (size_t)(row0 + ai * HALF + m * 16) * ldc + col0;
#pragma unroll
                for (int bj = 0; bj < 2; ++bj) { f32x4 v0 = acc[ai][bj][m][0] + bv[bj][0], v1 = acc[ai][bj][m][1] + bv[bj][1];
                    if (gate) {
#pragma unroll
                        for (int j = 0; j < 4; ++j) { v0[j] = sigm(v0[j]); v1[j] = sigm(v1[j]); } }
                    u32x4 w; w.x = cvt_pk_bf16(v0[0], v0[1]); w.y = cvt_pk_bf16(v0[2], v0[3]); w.z = cvt_pk_bf16(v1[0], v1[1]); w.w = cvt_pk_bf16(v1[2], v1[3]);
                    *(u32x4*)(rowp + bj * HALF) = w; } }
    }
};
struct EpiUp1 {
    static constexpr bool PERM = false, AFTER_DRAIN = false;
    float* SCR; const bf16_t* PG;
    __device__ __forceinline__ void operator()(const f32x4 (&acc)[2][2][4][2], const Unit& u, int wr, int wc, int fr, int fq) const {
        const int row0 = u.pm * BM + wr * 64 + fr, col0 = u.pn * BM + wc * 32 + 4 * fq;
#pragma unroll
        for (int ai = 0; ai < 2; ++ai)
#pragma unroll
            for (int m = 0; m < 4; ++m) { const size_t row = (size_t)(row0 + ai * HALF + m * 16);
#pragma unroll
                for (int bj = 0; bj < 2; ++bj)
#pragma unroll
                    for (int n = 0; n < 2; ++n) { const int c = col0 + bj * HALF + n * 16; const u32x2 g = *(const u32x2*)(PG + row * 2048 + c);
                        f32x4 v = acc[ai][bj][m][n]; v[0] *= bf_lo(g.x); v[1] *= bf_hi(g.x); v[2] *= bf_lo(g.y); v[3] *= bf_hi(g.y);
                        *(f32x4*)(SCR + row * 1024 + c) = v; } }
    }
};
struct EpiUp2 {
    static constexpr bool PERM = false, AFTER_DRAIN = false;
    const float* SCR; const bf16_t* PG; bf16_t* MG;
    __device__ __forceinline__ void operator()(const f32x4 (&acc)[2][2][4][2], const Unit& u, int wr, int wc, int fr, int fq) const {
        const int row0 = u.pm * BM + wr * 64 + fr, col0 = u.pn * BM + wc * 32 + 4 * fq;
#pragma unroll
        for (int ai = 0; ai < 2; ++ai)
#pragma unroll
            for (int m = 0; m < 4; ++m) { const size_t row = (size_t)(row0 + ai * HALF + m * 16);
#pragma unroll
                for (int bj = 0; bj < 2; ++bj)
#pragma unroll
                    for (int n = 0; n < 2; ++n) { const int c = col0 + bj * HALF + n * 16; const u32x2 g = *(const u32x2*)(PG + row * 2048 + 1024 + c);
                        const f32x4 s = *(const f32x4*)(SCR + row * 1024 + c); f32x4 v = acc[ai][bj][m][n];
                        v[0] = s[0] + v[0] * bf_lo(g.x); v[1] = s[1] + v[1] * bf_hi(g.x); v[2] = s[2] + v[2] * bf_lo(g.y); v[3] = s[3] + v[3] * bf_hi(g.y);
                        u32x2 w; w.x = cvt_pk_bf16(v[0], v[1]); w.y = cvt_pk_bf16(v[2], v[3]); *(u32x2*)(MG + row * 1024 + c) = w; } }
    }
};
struct EpiOut {
    static constexpr bool PERM = false, AFTER_DRAIN = false;
    const float *xp, *xs; float* OUT; bf16_t* X2B; const float* gffn; float* ssq;
    __device__ __forceinline__ void operator()(const f32x4 (&acc)[2][2][4][2], const Unit& u, int wr, int wc, int fr, int fq) const {
        const int row0 = u.pm * BM + wr * 64 + fr, col0 = u.pn * BM + wc * 32 + 4 * fq;
        f32x4 gv[2][2];
#pragma unroll
        for (int bj = 0; bj < 2; ++bj)
#pragma unroll
            for (int n = 0; n < 2; ++n) gv[bj][n] = *(const f32x4*)(gffn + col0 + bj * HALF + n * 16);
#pragma unroll
        for (int ai = 0; ai < 2; ++ai) {
            if (u.pm * BM + ai * HALF >= 16512) continue;
#pragma unroll
            for (int m = 0; m < 4; ++m) { const int row = row0 + ai * HALF + m * 16;
                const float* xin = row < 16384 ? xp + (size_t)row * 1024 : xs + (size_t)(row - 16384) * 1024; float sq = 0.f;
#pragma unroll
                for (int bj = 0; bj < 2; ++bj)
#pragma unroll
                    for (int n = 0; n < 2; ++n) { const int c = col0 + bj * HALF + n * 16; const f32x4 v = *(const f32x4*)(xin + c) + acc[ai][bj][m][n];
                        *(f32x4*)(OUT + (size_t)row * 1024 + c) = v; sq += (v[0] * v[0] + v[1] * v[1]) + (v[2] * v[2] + v[3] * v[3]);
                        const f32x4 h = v * gv[bj][n]; u32x2 w; w.x = cvt_pk_bf16(h[0], h[1]); w.y = cvt_pk_bf16(h[2], h[3]); *(u32x2*)(X2B + (size_t)row * 1024 + c) = w; }
                sq += __shfl_xor(sq, 16); sq += __shfl_xor(sq, 32);
                if (fq == 0) atomicAdd(ssq + row, sq); }
        }
    }
};
struct EpiFfn1 {
    static constexpr bool PERM = true, AFTER_DRAIN = false;
    bf16_t* H; const float* ssq;
    __device__ __forceinline__ void operator()(const f32x4 (&acc)[2][2][4][2], const Unit& u, int wr, int wc, int fr, int fq) const {
        const int row0 = u.pm * BM + wr * 64 + fr, col0 = u.pn * BM + wc * 32 + 8 * fq;
#pragma unroll
        for (int ai = 0; ai < 2; ++ai)
#pragma unroll
            for (int m = 0; m < 4; ++m) { const int row = row0 + ai * HALF + m * 16; const float rs = rsqrtf(ssq[row] * (1.0f / 1024.0f) + 1e-6f);
                bf16_t* rowp = H + (size_t)row * 4096 + col0;
#pragma unroll
                for (int bj = 0; bj < 2; ++bj) { f32x4 v0 = acc[ai][bj][m][0] * rs, v1 = acc[ai][bj][m][1] * rs;
#pragma unroll
                    for (int j = 0; j < 4; ++j) { const float a = fmaxf(v0[j], 0.f), b = fmaxf(v1[j], 0.f); v0[j] = a * a; v1[j] = b * b; }
                    u32x4 w; w.x = cvt_pk_bf16(v0[0], v0[1]); w.y = cvt_pk_bf16(v0[2], v0[3]); w.z = cvt_pk_bf16(v1[0], v1[1]); w.w = cvt_pk_bf16(v1[2], v1[3]);
                    *(u32x4*)(rowp + bj * HALF) = w; } }
    }
};
struct EpiFfn2 {
    static constexpr bool PERM = false, AFTER_DRAIN = false;
    float* OUT; float* ssq;
    __device__ __forceinline__ void operator()(const f32x4 (&acc)[2][2][4][2], const Unit& u, int wr, int wc, int fr, int fq) const {
        const int row0 = u.pm * BM + wr * 64 + fr, col0 = u.pn * BM + wc * 32 + 4 * fq;
#pragma unroll
        for (int ai = 0; ai < 2; ++ai) {
            if (u.pm * BM + ai * HALF >= 16512) continue;
#pragma unroll
            for (int m = 0; m < 4; ++m) { const int row = row0 + ai * HALF + m * 16; float sq = 0.f;
#pragma unroll
                for (int bj = 0; bj < 2; ++bj)
#pragma unroll
                    for (int n = 0; n < 2; ++n) { float* p = OUT + (size_t)row * 1024 + col0 + bj * HALF + n * 16; const f32x4 v = *(const f32x4*)p + acc[ai][bj][m][n];
                        *(f32x4*)p = v; sq += (v[0] * v[0] + v[1] * v[1]) + (v[2] * v[2] + v[3] * v[3]); }
                sq += __shfl_xor(sq, 16); sq += __shfl_xor(sq, 32);
                if (fq == 0) atomicAdd(ssq + row, sq); }
        }
    }
};

template <class Epi, class Sched, bool ALIGN_EPI = false, bool SP2 = false>
__device__ __forceinline__ void gemm_phase(PG8_LAS unsigned char* lds, const Gemm g, const Sched& S, const Epi& E) {
    const int tid = threadIdx.x, wid = __builtin_amdgcn_readfirstlane(tid >> 6), lane = tid & 63, wr = wid >> 2, wc = wid & 3, fr = lane & 15, fq = lane >> 4;
    const int K = g.K, nt = K / BK;
    unsigned voffA[2], voffB[2];
#pragma unroll
    for (int i = 0; i < 2; ++i) { int R, C; stage_rc(tid * 16 + i * 8192, R, C); const int Rb = Epi::PERM ? ((R & ~31) + perm32(R & 31)) : R;
        voffA[i] = (unsigned)(R * K + C) * 2u; voffB[i] = (unsigned)(Rb * K + C) * 2u; }
    const size_t kstep = (size_t)(BK * 2);
    const size_t hstep = (size_t)HALF * K * 2;
    const size_t tstep = 2 * hstep;
    const unsigned ldsw = (unsigned)wid * 1024u;
    const int aoff = lds_byte(wr * 64 + fr, fq * 8), boff = lds_byte(wc * 32 + fr, fq * 8);
#define PG8_SA(b, h) (((b) * 2 + (h)) * HTB)
#define PG8_SB(b, h) ((4 + (b) * 2 + (h)) * HTB)
#define PG8_STAGE(bufoff, gbase, voff) do { _Pragma("unroll") for (int _i = 0; _i < 2; ++_i) \
        __builtin_amdgcn_global_load_lds((const unsigned*)((const char*)(gbase) + (voff)[_i]), (PG8_LAS unsigned*)(lds + (bufoff) + ldsw + _i * 8192), 16, 0, 0); } while (0)
#define PG8_LDA(dst, b, h) do { _Pragma("unroll") for (int m = 0; m < 4; ++m) _Pragma("unroll") for (int k = 0; k < 2; ++k) dst[m][k] = *(const PG8_LAS bf16x8*)(lds + PG8_SA(b, h) + aoff + m * 2048 + k * 1024); } while (0)
#define PG8_LDB(dst, b, h) do { _Pragma("unroll") for (int n = 0; n < 2; ++n) _Pragma("unroll") for (int k = 0; k < 2; ++k) dst[n][k] = *(const PG8_LAS bf16x8*)(lds + PG8_SB(b, h) + boff + n * 2048 + k * 1024); } while (0)
#define PG8_MMA(ai, bj, At, Bt) do { __builtin_amdgcn_s_setprio(1); _Pragma("unroll") for (int m = 0; m < 4; ++m) _Pragma("unroll") for (int n = 0; n < 2; ++n) _Pragma("unroll") for (int k = 0; k < 2; ++k) \
        acc[ai][bj][m][n] = __builtin_amdgcn_mfma_f32_16x16x32_bf16(Bt[n][k], At[m][k], acc[ai][bj][m][n], 0, 0, 0); __builtin_amdgcn_s_setprio(0); } while (0)
#define PG8_WAIT_V(n) asm volatile("s_waitcnt vmcnt(" #n ")" ::: "memory")
#define PG8_WAIT_L(n) asm volatile("s_waitcnt lgkmcnt(" #n ")" ::: "memory")
#define PG8_BAR __builtin_amdgcn_s_barrier()
#define PG8_SCHED __builtin_amdgcn_sched_barrier(0)
    Unit cur, nxt; int ui = 0;
    if (!S.next(0, cur)) return;
    f32x4 acc[2][2][4][2];
#pragma unroll
    for (int a = 0; a < 2; ++a)
#pragma unroll
        for (int b = 0; b < 2; ++b)
#pragma unroll
            for (int m = 0; m < 4; ++m)
#pragma unroll
                for (int n = 0; n < 2; ++n) acc[a][b][m][n] = (f32x4){0.f, 0.f, 0.f, 0.f};
    bf16x8 At[4][2], B0[2][2], B1[2][2];
    const char* cA = (const char*)g.A + (size_t)cur.pm * tstep; const char* cB = (const char*)g.Bt + (size_t)cur.pn * tstep;
    S.a_ready(cur);
    if constexpr (SP2) {
        PG8_STAGE(PG8_SB(0, 0), cB, voffB); PG8_STAGE(PG8_SB(0, 1), cB + hstep, voffB); PG8_STAGE(PG8_SA(0, 0), cA, voffA); PG8_STAGE(PG8_SA(0, 1), cA + hstep, voffA);
        if (wr == 1) PG8_BAR;
        PG8_WAIT_V(2); PG8_BAR;
        PG8_STAGE(PG8_SB(1, 0), cB + kstep, voffB); PG8_STAGE(PG8_SA(1, 0), cA + kstep, voffA); PG8_STAGE(PG8_SB(1, 1), cB + hstep + kstep, voffB);
        PG8_WAIT_V(6); PG8_BAR;
    } else {
        PG8_STAGE(PG8_SB(0, 0), cB, voffB); PG8_STAGE(PG8_SA(0, 0), cA, voffA); PG8_STAGE(PG8_SB(0, 1), cB + hstep, voffB); PG8_STAGE(PG8_SA(0, 1), cA + hstep, voffA);
        if (wr == 1) PG8_BAR;
        PG8_WAIT_V(4); PG8_BAR;
        PG8_STAGE(PG8_SB(1, 0), cB + kstep, voffB); PG8_STAGE(PG8_SA(1, 0), cA + kstep, voffA); PG8_STAGE(PG8_SB(1, 1), cB + hstep + kstep, voffB);
        PG8_WAIT_V(6); PG8_BAR;
    }
    for (;;) {
        const bool has_next = S.next(ui + 1, nxt);
        const char* nA = has_next ? (const char*)g.A + (size_t)nxt.pm * tstep : cA; const char* nB = has_next ? (const char*)g.Bt + (size_t)nxt.pn * tstep : cB;
        for (int t = 0; t < nt; t += 2) {
            const bool last = (t == nt - 2);
            const char* a1 = cA + (size_t)(t + 1) * kstep;
            const char* a2 = last ? nA : cA + (size_t)(t + 2) * kstep; const char* b2 = last ? nB : cB + (size_t)(t + 2) * kstep;
            const char* a3 = a2 + kstep; const char* b3 = b2 + kstep;
            if (last && has_next) S.a_ready(nxt);
            if constexpr (SP2) {
            PG8_LDB(B0, 0, 0); PG8_LDB(B1, 0, 1); PG8_SCHED; PG8_LDA(At, 0, 0); PG8_STAGE(PG8_SA(1, 1), a1 + hstep, voffA);
            PG8_WAIT_V(8); PG8_WAIT_L(0); PG8_BAR; PG8_MMA(0, 0, At, B0); PG8_MMA(0, 1, At, B1); PG8_BAR; PG8_SCHED;
            PG8_LDA(At, 0, 1); PG8_STAGE(PG8_SB(0, 0), b2, voffB); PG8_STAGE(PG8_SB(0, 1), b2 + hstep, voffB); PG8_STAGE(PG8_SA(0, 0), a2, voffA);
            PG8_WAIT_V(8); PG8_WAIT_L(0); PG8_BAR; PG8_MMA(1, 0, At, B0); PG8_MMA(1, 1, At, B1); PG8_BAR; PG8_SCHED;
            PG8_LDB(B0, 1, 0); PG8_LDB(B1, 1, 1); PG8_SCHED; PG8_LDA(At, 1, 0); PG8_STAGE(PG8_SA(0, 1), a2 + hstep, voffA);
            PG8_WAIT_V(8); PG8_WAIT_L(0); PG8_BAR; PG8_MMA(0, 0, At, B0); PG8_MMA(0, 1, At, B1); PG8_BAR; PG8_SCHED;
            PG8_LDA(At, 1, 1); PG8_STAGE(PG8_SB(1, 0), b3, voffB); PG8_STAGE(PG8_SB(1, 1), b3 + hstep, voffB); PG8_STAGE(PG8_SA(1, 0), a3, voffA);
            PG8_WAIT_V(8); PG8_WAIT_L(0); PG8_BAR; PG8_MMA(1, 0, At, B0); PG8_MMA(1, 1, At, B1); PG8_BAR; PG8_SCHED;
            } else {
            PG8_LDB(B0, 0, 0); PG8_SCHED; PG8_LDA(At, 0, 0); PG8_STAGE(PG8_SA(1, 1), a1 + hstep, voffA);
            PG8_WAIT_L(8); PG8_BAR; PG8_WAIT_L(0); PG8_MMA(0, 0, At, B0); PG8_BAR; PG8_SCHED;
            PG8_LDB(B1, 0, 1); PG8_STAGE(PG8_SB(0, 0), b2, voffB);
            PG8_BAR; PG8_WAIT_L(0); PG8_MMA(0, 1, At, B1); PG8_BAR;
            PG8_LDA(At, 0, 1); PG8_STAGE(PG8_SA(0, 0), a2, voffA);
            PG8_BAR; PG8_WAIT_L(0); PG8_MMA(1, 0, At, B0); PG8_BAR; PG8_SCHED;
            PG8_STAGE(PG8_SB(0, 1), b2 + hstep, voffB);
            PG8_WAIT_V(6); PG8_BAR; PG8_MMA(1, 1, At, B1); PG8_BAR;
            PG8_LDB(B0, 1, 0); PG8_SCHED; PG8_LDA(At, 1, 0); PG8_STAGE(PG8_SA(0, 1), a2 + hstep, voffA);
            PG8_WAIT_L(8); PG8_BAR; PG8_WAIT_L(0); PG8_MMA(0, 0, At, B0); PG8_BAR; PG8_SCHED;
            PG8_LDB(B1, 1, 1); PG8_STAGE(PG8_SB(1, 0), b3, voffB);
            PG8_BAR; PG8_WAIT_L(0); PG8_MMA(0, 1, At, B1); PG8_BAR;
            PG8_LDA(At, 1, 1); PG8_STAGE(PG8_SA(1, 0), a3, voffA);
            PG8_BAR; PG8_WAIT_L(0); PG8_MMA(1, 0, At, B0); PG8_BAR; PG8_SCHED;
            PG8_STAGE(PG8_SB(1, 1), b3 + hstep, voffB);
            PG8_WAIT_V(6); PG8_BAR; PG8_MMA(1, 1, At, B1); PG8_BAR;
            }
        }
        if constexpr (ALIGN_EPI) { if (wr == 0) PG8_BAR; }
        if constexpr (!Epi::AFTER_DRAIN) { E(acc, cur, wr, wc, fr, fq); S.done(cur); }
        if (!has_next) break;
#pragma unroll
        for (int a = 0; a < 2; ++a)
#pragma unroll
            for (int b = 0; b < 2; ++b)
#pragma unroll
                for (int m = 0; m < 4; ++m)
#pragma unroll
                    for (int n = 0; n < 2; ++n) acc[a][b][m][n] = (f32x4){0.f, 0.f, 0.f, 0.f};
        cur = nxt; cA = nA; cB = nB; ++ui;
        if constexpr (ALIGN_EPI) { if (wr == 1) PG8_BAR; }
    }
    PG8_WAIT_V(0);
    if constexpr (!ALIGN_EPI) { if (wr == 0) PG8_BAR; }
    PG8_BAR;
    if constexpr (Epi::AFTER_DRAIN) { E.fused(acc, cur, wr, wc, fr, fq, lds, wid, lane); S.done(cur); }
#undef PG8_SA
#undef PG8_SB
#undef PG8_STAGE
#undef PG8_LDA
#undef PG8_LDB
#undef PG8_MMA
#undef PG8_WAIT_V
#undef PG8_WAIT_L
#undef PG8_BAR
#undef PG8_SCHED
}
}

struct Args {
    const float* in[37];
    float* out; unsigned char* ws;
};
constexpr int NWAVES = 8, NTHR = 512;
constexpr int GEMM_LDS = 131072;

#define LDS_WAIT() asm volatile("s_waitcnt lgkmcnt(0)" ::: "memory")

__device__ __forceinline__ void transpose_item(const float* W, int ldw, int nblk, bf16* WT, int ldt, int item, LAS float* scr, int lane) {
    const int kb = item / nblk, nb = item % nblk, k0 = 64 * kb, n0 = 32 * nb;
#pragma unroll 8
    for (int i = 0; i < 32; ++i) { const int kk = 2 * i + (lane >> 5); scr[kk * 33 + (lane & 31)] = W[(size_t)(k0 + kk) * ldw + n0 + (lane & 31)]; }
    LDS_WAIT(); asm volatile("" ::: "memory");
    const int c = lane & 7;
#pragma unroll
    for (int j = 0; j < 4; ++j) { const int n = (lane >> 3) + 8 * j; const LAS float* s = scr + (8 * c) * 33 + n;
        v4u o; o.x = pk2(s[0 * 33], s[1 * 33]); o.y = pk2(s[2 * 33], s[3 * 33]); o.z = pk2(s[4 * 33], s[5 * 33]); o.w = pk2(s[6 * 33], s[7 * 33]);
        *(v4u*)(WT + (size_t)(n0 + n) * ldt + k0 + 8 * c) = o; }
    LDS_WAIT(); asm volatile("" ::: "memory");
}

constexpr int P0_LDS = 8 * 64 * 33 * 4 + 8 * 1024 * 4;
__device__ __forceinline__ void p0_prologue(const Args& a, LAS unsigned char* lds, int gw, int NGW, int lane, int wave) {
    unsigned char* ws = a.ws;
    LAS float* scr = (LAS float*)(lds) + wave * (64 * 33);
    LAS float* wg = (LAS float*)(lds + 8 * 64 * 33 * 4);
    const float* w_in = a.in[9];
    for (int i = threadIdx.x; i < 8 * 1024; i += NTHR) { const int k = i >> 3, c = i & 7; wg[c * 1024 + k] = w_in[(size_t)k * INCOLS + GCOL0 + c]; }
    { float* z = (float*)(ws + WS_CTL); for (int i = gw * 64 + lane; i < 65536; i += NGW * 64) z[i] = 0.f; }
    constexpr int I_IN1 = 16 * (3328 / 32), I_IN2 = 16 * (2048 / 32), I_UP = 8 * 32, I_OUT = 16 * 32, I_F1 = 16 * 128, I_F2 = 64 * 32;
    constexpr int NITEMS = I_IN1 + I_IN2 + 2 * I_UP + I_OUT + I_F1 + I_F2;
    for (int it = gw; it < NITEMS; it += NGW) {
        int r = it;
        if (r < I_IN1) { transpose_item(w_in, INCOLS, 3328 / 32, (bf16*)(ws + WS_WINT), 1024, r, scr, lane); continue; } r -= I_IN1;
        if (r < I_IN2) { transpose_item(w_in + 3336, INCOLS, 2048 / 32, (bf16*)(ws + WS_WINT) + (size_t)3328 * 1024, 1024, r, scr, lane); continue; } r -= I_IN2;
        if (r < I_UP) { transpose_item(a.in[21], 1024, 32, (bf16*)(ws + WS_UPRT), 512, r, scr, lane); continue; } r -= I_UP;
        if (r < I_UP) { transpose_item(a.in[30], 1024, 32, (bf16*)(ws + WS_UPMT), 512, r, scr, lane); continue; } r -= I_UP;
        if (r < I_OUT) { transpose_item(a.in[32], 1024, 32, (bf16*)(ws + WS_WOUTT), 1024, r, scr, lane); continue; } r -= I_OUT;
        if (r < I_F1) { transpose_item(a.in[34], 4096, 128, (bf16*)(ws + WS_W1T), 1024, r, scr, lane); continue; } r -= I_F1;
        transpose_item(a.in[35], 1024, 32, (bf16*)(ws + WS_W2T), 4096, r, scr, lane);
    }
    __syncthreads();
    const float* gmix = a.in[8];
    f32x4 gv[4];
#pragma unroll
    for (int j = 0; j < 4; ++j) gv[j] = ((const f32x4*)gmix)[lane + 64 * j];
    bf16* XN = (bf16*)(ws + WS_XN); float* GATES = (float*)(ws + WS_GATES);
    for (int row = gw; row < MT; row += NGW) {
        unsigned long long* o8 = (unsigned long long*)(XN + (size_t)row * 1024) + lane;
        if (row >= MTOK) {
            const f32x4* xr = (const f32x4*)(a.in[2] + (size_t)(row - MTOK) * 1024) + lane;
#pragma unroll
            for (int j = 0; j < 4; ++j) { const f32x4 v = xr[64 * j]; o8[64 * j] = (unsigned long long)pk2(v.x, v.y) | ((unsigned long long)pk2(v.z, v.w) << 32); }
            continue;
        }
        const f32x4* xr = (const f32x4*)(row < MP ? a.in[0] + (size_t)row * 1024 : a.in[1] + (size_t)(row - MP) * 1024) + lane;
        f32x4 v[4]; float s = 0.f;
#pragma unroll
        for (int j = 0; j < 4; ++j) { v[j] = xr[64 * j]; s += (v[j].x * v[j].x + v[j].y * v[j].y) + (v[j].z * v[j].z + v[j].w * v[j].w); }
        const float rstd = rsqrtf(wave_sum(s) * (1.f / 1024.f) + RMS_EPS);
#pragma unroll
        for (int j = 0; j < 4; ++j) { v[j] = v[j] * rstd * gv[j]; o8[64 * j] = (unsigned long long)pk2(v[j].x, v[j].y) | ((unsigned long long)pk2(v[j].z, v[j].w) << 32); }
        float gsum[8];
#pragma unroll
        for (int c = 0; c < 8; ++c) { float p = 0.f;
#pragma unroll
            for (int j = 0; j < 4; ++j) { const f32x4 w = *(const LAS f32x4*)(wg + c * 1024 + 4 * (lane + 64 * j)); p += (v[j].x * w.x + v[j].y * w.y) + (v[j].z * w.z + v[j].w * w.w); }
            gsum[c] = wave_sum(p); }
        if (lane < 8) { float g = gsum[0];
#pragma unroll
            for (int c = 1; c < 8; ++c) g = (lane == c) ? gsum[c] : g;
            GATES[(size_t)row * 8 + lane] = g; }
        float* so = nullptr;
        if (row >= MP) so = a.out + O_SSHIFT + (size_t)(row - MP) * 1024;
        else if ((row & (SEQ - 1)) == SEQ - 1) so = a.out + O_PSHIFT + (size_t)(row >> 11) * 1024;
        if (so) {
#pragma unroll
            for (int j = 0; j < 4; ++j) ((f32x4*)so)[lane + 64 * j] = v[j]; }
    }
}

constexpr int RCH = 16;
constexpr int RWKV_LDS = (RCH * 256 + 8 * RCH * 64 + RCH) * 4;
__device__ __forceinline__ void rwkv_seq_item(const Args& a, LAS unsigned char* ldsb0, int item0) {
    const int tid = threadIdx.x & 255, lane = tid & 63, wv = tid >> 6; const int item = item0 + (threadIdx.x >> 8);
    LAS unsigned char* ldsb = ldsb0 + (threadIdx.x >> 8) * RWKV_LDS;
    const bf16* PR = (const bf16*)(a.ws + WS_PR); bf16* YR = (bf16*)(a.ws + WS_YR);
    const float *mu = a.in[10], *w0 = a.in[11], *w2 = a.in[12], *a0 = a.in[13], *a2 = a.in[14], *g2 = a.in[15], *rkk = a.in[16], *rka = a.in[17], *rrk = a.in[18], *gnw = a.in[19], *gnb = a.in[20];
    int T, row0, h, prevrow0; const float* S0 = nullptr; float* Sout;
    if (item < 64) { const int b = item >> 3; h = item & 7; T = SEQ; row0 = b * SEQ; prevrow0 = -1; Sout = a.out + O_PWKV + (size_t)item * 4096; }
    else { const int sb = (item - 64) >> 3; h = (item - 64) & 7; T = 1; row0 = MP + sb; prevrow0 = MTOK + sb; S0 = a.in[3] + (size_t)(item - 64) * 4096; Sout = a.out + O_SWKV + (size_t)(item - 64) * 4096; }
    const int hc = h * 64;
    LAS float* MIXW = (LAS float*)ldsb;
    LAS float* MIXA = MIXW + RCH * 64;
    LAS float* MIXG = MIXA + RCH * 64;
    LAS float* Rb = MIXG + RCH * 128;
    LAS float* Kb = Rb + RCH * 64;
    LAS float* Vb = Kb + RCH * 64;
    LAS float* Wb = Vb + RCH * 64;
    LAS float* KKb = Wb + RCH * 64;
    LAS float* Bb = KKb + RCH * 64;
    LAS float* Gb = Bb + RCH * 64;
    LAS float* Yb = Gb + RCH * 64;
    LAS float* BON = Yb + RCH * 64;
    const int sv = tid >> 2, kq = tid & 3;
    float S[16];
    if (S0) {
#pragma unroll
        for (int i = 0; i < 4; ++i) { const f32x4 t = *(const f32x4*)(S0 + sv * 64 + 16 * kq + 4 * i); S[4 * i] = t.x; S[4 * i + 1] = t.y; S[4 * i + 2] = t.z; S[4 * i + 3] = t.w; }
    } else {
#pragma unroll
        for (int i = 0; i < 16; ++i) S[i] = 0.f;
    }
    const int j = lane;
    const float w0j = w0[hc + j], a0j = a0[hc + j], rkkj = rkk[hc + j], rkaj = rka[hc + j], rrkj = rrk[hc + j], gnwj = gnw[hc + j], gnbj = gnb[hc + j];
    for (int t0 = 0; t0 < T; t0 += RCH) {
        const int nt = (T - t0) < RCH ? (T - t0) : RCH;
        for (int it = tid; it < nt * 56; it += 256) {
            const int t = it / 56, g = it % 56;
            int col; LAS float* dst; int kind;
            if (g < 8) { col = hc + 8 * g; dst = Rb + t * 64 + 8 * g; kind = 0; }
            else if (g < 16) { col = 512 + hc + 8 * (g - 8); dst = Kb + t * 64 + 8 * (g - 8); kind = 0; }
            else if (g < 24) { col = 1024 + hc + 8 * (g - 16); dst = Vb + t * 64 + 8 * (g - 16); kind = 0; }
            else if (g < 32) { col = 1536 + 8 * (g - 24); dst = MIXW + t * 64 + 8 * (g - 24); kind = 1; }
            else if (g < 40) { col = 1600 + 8 * (g - 32); dst = MIXA + t * 64 + 8 * (g - 32); kind = 0; }
            else { col = 1664 + 8 * (g - 40); dst = MIXG + t * 128 + 8 * (g - 40); kind = 2; }
            const int tg = t0 + t;
            const v4u cur = *(const v4u*)(PR + (size_t)(row0 + tg) * NPR + col);
            v4u prv = (v4u){0u, 0u, 0u, 0u};
            if (tg > 0) prv = *(const v4u*)(PR + (size_t)(row0 + tg - 1) * NPR + col);
            else if (prevrow0 >= 0) prv = *(const v4u*)(PR + (size_t)prevrow0 * NPR + col);
            const f32x4 m0 = *(const f32x4*)(mu + col), m1 = *(const f32x4*)(mu + col + 4);
            float c[8], p[8], mm[8] = {m0.x, m0.y, m0.z, m0.w, m1.x, m1.y, m1.z, m1.w};
            c[0] = bflo(cur.x); c[1] = bfhi(cur.x); c[2] = bflo(cur.y); c[3] = bfhi(cur.y); c[4] = bflo(cur.z); c[5] = bfhi(cur.z); c[6] = bflo(cur.w); c[7] = bfhi(cur.w);
            p[0] = bflo(prv.x); p[1] = bfhi(prv.x); p[2] = bflo(prv.y); p[3] = bfhi(prv.y); p[4] = bflo(prv.z); p[5] = bfhi(prv.z); p[6] = bflo(prv.w); p[7] = bfhi(prv.w);
#pragma unroll
            for (int i = 0; i < 8; ++i) { float m = c[i] + (p[i] - c[i]) * mm[i]; if (kind == 1) m = tanhf(m); else if (kind == 2) m = sigmoidf_(m); dst[i] = m; }
        }
        __syncthreads();
        float accw[RCH / 4], acca[RCH / 4], accg[RCH / 4];
#pragma unroll
        for (int i = 0; i < RCH / 4; ++i) { accw[i] = 0.f; acca[i] = 0.f; accg[i] = 0.f; }
        for (int i4 = 0; i4 < 16; ++i4) {
            float wv4[4], av4[4];
#pragma unroll
            for (int q = 0; q < 4; ++q) { wv4[q] = w2[(size_t)(4 * i4 + q) * 512 + hc + j]; av4[q] = a2[(size_t)(4 * i4 + q) * 512 + hc + j]; }
#pragma unroll
            for (int tt = 0; tt < RCH / 4; ++tt) { const int t = wv + 4 * tt; if (t < nt) {
                const f32x4 xw = *(const LAS f32x4*)(MIXW + t * 64 + 4 * i4), xa = *(const LAS f32x4*)(MIXA + t * 64 + 4 * i4);
                accw[tt] += (xw.x * wv4[0] + xw.y * wv4[1]) + (xw.z * wv4[2] + xw.w * wv4[3]);
                acca[tt] += (xa.x * av4[0] + xa.y * av4[1]) + (xa.z * av4[2] + xa.w * av4[3]); } }
        }
        for (int i4 = 0; i4 < 32; ++i4) {
            float gv4[4];
#pragma unroll
            for (int q = 0; q < 4; ++q) gv4[q] = g2[(size_t)(4 * i4 + q) * 512 + hc + j];
#pragma unroll
            for (int tt = 0; tt < RCH / 4; ++tt) { const int t = wv + 4 * tt; if (t < nt) {
                const f32x4 xg = *(const LAS f32x4*)(MIXG + t * 128 + 4 * i4);
                accg[tt] += (xg.x * gv4[0] + xg.y * gv4[1]) + (xg.z * gv4[2] + xg.w * gv4[3]); } }
        }
#pragma unroll
        for (int tt = 0; tt < RCH / 4; ++tt) { const int t = wv + 4 * tt; if (t < nt) {
            const float wl = w0j + accw[tt]; const float sg = 1.0f / (1.0f + expf(-wl));
            const float dec = expf(-0.6065306597126334f * sg);
            const float aa = 1.0f / (1.0f + expf(-(a0j + acca[tt])));
            const float kraw = Kb[t * 64 + j]; const float kkr = kraw * rkkj;
            const float ss = wave_sum(kkr * kkr); const float kk = kkr / fmaxf(sqrtf(ss), 1e-12f);
            const float k2 = kraw * (1.0f + (aa - 1.0f) * rkaj);
            const float bon = wave_sum(Rb[t * 64 + j] * k2 * rrkj);
            Wb[t * 64 + j] = dec; KKb[t * 64 + j] = kk; Bb[t * 64 + j] = kk * aa; Kb[t * 64 + j] = k2; Gb[t * 64 + j] = accg[tt];
            if (j == 0) BON[t] = bon; } }
        __syncthreads();
        for (int t = 0; t < nt; ++t) {
            float kk[16], p = 0.f;
#pragma unroll
            for (int i = 0; i < 4; ++i) { const f32x4 x = *(const LAS f32x4*)(KKb + t * 64 + 16 * kq + 4 * i); kk[4 * i] = x.x; kk[4 * i + 1] = x.y; kk[4 * i + 2] = x.z; kk[4 * i + 3] = x.w; }
#pragma unroll
            for (int i = 0; i < 16; ++i) p += S[i] * kk[i];
            p += __shfl_xor(p, 1); p += __shfl_xor(p, 2);
            const float vv = Vb[t * 64 + sv]; float y = 0.f;
#pragma unroll
            for (int i = 0; i < 4; ++i) {
                const f32x4 w = *(const LAS f32x4*)(Wb + t * 64 + 16 * kq + 4 * i), bb = *(const LAS f32x4*)(Bb + t * 64 + 16 * kq + 4 * i), k2 = *(const LAS f32x4*)(Kb + t * 64 + 16 * kq + 4 * i), r = *(const LAS f32x4*)(Rb + t * 64 + 16 * kq + 4 * i);
                S[4 * i + 0] = S[4 * i + 0] * w.x - p * bb.x + vv * k2.x; y += S[4 * i + 0] * r.x;
                S[4 * i + 1] = S[4 * i + 1] * w.y - p * bb.y + vv * k2.y; y += S[4 * i + 1] * r.y;
                S[4 * i + 2] = S[4 * i + 2] * w.z - p * bb.z + vv * k2.z; y += S[4 * i + 2] * r.z;
                S[4 * i + 3] = S[4 * i + 3] * w.w - p * bb.w + vv * k2.w; y += S[4 * i + 3] * r.w;
            }
            y += __shfl_xor(y, 1); y += __shfl_xor(y, 2);
            if (kq == 0) Yb[t * 64 + sv] = y;
        }
        __syncthreads();
#pragma unroll
        for (int tt = 0; tt < RCH / 4; ++tt) { const int t = wv + 4 * tt; if (t < nt) {
            const float y = Yb[t * 64 + j]; const float mean = wave_sum(y) * (1.0f / 64.0f); const float d = y - mean; const float var = wave_sum(d * d) * (1.0f / 64.0f);
            float o = d * rsqrtf(var + R_GN_EPS) * gnwj + gnbj; o += BON[t] * Vb[t * 64 + j]; o *= Gb[t * 64 + j];
            YR[(size_t)(row0 + t0 + t) * 512 + hc + j] = (bf16)f2bf(o); } }
        __syncthreads();
    }
#pragma unroll
    for (int i = 0; i < 4; ++i) *(f32x4*)(Sout + sv * 64 + 16 * kq + 4 * i) = (f32x4){S[4 * i], S[4 * i + 1], S[4 * i + 2], S[4 * i + 3]};
}

constexpr int MCH = 16;
constexpr int MLSTM_LDS = ((MCH + 3) * 128 + 5 * MCH * 128 + MCH * 4 * 128 + 8 * MCH) * 4;
__device__ __forceinline__ void mlstm_seq_item(const Args& a, LAS unsigned char* ldsb, int item) {
    const int tid = threadIdx.x, lane = tid & 63, wv = tid >> 6;
    const bf16* PM = (const bf16*)(a.ws + WS_PM); bf16* YM = (bf16*)(a.ws + WS_YM); const float* GATES = (const float*)(a.ws + WS_GATES);
    const float *convw = a.in[22], *convb = a.in[23], *wq = a.in[24], *wk = a.in[25], *ib = a.in[26], *fb = a.in[27], *gnw = a.in[28], *skip = a.in[29];
    int T, row0, h, sb = -1; float *Cout, *nout, *mout, *convout;
    if (item < 32) { const int b = item >> 2; h = item & 3; T = SEQ; row0 = b * SEQ; Cout = a.out + O_PC + (size_t)item * 16384; nout = a.out + O_PN + (size_t)item * 128; mout = a.out + O_PMM + item; convout = a.out + O_PCONV + (size_t)b * 3 * 512 + h * 128; }
    else { const int it2 = item - 32; sb = it2 >> 2; h = it2 & 3; T = 1; row0 = MP + sb; Cout = a.out + O_SC + (size_t)it2 * 16384; nout = a.out + O_SN + (size_t)it2 * 128; mout = a.out + O_SMM + it2; convout = a.out + O_SCONV + (size_t)sb * 3 * 512 + h * 128; }
    const int hc = h * 128;
    LAS float* XMW = (LAS float*)ldsb;
    LAS float* XC = XMW + (MCH + 3) * 128;
    LAS float* Qb = XC + MCH * 128;
    LAS float* Kb = Qb + MCH * 128;
    LAS float* Vb = Kb + MCH * 128;
    LAS float* Ob = Vb + MCH * 128;
    LAS float* HP = Ob + MCH * 128;
    LAS float* FS = HP + MCH * 512;
    LAS float* IS = FS + MCH;
    LAS float* EM = IS + MCH;
    LAS float* DEN = EM + MCH;
    LAS float* MST = DEN + 2 * MCH;
    const int e = tid & 127, dq = tid >> 7;
    float C[32]; float nreg = 0.f;
    if (sb >= 0) {
        const float* C0 = a.in[4] + (size_t)(item - 32) * 16384;
#pragma unroll
        for (int i = 0; i < 32; ++i) C[i] = C0[(size_t)(32 * dq + i) * 128 + e];
        if (tid < 128) nreg = a.in[5][(size_t)(item - 32) * 128 + tid];
        if (tid == 0) MST[0] = a.in[6][item - 32];
        if (tid < 384) XMW[tid] = a.in[7][(size_t)sb * 3 * 512 + (tid >> 7) * 512 + hc + (tid & 127)];
    } else {
#pragma unroll
        for (int i = 0; i < 32; ++i) C[i] = 0.f;
        if (tid == 0) MST[0] = 0.f;
        if (tid < 384) XMW[tid] = 0.f;
    }
    const float cw0 = convw[0 * 512 + hc + e], cw1 = convw[1 * 512 + hc + e], cw2 = convw[2 * 512 + hc + e], cw3 = convw[3 * 512 + hc + e], cbe = convb[hc + e];
    const float ibh = ib[h], fbh = fb[h];
    __syncthreads();
    for (int t0 = 0; t0 < T; t0 += MCH) {
        const int nt = (T - t0) < MCH ? (T - t0) : MCH;
        for (int t = dq; t < nt; t += 4) { const size_t r = (size_t)(row0 + t0 + t) * NPM;
            XMW[(t + 3) * 128 + e] = bf2f(PM[r + hc + e]); Vb[t * 128 + e] = bf2f(PM[r + 512 + hc + e]); Ob[t * 128 + e] = sigmoidf_(bf2f(PM[r + 1024 + hc + e])); }
        __syncthreads();
        for (int t = dq; t < nt; t += 4) { const float x = cbe + XMW[t * 128 + e] * cw0 + XMW[(t + 1) * 128 + e] * cw1 + XMW[(t + 2) * 128 + e] * cw2 + XMW[(t + 3) * 128 + e] * cw3;
            XC[t * 128 + e] = x / (1.0f + expf(-x)); }
        if (tid == 0) { float m = MST[0];
            for (int t = 0; t < nt; ++t) { const float* g = GATES + (size_t)(row0 + t0 + t) * 8;
                const float li = g[h] + ibh, fr = g[4 + h] + fbh; const float lf = fminf(fr, 0.f) - log1pf(expf(-fabsf(fr)));
                const float mn = fmaxf(lf + m, li); FS[t] = expf(lf + m - mn); IS[t] = expf(li - mn); EM[t] = expf(-mn); m = mn; }
            MST[0] = m; }
        __syncthreads();
        { float aq[MCH / 4], ak[MCH / 4];
#pragma unroll
          for (int i = 0; i < MCH / 4; ++i) { aq[i] = 0.f; ak[i] = 0.f; }
          for (int d4 = 0; d4 < 32; ++d4) {
              float q4[4], k4[4];
#pragma unroll
              for (int q = 0; q < 4; ++q) { q4[q] = wq[(size_t)(hc + 4 * d4 + q) * 128 + e]; k4[q] = wk[(size_t)(hc + 4 * d4 + q) * 128 + e]; }
#pragma unroll
              for (int tt = 0; tt < MCH / 4; ++tt) { const int t = dq + 4 * tt; if (t < nt) { const f32x4 x = *(const LAS f32x4*)(XC + t * 128 + 4 * d4);
                  aq[tt] += (x.x * q4[0] + x.y * q4[1]) + (x.z * q4[2] + x.w * q4[3]); ak[tt] += (x.x * k4[0] + x.y * k4[1]) + (x.z * k4[2] + x.w * k4[3]); } }
          }
#pragma unroll
          for (int tt = 0; tt < MCH / 4; ++tt) { const int t = dq + 4 * tt; if (t < nt) { Qb[t * 128 + e] = aq[tt] * 0.08838834764831845f; Kb[t * 128 + e] = ak[tt]; } }
        }
        __syncthreads();
        for (int t = 0; t < nt; ++t) {
            const float fs = FS[t], is = IS[t]; const float ve = Vb[t * 128 + e] * is; float hp = 0.f;
#pragma unroll
            for (int i = 0; i < 8; ++i) { const f32x4 k = *(const LAS f32x4*)(Kb + t * 128 + 32 * dq + 4 * i), q = *(const LAS f32x4*)(Qb + t * 128 + 32 * dq + 4 * i);
                C[4 * i + 0] = fs * C[4 * i + 0] + k.x * ve; hp += q.x * C[4 * i + 0];
                C[4 * i + 1] = fs * C[4 * i + 1] + k.y * ve; hp += q.y * C[4 * i + 1];
                C[4 * i + 2] = fs * C[4 * i + 2] + k.z * ve; hp += q.z * C[4 * i + 2];
                C[4 * i + 3] = fs * C[4 * i + 3] + k.w * ve; hp += q.w * C[4 * i + 3]; }
            HP[t * 512 + dq * 128 + e] = hp;
            if (tid < 128) { nreg = fs * nreg + is * Kb[t * 128 + tid]; const float dn = wave_sum(Qb[t * 128 + tid] * nreg); if (lane == 0) DEN[t * 2 + wv] = dn; }
        }
        __syncthreads();
        for (int t = wv; t < nt; t += 8) {
            const float den = DEN[t * 2] + DEN[t * 2 + 1]; const float dd = fmaxf(fabsf(den), EM[t]);
            float hv[2];
#pragma unroll
            for (int q = 0; q < 2; ++q) { const int ee = lane + 64 * q; hv[q] = (HP[t * 512 + ee] + HP[t * 512 + 128 + ee] + HP[t * 512 + 256 + ee] + HP[t * 512 + 384 + ee]) / dd; }
            const float mean = wave_sum(hv[0] + hv[1]) * (1.0f / 128.0f); const float d0 = hv[0] - mean, d1 = hv[1] - mean;
            const float var = wave_sum(d0 * d0 + d1 * d1) * (1.0f / 128.0f); const float rs = rsqrtf(var + M_GN_EPS);
#pragma unroll
            for (int q = 0; q < 2; ++q) { const int ee = lane + 64 * q; float o = (q ? d1 : d0) * rs * gnw[hc + ee] + skip[hc + ee] * XC[t * 128 + ee]; o *= Ob[t * 128 + ee];
                YM[(size_t)(row0 + t0 + t) * 512 + hc + ee] = (bf16)f2bf(o); }
        }
        __syncthreads();
        float keep = 0.f; if (tid < 384) keep = XMW[(nt + (tid >> 7)) * 128 + (tid & 127)];
        __syncthreads();
        if (tid < 384) XMW[tid] = keep;
        __syncthreads();
    }
#pragma unroll
    for (int i = 0; i < 32; ++i) Cout[(size_t)(32 * dq + i) * 128 + e] = C[i];
    if (tid < 128) nout[tid] = nreg;
    if (tid == 0) mout[0] = MST[0];
    if (tid < 384) convout[(tid >> 7) * 512 + (tid & 127)] = XMW[tid];
}

__device__ __forceinline__ void final_norm_rows(const Args& a, int gw, int NGW, int lane) {
    const float* ssq = (const float*)(a.ws + WS_SSQ2); const float* gf = a.in[36];
    f32x4 gv[4];
#pragma unroll
    for (int j = 0; j < 4; ++j) gv[j] = ((const f32x4*)gf)[lane + 64 * j];
    for (int row = gw; row < MTOK; row += NGW) { const float rs = rsqrtf(ssq[row] * (1.0f / 1024.0f) + RMS_EPS); f32x4* p = (f32x4*)(a.out + (size_t)row * 1024) + lane;
#pragma unroll
        for (int j = 0; j < 4; ++j) p[64 * j] = p[64 * j] * rs * gv[j]; }
}


__device__ __forceinline__ unsigned long long rt() { return __builtin_amdgcn_s_memrealtime(); }
#define XB_TMO      128
#define XB_XCNT(j)  (256  + 64 * (j))
#define XB_XSUB(j)  (1280 + 64 * (j))
#define XB_XGEN(j)  (2304 + 64 * (j))
#define XB_TOP      3328
#define XB_TOPGEN   3392
#define XCD_BAR_WORDS 3456
#define XB_SPIN_CAP (1u << 18)

__device__ __forceinline__ unsigned xb_ld(unsigned* p)              { return __hip_atomic_load(p, __ATOMIC_RELAXED, __HIP_MEMORY_SCOPE_AGENT); }
__device__ __forceinline__ unsigned xb_add(unsigned* p, unsigned v) { return __hip_atomic_fetch_add(p, v, __ATOMIC_RELAXED, __HIP_MEMORY_SCOPE_AGENT); }
__device__ __forceinline__ unsigned xb_xcc_id() { return (unsigned)__builtin_amdgcn_s_getreg((3 << 11) | 20) & 0xFu; }
#define XB_SPIN(cond, bar) do { unsigned _sp = 0; while (cond) { __builtin_amdgcn_s_sleep(1); \
    if ((++_sp & 255u) == 0u) { if (xb_ld(&(bar)[XB_TMO])) break; if (_sp > XB_SPIN_CAP) { atomicAdd(&(bar)[XB_TMO], 1u); break; } } } } while (0)

struct XcdBarrier {
    unsigned* bar; unsigned x;
    volatile LAS unsigned* st;
};

__device__ __forceinline__ XcdBarrier xcd_barrier_post(unsigned* bar, volatile LAS unsigned* st) {
    XcdBarrier b; b.bar = bar; b.x = xb_xcc_id(); b.st = st;
    if (threadIdx.x == 0) (void)xb_add(&bar[XB_XCNT(b.x)], 1u);
    return b;
}
__device__ __forceinline__ void xcd_barrier_complete(unsigned* bar, unsigned x, unsigned& nloc, unsigned& nx) {
    const unsigned G = gridDim.x * gridDim.y * gridDim.z;
    unsigned sum, cnt, mine, sp = 0u;
    for (;;) {
        sum = 0u; cnt = 0u; mine = 0u;
#pragma unroll
        for (unsigned j = 0; j < 16; ++j) { const unsigned c = xb_ld(&bar[XB_XCNT(j)]); sum += c; cnt += (c > 0u) ? 1u : 0u; mine = (j == x) ? c : mine; }
        if (sum == G) break;
        __builtin_amdgcn_s_sleep(1);
        if ((++sp & 255u) == 0u) { if (xb_ld(&bar[XB_TMO])) break; if (sp > XB_SPIN_CAP) { atomicAdd(&bar[XB_TMO], 1u); break; } }
    }
    nloc = mine > 0u ? mine : 1u; nx = cnt > 0u ? cnt : 1u;
}

__device__ __forceinline__ void xcd_barrier(const XcdBarrier& b) {
    asm volatile("s_waitcnt vmcnt(0)" ::: "memory");
    __syncthreads();
    if (threadIdx.x == 0) {
        unsigned* bar = b.bar;
        __builtin_amdgcn_s_waitcnt(0);
        unsigned nloc = b.st[0], nx = b.st[1];
        if (nloc == 0u) { xcd_barrier_complete(bar, b.x, nloc, nx); b.st[0] = nloc; b.st[1] = nx; }
        const unsigned old = xb_add(&bar[XB_XSUB(b.x)], 1u);
        const unsigned gen = old / nloc;
        if (old + 1u == (gen + 1u) * nloc) {
            __builtin_amdgcn_fence(__ATOMIC_RELEASE, "agent");
            asm volatile("s_waitcnt vmcnt(0)" ::: "memory");
            const unsigned og = xb_add(&bar[XB_TOP], 1u);
            const unsigned tg = og / nx;
            if (og + 1u == (tg + 1u) * nx) xb_add(&bar[XB_TOPGEN], 1u);
            else XB_SPIN(xb_ld(&bar[XB_TOPGEN]) == tg, bar);
            __builtin_amdgcn_fence(__ATOMIC_ACQUIRE, "agent");
            xb_add(&bar[XB_XGEN(b.x)], 1u);
            asm volatile("s_waitcnt vmcnt(0)" ::: "memory");
        } else {
            XB_SPIN(xb_ld(&bar[XB_XGEN(b.x)]) == gen, bar);
            __builtin_amdgcn_fence(__ATOMIC_ACQUIRE, "agent");
            asm volatile("s_waitcnt vmcnt(0)" ::: "memory");
        }
    }
    __syncthreads();
}


constexpr size_t WS_BAR = 512 * 1024;
constexpr int MISC_OFF = 131072, MEGA_LDS = 147456;
static_assert(2 * RWKV_LDS <= MISC_OFF && MLSTM_LDS <= MISC_OFF && P0_LDS <= MISC_OFF, "LDS map");

__global__ void __launch_bounds__(NTHR, 2) mega_fwd(Args a) {
    extern __shared__ __attribute__((aligned(16))) unsigned char lds_raw[];
    LAS unsigned char* lds = (LAS unsigned char*)lds_raw;
    volatile LAS unsigned* MISC = (volatile LAS unsigned*)(lds + MISC_OFF);
    const int tid = threadIdx.x, lane = tid & 63, wave = __builtin_amdgcn_readfirstlane(tid >> 6);
    const int G = gridDim.x, bx = blockIdx.x;
    unsigned char* ws = a.ws;
    if (tid < 64) MISC[tid] = 0u;
    __syncthreads();
    XcdBarrier bar = xcd_barrier_post((unsigned*)(ws + WS_BAR), MISC + 8);

    p0_prologue(a, lds, bx * NWAVES + wave, G * NWAVES, lane, wave);
    xcd_barrier(bar);
    { pg8::StaticOrder S; pg8::Gemm g{(const bf16*)(ws + WS_XN), (const bf16*)(ws + WS_WINT), MT, NPROJ, 1024}; S.init(MT, NPROJ, G, bx);
      pg8::EpiProj E{(bf16*)(ws + WS_PR), (bf16*)(ws + WS_PM), (bf16*)(ws + WS_PG), a.in[31]}; pg8::gemm_phase<pg8::EpiProj, pg8::StaticOrder, true, true>(lds, g, S, E); }
    xcd_barrier(bar);
    {
        for (int bi = bx; bi < 64; bi += G) { if (bi < 32) rwkv_seq_item(a, lds, 2 * bi); else mlstm_seq_item(a, lds, bi - 32); __syncthreads(); }
        const int first = G > 64 ? 64 : 0, nsb = G - first;
        if (bx >= first) for (int s = bx - first; s < 1024; s += nsb) { if (s < 512) rwkv_seq_item(a, lds, 64 + 2 * s); else mlstm_seq_item(a, lds, 32 + (s - 512)); __syncthreads(); }
    }
    xcd_barrier(bar);
    { pg8::StaticOrder S; pg8::Gemm g{(const bf16*)(ws + WS_YR), (const bf16*)(ws + WS_UPRT), MT, 1024, 512}; S.init(MT, 1024, G, bx);
      pg8::EpiUp1 E{(float*)(ws + WS_UPSCR), (const bf16*)(ws + WS_PG)}; pg8::gemm_phase<pg8::EpiUp1, pg8::StaticOrder, true, true>(lds, g, S, E); }
    xcd_barrier(bar);
    { pg8::StaticOrder S; pg8::Gemm g{(const bf16*)(ws + WS_YM), (const bf16*)(ws + WS_UPMT), MT, 1024, 512}; S.init(MT, 1024, G, bx);
      pg8::EpiUp2 E{(const float*)(ws + WS_UPSCR), (const bf16*)(ws + WS_PG), (bf16*)(ws + WS_MERGED)}; pg8::gemm_phase<pg8::EpiUp2, pg8::StaticOrder, true, true>(lds, g, S, E); }
    xcd_barrier(bar);
    { pg8::StaticOrder S; pg8::Gemm g{(const bf16*)(ws + WS_MERGED), (const bf16*)(ws + WS_WOUTT), MT, 1024, 1024}; S.init(MT, 1024, G, bx);
      pg8::EpiOut E{a.in[0], a.in[1], a.out, (bf16*)(ws + WS_X2B), a.in[33], (float*)(ws + WS_SSQ1)}; pg8::gemm_phase<pg8::EpiOut, pg8::StaticOrder, true, true>(lds, g, S, E); }
    xcd_barrier(bar);
    { pg8::StaticOrder S; pg8::Gemm g{(const bf16*)(ws + WS_X2B), (const bf16*)(ws + WS_W1T), MT, FF, 1024}; S.init(MT, FF, G, bx);
      pg8::EpiFfn1 E{(bf16*)(ws + WS_H), (const float*)(ws + WS_SSQ1)}; pg8::gemm_phase<pg8::EpiFfn1, pg8::StaticOrder, true, true>(lds, g, S, E); }
    xcd_barrier(bar);
    { pg8::StaticOrder S; pg8::Gemm g{(const bf16*)(ws + WS_H), (const bf16*)(ws + WS_W2T), MT, 1024, FF}; S.init(MT, 1024, G, bx);
      pg8::EpiFfn2 E{a.out, (float*)(ws + WS_SSQ2)}; pg8::gemm_phase<pg8::EpiFfn2, pg8::StaticOrder, true, true>(lds, g, S, E); }
    xcd_barrier(bar);
    final_norm_rows(a, bx * NWAVES + wave, G * NWAVES, lane);
}

extern "C" void kernel_launch(void* const* d_in, const int* in_sizes, int n_in, void* d_out, int out_size, void* d_ws, size_t ws_size, hipStream_t stream) {
    static int grid = 0;
    if (grid == 0) {
        if (n_in != 37 || (size_t)out_size != O_END || ws_size < WS_NEED) { fprintf(stderr, "kernel_launch: unexpected problem: n_in %d out %d ws %zu\n", n_in, out_size, ws_size); grid = -1; return; }
        int dev = 0, cus = 0, per_cu = 0;
        if (hipGetDevice(&dev) != hipSuccess || hipDeviceGetAttribute(&cus, hipDeviceAttributeMultiprocessorCount, dev) != hipSuccess) { fprintf(stderr, "kernel_launch: device query failed\n"); grid = -1; return; }
        if (hipFuncSetAttribute((const void*)mega_fwd, hipFuncAttributeMaxDynamicSharedMemorySize, MEGA_LDS) != hipSuccess) { fprintf(stderr, "kernel_launch: hipFuncSetAttribute failed\n"); grid = -1; return; }
        if (hipOccupancyMaxActiveBlocksPerMultiprocessor(&per_cu, (const void*)mega_fwd, NTHR, MEGA_LDS) != hipSuccess || per_cu < 1) { fprintf(stderr, "kernel_launch: occupancy query reports %d workgroups per CU\n", per_cu); (void)hipGetLastError(); per_cu = 1; }
        grid = cus;
    }
    if (grid < 0) return;
    if (hipMemsetAsync((char*)d_ws + WS_BAR, 0, 16384, stream) != hipSuccess) { fprintf(stderr, "kernel_launch: memset failed\n"); return; }
    Args a{};
    for (int i = 0; i < 37; ++i) a.in[i] = (const float*)d_in[i];
    a.out = (float*)d_out; a.ws = (unsigned char*)d_ws;
    void* args[] = {&a};
    hipError_t e = hipLaunchCooperativeKernel((const void*)mega_fwd, dim3(grid), dim3(NTHR), args, MEGA_LDS, stream);
    if (e != hipSuccess) fprintf(stderr, "kernel_launch: cooperative launch failed: %s (grid %d)\n", hipGetErrorString(e), grid);
}
```

```cpp
#include <hip/hip_runtime.h>
#include <cstdio>
#include <cstdint>

constexpr int DM = 1024, MP = 16384, MS = 128, MTOK = MP + MS, MT = 16640;
constexpr int SEQ = 2048, NB = 8;
constexpr int NPR = 1792, NPM = 1536, NPG = 2048, NPROJ = NPR + NPM + NPG, INCOLS = 5384, GCOL0 = 3328;
constexpr int RH = 8, RN = 64, RW = 512, MH = 4, MD = 128, MW = 512, FF = 4096;
constexpr float RMS_EPS = 1e-6f, R_GN_EPS = 64e-5f, M_GN_EPS = 1e-5f;

constexpr size_t O_Y = 0;
constexpr size_t O_PSHIFT = (size_t)MTOK * DM;
constexpr size_t O_PWKV = O_PSHIFT + (size_t)NB * DM;
constexpr size_t O_PC = O_PWKV + (size_t)NB * RH * RN * RN;
constexpr size_t O_PN = O_PC + (size_t)NB * MH * MD * MD;
constexpr size_t O_PMM = O_PN + (size_t)NB * MH * MD;
constexpr size_t O_PCONV = O_PMM + (size_t)NB * MH;
constexpr size_t O_SSHIFT = O_PCONV + (size_t)NB * 3 * MW;
constexpr size_t O_SWKV = O_SSHIFT + (size_t)MS * DM;
constexpr size_t O_SC = O_SWKV + (size_t)MS * RH * RN * RN;
constexpr size_t O_SN = O_SC + (size_t)MS * MH * MD * MD;
constexpr size_t O_SMM = O_SN + (size_t)MS * MH * MD;
constexpr size_t O_SCONV = O_SMM + (size_t)MS * MH;
constexpr size_t O_END = O_SCONV + (size_t)MS * 3 * MW;
static_assert(O_END == 30695968, "output size");

constexpr size_t MiB = 1u << 20;
constexpr size_t WS_CTL = 0;
constexpr size_t WS_SSQ1 = 0, WS_SSQ2 = 128 * 1024;
constexpr size_t WS_WINT = 1 * MiB, WS_UPRT = 12 * MiB, WS_UPMT = 13 * MiB, WS_WOUTT = 14 * MiB, WS_W1T = 16 * MiB, WS_W2T = 24 * MiB;
constexpr size_t WS_GATES = 32 * MiB;
constexpr size_t WS_WQT = 32 * MiB + 576 * 1024, WS_WKT = 32 * MiB + 704 * 1024;
constexpr size_t WS_XN = 33 * MiB;
constexpr size_t WS_YM = 33 * MiB, WS_X2B = 33 * MiB;
constexpr size_t WS_PR = 66 * MiB;
constexpr size_t WS_PM = 123 * MiB;
constexpr size_t WS_PG = 172 * MiB;
constexpr size_t WS_YR = 237 * MiB;
constexpr size_t WS_MERGED = 66 * MiB;
constexpr size_t WS_UPSCR = 100 * MiB;
constexpr size_t WS_H = 66 * MiB;
constexpr size_t WS_NEED = 256 * MiB;
static_assert(WS_YR + (size_t)MT * 512 * 2 <= WS_NEED && WS_H + (size_t)MT * FF * 2 <= WS_NEED && WS_PG + (size_t)MT * NPG * 2 <= WS_YR && WS_UPSCR + (size_t)MT * DM * 4 <= WS_PG, "ws map");

#define GAS __attribute__((address_space(1)))
#define LAS __attribute__((address_space(3)))
typedef unsigned short bf16;
typedef unsigned v4u __attribute__((ext_vector_type(4)));
typedef unsigned v2u __attribute__((ext_vector_type(2)));
typedef float f32x4 __attribute__((ext_vector_type(4)));
typedef float f32x2 __attribute__((ext_vector_type(2)));
__device__ __forceinline__ unsigned f2bf(float f) { unsigned u = __builtin_bit_cast(unsigned, f); return (u + 0x7fffu + ((u >> 16) & 1u)) >> 16; }
__device__ __forceinline__ unsigned pk2(float lo, float hi) { return f2bf(lo) | (f2bf(hi) << 16); }
__device__ __forceinline__ float bf2f(unsigned b) { return __builtin_bit_cast(float, b << 16); }
__device__ __forceinline__ float bflo(unsigned w) { return __builtin_bit_cast(float, w << 16); }
__device__ __forceinline__ float bfhi(unsigned w) { return __builtin_bit_cast(float, w & 0xffff0000u); }
__device__ __forceinline__ float sigmoidf_(float x) { return 1.0f / (1.0f + __expf(-x)); }
__device__ __forceinline__ float wave_sum(float v) {
#pragma unroll
    for (int o = 1; o < 64; o <<= 1) v += __shfl_xor(v, o);
    return v;
}

namespace pg8 {
#define PG8_LAS __attribute__((address_space(3)))
typedef unsigned short bf16_t;
typedef short bf16x8 __attribute__((ext_vector_type(8)));
typedef float f32x4 __attribute__((ext_vector_type(4)));
typedef unsigned u32x4 __attribute__((ext_vector_type(4)));
constexpr int BM = 256, BK = 64, HALF = 128, HTB = HALF * BK * 2  , STAGE_BYTES = 8 * HTB, NXCD = 8, WGM = 8;

__host__ __device__ __forceinline__ int lds_byte(int r, int c) { const int st = (r >> 4) * 2 + (c >> 5), rr = r & 15, cc = c & 31, ob = rr * 64 + cc * 2; return st * 1024 + (ob ^ (((ob >> 9) & 1) << 5)); }
__host__ __device__ __forceinline__ void stage_rc(int b, int& R, int& C) { const int st = b / 1024, sb = b % 1024, swz = sb ^ (((sb >> 9) & 1) << 5); R = (st >> 1) * 16 + swz / 64; C = (st & 1) * 32 + (swz % 64) / 2; }
__host__ __device__ __forceinline__ int perm32(int rho) { const int n = rho >> 4, i = rho & 15; return 8 * (i >> 2) + 4 * n + (i & 3); }

struct Unit { int pm, pn; };
struct Gemm { const bf16_t* A; const bf16_t* Bt; int M, N, K; };

struct StaticOrder {
    int nM, nN, nwg, G, c;
    __host__ __device__ void init(int M, int N, int G_, int c_) { nM = M / BM; nN = N / BM; nwg = nM * nN; G = G_; c = c_; }
    __host__ __device__ bool next(int i, Unit& u) const {
        const long L = (long)i * G + c; if (L >= nwg) return false;
        int wgid = (int)L; { const int q = nwg / NXCD, r = nwg % NXCD, xcd = wgid % NXCD, off = wgid / NXCD; wgid = (xcd < r ? xcd * (q + 1) : r * (q + 1) + (xcd - r) * q) + off; }
        const int nig = WGM * nN, gid = wgid / nig, fm = gid * WGM, gsz = (nM - fm) < WGM ? (nM - fm) : WGM;
        u.pm = fm + ((wgid % nig) % gsz); u.pn = (wgid % nig) / gsz; return true;
    }
    __device__ __forceinline__ void a_ready(const Unit&) const {}
    __device__ __forceinline__ void done(const Unit&) const {}
};

__device__ __forceinline__ unsigned cvt_pk_bf16(float lo, float hi) { unsigned r; asm volatile("v_cvt_pk_bf16_f32 %0, %1, %2" : "=v"(r) : "v"(lo), "v"(hi)); return r; }
typedef unsigned u32x2 __attribute__((ext_vector_type(2)));
__device__ __forceinline__ float sigm(float x) { return 1.0f / (1.0f + __expf(-x)); }
__device__ __forceinline__ float bf_lo(unsigned w) { return __builtin_bit_cast(float, w << 16); }
__device__ __forceinline__ float bf_hi(unsigned w) { return __builtin_bit_cast(float, w & 0xffff0000u); }

struct EpiProj {
    static constexpr bool PERM = true, AFTER_DRAIN = false;
    bf16_t *PR, *PM, *PG; const float* gate_b;
    __device__ __forceinline__ void operator()(const f32x4 (&acc)[2][2][4][2], const Unit& u, int wr, int wc, int fr, int fq) const {
        int colt = u.pn * BM; bf16_t* base; int ldc; bool gate = false;
        if (colt < 1792) { base = PR; ldc = 1792; } else if (colt < 3328) { base = PM; ldc = 1536; colt -= 1792; } else { base = PG; ldc = 2048; colt -= 3328; gate = true; }
        const int row0 = u.pm * BM + wr * 64 + fr, col0 = colt + wc * 32 + 8 * fq;
        f32x4 bv[2][2];
#pragma unroll
        for (int bj = 0; bj < 2; ++bj)
#pragma unroll
            for (int n = 0; n < 2; ++n) bv[bj][n] = gate ? *(const f32x4*)(gate_b + col0 + bj * HALF + 4 * n) : (f32x4){0.f, 0.f, 0.f, 0.f};
#pragma unroll
        for (int ai = 0; ai < 2; ++ai)
#pragma unroll
            for (int m = 0; m < 4; ++m) { bf16_t* rowp = base + (size_t)(row0 + ai * HALF + m * 16) * ldc + col0;
#pragma unroll
                for (int bj = 0; bj < 2; ++bj) { f32x4 v0 = acc[ai][bj][m][0] + bv[bj][0], v1 = acc[ai][bj][m][1] + bv[bj][1];
                    if (gate) {
#pragma unroll
                        for (int j = 0; j < 4; ++j) { v0[j] = sigm(v0[j]); v1[j] = sigm(v1[j]); } }
                    u32x4 w; w.x = cvt_pk_bf16(v0[0], v0[1]); w.y = cvt_pk_bf16(v0[2], v0[3]); w.z = cvt_pk_bf16(v1[0], v1[1]); w.w = cvt_pk_bf16(v1[2], v1[3]);
                    *(u32x4*)(rowp + bj * HALF) = w; } }
    }
};
struct EpiUp1 {
    static constexpr bool PERM = false, AFTER_DRAIN = false;
    float* SCR; const bf16_t* PG;
    __device__ __forceinline__ void operator()(const f32x4 (&acc)[2][2][4][2], const Unit& u, int wr, int wc, int fr, int fq) const {
        const int row0 = u.pm * BM + wr * 64 + fr, col0 = u.pn * BM + wc * 32 + 4 * fq;
#pragma unroll
        for (int ai = 0; ai < 2; ++ai)
#pragma unroll
            for (int m = 0; m < 4; ++m) { const size_t row = (size_t)(row0 + ai * HALF + m * 16);
#pragma unroll
                for (int bj = 0; bj < 2; ++bj)
#pragma unroll
                    for (int n = 0; n < 2; ++n) { const int c = col0 + bj * HALF + n * 16; const u32x2 g = *(const u32x2*)(PG + row * 2048 + c);
                        f32x4 v = acc[ai][bj][m][n]; v[0] *= bf_lo(g.x); v[1] *= bf_hi(g.x); v[2] *= bf_lo(g.y); v[3] *= bf_hi(g.y);
                        *(f32x4*)(SCR + row * 1024 + c) = v; } }
    }
};
struct EpiUp2 {
    static constexpr bool PERM = false, AFTER_DRAIN = false;
    const float* SCR; const bf16_t* PG; bf16_t* MG;
    __device__ __forceinline__ void operator()(const f32x4 (&acc)[2][2][4][2], const Unit& u, int wr, int wc, int fr, int fq) const {
        const int row0 = u.pm * BM + wr * 64 + fr, col0 = u.pn * BM + wc * 32 + 4 * fq;
#pragma unroll
        for (int ai = 0; ai < 2; ++ai)
#pragma unroll
            for (int m = 0; m < 4; ++m) { const size_t row = (size_t)(row0 + ai * HALF + m * 16);
#pragma unroll
                for (int bj = 0; bj < 2; ++bj)
#pragma unroll
                    for (int n = 0; n < 2; ++n) { const int c = col0 + bj * HALF + n * 16; const u32x2 g = *(const u32x2*)(PG + row * 2048 + 1024 + c);
                        const f32x4 s = *(const f32x4*)(SCR + row * 1024 + c); f32x4 v = acc[ai][bj][m][n];
                        v[0] = s[0] + v[0] * bf_lo(g.x); v[1] = s[1] + v[1] * bf_hi(g.x); v[2] = s[2] + v[2] * bf_lo(g.y); v[3] = s[3] + v[3] * bf_hi(g.y);
                        u32x2 w; w.x = cvt_pk_bf16(v[0], v[1]); w.y = cvt_pk_bf16(v[2], v[3]); *(u32x2*)(MG + row * 1024 + c) = w; } }
    }
};
struct EpiOut {
    static constexpr bool PERM = false, AFTER_DRAIN = false;
    const float *xp, *xs; float* OUT; bf16_t* X2B; const float* gffn; float* ssq;
    __device__ __forceinline__ void operator()(const f32x4 (&acc)[2][2][4][2], const Unit& u, int wr, int wc, int fr, int fq) const {
        const int row0 = u.pm * BM + wr * 64 + fr, col0 = u.pn * BM + wc * 32 + 4 * fq;
        f32x4 gv[2][2];
#pragma unroll
        for (int bj = 0; bj < 2; ++bj)
#pragma unroll
            for (int n = 0; n < 2; ++n) gv[bj][n] = *(const f32x4*)(gffn + col0 + bj * HALF + n * 16);
#pragma unroll
        for (int ai = 0; ai < 2; ++ai) {
            if (u.pm * BM + ai * HALF >= 16512) continue;
#pragma unroll
            for (int m = 0; m < 4; ++m) { const int row = row0 + ai * HALF + m * 16;
                const float* xin = row < 16384 ? xp + (size_t)row * 1024 : xs + (size_t)(row - 16384) * 1024; float sq = 0.f;
#pragma unroll
                for (int bj = 0; bj < 2; ++bj)
#pragma unroll
                    for (int n = 0; n < 2; ++n) { const int c = col0 + bj * HALF + n * 16; const f32x4 v = *(const f32x4*)(xin + c) + acc[ai][bj][m][n];
                        *(f32x4*)(OUT + (size_t)row * 1024 + c) = v; sq += (v[0] * v[0] + v[1] * v[1]) + (v[2] * v[2] + v[3] * v[3]);
                        const f32x4 h = v * gv[bj][n]; u32x2 w; w.x = cvt_pk_bf16(h[0], h[1]); w.y = cvt_pk_bf16(h[2], h[3]); *(u32x2*)(X2B + (size_t)row * 1024 + c) = w; }
                sq += __shfl_xor(sq, 16); sq += __shfl_xor(sq, 32);
                if (fq == 0) atomicAdd(ssq + row, sq); }
        }
    }
};
struct EpiFfn1 {
    static constexpr bool PERM = true, AFTER_DRAIN = false;
    bf16_t* H; const float* ssq;
    __device__ __forceinline__ void operator()(const f32x4 (&acc)[2][2][4][2], const Unit& u, int wr, int wc, int fr, int fq) const {
        const int row0 = u.pm * BM + wr * 64 + fr, col0 = u.pn * BM + wc * 32 + 8 * fq;
#pragma unroll
        for (int ai = 0; ai < 2; ++ai)
#pragma unroll
            for (int m = 0; m < 4; ++m) { const int row = row0 + ai * HALF + m * 16; const float rs = rsqrtf(ssq[row] * (1.0f / 1024.0f) + 1e-6f);
                bf16_t* rowp = H + (size_t)row * 4096 + col0;
#pragma unroll
                for (int bj = 0; bj < 2; ++bj) { f32x4 v0 = acc[ai][bj][m][0] * rs, v1 = acc[ai][bj][m][1] * rs;
#pragma unroll
                    for (int j = 0; j < 4; ++j) { const float a = fmaxf(v0[j], 0.f), b = fmaxf(v1[j], 0.f); v0[j] = a * a; v1[j] = b * b; }
                    u32x4 w; w.x = cvt_pk_bf16(v0[0], v0[1]); w.y = cvt_pk_bf16(v0[2], v0[3]); w.z = cvt_pk_bf16(v1[0], v1[1]); w.w = cvt_pk_bf16(v1[2], v1[3]);
                    *(u32x4*)(rowp + bj * HALF) = w; } }
    }
};
struct EpiFfn2 {
    static constexpr bool PERM = false, AFTER_DRAIN = false;
    float* OUT; float* ssq;
    __device__ __forceinline__ void operator()(const f32x4 (&acc)[2][2][4][2], const Unit& u, int wr, int wc, int fr, int fq) const {
        const int row0 = u.pm * BM + wr * 64 + fr, col0 = u.pn * BM + wc * 32 + 4 * fq;
#pragma unroll
        for (int ai = 0; ai < 2; ++ai) {
            if (u.pm * BM + ai * HALF >= 16512) continue;
#pragma unroll
            for (int m = 0; m < 4; ++m) { const int row = row0 + ai * HALF + m * 16; float sq = 0.f;
#pragma unroll
                for (int bj = 0; bj < 2; ++bj)
#pragma unroll
                    for (int n = 0; n < 2; ++n) { float* p = OUT + (size_t)row * 1024 + col0 + bj * HALF + n * 16; const f32x4 v = *(const f32x4*)p + acc[ai][bj][m][n];
                        *(f32x4*)p = v; sq += (v[0] * v[0] + v[1] * v[1]) + (v[2] * v[2] + v[3] * v[3]); }
                sq += __shfl_xor(sq, 16); sq += __shfl_xor(sq, 32);
                if (fq == 0) atomicAdd(ssq + row, sq); }
        }
    }
};

template <class Epi, class Sched, bool ALIGN_EPI = false, bool SP2 = false>
__device__ __forceinline__ void gemm_phase(PG8_LAS unsigned char* lds, const Gemm g, const Sched& S, const Epi& E) {
    const int tid = threadIdx.x, wid = __builtin_amdgcn_readfirstlane(tid >> 6), lane = tid & 63, wr = wid >> 2, wc = wid & 3, fr = lane & 15, fq = lane >> 4;
    const int K = g.K, nt = K / BK;
    unsigned voffA[2], voffB[2];
#pragma unroll
    for (int i = 0; i < 2; ++i) { int R, C; stage_rc(tid * 16 + i * 8192, R, C); const int Rb = Epi::PERM ? ((R & ~31) + perm32(R & 31)) : R;
        voffA[i] = (unsigned)(R * K + C) * 2u; voffB[i] = (unsigned)(Rb * K + C) * 2u; }
    const size_t kstep = (size_t)(BK * 2);
    const size_t hstep = (size_t)HALF * K * 2;
    const size_t tstep = 2 * hstep;
    const unsigned ldsw = (unsigned)wid * 1024u;
    const int aoff = lds_byte(wr * 64 + fr, fq * 8), boff = lds_byte(wc * 32 + fr, fq * 8);
#define PG8_SA(b, h) (((b) * 2 + (h)) * HTB)
#define PG8_SB(b, h) ((4 + (b) * 2 + (h)) * HTB)
#define PG8_STAGE(bufoff, gbase, voff) do { _Pragma("unroll") for (int _i = 0; _i < 2; ++_i) \
        __builtin_amdgcn_global_load_lds((const unsigned*)((const char*)(gbase) + (voff)[_i]), (PG8_LAS unsigned*)(lds + (bufoff) + ldsw + _i * 8192), 16, 0, 0); } while (0)
#define PG8_LDA(dst, b, h) do { _Pragma("unroll") for (int m = 0; m < 4; ++m) _Pragma("unroll") for (int k = 0; k < 2; ++k) dst[m][k] = *(const PG8_LAS bf16x8*)(lds + PG8_SA(b, h) + aoff + m * 2048 + k * 1024); } while (0)
#define PG8_LDB(dst, b, h) do { _Pragma("unroll") for (int n = 0; n < 2; ++n) _Pragma("unroll") for (int k = 0; k < 2; ++k) dst[n][k] = *(const PG8_LAS bf16x8*)(lds + PG8_SB(b, h) + boff + n * 2048 + k * 1024); } while (0)
#define PG8_MMA(ai, bj, At, Bt) do { __builtin_amdgcn_s_setprio(1); _Pragma("unroll") for (int m = 0; m < 4; ++m) _Pragma("unroll") for (int n = 0; n < 2; ++n) _Pragma("unroll") for (int k = 0; k < 2; ++k) \
        acc[ai][bj][m][n] = __builtin_amdgcn_mfma_f32_16x16x32_bf16(Bt[n][k], At[m][k], acc[ai][bj][m][n], 0, 0, 0); __builtin_amdgcn_s_setprio(0); } while (0)
#define PG8_WAIT_V(n) asm volatile("s_waitcnt vmcnt(" #n ")" ::: "memory")
#define PG8_WAIT_L(n) asm volatile("s_waitcnt lgkmcnt(" #n ")" ::: "memory")
#define PG8_BAR __builtin_amdgcn_s_barrier()
#define PG8_SCHED __builtin_amdgcn_sched_barrier(0)
    Unit cur, nxt; int ui = 0;
    if (!S.next(0, cur)) return;
    f32x4 acc[2][2][4][2];
#pragma unroll
    for (int a = 0; a < 2; ++a)
#pragma unroll
        for (int b = 0; b < 2; ++b)
#pragma unroll
            for (int m = 0; m < 4; ++m)
#pragma unroll
                for (int n = 0; n < 2; ++n) acc[a][b][m][n] = (f32x4){0.f, 0.f, 0.f, 0.f};
    bf16x8 At[4][2], B0[2][2], B1[2][2];
    const char* cA = (const char*)g.A + (size_t)cur.pm * tstep; const char* cB = (const char*)g.Bt + (size_t)cur.pn * tstep;
    S.a_ready(cur);
    if constexpr (SP2) {
        PG8_STAGE(PG8_SB(0, 0), cB, voffB); PG8_STAGE(PG8_SB(0, 1), cB + hstep, voffB); PG8_STAGE(PG8_SA(0, 0), cA, voffA); PG8_STAGE(PG8_SA(0, 1), cA + hstep, voffA);
        if (wr == 1) PG8_BAR;
        PG8_WAIT_V(2); PG8_BAR;
        PG8_STAGE(PG8_SB(1, 0), cB + kstep, voffB); PG8_STAGE(PG8_SA(1, 0), cA + kstep, voffA); PG8_STAGE(PG8_SB(1, 1), cB + hstep + kstep, voffB);
        PG8_WAIT_V(6); PG8_BAR;
    } else {
        PG8_STAGE(PG8_SB(0, 0), cB, voffB); PG8_STAGE(PG8_SA(0, 0), cA, voffA); PG8_STAGE(PG8_SB(0, 1), cB + hstep, voffB); PG8_STAGE(PG8_SA(0, 1), cA + hstep, voffA);
        if (wr == 1) PG8_BAR;
        PG8_WAIT_V(4); PG8_BAR;
        PG8_STAGE(PG8_SB(1, 0), cB + kstep, voffB); PG8_STAGE(PG8_SA(1, 0), cA + kstep, voffA); PG8_STAGE(PG8_SB(1, 1), cB + hstep + kstep, voffB);
        PG8_WAIT_V(6); PG8_BAR;
    }
    for (;;) {
        const bool has_next = S.next(ui + 1, nxt);
        const char* nA = has_next ? (const char*)g.A + (size_t)nxt.pm * tstep : cA; const char* nB = has_next ? (const char*)g.Bt + (size_t)nxt.pn * tstep : cB;
        for (int t = 0; t < nt; t += 2) {
            const bool last = (t == nt - 2);
            const char* a1 = cA + (size_t)(t + 1) * kstep;
            const char* a2 = last ? nA : cA + (size_t)(t + 2) * kstep; const char* b2 = last ? nB : cB + (size_t)(t + 2) * kstep;
            const char* a3 = a2 + kstep; const char* b3 = b2 + kstep;
            if (last && has_next) S.a_ready(nxt);
            if constexpr (SP2) {
            PG8_LDB(B0, 0, 0); PG8_LDB(B1, 0, 1); PG8_SCHED; PG8_LDA(At, 0, 0); PG8_STAGE(PG8_SA(1, 1), a1 + hstep, voffA);
            PG8_WAIT_V(8); PG8_WAIT_L(0); PG8_BAR; PG8_MMA(0, 0, At, B0); PG8_MMA(0, 1, At, B1); PG8_BAR; PG8_SCHED;
            PG8_LDA(At, 0, 1); PG8_STAGE(PG8_SB(0, 0), b2, voffB); PG8_STAGE(PG8_SB(0, 1), b2 + hstep, voffB); PG8_STAGE(PG8_SA(0, 0), a2, voffA);
            PG8_WAIT_V(8); PG8_WAIT_L(0); PG8_BAR; PG8_MMA(1, 0, At, B0); PG8_MMA(1, 1, At, B1); PG8_BAR; PG8_SCHED;
            PG8_LDB(B0, 1, 0); PG8_LDB(B1, 1, 1); PG8_SCHED; PG8_LDA(At, 1, 0); PG8_STAGE(PG8_SA(0, 1), a2 + hstep, voffA);
            PG8_WAIT_V(8); PG8_WAIT_L(0); PG8_BAR; PG8_MMA(0, 0, At, B0); PG8_MMA(0, 1, At, B1); PG8_BAR; PG8_SCHED;
            PG8_LDA(At, 1, 1); PG8_STAGE(PG8_SB(1, 0), b3, voffB); PG8_STAGE(PG8_SB(1, 1), b3 + hstep, voffB); PG8_STAGE(PG8_SA(1, 0), a3, voffA);
            PG8_WAIT_V(8); PG8_WAIT_L(0); PG8_BAR; PG8_MMA(1, 0, At, B0); PG8_MMA(1, 1, At, B1); PG8_BAR; PG8_SCHED;
            } else {
            PG8_LDB(B0, 0, 0); PG8_SCHED; PG8_LDA(At, 0, 0); PG8_STAGE(PG8_SA(1, 1), a1 + hstep, voffA);
            PG8_WAIT_L(8); PG8_BAR; PG8_WAIT_L(0); PG8_MMA(0, 0, At, B0); PG8_BAR; PG8_SCHED;
            PG8_LDB(B1, 0, 1); PG8_STAGE(PG8_SB(0, 0), b2, voffB);
            PG8_BAR; PG8_WAIT_L(0); PG8_MMA(0, 1, At, B1); PG8_BAR;
            PG8_LDA(At, 0, 1); PG8_STAGE(PG8_SA(0, 0), a2, voffA);
            PG8_BAR; PG8_WAIT_L(0); PG8_MMA(1, 0, At, B0); PG8_BAR; PG8_SCHED;
            PG8_STAGE(PG8_SB(0, 1), b2 + hstep, voffB);
            PG8_WAIT_V(6); PG8_BAR; PG8_MMA(1, 1, At, B1); PG8_BAR;
            PG8_LDB(B0, 1, 0); PG8_SCHED; PG8_LDA(At, 1, 0); PG8_STAGE(PG8_SA(0, 1), a2 + hstep, voffA);
            PG8_WAIT_L(8); PG8_BAR; PG8_WAIT_L(0); PG8_MMA(0, 0, At, B0); PG8_BAR; PG8_SCHED;
            PG8_LDB(B1, 1, 1); PG8_STAGE(PG8_SB(1, 0), b3, voffB);
            PG8_BAR; PG8_WAIT_L(0); PG8_MMA(0, 1, At, B1); PG8_BAR;
            PG8_LDA(At, 1, 1); PG8_STAGE(PG8_SA(1, 0), a3, voffA);
            PG8_BAR; PG8_WAIT_L(0); PG8_MMA(1, 0, At, B0); PG8_BAR; PG8_SCHED;
            PG8_STAGE(PG8_SB(1, 1), b3 + hstep, voffB);
            PG8_WAIT_V(6); PG8_BAR; PG8_MMA(1, 1, At, B1); PG8_BAR;
            }
        }
        if constexpr (ALIGN_EPI) { if (wr == 0) PG8_BAR; }
        if constexpr (!Epi::AFTER_DRAIN) { E(acc, cur, wr, wc, fr, fq); S.done(cur); }
        if (!has_next) break;
#pragma unroll
        for (int a = 0; a < 2; ++a)
#pragma unroll
            for (int b = 0; b < 2; ++b)
#pragma unroll
                for (int m = 0; m < 4; ++m)
#pragma unroll
                    for (int n = 0; n < 2; ++n) acc[a][b][m][n] = (f32x4){0.f, 0.f, 0.f, 0.f};
        cur = nxt; cA = nA; cB = nB; ++ui;
        if constexpr (ALIGN_EPI) { if (wr == 1) PG8_BAR; }
    }
    PG8_WAIT_V(0);
    if constexpr (!ALIGN_EPI) { if (wr == 0) PG8_BAR; }
    PG8_BAR;
    if constexpr (Epi::AFTER_DRAIN) { E.fused(acc, cur, wr, wc, fr, fq, lds, wid, lane); S.done(cur); }
#undef PG8_SA
#undef PG8_SB
#undef PG8_STAGE
#undef PG8_LDA
#undef PG8_LDB
#undef PG8_MMA
#undef PG8_WAIT_V
#undef PG8_WAIT_L
#undef PG8_BAR
#undef PG8_SCHED
}
}

struct Args {
    const float* in[37];
    float* out; unsigned char* ws;
};
constexpr int NWAVES = 8, NTHR = 512;
constexpr int GEMM_LDS = 131072;

#define LDS_WAIT() asm volatile("s_waitcnt lgkmcnt(0)" ::: "memory")

__device__ __forceinline__ void transpose_item(const float* W, int ldw, int nblk, bf16* WT, int ldt, int item, LAS float* scr, int lane, float sc = 1.0f) {
    const int kb = item / nblk, nb = item % nblk, k0 = 64 * kb, n0 = 32 * nb;
#pragma unroll 8
    for (int i = 0; i < 32; ++i) { const int kk = 2 * i + (lane >> 5); scr[kk * 33 + (lane & 31)] = W[(size_t)(k0 + kk) * ldw + n0 + (lane & 31)]; }
    LDS_WAIT(); asm volatile("" ::: "memory");
    const int c = lane & 7;
#pragma unroll
    for (int j = 0; j < 4; ++j) { const int n = (lane >> 3) + 8 * j; const LAS float* s = scr + (8 * c) * 33 + n;
        v4u o; o.x = pk2(s[0 * 33] * sc, s[1 * 33] * sc); o.y = pk2(s[2 * 33] * sc, s[3 * 33] * sc); o.z = pk2(s[4 * 33] * sc, s[5 * 33] * sc); o.w = pk2(s[6 * 33] * sc, s[7 * 33] * sc);
        *(v4u*)(WT + (size_t)(n0 + n) * ldt + k0 + 8 * c) = o; }
    LDS_WAIT(); asm volatile("" ::: "memory");
}

constexpr int P0_LDS = 8 * 64 * 33 * 4 + 8 * 1024 * 4;
__device__ __forceinline__ void p0_prologue(const Args& a, LAS unsigned char* lds, int gw, int NGW, int lane, int wave) {
    unsigned char* ws = a.ws;
    LAS float* scr = (LAS float*)(lds) + wave * (64 * 33);
    LAS float* wg = (LAS float*)(lds + 8 * 64 * 33 * 4);
    const float* w_in = a.in[9];
    for (int i = threadIdx.x; i < 8 * 1024; i += NTHR) { const int k = i >> 3, c = i & 7; wg[c * 1024 + k] = w_in[(size_t)k * INCOLS + GCOL0 + c]; }
    { float* z = (float*)(ws + WS_CTL); for (int i = gw * 64 + lane; i < 65536; i += NGW * 64) z[i] = 0.f; }
    constexpr int I_IN1 = 16 * (3328 / 32), I_IN2 = 16 * (2048 / 32), I_UP = 8 * 32, I_OUT = 16 * 32, I_F1 = 16 * 128, I_F2 = 64 * 32;
    constexpr int I_QK = 8 * 8;
    constexpr int NITEMS = I_IN1 + I_IN2 + 2 * I_UP + I_OUT + I_F1 + I_F2 + I_QK;
    for (int it = gw; it < NITEMS; it += NGW) {
        int r = it;
        if (r < I_IN1) { transpose_item(w_in, INCOLS, 3328 / 32, (bf16*)(ws + WS_WINT), 1024, r, scr, lane); continue; } r -= I_IN1;
        if (r < I_IN2) { transpose_item(w_in + 3336, INCOLS, 2048 / 32, (bf16*)(ws + WS_WINT) + (size_t)3328 * 1024, 1024, r, scr, lane); continue; } r -= I_IN2;
        if (r < I_UP) { transpose_item(a.in[21], 1024, 32, (bf16*)(ws + WS_UPRT), 512, r, scr, lane); continue; } r -= I_UP;
        if (r < I_UP) { transpose_item(a.in[30], 1024, 32, (bf16*)(ws + WS_UPMT), 512, r, scr, lane); continue; } r -= I_UP;
        if (r < I_OUT) { transpose_item(a.in[32], 1024, 32, (bf16*)(ws + WS_WOUTT), 1024, r, scr, lane); continue; } r -= I_OUT;
        if (r < I_F1) { transpose_item(a.in[34], 4096, 128, (bf16*)(ws + WS_W1T), 1024, r, scr, lane); continue; } r -= I_F1;
        if (r < I_F2) { transpose_item(a.in[35], 1024, 32, (bf16*)(ws + WS_W2T), 4096, r, scr, lane); continue; } r -= I_F2;
        { const int mat = r >> 3, hq = mat & 3, isk = mat >> 2;
          transpose_item((isk ? a.in[25] : a.in[24]) + (size_t)hq * 16384, 128, 4, (bf16*)(ws + (isk ? WS_WKT : WS_WQT)) + (size_t)hq * 16384, 128, r & 7, scr, lane, isk ? 1.0f : 0.08838834764831845f); }
    }
    __syncthreads();
    const float* gmix = a.in[8];
    f32x4 gv[4];
#pragma unroll
    for (int j = 0; j < 4; ++j) gv[j] = ((const f32x4*)gmix)[lane + 64 * j];
    bf16* XN = (bf16*)(ws + WS_XN); float* GATES = (float*)(ws + WS_GATES);
    for (int row = gw; row < MT; row += NGW) {
        unsigned long long* o8 = (unsigned long long*)(XN + (size_t)row * 1024) + lane;
        if (row >= MTOK) {
            const f32x4* xr = (const f32x4*)(a.in[2] + (size_t)(row - MTOK) * 1024) + lane;
#pragma unroll
            for (int j = 0; j < 4; ++j) { const f32x4 v = xr[64 * j]; o8[64 * j] = (unsigned long long)pk2(v.x, v.y) | ((unsigned long long)pk2(v.z, v.w) << 32); }
            continue;
        }
        const f32x4* xr = (const f32x4*)(row < MP ? a.in[0] + (size_t)row * 1024 : a.in[1] + (size_t)(row - MP) * 1024) + lane;
        f32x4 v[4]; float s = 0.f;
#pragma unroll
        for (int j = 0; j < 4; ++j) { v[j] = xr[64 * j]; s += (v[j].x * v[j].x + v[j].y * v[j].y) + (v[j].z * v[j].z + v[j].w * v[j].w); }
        const float rstd = rsqrtf(wave_sum(s) * (1.f / 1024.f) + RMS_EPS);
#pragma unroll
        for (int j = 0; j < 4; ++j) { v[j] = v[j] * rstd * gv[j]; o8[64 * j] = (unsigned long long)pk2(v[j].x, v[j].y) | ((unsigned long long)pk2(v[j].z, v[j].w) << 32); }
        float gsum[8];
#pragma unroll
        for (int c = 0; c < 8; ++c) { float p = 0.f;
#pragma unroll
            for (int j = 0; j < 4; ++j) { const f32x4 w = *(const LAS f32x4*)(wg + c * 1024 + 4 * (lane + 64 * j)); p += (v[j].x * w.x + v[j].y * w.y) + (v[j].z * w.z + v[j].w * w.w); }
            gsum[c] = wave_sum(p); }
        if (lane < 8) { float g = gsum[0];
#pragma unroll
            for (int c = 1; c < 8; ++c) g = (lane == c) ? gsum[c] : g;
            GATES[(size_t)row * 8 + lane] = g; }
        float* so = nullptr;
        if (row >= MP) so = a.out + O_SSHIFT + (size_t)(row - MP) * 1024;
        else if ((row & (SEQ - 1)) == SEQ - 1) so = a.out + O_PSHIFT + (size_t)(row >> 11) * 1024;
        if (so) {
#pragma unroll
            for (int j = 0; j < 4; ++j) ((f32x4*)so)[lane + 64 * j] = v[j]; }
    }
}

constexpr int RCH = 16;
constexpr int RWKV_LDS = (RCH * 256 + 8 * RCH * 64 + RCH) * 4;
__device__ __forceinline__ void rwkv_seq_item(const Args& a, LAS unsigned char* ldsb0, int item0) {
    const int tid = threadIdx.x & 255, lane = tid & 63, wv = tid >> 6; const int item = item0 + (threadIdx.x >> 8);
    LAS unsigned char* ldsb = ldsb0 + (threadIdx.x >> 8) * RWKV_LDS;
    const bf16* PR = (const bf16*)(a.ws + WS_PR); bf16* YR = (bf16*)(a.ws + WS_YR);
    const float *mu = a.in[10], *w0 = a.in[11], *w2 = a.in[12], *a0 = a.in[13], *a2 = a.in[14], *g2 = a.in[15], *rkk = a.in[16], *rka = a.in[17], *rrk = a.in[18], *gnw = a.in[19], *gnb = a.in[20];
    int T, row0, h, prevrow0; const float* S0 = nullptr; float* Sout;
    if (item < 64) { const int b = item >> 3; h = item & 7; T = SEQ; row0 = b * SEQ; prevrow0 = -1; Sout = a.out + O_PWKV + (size_t)item * 4096; }
    else { const int sb = (item - 64) >> 3; h = (item - 64) & 7; T = 1; row0 = MP + sb; prevrow0 = MTOK + sb; S0 = a.in[3] + (size_t)(item - 64) * 4096; Sout = a.out + O_SWKV + (size_t)(item - 64) * 4096; }
    const int hc = h * 64;
    LAS float* MIXW = (LAS float*)ldsb;
    LAS float* MIXA = MIXW + RCH * 64;
    LAS float* MIXG = MIXA + RCH * 64;
    LAS float* Rb = MIXG + RCH * 128;
    LAS float* Kb = Rb + RCH * 64;
    LAS float* Vb = Kb + RCH * 64;
    LAS float* Wb = Vb + RCH * 64;
    LAS float* KKb = Wb + RCH * 64;
    LAS float* Bb = KKb + RCH * 64;
    LAS float* Gb = Bb + RCH * 64;
    LAS float* Yb = Gb + RCH * 64;
    LAS float* BON = Yb + RCH * 64;
    const int sv = tid >> 2, kq = tid & 3;
    float S[16];
    if (S0) {
#pragma unroll
        for (int i = 0; i < 4; ++i) { const f32x4 t = *(const f32x4*)(S0 + sv * 64 + 16 * kq + 4 * i); S[4 * i] = t.x; S[4 * i + 1] = t.y; S[4 * i + 2] = t.z; S[4 * i + 3] = t.w; }
    } else {
#pragma unroll
        for (int i = 0; i < 16; ++i) S[i] = 0.f;
    }
    const int j = lane;
    const float w0j = w0[hc + j], a0j = a0[hc + j], rkkj = rkk[hc + j], rkaj = rka[hc + j], rrkj = rrk[hc + j], gnwj = gnw[hc + j], gnbj = gnb[hc + j];
    for (int t0 = 0; t0 < T; t0 += RCH) {
        const int nt = (T - t0) < RCH ? (T - t0) : RCH;
        for (int it = tid; it < nt * 56; it += 256) {
            const int t = it / 56, g = it % 56;
            int col; LAS float* dst; int kind;
            if (g < 8) { col = hc + 8 * g; dst = Rb + t * 64 + 8 * g; kind = 0; }
            else if (g < 16) { col = 512 + hc + 8 * (g - 8); dst = Kb + t * 64 + 8 * (g - 8); kind = 0; }
            else if (g < 24) { col = 1024 + hc + 8 * (g - 16); dst = Vb + t * 64 + 8 * (g - 16); kind = 0; }
            else if (g < 32) { col = 1536 + 8 * (g - 24); dst = MIXW + t * 64 + 8 * (g - 24); kind = 1; }
            else if (g < 40) { col = 1600 + 8 * (g - 32); dst = MIXA + t * 64 + 8 * (g - 32); kind = 0; }
            else { col = 1664 + 8 * (g - 40); dst = MIXG + t * 128 + 8 * (g - 40); kind = 2; }
            const int tg = t0 + t;
            const v4u cur = *(const v4u*)(PR + (size_t)(row0 + tg) * NPR + col);
            v4u prv = (v4u){0u, 0u, 0u, 0u};
            if (tg > 0) prv = *(const v4u*)(PR + (size_t)(row0 + tg - 1) * NPR + col);
            else if (prevrow0 >= 0) prv = *(const v4u*)(PR + (size_t)prevrow0 * NPR + col);
            const f32x4 m0 = *(const f32x4*)(mu + col), m1 = *(const f32x4*)(mu + col + 4);
            float c[8], p[8], mm[8] = {m0.x, m0.y, m0.z, m0.w, m1.x, m1.y, m1.z, m1.w};
            c[0] = bflo(cur.x); c[1] = bfhi(cur.x); c[2] = bflo(cur.y); c[3] = bfhi(cur.y); c[4] = bflo(cur.z); c[5] = bfhi(cur.z); c[6] = bflo(cur.w); c[7] = bfhi(cur.w);
            p[0] = bflo(prv.x); p[1] = bfhi(prv.x); p[2] = bflo(prv.y); p[3] = bfhi(prv.y); p[4] = bflo(prv.z); p[5] = bfhi(prv.z); p[6] = bflo(prv.w); p[7] = bfhi(prv.w);
#pragma unroll
            for (int i = 0; i < 8; ++i) { float m = c[i] + (p[i] - c[i]) * mm[i]; if (kind == 1) m = tanhf(m); else if (kind == 2) m = sigmoidf_(m); dst[i] = m; }
        }
        __syncthreads();
        float accw[RCH / 4], acca[RCH / 4], accg[RCH / 4];
#pragma unroll
        for (int i = 0; i < RCH / 4; ++i) { accw[i] = 0.f; acca[i] = 0.f; accg[i] = 0.f; }
        for (int i4 = 0; i4 < 16; ++i4) {
            float wv4[4], av4[4];
#pragma unroll
            for (int q = 0; q < 4; ++q) { wv4[q] = w2[(size_t)(4 * i4 + q) * 512 + hc + j]; av4[q] = a2[(size_t)(4 * i4 + q) * 512 + hc + j]; }
#pragma unroll
            for (int tt = 0; tt < RCH / 4; ++tt) { const int t = wv + 4 * tt; if (t < nt) {
                const f32x4 xw = *(const LAS f32x4*)(MIXW + t * 64 + 4 * i4), xa = *(const LAS f32x4*)(MIXA + t * 64 + 4 * i4);
                accw[tt] += (xw.x * wv4[0] + xw.y * wv4[1]) + (xw.z * wv4[2] + xw.w * wv4[3]);
                acca[tt] += (xa.x * av4[0] + xa.y * av4[1]) + (xa.z * av4[2] + xa.w * av4[3]); } }
        }
        for (int i4 = 0; i4 < 32; ++i4) {
            float gv4[4];
#pragma unroll
            for (int q = 0; q < 4; ++q) gv4[q] = g2[(size_t)(4 * i4 + q) * 512 + hc + j];
#pragma unroll
            for (int tt = 0; tt < RCH / 4; ++tt) { const int t = wv + 4 * tt; if (t < nt) {
                const f32x4 xg = *(const LAS f32x4*)(MIXG + t * 128 + 4 * i4);
                accg[tt] += (xg.x * gv4[0] + xg.y * gv4[1]) + (xg.z * gv4[2] + xg.w * gv4[3]); } }
        }
#pragma unroll
        for (int tt = 0; tt < RCH / 4; ++tt) { const int t = wv + 4 * tt; if (t < nt) {
            const float wl = w0j + accw[tt]; const float sg = 1.0f / (1.0f + expf(-wl));
            const float dec = expf(-0.6065306597126334f * sg);
            const float aa = 1.0f / (1.0f + expf(-(a0j + acca[tt])));
            const float kraw = Kb[t * 64 + j]; const float kkr = kraw * rkkj;
            const float ss = wave_sum(kkr * kkr); const float kk = kkr / fmaxf(sqrtf(ss), 1e-12f);
            const float k2 = kraw * (1.0f + (aa - 1.0f) * rkaj);
            const float bon = wave_sum(Rb[t * 64 + j] * k2 * rrkj);
            Wb[t * 64 + j] = dec; KKb[t * 64 + j] = kk; Bb[t * 64 + j] = kk * aa; Kb[t * 64 + j] = k2; Gb[t * 64 + j] = accg[tt];
            if (j == 0) BON[t] = bon; } }
        __syncthreads();
        for (int t = 0; t < nt; ++t) {
            float kk[16], p = 0.f;
#pragma unroll
            for (int i = 0; i < 4; ++i) { const f32x4 x = *(const LAS f32x4*)(KKb + t * 64 + 16 * kq + 4 * i); kk[4 * i] = x.x; kk[4 * i + 1] = x.y; kk[4 * i + 2] = x.z; kk[4 * i + 3] = x.w; }
#pragma unroll
            for (int i = 0; i < 16; ++i) p += S[i] * kk[i];
            p += __shfl_xor(p, 1); p += __shfl_xor(p, 2);
            const float vv = Vb[t * 64 + sv]; float y = 0.f;
#pragma unroll
            for (int i = 0; i < 4; ++i) {
                const f32x4 w = *(const LAS f32x4*)(Wb + t * 64 + 16 * kq + 4 * i), bb = *(const LAS f32x4*)(Bb + t * 64 + 16 * kq + 4 * i), k2 = *(const LAS f32x4*)(Kb + t * 64 + 16 * kq + 4 * i), r = *(const LAS f32x4*)(Rb + t * 64 + 16 * kq + 4 * i);
                S[4 * i + 0] = S[4 * i + 0] * w.x - p * bb.x + vv * k2.x; y += S[4 * i + 0] * r.x;
                S[4 * i + 1] = S[4 * i + 1] * w.y - p * bb.y + vv * k2.y; y += S[4 * i + 1] * r.y;
                S[4 * i + 2] = S[4 * i + 2] * w.z - p * bb.z + vv * k2.z; y += S[4 * i + 2] * r.z;
                S[4 * i + 3] = S[4 * i + 3] * w.w - p * bb.w + vv * k2.w; y += S[4 * i + 3] * r.w;
            }
            y += __shfl_xor(y, 1); y += __shfl_xor(y, 2);
            if (kq == 0) Yb[t * 64 + sv] = y;
        }
        __syncthreads();
#pragma unroll
        for (int tt = 0; tt < RCH / 4; ++tt) { const int t = wv + 4 * tt; if (t < nt) {
            const float y = Yb[t * 64 + j]; const float mean = wave_sum(y) * (1.0f / 64.0f); const float d = y - mean; const float var = wave_sum(d * d) * (1.0f / 64.0f);
            float o = d * rsqrtf(var + R_GN_EPS) * gnwj + gnbj; o += BON[t] * Vb[t * 64 + j]; o *= Gb[t * 64 + j];
            YR[(size_t)(row0 + t0 + t) * 512 + hc + j] = (bf16)f2bf(o); } }
        __syncthreads();
    }
#pragma unroll
    for (int i = 0; i < 4; ++i) *(f32x4*)(Sout + sv * 64 + 16 * kq + 4 * i) = (f32x4){S[4 * i], S[4 * i + 1], S[4 * i + 2], S[4 * i + 3]};
}

constexpr int MCH = 16;
constexpr int MLSTM_LDS = ((MCH + 3) * 128 + 5 * MCH * 128 + MCH * 4 * 128 + 8 * MCH) * 4;
__device__ __forceinline__ void mlstm_seq_item(const Args& a, LAS unsigned char* ldsb, int item) {
    const int tid = threadIdx.x, lane = tid & 63, wv = tid >> 6;
    const bf16* PM = (const bf16*)(a.ws + WS_PM); bf16* YM = (bf16*)(a.ws + WS_YM); const float* GATES = (const float*)(a.ws + WS_GATES);
    const float *convw = a.in[22], *convb = a.in[23], *wq = a.in[24], *wk = a.in[25], *ib = a.in[26], *fb = a.in[27], *gnw = a.in[28], *skip = a.in[29];
    int T, row0, h, sb = -1; float *Cout, *nout, *mout, *convout;
    if (item < 32) { const int b = item >> 2; h = item & 3; T = SEQ; row0 = b * SEQ; Cout = a.out + O_PC + (size_t)item * 16384; nout = a.out + O_PN + (size_t)item * 128; mout = a.out + O_PMM + item; convout = a.out + O_PCONV + (size_t)b * 3 * 512 + h * 128; }
    else { const int it2 = item - 32; sb = it2 >> 2; h = it2 & 3; T = 1; row0 = MP + sb; Cout = a.out + O_SC + (size_t)it2 * 16384; nout = a.out + O_SN + (size_t)it2 * 128; mout = a.out + O_SMM + it2; convout = a.out + O_SCONV + (size_t)sb * 3 * 512 + h * 128; }
    const int hc = h * 128;
    LAS float* XMW = (LAS float*)ldsb;
    LAS float* XC = XMW + (MCH + 3) * 128;
    LAS float* Qb = XC + MCH * 128;
    LAS float* Kb = Qb + MCH * 128;
    LAS float* Vb = Kb + MCH * 128;
    LAS float* Ob = Vb + MCH * 128;
    LAS float* HP = Ob + MCH * 128;
    LAS float* FS = HP + MCH * 512;
    LAS float* IS = FS + MCH;
    LAS float* EM = IS + MCH;
    LAS float* DEN = EM + MCH;
    LAS float* MST = DEN + 2 * MCH;
    const int e = tid & 127, dq = tid >> 7;
    float C[32]; float nreg = 0.f;
    if (sb >= 0) {
        const float* C0 = a.in[4] + (size_t)(item - 32) * 16384;
#pragma unroll
        for (int i = 0; i < 32; ++i) C[i] = C0[(size_t)(32 * dq + i) * 128 + e];
        if (tid < 128) nreg = a.in[5][(size_t)(item - 32) * 128 + tid];
        if (tid == 0) MST[0] = a.in[6][item - 32];
        if (tid < 384) XMW[tid] = a.in[7][(size_t)sb * 3 * 512 + (tid >> 7) * 512 + hc + (tid & 127)];
    } else {
#pragma unroll
        for (int i = 0; i < 32; ++i) C[i] = 0.f;
        if (tid == 0) MST[0] = 0.f;
        if (tid < 384) XMW[tid] = 0.f;
    }
    const float cw0 = convw[0 * 512 + hc + e], cw1 = convw[1 * 512 + hc + e], cw2 = convw[2 * 512 + hc + e], cw3 = convw[3 * 512 + hc + e], cbe = convb[hc + e];
    const float ibh = ib[h], fbh = fb[h];
    __syncthreads();
    for (int t0 = 0; t0 < T; t0 += MCH) {
        const int nt = (T - t0) < MCH ? (T - t0) : MCH;
        for (int t = dq; t < nt; t += 4) { const size_t r = (size_t)(row0 + t0 + t) * NPM;
            XMW[(t + 3) * 128 + e] = bf2f(PM[r + hc + e]); Vb[t * 128 + e] = bf2f(PM[r + 512 + hc + e]); Ob[t * 128 + e] = sigmoidf_(bf2f(PM[r + 1024 + hc + e])); }
        __syncthreads();
        for (int t = dq; t < nt; t += 4) { const float x = cbe + XMW[t * 128 + e] * cw0 + XMW[(t + 1) * 128 + e] * cw1 + XMW[(t + 2) * 128 + e] * cw2 + XMW[(t + 3) * 128 + e] * cw3;
            XC[t * 128 + e] = x / (1.0f + expf(-x)); }
        if (tid == 0) { float m = MST[0];
            for (int t = 0; t < nt; ++t) { const float* g = GATES + (size_t)(row0 + t0 + t) * 8;
                const float li = g[h] + ibh, fr = g[4 + h] + fbh; const float lf = fminf(fr, 0.f) - log1pf(expf(-fabsf(fr)));
                const float mn = fmaxf(lf + m, li); FS[t] = expf(lf + m - mn); IS[t] = expf(li - mn); EM[t] = expf(-mn); m = mn; }
            MST[0] = m; }
        __syncthreads();
        { float aq[MCH / 4], ak[MCH / 4];
#pragma unroll
          for (int i = 0; i < MCH / 4; ++i) { aq[i] = 0.f; ak[i] = 0.f; }
          for (int d4 = 0; d4 < 32; ++d4) {
              float q4[4], k4[4];
#pragma unroll
              for (int q = 0; q < 4; ++q) { q4[q] = wq[(size_t)(hc + 4 * d4 + q) * 128 + e]; k4[q] = wk[(size_t)(hc + 4 * d4 + q) * 128 + e]; }
#pragma unroll
              for (int tt = 0; tt < MCH / 4; ++tt) { const int t = dq + 4 * tt; if (t < nt) { const f32x4 x = *(const LAS f32x4*)(XC + t * 128 + 4 * d4);
                  aq[tt] += (x.x * q4[0] + x.y * q4[1]) + (x.z * q4[2] + x.w * q4[3]); ak[tt] += (x.x * k4[0] + x.y * k4[1]) + (x.z * k4[2] + x.w * k4[3]); } }
          }
#pragma unroll
          for (int tt = 0; tt < MCH / 4; ++tt) { const int t = dq + 4 * tt; if (t < nt) { Qb[t * 128 + e] = aq[tt] * 0.08838834764831845f; Kb[t * 128 + e] = ak[tt]; } }
        }
        __syncthreads();
        for (int t = 0; t < nt; ++t) {
            const float fs = FS[t], is = IS[t]; const float ve = Vb[t * 128 + e] * is; float hp = 0.f;
#pragma unroll
            for (int i = 0; i < 8; ++i) { const f32x4 k = *(const LAS f32x4*)(Kb + t * 128 + 32 * dq + 4 * i), q = *(const LAS f32x4*)(Qb + t * 128 + 32 * dq + 4 * i);
                C[4 * i + 0] = fs * C[4 * i + 0] + k.x * ve; hp += q.x * C[4 * i + 0];
                C[4 * i + 1] = fs * C[4 * i + 1] + k.y * ve; hp += q.y * C[4 * i + 1];
                C[4 * i + 2] = fs * C[4 * i + 2] + k.z * ve; hp += q.z * C[4 * i + 2];
                C[4 * i + 3] = fs * C[4 * i + 3] + k.w * ve; hp += q.w * C[4 * i + 3]; }
            HP[t * 512 + dq * 128 + e] = hp;
            if (tid < 128) { nreg = fs * nreg + is * Kb[t * 128 + tid]; const float dn = wave_sum(Qb[t * 128 + tid] * nreg); if (lane == 0) DEN[t * 2 + wv] = dn; }
        }
        __syncthreads();
        for (int t = wv; t < nt; t += 8) {
            const float den = DEN[t * 2] + DEN[t * 2 + 1]; const float dd = fmaxf(fabsf(den), EM[t]);
            float hv[2];
#pragma unroll
            for (int q = 0; q < 2; ++q) { const int ee = lane + 64 * q; hv[q] = (HP[t * 512 + ee] + HP[t * 512 + 128 + ee] + HP[t * 512 + 256 + ee] + HP[t * 512 + 384 + ee]) / dd; }
            const float mean = wave_sum(hv[0] + hv[1]) * (1.0f / 128.0f); const float d0 = hv[0] - mean, d1 = hv[1] - mean;
            const float var = wave_sum(d0 * d0 + d1 * d1) * (1.0f / 128.0f); const float rs = rsqrtf(var + M_GN_EPS);
#pragma unroll
            for (int q = 0; q < 2; ++q) { const int ee = lane + 64 * q; float o = (q ? d1 : d0) * rs * gnw[hc + ee] + skip[hc + ee] * XC[t * 128 + ee]; o *= Ob[t * 128 + ee];
                YM[(size_t)(row0 + t0 + t) * 512 + hc + ee] = (bf16)f2bf(o); }
        }
        __syncthreads();
        float keep = 0.f; if (tid < 384) keep = XMW[(nt + (tid >> 7)) * 128 + (tid & 127)];
        __syncthreads();
        if (tid < 384) XMW[tid] = keep;
        __syncthreads();
    }
#pragma unroll
    for (int i = 0; i < 32; ++i) Cout[(size_t)(32 * dq + i) * 128 + e] = C[i];
    if (tid < 128) nout[tid] = nreg;
    if (tid == 0) mout[0] = MST[0];
    if (tid < 384) convout[(tid >> 7) * 512 + (tid & 127)] = XMW[tid];
}

__device__ __forceinline__ void final_norm_rows(const Args& a, int gw, int NGW, int lane) {
    const float* ssq = (const float*)(a.ws + WS_SSQ2); const float* gf = a.in[36];
    f32x4 gv[4];
#pragma unroll
    for (int j = 0; j < 4; ++j) gv[j] = ((const f32x4*)gf)[lane + 64 * j];
    for (int row = gw; row < MTOK; row += NGW) { const float rs = rsqrtf(ssq[row] * (1.0f / 1024.0f) + RMS_EPS); f32x4* p = (f32x4*)(a.out + (size_t)row * 1024) + lane;
#pragma unroll
        for (int j = 0; j < 4; ++j) p[64 * j] = p[64 * j] * rs * gv[j]; }
}


typedef short bf16x8 __attribute__((ext_vector_type(8)));
typedef float f32x16 __attribute__((ext_vector_type(16)));
constexpr size_t WS_KT = 49 * MiB + 512 * 1024;
constexpr size_t DO_CTP = 0;
constexpr size_t DO_VT = 40 * MiB;
constexpr size_t DO_UU = 60 * MiB, DO_BCUM = DO_UU + 256 * 1024, DO_PPFX = DO_BCUM + 256 * 1024;
constexpr size_t DO_BL = DO_PPFX + 256 * 1024, DO_PMX = DO_BL + 4096, DO_MPREV = DO_PMX + 4096;
static_assert(DO_MPREV + 4096 <= (size_t)MTOK * DM * 4, "d_out scratch");

typedef float f32x2_t __attribute__((ext_vector_type(2))); typedef __bf16 bf16x2_t __attribute__((ext_vector_type(2)));
__device__ __forceinline__ unsigned cvtpk(float lo, float hi) { f32x2_t v = {lo, hi}; bf16x2_t b = __builtin_convertvector(v, bf16x2_t); return __builtin_bit_cast(unsigned, b); }
__device__ __forceinline__ bf16x8 pack8(float a0, float a1, float a2, float a3, float a4, float a5, float a6, float a7) {
    v4u w; w.x = cvtpk(a0, a1); w.y = cvtpk(a2, a3); w.z = cvtpk(a4, a5); w.w = cvtpk(a6, a7); return __builtin_bit_cast(bf16x8, w); }
__device__ __forceinline__ bf16x8 acc_frag(const f32x16& x, int s2) { return s2 == 0 ? pack8(x[0], x[1], x[2], x[3], x[4], x[5], x[6], x[7]) : pack8(x[8], x[9], x[10], x[11], x[12], x[13], x[14], x[15]); }
__device__ __forceinline__ bf16x8 ld16(const bf16* p) { return __builtin_bit_cast(bf16x8, *(const v4u*)p); }
__device__ __forceinline__ bf16x8 ld8x2(const bf16* p0, const bf16* p1) { const v2u a = *(const v2u*)p0, b = *(const v2u*)p1; v4u w; w.x = a.x; w.y = a.y; w.z = b.x; w.w = b.y; return __builtin_bit_cast(bf16x8, w); }
#define MFMA32(a, b, c) __builtin_amdgcn_mfma_f32_32x32x16_bf16((a), (b), (c), 0, 0, 0)

__device__ __forceinline__ void stage_conv_head(const Args& a, LAS float* CW, int h, int tid, int nthr) {
    for (int i = tid; i < 640; i += nthr) CW[i] = i < 512 ? a.in[22][(size_t)(i >> 7) * 512 + h * 128 + (i & 127)] : a.in[23][h * 128 + (i - 512)];
}
__device__ __forceinline__ void xc8(const bf16* xmcol, int t, int d0, const LAS float* CW, float (&x)[8]) {
    const f32x4 b0 = *(const LAS f32x4*)(CW + 512 + d0), b1 = *(const LAS f32x4*)(CW + 512 + d0 + 4);
    x[0] = b0.x; x[1] = b0.y; x[2] = b0.z; x[3] = b0.w; x[4] = b1.x; x[5] = b1.y; x[6] = b1.z; x[7] = b1.w;
#pragma unroll
    for (int tap = 0; tap < 4; ++tap) { const int tt = t - 3 + tap;
        if (tt >= 0) { const v4u v = *(const v4u*)(xmcol + (size_t)tt * NPM + d0);
            const f32x4 w0 = *(const LAS f32x4*)(CW + tap * 128 + d0), w1 = *(const LAS f32x4*)(CW + tap * 128 + d0 + 4);
            x[0] += bflo(v.x) * w0.x; x[1] += bfhi(v.x) * w0.y; x[2] += bflo(v.y) * w0.z; x[3] += bfhi(v.y) * w0.w;
            x[4] += bflo(v.z) * w1.x; x[5] += bfhi(v.z) * w1.y; x[6] += bflo(v.w) * w1.z; x[7] += bfhi(v.w) * w1.w; } }
#pragma unroll
    for (int i = 0; i < 8; ++i) x[i] = x[i] / (1.0f + __expf(-x[i]));
}
__device__ __forceinline__ bf16x8 xc_frag(const bf16* xmcol, int t, int d0, const LAS float* CW) { float x[8]; xc8(xmcol, t, d0, CW, x); return pack8(x[0], x[1], x[2], x[3], x[4], x[5], x[6], x[7]); }

__device__ __forceinline__ void mlstm_prep_task(const Args& a, int item, int blk, const LAS float* CW, int lane) {
    const int r = lane & 31, hh = lane >> 5, bh = item >> 5, c = item & 31, b = bh >> 2, h = bh & 3, hc = h * 128, row0 = b * SEQ, t0 = c * 64, db = blk & 3, sb = blk >> 2;
    const bf16* PM = (const bf16*)(a.ws + WS_PM); const bf16* xmcol = PM + (size_t)row0 * NPM + hc;
    const bf16* WKT = (const bf16*)(a.ws + WS_WKT) + (size_t)h * 16384;
    bf16* KT = (bf16*)(a.ws + WS_KT) + (size_t)item * 8192; bf16* VT = (bf16*)((unsigned char*)a.out + DO_VT) + (size_t)item * 10240;
    f32x16 acc;
#pragma unroll
    for (int i = 0; i < 16; ++i) acc[i] = 0.f;
#pragma unroll
    for (int ks = 0; ks < 8; ++ks) { const bf16x8 A = ld16(WKT + (size_t)(32 * db + r) * 128 + 16 * ks + 8 * hh); const bf16x8 B = xc_frag(xmcol, t0 + 32 * sb + r, 16 * ks + 8 * hh, CW); acc = MFMA32(A, B, acc); }
#pragma unroll
    for (int reg = 0; reg < 16; ++reg) { const int d = 32 * db + (reg & 3) + 8 * (reg >> 2) + 4 * hh; KT[(size_t)d * 64 + 32 * sb + r] = (bf16)f2bf(acc[reg]); }
    { const bf16* vp = PM + (size_t)(row0 + t0 + 32 * sb + r) * NPM + 512 + hc + 32 * db + 16 * hh; const v4u v0 = *(const v4u*)vp, v1 = *(const v4u*)(vp + 8);
      const unsigned w[8] = {v0.x, v0.y, v0.z, v0.w, v1.x, v1.y, v1.z, v1.w}; bf16* o = VT + (size_t)(32 * db + 16 * hh) * 64 + 32 * sb + r;
#pragma unroll
      for (int i = 0; i < 8; ++i) { o[(size_t)(2 * i) * 64] = (bf16)(w[i] & 0xffffu); o[(size_t)(2 * i + 1) * 64] = (bf16)(w[i] >> 16); } }
#pragma unroll
    for (int i = 0; i < 4; ++i) VT[(size_t)(128 + 4 * blk + i) * 64 + lane] = (blk == 0 && i == 0) ? (bf16)0x3f80u : (bf16)0u;
    if (blk == 1 && c == 31) {
        float* co = a.out + O_PCONV + (size_t)b * 3 * 512 + hc;
        for (int i = lane; i < 384; i += 64) co[(i >> 7) * 512 + (i & 127)] = bf2f(xmcol[(size_t)(SEQ - 3 + (i >> 7)) * NPM + (i & 127)]);
    }
    if (blk == 0) {
        const float* g = (const float*)(a.ws + WS_GATES) + (size_t)(row0 + t0 + lane) * 8;
        const float li = g[h] + a.in[26][h], fr = g[4 + h] + a.in[27][h]; const float lf = fminf(fr, 0.f) - log1pf(expf(-fabsf(fr)));
        float bc = lf;
#pragma unroll
        for (int o = 1; o < 64; o <<= 1) { const float t = __shfl_up(bc, o); if (lane >= o) bc += t; }
        const float u = li - bc; float p = u;
#pragma unroll
        for (int o = 1; o < 64; o <<= 1) { const float t = __shfl_up(p, o); if (lane >= o) p = fmaxf(p, t); }
        float* dof = (float*)a.out; const size_t ti = (size_t)bh * 2048 + t0 + lane;
        dof[DO_UU / 4 + ti] = u; dof[DO_BCUM / 4 + ti] = bc; dof[DO_PPFX / 4 + ti] = p;
        if (lane == 63) { dof[DO_BL / 4 + item] = bc; dof[DO_PMX / 4 + item] = p; }
    }
}

__device__ __forceinline__ void mlstm_scan_task(const Args& a, int bh, int eb, LAS float* WE, int lane) {
    const int r = lane & 31, hh = lane >> 5;
    const float* dof = (const float*)a.out;
    f32x16 CT[4];
#pragma unroll
    for (int cb = 0; cb < 4; ++cb)
#pragma unroll
        for (int i = 0; i < 16; ++i) CT[cb][i] = 0.f;
    float m = 0.f;
    for (int c = 0; c < 32; ++c) {
        const int item = bh * 32 + c;
        const bf16* KT = (const bf16*)(a.ws + WS_KT) + (size_t)item * 8192; const bf16* VT = (const bf16*)((const unsigned char*)a.out + DO_VT) + (size_t)item * 10240;
        bf16* CTP = (bf16*)((unsigned char*)a.out + DO_CTP) + (size_t)item * 20480;
        const float u = dof[DO_UU / 4 + (size_t)bh * 2048 + 64 * c + lane]; const float pmx = dof[DO_PMX / 4 + item], bl = dof[DO_BL / 4 + item];
        const float Mx = fmaxf(m, pmx); const float ge = expf(m - Mx);
        WE[lane] = expf(u - Mx);
#pragma unroll
        for (int cb = 0; cb < 4; ++cb)
#pragma unroll
            for (int reg = 0; reg < 16; ++reg) { CTP[(size_t)(32 * eb + (reg & 3) + 8 * (reg >> 2) + 4 * hh) * 128 + 32 * cb + r] = (bf16)f2bf(CT[cb][reg]); CT[cb][reg] *= ge; }
        if (eb == 0 && lane == 0) ((float*)a.out)[DO_MPREV / 4 + item] = m;
        LDS_WAIT(); asm volatile("" ::: "memory");
#pragma unroll
        for (int ks = 0; ks < 4; ++ks) {
            const v4u av = *(const v4u*)(VT + (size_t)(32 * eb + r) * 64 + 16 * ks + 8 * hh);
            const f32x4 w0 = *(const LAS f32x4*)(WE + 16 * ks + 8 * hh), w1 = *(const LAS f32x4*)(WE + 16 * ks + 8 * hh + 4);
            const bf16x8 A = pack8(bflo(av.x) * w0.x, bfhi(av.x) * w0.y, bflo(av.y) * w0.z, bfhi(av.y) * w0.w, bflo(av.z) * w1.x, bfhi(av.z) * w1.y, bflo(av.w) * w1.z, bfhi(av.w) * w1.w);
#pragma unroll
            for (int cb = 0; cb < 4; ++cb) { const bf16x8 B = ld16(KT + (size_t)(32 * cb + r) * 64 + 16 * ks + 8 * hh); CT[cb] = MFMA32(A, B, CT[cb]); }
        }
        m = bl + Mx;
        LDS_WAIT(); asm volatile("" ::: "memory");
    }
    if (eb < 4) { float* Co = a.out + O_PC + (size_t)bh * 16384;
#pragma unroll
        for (int cb = 0; cb < 4; ++cb)
#pragma unroll
            for (int reg = 0; reg < 16; ++reg) Co[(size_t)(32 * cb + r) * 128 + 32 * eb + (reg & 3) + 8 * (reg >> 2) + 4 * hh] = CT[cb][reg];
    } else if (hh == 0) {
#pragma unroll
        for (int cb = 0; cb < 4; ++cb) a.out[O_PN + (size_t)bh * 128 + 32 * cb + r] = CT[cb][0];
    }
    if (eb == 0 && lane == 0) a.out[O_PMM + bh] = m;
}

__device__ __forceinline__ void mlstm_st_tile(int sb, int tb, const bf16x8 (&XB)[8], const bf16x8 (&QTb)[4][2], const bf16* WKT, const bf16* xmcol, const LAS float* CW, const float* uu, int t0, int tl, float Mt, int r, int hh, bf16x8& o0, bf16x8& o1) {
    f32x16 st;
#pragma unroll
    for (int i = 0; i < 16; ++i) st[i] = 0.f;
#pragma unroll
    for (int db = 0; db < 4; ++db) { f32x16 k;
#pragma unroll
        for (int i = 0; i < 16; ++i) k[i] = 0.f;
#pragma unroll
        for (int ks = 0; ks < 8; ++ks) { const bf16x8 B = (sb == tb) ? XB[ks] : xc_frag(xmcol, t0 + 32 * sb + r, 16 * ks + 8 * hh, CW);
            k = MFMA32(ld16(WKT + (size_t)(32 * db + r) * 128 + 16 * ks + 8 * hh), B, k); }
        st = MFMA32(acc_frag(k, 0), QTb[db][0], st); st = MFMA32(acc_frag(k, 1), QTb[db][1], st); __builtin_amdgcn_sched_barrier(0); }
#pragma unroll
    for (int g = 0; g < 4; ++g) { const f32x4 u4 = *(const f32x4*)(uu + 32 * sb + 8 * g + 4 * hh);
#pragma unroll
        for (int i = 0; i < 4; ++i) { const int sidx = 32 * sb + 8 * g + 4 * hh + i; st[4 * g + i] = (sidx <= tl) ? st[4 * g + i] * expf(u4[i] - Mt) : 0.f; } }
    o0 = acc_frag(st, 0); o1 = acc_frag(st, 1);
}

__device__ __forceinline__ void mlstm_out_task(const Args& a, int item, int tb, const LAS float* CWall, int lane) {
    const int r = lane & 31, hh = lane >> 5, bh = item >> 5, c = item & 31, b = bh >> 2, h = bh & 3, hc = h * 128, row0 = b * SEQ, t0 = c * 64;
    const bf16* PM = (const bf16*)(a.ws + WS_PM); const bf16* xmcol = PM + (size_t)row0 * NPM + hc; const LAS float* CW = CWall + h * 640;
    const bf16* WQT = (const bf16*)(a.ws + WS_WQT) + (size_t)h * 16384; const bf16* WKT = (const bf16*)(a.ws + WS_WKT) + (size_t)h * 16384;
    const bf16* VT = (const bf16*)((const unsigned char*)a.out + DO_VT) + (size_t)item * 10240; const bf16* CTP = (const bf16*)((const unsigned char*)a.out + DO_CTP) + (size_t)item * 20480;
    const float* dof = (const float*)a.out;
    const int tl = 32 * tb + r, t = t0 + tl;
    bf16x8 XB[8];
#pragma unroll
    for (int ks = 0; ks < 8; ++ks) XB[ks] = xc_frag(xmcol, t, 16 * ks + 8 * hh, CW);
    bf16x8 QTb[4][2];
#pragma unroll
    for (int eb = 0; eb < 4; ++eb) { f32x16 q;
#pragma unroll
        for (int i = 0; i < 16; ++i) q[i] = 0.f;
#pragma unroll
        for (int ks = 0; ks < 8; ++ks) q = MFMA32(ld16(WQT + (size_t)(32 * eb + r) * 128 + 16 * ks + 8 * hh), XB[ks], q);
        QTb[eb][0] = acc_frag(q, 0); QTb[eb][1] = acc_frag(q, 1); __builtin_amdgcn_sched_barrier(0); }
    const float mprev = dof[DO_MPREV / 4 + item], pp = dof[DO_PPFX / 4 + (size_t)bh * 2048 + t], bc = dof[DO_BCUM / 4 + (size_t)bh * 2048 + t];
    const float Mt = fmaxf(mprev, pp), wst = expf(mprev - Mt), em = expf(-bc - Mt);
    bf16x8 STb[2][2];
    mlstm_st_tile(0, tb, XB, QTb, WKT, xmcol, CW, dof + DO_UU / 4 + (size_t)bh * 2048 + t0, t0, tl, Mt, r, hh, STb[0][0], STb[0][1]);
    if (tb == 1) mlstm_st_tile(1, tb, XB, QTb, WKT, xmcol, CW, dof + DO_UU / 4 + (size_t)bh * 2048 + t0, t0, tl, Mt, r, hh, STb[1][0], STb[1][1]);
    else { STb[1][0] = (bf16x8){0, 0, 0, 0, 0, 0, 0, 0}; STb[1][1] = STb[1][0]; }
    auto num_block = [&](int eb, f32x16& nt) {
#pragma unroll
        for (int i = 0; i < 16; ++i) nt[i] = 0.f;
        const bf16* crow = CTP + (size_t)(32 * eb + r) * 128 + 4 * hh;
#pragma unroll
        for (int rb = 0; rb < 4; ++rb) {
#pragma unroll
            for (int s2 = 0; s2 < 2; ++s2) nt = MFMA32(ld8x2(crow + 32 * rb + 16 * s2, crow + 32 * rb + 16 * s2 + 8), QTb[rb][s2], nt);
            if (rb == 1) __builtin_amdgcn_sched_barrier(0); }
#pragma unroll
        for (int i = 0; i < 16; ++i) nt[i] *= wst;
        __builtin_amdgcn_sched_barrier(0);
        const bf16* vrow = VT + (size_t)(32 * eb + r) * 64 + 4 * hh;
#pragma unroll
        for (int s2 = 0; s2 < 2; ++s2) nt = MFMA32(ld8x2(vrow + 16 * s2, vrow + 16 * s2 + 8), STb[0][s2], nt);
        if (tb == 1) {
#pragma unroll
            for (int s2 = 0; s2 < 2; ++s2) nt = MFMA32(ld8x2(vrow + 32 + 16 * s2, vrow + 32 + 16 * s2 + 8), STb[1][s2], nt); }
        __builtin_amdgcn_sched_barrier(0);
    };
    float inv;
    { f32x16 nd; num_block(4, nd); const float den = __shfl(nd[0], r); inv = 1.0f / fmaxf(fabsf(den), em); }
    f32x16 NT[4];
#pragma unroll
    for (int eb = 0; eb < 4; ++eb) num_block(eb, NT[eb]);
    float s1 = 0.f;
#pragma unroll
    for (int eb = 0; eb < 4; ++eb)
#pragma unroll
        for (int i = 0; i < 16; ++i) { NT[eb][i] *= inv; s1 += NT[eb][i]; }
    s1 += __shfl_xor(s1, 32); const float mean = s1 * (1.0f / 128.0f); float s2v = 0.f;
#pragma unroll
    for (int eb = 0; eb < 4; ++eb)
#pragma unroll
        for (int i = 0; i < 16; ++i) { const float d = NT[eb][i] - mean; s2v += d * d; }
    s2v += __shfl_xor(s2v, 32); const float rs = rsqrtf(s2v * (1.0f / 128.0f) + M_GN_EPS);
    bf16* YM = (bf16*)(a.ws + WS_YM) + (size_t)(row0 + t) * 512 + hc; const bf16* orow = PM + (size_t)(row0 + t) * NPM + 1024 + hc;
    const float* gnw = a.in[28] + hc; const float* skp = a.in[29] + hc;
#pragma unroll
    for (int eb = 0; eb < 4; ++eb)
#pragma unroll
        for (int g = 0; g < 4; ++g) { const int e0 = 32 * eb + 8 * g + 4 * hh;
            const f32x4 cb4 = *(const LAS f32x4*)(CW + 512 + e0); float x[4] = {cb4.x, cb4.y, cb4.z, cb4.w};
#pragma unroll
            for (int tap = 0; tap < 4; ++tap) { const int tt = t - 3 + tap; if (tt >= 0) { const v2u v = *(const v2u*)(xmcol + (size_t)tt * NPM + e0); const f32x4 w = *(const LAS f32x4*)(CW + tap * 128 + e0);
                x[0] += bflo(v.x) * w.x; x[1] += bfhi(v.x) * w.y; x[2] += bflo(v.y) * w.z; x[3] += bfhi(v.y) * w.w; } }
            const v2u ov = *(const v2u*)(orow + e0); const float og[4] = {bflo(ov.x), bfhi(ov.x), bflo(ov.y), bfhi(ov.y)};
            const f32x4 gw = *(const f32x4*)(gnw + e0), sk = *(const f32x4*)(skp + e0); float o[4];
#pragma unroll
            for (int i = 0; i < 4; ++i) { const float xc = x[i] / (1.0f + __expf(-x[i])); o[i] = ((NT[eb][4 * g + i] - mean) * rs * gw[i] + sk[i] * xc) * sigmoidf_(og[i]); }
            v2u w; w.x = cvtpk(o[0], o[1]); w.y = cvtpk(o[2], o[3]); *(v2u*)(YM + e0) = w; __builtin_amdgcn_sched_barrier(0); }
}

__device__ __forceinline__ unsigned long long rt() { return __builtin_amdgcn_s_memrealtime(); }
#define XB_TMO      128
#define XB_XCNT(j)  (256  + 64 * (j))
#define XB_XSUB(j)  (1280 + 64 * (j))
#define XB_XGEN(j)  (2304 + 64 * (j))
#define XB_TOP      3328
#define XB_TOPGEN   3392
#define XCD_BAR_WORDS 3456
#define XB_SPIN_CAP (1u << 18)

__device__ __forceinline__ unsigned xb_ld(unsigned* p)              { return __hip_atomic_load(p, __ATOMIC_RELAXED, __HIP_MEMORY_SCOPE_AGENT); }
__device__ __forceinline__ unsigned xb_add(unsigned* p, unsigned v) { return __hip_atomic_fetch_add(p, v, __ATOMIC_RELAXED, __HIP_MEMORY_SCOPE_AGENT); }
__device__ __forceinline__ unsigned xb_xcc_id() { return (unsigned)__builtin_amdgcn_s_getreg((3 << 11) | 20) & 0xFu; }
#define XB_SPIN(cond, bar) do { unsigned _sp = 0; while (cond) { __builtin_amdgcn_s_sleep(1); \
    if ((++_sp & 255u) == 0u) { if (xb_ld(&(bar)[XB_TMO])) break; if (_sp > XB_SPIN_CAP) { atomicAdd(&(bar)[XB_TMO], 1u); break; } } } } while (0)

struct XcdBarrier {
    unsigned* bar; unsigned x;
    volatile LAS unsigned* st;
};

__device__ __forceinline__ XcdBarrier xcd_barrier_post(unsigned* bar, volatile LAS unsigned* st) {
    XcdBarrier b; b.bar = bar; b.x = xb_xcc_id(); b.st = st;
    if (threadIdx.x == 0) (void)xb_add(&bar[XB_XCNT(b.x)], 1u);
    return b;
}
__device__ __forceinline__ void xcd_barrier_complete(unsigned* bar, unsigned x, unsigned& nloc, unsigned& nx) {
    const unsigned G = gridDim.x * gridDim.y * gridDim.z;
    unsigned sum, cnt, mine, sp = 0u;
    for (;;) {
        sum = 0u; cnt = 0u; mine = 0u;
#pragma unroll
        for (unsigned j = 0; j < 16; ++j) { const unsigned c = xb_ld(&bar[XB_XCNT(j)]); sum += c; cnt += (c > 0u) ? 1u : 0u; mine = (j == x) ? c : mine; }
        if (sum == G) break;
        __builtin_amdgcn_s_sleep(1);
        if ((++sp & 255u) == 0u) { if (xb_ld(&bar[XB_TMO])) break; if (sp > XB_SPIN_CAP) { atomicAdd(&bar[XB_TMO], 1u); break; } }
    }
    nloc = mine > 0u ? mine : 1u; nx = cnt > 0u ? cnt : 1u;
}

__device__ __forceinline__ void xcd_barrier(const XcdBarrier& b) {
    asm volatile("s_waitcnt vmcnt(0)" ::: "memory");
    __syncthreads();
    if (threadIdx.x == 0) {
        unsigned* bar = b.bar;
        __builtin_amdgcn_s_waitcnt(0);
        unsigned nloc = b.st[0], nx = b.st[1];
        if (nloc == 0u) { xcd_barrier_complete(bar, b.x, nloc, nx); b.st[0] = nloc; b.st[1] = nx; }
        const unsigned old = xb_add(&bar[XB_XSUB(b.x)], 1u);
        const unsigned gen = old / nloc;
        if (old + 1u == (gen + 1u) * nloc) {
            __builtin_amdgcn_fence(__ATOMIC_RELEASE, "agent");
            asm volatile("s_waitcnt vmcnt(0)" ::: "memory");
            const unsigned og = xb_add(&bar[XB_TOP], 1u);
            const unsigned tg = og / nx;
            if (og + 1u == (tg + 1u) * nx) xb_add(&bar[XB_TOPGEN], 1u);
            else XB_SPIN(xb_ld(&bar[XB_TOPGEN]) == tg, bar);
            __builtin_amdgcn_fence(__ATOMIC_ACQUIRE, "agent");
            xb_add(&bar[XB_XGEN(b.x)], 1u);
            asm volatile("s_waitcnt vmcnt(0)" ::: "memory");
        } else {
            XB_SPIN(xb_ld(&bar[XB_XGEN(b.x)]) == gen, bar);
            __builtin_amdgcn_fence(__ATOMIC_ACQUIRE, "agent");
            asm volatile("s_waitcnt vmcnt(0)" ::: "memory");
        }
    }
    __syncthreads();
}


constexpr size_t WS_BAR = 512 * 1024;
constexpr int MISC_OFF = 131072, MEGA_LDS = 147456;
static_assert(2 * RWKV_LDS <= MISC_OFF && MLSTM_LDS <= MISC_OFF && P0_LDS <= MISC_OFF, "LDS map");

__global__ void __launch_bounds__(NTHR, 2) mega_fwd(Args a) {
    extern __shared__ __attribute__((aligned(16))) unsigned char lds_raw[];
    LAS unsigned char* lds = (LAS unsigned char*)lds_raw;
    volatile LAS unsigned* MISC = (volatile LAS unsigned*)(lds + MISC_OFF);
    const int tid = threadIdx.x, lane = tid & 63, wave = __builtin_amdgcn_readfirstlane(tid >> 6);
    const int G = gridDim.x, bx = blockIdx.x;
    unsigned char* ws = a.ws;
    if (tid < 64) MISC[tid] = 0u;
    __syncthreads();
    XcdBarrier bar = xcd_barrier_post((unsigned*)(ws + WS_BAR), MISC + 8);

    p0_prologue(a, lds, bx * NWAVES + wave, G * NWAVES, lane, wave);
    xcd_barrier(bar);
    { pg8::StaticOrder S; pg8::Gemm g{(const bf16*)(ws + WS_XN), (const bf16*)(ws + WS_WINT), MT, NPROJ, 1024}; S.init(MT, NPROJ, G, bx);
      pg8::EpiProj E{(bf16*)(ws + WS_PR), (bf16*)(ws + WS_PM), (bf16*)(ws + WS_PG), a.in[31]}; pg8::gemm_phase<pg8::EpiProj, pg8::StaticOrder, true, true>(lds, g, S, E); }
    xcd_barrier(bar);
    {
        for (int bi = bx; bi < 32; bi += G) { rwkv_seq_item(a, lds, 2 * bi); __syncthreads(); }
        if (bx >= 32) { LAS float* CW = (LAS float*)lds;
            for (int item = bx - 32; item < 1024; item += G - 32) { stage_conv_head(a, CW, (item >> 5) & 3, tid, NTHR); __syncthreads(); mlstm_prep_task(a, item, wave, CW, lane); __syncthreads(); } }
    }
    xcd_barrier(bar);
    {
        if (bx >= 64 && bx < 104) { if (wave < 4) { const int task = (bx - 64) * 4 + wave; mlstm_scan_task(a, task / 5, task % 5, (LAS float*)lds + wave * 64, lane); } }
        else if (bx >= 104) { for (int s = bx - 104; s < 1024; s += G - 104) { if (s < 512) rwkv_seq_item(a, lds, 64 + 2 * s); else mlstm_seq_item(a, lds, 32 + (s - 512)); __syncthreads(); } }
    }
    xcd_barrier(bar);
    {
        LAS float* CWall = (LAS float*)lds;
        for (int hq = 0; hq < 4; ++hq) stage_conv_head(a, CWall + hq * 640, hq, tid, NTHR);
        __syncthreads();
        for (int task = bx * NWAVES + wave; task < 2048; task += G * NWAVES) mlstm_out_task(a, task >> 1, task & 1, CWall, lane);
    }
    xcd_barrier(bar);
    { pg8::StaticOrder S; pg8::Gemm g{(const bf16*)(ws + WS_YR), (const bf16*)(ws + WS_UPRT), MT, 1024, 512}; S.init(MT, 1024, G, bx);
      pg8::EpiUp1 E{(float*)(ws + WS_UPSCR), (const bf16*)(ws + WS_PG)}; pg8::gemm_phase<pg8::EpiUp1, pg8::StaticOrder, true, true>(lds, g, S, E); }
    xcd_barrier(bar);
    { pg8::StaticOrder S; pg8::Gemm g{(const bf16*)(ws + WS_YM), (const bf16*)(ws + WS_UPMT), MT, 1024, 512}; S.init(MT, 1024, G, bx);
      pg8::EpiUp2 E{(const float*)(ws + WS_UPSCR), (const bf16*)(ws + WS_PG), (bf16*)(ws + WS_MERGED)}; pg8::gemm_phase<pg8::EpiUp2, pg8::StaticOrder, true, true>(lds, g, S, E); }
    xcd_barrier(bar);
    { pg8::StaticOrder S; pg8::Gemm g{(const bf16*)(ws + WS_MERGED), (const bf16*)(ws + WS_WOUTT), MT, 1024, 1024}; S.init(MT, 1024, G, bx);
      pg8::EpiOut E{a.in[0], a.in[1], a.out, (bf16*)(ws + WS_X2B), a.in[33], (float*)(ws + WS_SSQ1)}; pg8::gemm_phase<pg8::EpiOut, pg8::StaticOrder, true, true>(lds, g, S, E); }
    xcd_barrier(bar);
    { pg8::StaticOrder S; pg8::Gemm g{(const bf16*)(ws + WS_X2B), (const bf16*)(ws + WS_W1T), MT, FF, 1024}; S.init(MT, FF, G, bx);
      pg8::EpiFfn1 E{(bf16*)(ws + WS_H), (const float*)(ws + WS_SSQ1)}; pg8::gemm_phase<pg8::EpiFfn1, pg8::StaticOrder, true, true>(lds, g, S, E); }
    xcd_barrier(bar);
    { pg8::StaticOrder S; pg8::Gemm g{(const bf16*)(ws + WS_H), (const bf16*)(ws + WS_W2T), MT, 1024, FF}; S.init(MT, 1024, G, bx);
      pg8::EpiFfn2 E{a.out, (float*)(ws + WS_SSQ2)}; pg8::gemm_phase<pg8::EpiFfn2, pg8::StaticOrder, true, true>(lds, g, S, E); }
    xcd_barrier(bar);
    final_norm_rows(a, bx * NWAVES + wave, G * NWAVES, lane);
}

extern "C" void kernel_launch(void* const* d_in, const int* in_sizes, int n_in, void* d_out, int out_size, void* d_ws, size_t ws_size, hipStream_t stream) {
    static int grid = 0;
    if (grid == 0) {
        if (n_in != 37 || (size_t)out_size != O_END || ws_size < WS_NEED) { fprintf(stderr, "kernel_launch: unexpected problem: n_in %d out %d ws %zu\n", n_in, out_size, ws_size); grid = -1; return; }
        int dev = 0, cus = 0, per_cu = 0;
        if (hipGetDevice(&dev) != hipSuccess || hipDeviceGetAttribute(&cus, hipDeviceAttributeMultiprocessorCount, dev) != hipSuccess) { fprintf(stderr, "kernel_launch: device query failed\n"); grid = -1; return; }
        if (hipFuncSetAttribute((const void*)mega_fwd, hipFuncAttributeMaxDynamicSharedMemorySize, MEGA_LDS) != hipSuccess) { fprintf(stderr, "kernel_launch: hipFuncSetAttribute failed\n"); grid = -1; return; }
        if (hipOccupancyMaxActiveBlocksPerMultiprocessor(&per_cu, (const void*)mega_fwd, NTHR, MEGA_LDS) != hipSuccess || per_cu < 1) { fprintf(stderr, "kernel_launch: occupancy query reports %d workgroups per CU\n", per_cu); (void)hipGetLastError(); per_cu = 1; }
        grid = cus;
    }
    if (grid < 0) return;
    if (hipMemsetAsync((char*)d_ws + WS_BAR, 0, 16384, stream) != hipSuccess) { fprintf(stderr, "kernel_launch: memset failed\n"); return; }
    Args a{};
    for (int i = 0; i < 37; ++i) a.in[i] = (const float*)d_in[i];
    a.out = (float*)d_out; a.ws = (unsigned char*)d_ws;
    void* args[] = {&a};
    hipError_t e = hipLaunchCooperativeKernel((const void*)mega_fwd, dim3(grid), dim3(NTHR), args, MEGA_LDS, stream);
    if (e != hipSuccess) fprintf(stderr, "kernel_launch: cooperative launch failed: %s (grid %d)\n", hipGetErrorString(e), grid);
}
```

```cpp
#include <hip/hip_runtime.h>
#include <cstdio>
#include <cstdint>

constexpr int DM = 1024, MP = 16384, MS = 128, MTOK = MP + MS, MT = 16640;
constexpr int SEQ = 2048, NB = 8;
constexpr int NPR = 1792, NPM = 1536, NPG = 2048, NPROJ = NPR + NPM + NPG, INCOLS = 5384, GCOL0 = 3328;
constexpr int RH = 8, RN = 64, RW = 512, MH = 4, MD = 128, MW = 512, FF = 4096;
constexpr float RMS_EPS = 1e-6f, R_GN_EPS = 64e-5f, M_GN_EPS = 1e-5f;

constexpr size_t O_Y = 0;
constexpr size_t O_PSHIFT = (size_t)MTOK * DM;
constexpr size_t O_PWKV = O_PSHIFT + (size_t)NB * DM;
constexpr size_t O_PC = O_PWKV + (size_t)NB * RH * RN * RN;
constexpr size_t O_PN = O_PC + (size_t)NB * MH * MD * MD;
constexpr size_t O_PMM = O_PN + (size_t)NB * MH * MD;
constexpr size_t O_PCONV = O_PMM + (size_t)NB * MH;
constexpr size_t O_SSHIFT = O_PCONV + (size_t)NB * 3 * MW;
constexpr size_t O_SWKV = O_SSHIFT + (size_t)MS * DM;
constexpr size_t O_SC = O_SWKV + (size_t)MS * RH * RN * RN;
constexpr size_t O_SN = O_SC + (size_t)MS * MH * MD * MD;
constexpr size_t O_SMM = O_SN + (size_t)MS * MH * MD;
constexpr size_t O_SCONV = O_SMM + (size_t)MS * MH;
constexpr size_t O_END = O_SCONV + (size_t)MS * 3 * MW;
static_assert(O_END == 30695968, "output size");

constexpr size_t MiB = 1u << 20;
constexpr size_t WS_CTL = 0;
constexpr size_t WS_SSQ1 = 0, WS_SSQ2 = 128 * 1024;
constexpr size_t WS_WINT = 1 * MiB, WS_UPRT = 12 * MiB, WS_UPMT = 13 * MiB, WS_WOUTT = 14 * MiB, WS_W1T = 16 * MiB, WS_W2T = 24 * MiB;
constexpr size_t WS_GATES = 32 * MiB;
constexpr size_t WS_WQT = 32 * MiB + 576 * 1024, WS_WKT = 32 * MiB + 704 * 1024;
constexpr size_t WS_LW2T = 576 * 1024, WS_LA2T = 640 * 1024, WS_LG2T = 704 * 1024;
constexpr size_t WS_XN = 33 * MiB;
constexpr size_t WS_YM = 33 * MiB, WS_X2B = 33 * MiB;
constexpr size_t WS_PR = 66 * MiB;
constexpr size_t WS_PM = 123 * MiB;
constexpr size_t WS_PG = 172 * MiB;
constexpr size_t WS_YR = 237 * MiB;
constexpr size_t WS_MERGED = 66 * MiB;
constexpr size_t WS_UPSCR = 100 * MiB;
constexpr size_t WS_H = 66 * MiB;
constexpr size_t WS_NEED = 256 * MiB;
static_assert(WS_YR + (size_t)MT * 512 * 2 <= WS_NEED && WS_H + (size_t)MT * FF * 2 <= WS_NEED && WS_PG + (size_t)MT * NPG * 2 <= WS_YR && WS_UPSCR + (size_t)MT * DM * 4 <= WS_PG, "ws map");

#define GAS __attribute__((address_space(1)))
#define LAS __attribute__((address_space(3)))
typedef unsigned short bf16;
typedef unsigned v4u __attribute__((ext_vector_type(4)));
typedef unsigned v2u __attribute__((ext_vector_type(2)));
typedef float f32x4 __attribute__((ext_vector_type(4)));
typedef float f32x2 __attribute__((ext_vector_type(2)));
__device__ __forceinline__ unsigned f2bf(float f) { unsigned u = __builtin_bit_cast(unsigned, f); return (u + 0x7fffu + ((u >> 16) & 1u)) >> 16; }
__device__ __forceinline__ unsigned pk2(float lo, float hi) { return f2bf(lo) | (f2bf(hi) << 16); }
__device__ __forceinline__ float bf2f(unsigned b) { return __builtin_bit_cast(float, b << 16); }
__device__ __forceinline__ float bflo(unsigned w) { return __builtin_bit_cast(float, w << 16); }
__device__ __forceinline__ float bfhi(unsigned w) { return __builtin_bit_cast(float, w & 0xffff0000u); }
__device__ __forceinline__ float sigmoidf_(float x) { return 1.0f / (1.0f + __expf(-x)); }
__device__ __forceinline__ float wave_sum(float v) {
#pragma unroll
    for (int o = 1; o < 64; o <<= 1) v += __shfl_xor(v, o);
    return v;
}

namespace pg8 {
#define PG8_LAS __attribute__((address_space(3)))
typedef unsigned short bf16_t;
typedef short bf16x8 __attribute__((ext_vector_type(8)));
typedef float f32x4 __attribute__((ext_vector_type(4)));
typedef unsigned u32x4 __attribute__((ext_vector_type(4)));
constexpr int BM = 256, BK = 64, HALF = 128, HTB = HALF * BK * 2  , STAGE_BYTES = 8 * HTB, NXCD = 8, WGM = 8;

__host__ __device__ __forceinline__ int lds_byte(int r, int c) { const int st = (r >> 4) * 2 + (c >> 5), rr = r & 15, cc = c & 31, ob = rr * 64 + cc * 2; return st * 1024 + (ob ^ (((ob >> 9) & 1) << 5)); }
__host__ __device__ __forceinline__ void stage_rc(int b, int& R, int& C) { const int st = b / 1024, sb = b % 1024, swz = sb ^ (((sb >> 9) & 1) << 5); R = (st >> 1) * 16 + swz / 64; C = (st & 1) * 32 + (swz % 64) / 2; }
__host__ __device__ __forceinline__ int perm32(int rho) { const int n = rho >> 4, i = rho & 15; return 8 * (i >> 2) + 4 * n + (i & 3); }

struct Unit { int pm, pn; };
struct Gemm { const bf16_t* A; const bf16_t* Bt; int M, N, K, lda; };

struct StaticOrder {
    int nM, nN, nwg, G, c;
    __host__ __device__ void init(int M, int N, int G_, int c_) { nM = M / BM; nN = N / BM; nwg = nM * nN; G = G_; c = c_; }
    __host__ __device__ bool next(int i, Unit& u) const {
        const long L = (long)i * G + c; if (L >= nwg) return false;
        int wgid = (int)L; { const int q = nwg / NXCD, r = nwg % NXCD, xcd = wgid % NXCD, off = wgid / NXCD; wgid = (xcd < r ? xcd * (q + 1) : r * (q + 1) + (xcd - r) * q) + off; }
        const int nig = WGM * nN, gid = wgid / nig, fm = gid * WGM, gsz = (nM - fm) < WGM ? (nM - fm) : WGM;
        u.pm = fm + ((wgid % nig) % gsz); u.pn = (wgid % nig) / gsz; return true;
    }
    __device__ __forceinline__ void a_ready(const Unit&) const {}
    __device__ __forceinline__ void done(const Unit&) const {}
};

__device__ __forceinline__ unsigned cvt_pk_bf16(float lo, float hi) { unsigned r; asm volatile("v_cvt_pk_bf16_f32 %0, %1, %2" : "=v"(r) : "v"(lo), "v"(hi)); return r; }
typedef unsigned u32x2 __attribute__((ext_vector_type(2)));
__device__ __forceinline__ float sigm(float x) { return 1.0f / (1.0f + __expf(-x)); }
__device__ __forceinline__ float bf_lo(unsigned w) { return __builtin_bit_cast(float, w << 16); }
__device__ __forceinline__ float bf_hi(unsigned w) { return __builtin_bit_cast(float, w & 0xffff0000u); }

struct EpiProj {
    static constexpr bool PERM = true, AFTER_DRAIN = false;
    bf16_t *PR, *PM, *PG; const float* gate_b; bf16_t* BND;
    __device__ __forceinline__ void operator()(const f32x4 (&acc)[2][2][4][2], const Unit& u, int wr, int wc, int fr, int fq) const {
        int colt = u.pn * BM; bf16_t* base; int ldc; bool gate = false;
        if (colt < 1792) { base = PR; ldc = 1792; } else if (colt < 3328) { base = PM; ldc = 1536; colt -= 1792; } else { base = PG; ldc = 2048; colt -= 3328; gate = true; }
        const int row0 = u.pm * BM + wr * 64 + fr, col0 = colt + wc * 32 + 8 * fq;
        f32x4 bv[2][2];
#pragma unroll
        for (int bj = 0; bj < 2; ++bj)
#pragma unroll
            for (int n = 0; n < 2; ++n) bv[bj][n] = gate ? *(const f32x4*)(gate_b + col0 + bj * HALF + 4 * n) : (f32x4){0.f, 0.f, 0.f, 0.f};
#pragma unroll
        for (int ai = 0; ai < 2; ++ai)
#pragma unroll
            for (int m = 0; m < 4; ++m) { bf16_t* rowp = base + (size_t)(row0 + ai * HALF + m * 16) * ldc + col0;
#pragma unroll
                for (int bj = 0; bj < 2; ++bj) { f32x4 v0 = acc[ai][bj][m][0] + bv[bj][0], v1 = acc[ai][bj][m][1] + bv[bj][1];
                    if (gate) {
#pragma unroll
                        for (int j = 0; j < 4; ++j) { v0[j] = sigm(v0[j]); v1[j] = sigm(v1[j]); } }
                    u32x4 w; w.x = cvt_pk_bf16(v0[0], v0[1]); w.y = cvt_pk_bf16(v0[2], v0[3]); w.z = cvt_pk_bf16(v1[0], v1[1]); w.w = cvt_pk_bf16(v1[2], v1[3]);
                    *(u32x4*)(rowp + bj * HALF) = w;
                    if (m == 3 && fr == 15 && base == PR && u.pm < 64) *(u32x4*)(BND + (size_t)((row0 + ai * HALF + m * 16) >> 6) * 1792 + col0 + bj * HALF) = w; } }
    }
};
struct EpiUp1 {
    static constexpr bool PERM = false, AFTER_DRAIN = false;
    float* SCR; const bf16_t* PG;
    __device__ __forceinline__ void operator()(const f32x4 (&acc)[2][2][4][2], const Unit& u, int wr, int wc, int fr, int fq) const {
        const int row0 = u.pm * BM + wr * 64 + fr, col0 = u.pn * BM + wc * 32 + 4 * fq;
#pragma unroll
        for (int ai = 0; ai < 2; ++ai) {
            if (u.pm * BM + ai * HALF >= 16512) continue;
#pragma unroll
            for (int m = 0; m < 4; ++m) { const size_t row = (size_t)(row0 + ai * HALF + m * 16);
#pragma unroll
                for (int bj = 0; bj < 2; ++bj)
#pragma unroll
                    for (int n = 0; n < 2; ++n) { const int c = col0 + bj * HALF + n * 16; const u32x2 g = *(const u32x2*)(PG + row * 2048 + c);
                        f32x4 v = acc[ai][bj][m][n]; v[0] *= bf_lo(g.x); v[1] *= bf_hi(g.x); v[2] *= bf_lo(g.y); v[3] *= bf_hi(g.y);
                        *(f32x4*)(SCR + row * 1024 + c) = v; } } }
    }
};
struct EpiUp2 {
    static constexpr bool PERM = false, AFTER_DRAIN = false;
    const float* SCR; const bf16_t* PG; bf16_t* MG;
    __device__ __forceinline__ void operator()(const f32x4 (&acc)[2][2][4][2], const Unit& u, int wr, int wc, int fr, int fq) const {
        const int row0 = u.pm * BM + wr * 64 + fr, col0 = u.pn * BM + wc * 32 + 4 * fq;
#pragma unroll
        for (int ai = 0; ai < 2; ++ai) {
            if (u.pm * BM + ai * HALF >= 16512) continue;
#pragma unroll
            for (int m = 0; m < 4; ++m) { const size_t row = (size_t)(row0 + ai * HALF + m * 16);
#pragma unroll
                for (int bj = 0; bj < 2; ++bj)
#pragma unroll
                    for (int n = 0; n < 2; ++n) { const int c = col0 + bj * HALF + n * 16; const u32x2 g = *(const u32x2*)(PG + row * 2048 + 1024 + c);
                        const f32x4 s = *(const f32x4*)(SCR + row * 1024 + c); f32x4 v = acc[ai][bj][m][n];
                        v[0] = s[0] + v[0] * bf_lo(g.x); v[1] = s[1] + v[1] * bf_hi(g.x); v[2] = s[2] + v[2] * bf_lo(g.y); v[3] = s[3] + v[3] * bf_hi(g.y);
                        u32x2 w; w.x = cvt_pk_bf16(v[0], v[1]); w.y = cvt_pk_bf16(v[2], v[3]); *(u32x2*)(MG + row * 1024 + c) = w; } } }
    }
};
struct EpiOut {
    static constexpr bool PERM = false, AFTER_DRAIN = false;
    const float *xp, *xs; float* OUT; bf16_t* X2B; const float* gffn; float* ssq;
    __device__ __forceinline__ void operator()(const f32x4 (&acc)[2][2][4][2], const Unit& u, int wr, int wc, int fr, int fq) const {
        const int row0 = u.pm * BM + wr * 64 + fr, col0 = u.pn * BM + wc * 32 + 4 * fq;
        f32x4 gv[2][2];
#pragma unroll
        for (int bj = 0; bj < 2; ++bj)
#pragma unroll
            for (int n = 0; n < 2; ++n) gv[bj][n] = *(const f32x4*)(gffn + col0 + bj * HALF + n * 16);
#pragma unroll
        for (int ai = 0; ai < 2; ++ai) {
            if (u.pm * BM + ai * HALF >= 16512) continue;
#pragma unroll
            for (int m = 0; m < 4; ++m) { const int row = row0 + ai * HALF + m * 16;
                const float* xin = row < 16384 ? xp + (size_t)row * 1024 : xs + (size_t)(row - 16384) * 1024; float sq = 0.f;
#pragma unroll
                for (int bj = 0; bj < 2; ++bj)
#pragma unroll
                    for (int n = 0; n < 2; ++n) { const int c = col0 + bj * HALF + n * 16; const f32x4 v = *(const f32x4*)(xin + c) + acc[ai][bj][m][n];
                        *(f32x4*)(OUT + (size_t)row * 1024 + c) = v; sq += (v[0] * v[0] + v[1] * v[1]) + (v[2] * v[2] + v[3] * v[3]);
                        const f32x4 h = v * gv[bj][n]; u32x2 w; w.x = cvt_pk_bf16(h[0], h[1]); w.y = cvt_pk_bf16(h[2], h[3]); *(u32x2*)(X2B + (size_t)row * 1024 + c) = w; }
                sq += __shfl_xor(sq, 16); sq += __shfl_xor(sq, 32);
                if (fq == 0) atomicAdd(ssq + row, sq); }
        }
    }
};
struct EpiFfn1 {
    static constexpr bool PERM = true, AFTER_DRAIN = false;
    bf16_t* H; const float* ssq;
    __device__ __forceinline__ void operator()(const f32x4 (&acc)[2][2][4][2], const Unit& u, int wr, int wc, int fr, int fq) const {
        const int row0 = u.pm * BM + wr * 64 + fr, col0 = u.pn * BM + wc * 32 + 8 * fq;
#pragma unroll
        for (int ai = 0; ai < 2; ++ai)
#pragma unroll
            for (int m = 0; m < 4; ++m) { const int row = row0 + ai * HALF + m * 16; const float rs = rsqrtf(ssq[row] * (1.0f / 1024.0f) + 1e-6f);
                bf16_t* rowp = H + (size_t)row * 4096 + col0;
#pragma unroll
                for (int bj = 0; bj < 2; ++bj) { f32x4 v0 = acc[ai][bj][m][0] * rs, v1 = acc[ai][bj][m][1] * rs;
#pragma unroll
                    for (int j = 0; j < 4; ++j) { const float a = fmaxf(v0[j], 0.f), b = fmaxf(v1[j], 0.f); v0[j] = a * a; v1[j] = b * b; }
                    u32x4 w; w.x = cvt_pk_bf16(v0[0], v0[1]); w.y = cvt_pk_bf16(v0[2], v0[3]); w.z = cvt_pk_bf16(v1[0], v1[1]); w.w = cvt_pk_bf16(v1[2], v1[3]);
                    *(u32x4*)(rowp + bj * HALF) = w; } }
    }
};
struct EpiFfn2 {
    static constexpr bool PERM = false, AFTER_DRAIN = false;
    float* OUT; float* ssq;
    __device__ __forceinline__ void operator()(const f32x4 (&acc)[2][2][4][2], const Unit& u, int wr, int wc, int fr, int fq) const {
        const int row0 = u.pm * BM + wr * 64 + fr, col0 = u.pn * BM + wc * 32 + 4 * fq;
#pragma unroll
        for (int ai = 0; ai < 2; ++ai) {
            if (u.pm * BM + ai * HALF >= 16512) continue;
#pragma unroll
            for (int m = 0; m < 4; ++m) { const int row = row0 + ai * HALF + m * 16; float sq = 0.f;
#pragma unroll
                for (int bj = 0; bj < 2; ++bj)
#pragma unroll
                    for (int n = 0; n < 2; ++n) { float* p = OUT + (size_t)row * 1024 + col0 + bj * HALF + n * 16; const f32x4 v = *(const f32x4*)p + acc[ai][bj][m][n];
                        *(f32x4*)p = v; sq += (v[0] * v[0] + v[1] * v[1]) + (v[2] * v[2] + v[3] * v[3]); }
                sq += __shfl_xor(sq, 16); sq += __shfl_xor(sq, 32);
                if (fq == 0) atomicAdd(ssq + row, sq); }
        }
    }
};

template <class Epi, class Sched, bool ALIGN_EPI = false, bool SP2 = false>
__device__ __forceinline__ void gemm_phase(PG8_LAS unsigned char* lds, const Gemm g, const Sched& S, const Epi& E) {
    int tid_ = threadIdx.x; asm volatile("" : "+v"(tid_));
    const int tid = tid_, wid = __builtin_amdgcn_readfirstlane(tid >> 6), lane = tid & 63, wr = wid >> 2, wc = wid & 3, fr = lane & 15, fq = lane >> 4;
    const int K = g.K, nt = K / BK;
    unsigned voffA[2], voffB[2];
#pragma unroll
    for (int i = 0; i < 2; ++i) { int R, C; stage_rc(tid * 16 + i * 8192, R, C); const int Rb = Epi::PERM ? ((R & ~31) + perm32(R & 31)) : R;
        voffA[i] = (unsigned)(R * g.lda + C) * 2u; voffB[i] = (unsigned)(Rb * K + C) * 2u; }
    const size_t kstep = (size_t)(BK * 2);
    const size_t hstep = (size_t)HALF * K * 2;
    const size_t tstep = 2 * hstep;
    const size_t hstepA = (size_t)HALF * g.lda * 2, tstepA = 2 * hstepA;
    const unsigned ldsw = (unsigned)wid * 1024u;
    const int aoff = lds_byte(wr * 64 + fr, fq * 8), boff = lds_byte(wc * 32 + fr, fq * 8);
#define PG8_SA(b, h) (((b) * 2 + (h)) * HTB)
#define PG8_SB(b, h) ((4 + (b) * 2 + (h)) * HTB)
#define PG8_STAGE(bufoff, gbase, voff) do { _Pragma("unroll") for (int _i = 0; _i < 2; ++_i) \
        __builtin_amdgcn_global_load_lds((const unsigned*)((const char*)(gbase) + (voff)[_i]), (PG8_LAS unsigned*)(lds + (bufoff) + ldsw + _i * 8192), 16, 0, 0); } while (0)
#define PG8_LDA(dst, b, h) do { _Pragma("unroll") for (int m = 0; m < 4; ++m) _Pragma("unroll") for (int k = 0; k < 2; ++k) dst[m][k] = *(const PG8_LAS bf16x8*)(lds + PG8_SA(b, h) + aoff + m * 2048 + k * 1024); } while (0)
#define PG8_LDB(dst, b, h) do { _Pragma("unroll") for (int n = 0; n < 2; ++n) _Pragma("unroll") for (int k = 0; k < 2; ++k) dst[n][k] = *(const PG8_LAS bf16x8*)(lds + PG8_SB(b, h) + boff + n * 2048 + k * 1024); } while (0)
#define PG8_MMA(ai, bj, At, Bt) do { __builtin_amdgcn_s_setprio(1); _Pragma("unroll") for (int m = 0; m < 4; ++m) _Pragma("unroll") for (int n = 0; n < 2; ++n) _Pragma("unroll") for (int k = 0; k < 2; ++k) \
        acc[ai][bj][m][n] = __builtin_amdgcn_mfma_f32_16x16x32_bf16(Bt[n][k], At[m][k], acc[ai][bj][m][n], 0, 0, 0); __builtin_amdgcn_s_setprio(0); } while (0)
#define PG8_WAIT_V(n) asm volatile("s_waitcnt vmcnt(" #n ")" ::: "memory")
#define PG8_WAIT_L(n) asm volatile("s_waitcnt lgkmcnt(" #n ")" ::: "memory")
#define PG8_BAR __builtin_amdgcn_s_barrier()
#define PG8_SCHED __builtin_amdgcn_sched_barrier(0)
    Unit cur, nxt; int ui = 0;
    if (!S.next(0, cur)) return;
    f32x4 acc[2][2][4][2];
#pragma unroll
    for (int a = 0; a < 2; ++a)
#pragma unroll
        for (int b = 0; b < 2; ++b)
#pragma unroll
            for (int m = 0; m < 4; ++m)
#pragma unroll
                for (int n = 0; n < 2; ++n) acc[a][b][m][n] = (f32x4){0.f, 0.f, 0.f, 0.f};
    bf16x8 At[4][2], B0[2][2], B1[2][2];
    const char* cA = (const char*)g.A + (size_t)cur.pm * tstepA; const char* cB = (const char*)g.Bt + (size_t)cur.pn * tstep;
    S.a_ready(cur);
    if constexpr (SP2) {
        PG8_STAGE(PG8_SB(0, 0), cB, voffB); PG8_STAGE(PG8_SB(0, 1), cB + hstep, voffB); PG8_STAGE(PG8_SA(0, 0), cA, voffA); PG8_STAGE(PG8_SA(0, 1), cA + hstepA, voffA);
        if (wr == 1) PG8_BAR;
        PG8_WAIT_V(2); PG8_BAR;
        PG8_STAGE(PG8_SB(1, 0), cB + kstep, voffB); PG8_STAGE(PG8_SA(1, 0), cA + kstep, voffA); PG8_STAGE(PG8_SB(1, 1), cB + hstep + kstep, voffB);
        PG8_WAIT_V(6); PG8_BAR;
    } else {
        PG8_STAGE(PG8_SB(0, 0), cB, voffB); PG8_STAGE(PG8_SA(0, 0), cA, voffA); PG8_STAGE(PG8_SB(0, 1), cB + hstep, voffB); PG8_STAGE(PG8_SA(0, 1), cA + hstepA, voffA);
        if (wr == 1) PG8_BAR;
        PG8_WAIT_V(4); PG8_BAR;
        PG8_STAGE(PG8_SB(1, 0), cB + kstep, voffB); PG8_STAGE(PG8_SA(1, 0), cA + kstep, voffA); PG8_STAGE(PG8_SB(1, 1), cB + hstep + kstep, voffB);
        PG8_WAIT_V(6); PG8_BAR;
    }
    for (;;) {
        const bool has_next = S.next(ui + 1, nxt);
        const char* nA = has_next ? (const char*)g.A + (size_t)nxt.pm * tstepA : cA; const char* nB = has_next ? (const char*)g.Bt + (size_t)nxt.pn * tstep : cB;
        for (int t = 0; t < nt; t += 2) {
            const bool last = (t == nt - 2);
            const char* a1 = cA + (size_t)(t + 1) * kstep;
            const char* a2 = last ? nA : cA + (size_t)(t + 2) * kstep; const char* b2 = last ? nB : cB + (size_t)(t + 2) * kstep;
            const char* a3 = a2 + kstep; const char* b3 = b2 + kstep;
            if (last && has_next) S.a_ready(nxt);
            if constexpr (SP2) {
            PG8_LDB(B0, 0, 0); PG8_LDB(B1, 0, 1); PG8_SCHED; PG8_LDA(At, 0, 0); PG8_STAGE(PG8_SA(1, 1), a1 + hstepA, voffA);
            PG8_WAIT_V(8); PG8_WAIT_L(0); PG8_BAR; PG8_MMA(0, 0, At, B0); PG8_MMA(0, 1, At, B1); PG8_BAR; PG8_SCHED;
            PG8_LDA(At, 0, 1); PG8_STAGE(PG8_SB(0, 0), b2, voffB); PG8_STAGE(PG8_SB(0, 1), b2 + hstep, voffB); PG8_STAGE(PG8_SA(0, 0), a2, voffA);
            PG8_WAIT_V(8); PG8_WAIT_L(0); PG8_BAR; PG8_MMA(1, 0, At, B0); PG8_MMA(1, 1, At, B1); PG8_BAR; PG8_SCHED;
            PG8_LDB(B0, 1, 0); PG8_LDB(B1, 1, 1); PG8_SCHED; PG8_LDA(At, 1, 0); PG8_STAGE(PG8_SA(0, 1), a2 + hstepA, voffA);
            PG8_WAIT_V(8); PG8_WAIT_L(0); PG8_BAR; PG8_MMA(0, 0, At, B0); PG8_MMA(0, 1, At, B1); PG8_BAR; PG8_SCHED;
            PG8_LDA(At, 1, 1); PG8_STAGE(PG8_SB(1, 0), b3, voffB); PG8_STAGE(PG8_SB(1, 1), b3 + hstep, voffB); PG8_STAGE(PG8_SA(1, 0), a3, voffA);
            PG8_WAIT_V(8); PG8_WAIT_L(0); PG8_BAR; PG8_MMA(1, 0, At, B0); PG8_MMA(1, 1, At, B1); PG8_BAR; PG8_SCHED;
            } else {
            PG8_LDB(B0, 0, 0); PG8_SCHED; PG8_LDA(At, 0, 0); PG8_STAGE(PG8_SA(1, 1), a1 + hstepA, voffA);
            PG8_WAIT_L(8); PG8_BAR; PG8_WAIT_L(0); PG8_MMA(0, 0, At, B0); PG8_BAR; PG8_SCHED;
            PG8_LDB(B1, 0, 1); PG8_STAGE(PG8_SB(0, 0), b2, voffB);
            PG8_BAR; PG8_WAIT_L(0); PG8_MMA(0, 1, At, B1); PG8_BAR;
            PG8_LDA(At, 0, 1); PG8_STAGE(PG8_SA(0, 0), a2, voffA);
            PG8_BAR; PG8_WAIT_L(0); PG8_MMA(1, 0, At, B0); PG8_BAR; PG8_SCHED;
            PG8_STAGE(PG8_SB(0, 1), b2 + hstep, voffB);
            PG8_WAIT_V(6); PG8_BAR; PG8_MMA(1, 1, At, B1); PG8_BAR;
            PG8_LDB(B0, 1, 0); PG8_SCHED; PG8_LDA(At, 1, 0); PG8_STAGE(PG8_SA(0, 1), a2 + hstepA, voffA);
            PG8_WAIT_L(8); PG8_BAR; PG8_WAIT_L(0); PG8_MMA(0, 0, At, B0); PG8_BAR; PG8_SCHED;
            PG8_LDB(B1, 1, 1); PG8_STAGE(PG8_SB(1, 0), b3, voffB);
            PG8_BAR; PG8_WAIT_L(0); PG8_MMA(0, 1, At, B1); PG8_BAR;
            PG8_LDA(At, 1, 1); PG8_STAGE(PG8_SA(1, 0), a3, voffA);
            PG8_BAR; PG8_WAIT_L(0); PG8_MMA(1, 0, At, B0); PG8_BAR; PG8_SCHED;
            PG8_STAGE(PG8_SB(1, 1), b3 + hstep, voffB);
            PG8_WAIT_V(6); PG8_BAR; PG8_MMA(1, 1, At, B1); PG8_BAR;
            }
        }
        if constexpr (ALIGN_EPI) { if (wr == 0) PG8_BAR; }
        if constexpr (!Epi::AFTER_DRAIN) { E(acc, cur, wr, wc, fr, fq); S.done(cur); }
        if (!has_next) break;
#pragma unroll
        for (int a = 0; a < 2; ++a)
#pragma unroll
            for (int b = 0; b < 2; ++b)
#pragma unroll
                for (int m = 0; m < 4; ++m)
#pragma unroll
                    for (int n = 0; n < 2; ++n) acc[a][b][m][n] = (f32x4){0.f, 0.f, 0.f, 0.f};
        cur = nxt; cA = nA; cB = nB; ++ui;
        if constexpr (ALIGN_EPI) { if (wr == 1) PG8_BAR; }
    }
    PG8_WAIT_V(0);
    if constexpr (!ALIGN_EPI) { if (wr == 0) PG8_BAR; }
    PG8_BAR;
    if constexpr (Epi::AFTER_DRAIN) { E.fused(acc, cur, wr, wc, fr, fq, lds, wid, lane); S.done(cur); }
#undef PG8_SA
#undef PG8_SB
#undef PG8_STAGE
#undef PG8_LDA
#undef PG8_LDB
#undef PG8_MMA
#undef PG8_WAIT_V
#undef PG8_WAIT_L
#undef PG8_BAR
#undef PG8_SCHED
}
}

struct Args {
    const float* in[37];
    float* out; unsigned char* ws;
};
constexpr int NWAVES = 8, NTHR = 512;
constexpr int GEMM_LDS = 131072;

#define LDS_WAIT() asm volatile("s_waitcnt lgkmcnt(0)" ::: "memory")

__device__ __forceinline__ void transpose_item(const float* W, int ldw, int nblk, bf16* WT, int ldt, int item, LAS float* scr, int lane, float sc = 1.0f) {
    const int kb = item / nblk, nb = item % nblk, k0 = 64 * kb, n0 = 32 * nb;
#pragma unroll 8
    for (int i = 0; i < 32; ++i) { const int kk = 2 * i + (lane >> 5); scr[kk * 33 + (lane & 31)] = W[(size_t)(k0 + kk) * ldw + n0 + (lane & 31)]; }
    LDS_WAIT(); asm volatile("" ::: "memory");
    const int c = lane & 7;
#pragma unroll
    for (int j = 0; j < 4; ++j) { const int n = (lane >> 3) + 8 * j; const LAS float* s = scr + (8 * c) * 33 + n;
        v4u o; o.x = pk2(s[0 * 33] * sc, s[1 * 33] * sc); o.y = pk2(s[2 * 33] * sc, s[3 * 33] * sc); o.z = pk2(s[4 * 33] * sc, s[5 * 33] * sc); o.w = pk2(s[6 * 33] * sc, s[7 * 33] * sc);
        *(v4u*)(WT + (size_t)(n0 + n) * ldt + k0 + 8 * c) = o; }
    LDS_WAIT(); asm volatile("" ::: "memory");
}

constexpr int P0_LDS = 8 * 64 * 33 * 4 + 8 * 1024 * 4;
__device__ __forceinline__ void p0_prologue(const Args& a, LAS unsigned char* lds, int gw, int NGW, int lane, int wave) {
    unsigned char* ws = a.ws;
    LAS float* scr = (LAS float*)(lds) + wave * (64 * 33);
    LAS float* wg = (LAS float*)(lds + 8 * 64 * 33 * 4);
    const float* w_in = a.in[9];
    for (int i = threadIdx.x; i < 8 * 1024; i += NTHR) { const int k = i >> 3, c = i & 7; wg[c * 1024 + k] = w_in[(size_t)k * INCOLS + GCOL0 + c]; }
    { float* z = (float*)(ws + WS_CTL); for (int i = gw * 64 + lane; i < 65536; i += NGW * 64) z[i] = 0.f; }
    constexpr int I_IN1 = 16 * (3328 / 32), I_IN2 = 16 * (2048 / 32), I_UP = 8 * 32, I_OUT = 16 * 32, I_F1 = 16 * 128, I_F2 = 64 * 32;
    constexpr int I_QK = 8 * 8;
    constexpr int I_LW = 16, I_LG = 32;
    constexpr int NITEMS = I_IN1 + I_IN2 + 2 * I_UP + I_OUT + I_F1 + I_F2 + I_QK + 2 * I_LW + I_LG;
    for (int it = gw; it < NITEMS; it += NGW) {
        int r = it;
        if (r < I_IN1) { transpose_item(w_in, INCOLS, 3328 / 32, (bf16*)(ws + WS_WINT), 1024, r, scr, lane); continue; } r -= I_IN1;
        if (r < I_IN2) { transpose_item(w_in + 3336, INCOLS, 2048 / 32, (bf16*)(ws + WS_WINT) + (size_t)3328 * 1024, 1024, r, scr, lane); continue; } r -= I_IN2;
        if (r < I_UP) { transpose_item(a.in[21], 1024, 32, (bf16*)(ws + WS_UPRT), 512, r, scr, lane); continue; } r -= I_UP;
        if (r < I_UP) { transpose_item(a.in[30], 1024, 32, (bf16*)(ws + WS_UPMT), 512, r, scr, lane); continue; } r -= I_UP;
        if (r < I_OUT) { transpose_item(a.in[32], 1024, 32, (bf16*)(ws + WS_WOUTT), 1024, r, scr, lane); continue; } r -= I_OUT;
        if (r < I_F1) { transpose_item(a.in[34], 4096, 128, (bf16*)(ws + WS_W1T), 1024, r, scr, lane); continue; } r -= I_F1;
        if (r < I_F2) { transpose_item(a.in[35], 1024, 32, (bf16*)(ws + WS_W2T), 4096, r, scr, lane); continue; } r -= I_F2;
        if (r >= I_QK) { r -= I_QK;
            if (r < I_LW) { transpose_item(a.in[12], 512, 16, (bf16*)(ws + WS_LW2T), 64, r, scr, lane); continue; } r -= I_LW;
            if (r < I_LW) { transpose_item(a.in[14], 512, 16, (bf16*)(ws + WS_LA2T), 64, r, scr, lane); continue; } r -= I_LW;
            transpose_item(a.in[15], 512, 16, (bf16*)(ws + WS_LG2T), 128, r, scr, lane); continue; }
        { const int mat = r >> 3, hq = mat & 3, isk = mat >> 2;
          transpose_item((isk ? a.in[25] : a.in[24]) + (size_t)hq * 16384, 128, 4, (bf16*)(ws + (isk ? WS_WKT : WS_WQT)) + (size_t)hq * 16384, 128, r & 7, scr, lane, isk ? 1.0f : 0.08838834764831845f); }
    }
    __syncthreads();
    const float* gmix = a.in[8];
    f32x4 gv[4];
#pragma unroll
    for (int j = 0; j < 4; ++j) gv[j] = ((const f32x4*)gmix)[lane + 64 * j];
    bf16* XN = (bf16*)(ws + WS_XN); float* GATES = (float*)(ws + WS_GATES);
    for (int row = gw; row < MT; row += NGW) {
        unsigned long long* o8 = (unsigned long long*)(XN + (size_t)row * 1024) + lane;
        if (row >= MTOK) {
            const f32x4* xr = (const f32x4*)(a.in[2] + (size_t)(row - MTOK) * 1024) + lane;
#pragma unroll
            for (int j = 0; j < 4; ++j) { const f32x4 v = xr[64 * j]; o8[64 * j] = (unsigned long long)pk2(v.x, v.y) | ((unsigned long long)pk2(v.z, v.w) << 32); }
            continue;
        }
        const f32x4* xr = (const f32x4*)(row < MP ? a.in[0] + (size_t)row * 1024 : a.in[1] + (size_t)(row - MP) * 1024) + lane;
        f32x4 v[4]; float s = 0.f;
#pragma unroll
        for (int j = 0; j < 4; ++j) { v[j] = xr[64 * j]; s += (v[j].x * v[j].x + v[j].y * v[j].y) + (v[j].z * v[j].z + v[j].w * v[j].w); }
        const float rstd = rsqrtf(wave_sum(s) * (1.f / 1024.f) + RMS_EPS);
#pragma unroll
        for (int j = 0; j < 4; ++j) { v[j] = v[j] * rstd * gv[j]; o8[64 * j] = (unsigned long long)pk2(v[j].x, v[j].y) | ((unsigned long long)pk2(v[j].z, v[j].w) << 32); }
        float gsum[8];
#pragma unroll
        for (int c = 0; c < 8; ++c) { float p = 0.f;
#pragma unroll
            for (int j = 0; j < 4; ++j) { const f32x4 w = *(const LAS f32x4*)(wg + c * 1024 + 4 * (lane + 64 * j)); p += (v[j].x * w.x + v[j].y * w.y) + (v[j].z * w.z + v[j].w * w.w); }
            gsum[c] = wave_sum(p); }
        if (lane < 8) { float g = gsum[0];
#pragma unroll
            for (int c = 1; c < 8; ++c) g = (lane == c) ? gsum[c] : g;
            GATES[(size_t)row * 8 + lane] = g; }
        float* so = nullptr;
        if (row >= MP) so = a.out + O_SSHIFT + (size_t)(row - MP) * 1024;
        else if ((row & (SEQ - 1)) == SEQ - 1) so = a.out + O_PSHIFT + (size_t)(row >> 11) * 1024;
        if (so) {
#pragma unroll
            for (int j = 0; j < 4; ++j) ((f32x4*)so)[lane + 64 * j] = v[j]; }
    }
}

constexpr int RCH = 16;
constexpr int RWKV_LDS = (RCH * 256 + 8 * RCH * 64 + RCH) * 4;
__device__ __forceinline__ void rwkv_seq_item(const Args& a, LAS unsigned char* ldsb0, int item0) {
    const int tid = threadIdx.x & 255, lane = tid & 63, wv = tid >> 6; const int item = item0 + (threadIdx.x >> 8);
    LAS unsigned char* ldsb = ldsb0 + (threadIdx.x >> 8) * RWKV_LDS;
    const bf16* PR = (const bf16*)(a.ws + WS_PR); bf16* YR = (bf16*)(a.ws + WS_PR);
    const float *mu = a.in[10], *w0 = a.in[11], *w2 = a.in[12], *a0 = a.in[13], *a2 = a.in[14], *g2 = a.in[15], *rkk = a.in[16], *rka = a.in[17], *rrk = a.in[18], *gnw = a.in[19], *gnb = a.in[20];
    int T, row0, h, prevrow0; const float* S0 = nullptr; float* Sout;
    if (item < 64) { const int b = item >> 3; h = item & 7; T = SEQ; row0 = b * SEQ; prevrow0 = -1; Sout = a.out + O_PWKV + (size_t)item * 4096; }
    else { const int sb = (item - 64) >> 3; h = (item - 64) & 7; T = 1; row0 = MP + sb; prevrow0 = MTOK + sb; S0 = a.in[3] + (size_t)(item - 64) * 4096; Sout = a.out + O_SWKV + (size_t)(item - 64) * 4096; }
    const int hc = h * 64;
    LAS float* MIXW = (LAS float*)ldsb;
    LAS float* MIXA = MIXW + RCH * 64;
    LAS float* MIXG = MIXA + RCH * 64;
    LAS float* Rb = MIXG + RCH * 128;
    LAS float* Kb = Rb + RCH * 64;
    LAS float* Vb = Kb + RCH * 64;
    LAS float* Wb = Vb + RCH * 64;
    LAS float* KKb = Wb + RCH * 64;
    LAS float* Bb = KKb + RCH * 64;
    LAS float* Gb = Bb + RCH * 64;
    LAS float* Yb = Gb + RCH * 64;
    LAS float* BON = Yb + RCH * 64;
    const int sv = tid >> 2, kq = tid & 3;
    float S[16];
    if (S0) {
#pragma unroll
        for (int i = 0; i < 4; ++i) { const f32x4 t = *(const f32x4*)(S0 + sv * 64 + 16 * kq + 4 * i); S[4 * i] = t.x; S[4 * i + 1] = t.y; S[4 * i + 2] = t.z; S[4 * i + 3] = t.w; }
    } else {
#pragma unroll
        for (int i = 0; i < 16; ++i) S[i] = 0.f;
    }
    const int j = lane;
    const float w0j = w0[hc + j], a0j = a0[hc + j], rkkj = rkk[hc + j], rkaj = rka[hc + j], rrkj = rrk[hc + j], gnwj = gnw[hc + j], gnbj = gnb[hc + j];
    for (int t0 = 0; t0 < T; t0 += RCH) {
        const int nt = (T - t0) < RCH ? (T - t0) : RCH;
        for (int it = tid; it < nt * 56; it += 256) {
            const int t = it / 56, g = it % 56;
            int col; LAS float* dst; int kind;
            if (g < 8) { col = hc + 8 * g; dst = Rb + t * 64 + 8 * g; kind = 0; }
            else if (g < 16) { col = 512 + hc + 8 * (g - 8); dst = Kb + t * 64 + 8 * (g - 8); kind = 0; }
            else if (g < 24) { col = 1024 + hc + 8 * (g - 16); dst = Vb + t * 64 + 8 * (g - 16); kind = 0; }
            else if (g < 32) { col = 1536 + 8 * (g - 24); dst = MIXW + t * 64 + 8 * (g - 24); kind = 1; }
            else if (g < 40) { col = 1600 + 8 * (g - 32); dst = MIXA + t * 64 + 8 * (g - 32); kind = 0; }
            else { col = 1664 + 8 * (g - 40); dst = MIXG + t * 128 + 8 * (g - 40); kind = 2; }
            const int tg = t0 + t;
            const v4u cur = *(const v4u*)(PR + (size_t)(row0 + tg) * NPR + col);
            v4u prv = (v4u){0u, 0u, 0u, 0u};
            if (tg > 0) prv = *(const v4u*)(PR + (size_t)(row0 + tg - 1) * NPR + col);
            else if (prevrow0 >= 0) prv = *(const v4u*)(PR + (size_t)prevrow0 * NPR + col);
            const f32x4 m0 = *(const f32x4*)(mu + col), m1 = *(const f32x4*)(mu + col + 4);
            float c[8], p[8], mm[8] = {m0.x, m0.y, m0.z, m0.w, m1.x, m1.y, m1.z, m1.w};
            c[0] = bflo(cur.x); c[1] = bfhi(cur.x); c[2] = bflo(cur.y); c[3] = bfhi(cur.y); c[4] = bflo(cur.z); c[5] = bfhi(cur.z); c[6] = bflo(cur.w); c[7] = bfhi(cur.w);
            p[0] = bflo(prv.x); p[1] = bfhi(prv.x); p[2] = bflo(prv.y); p[3] = bfhi(prv.y); p[4] = bflo(prv.z); p[5] = bfhi(prv.z); p[6] = bflo(prv.w); p[7] = bfhi(prv.w);
#pragma unroll
            for (int i = 0; i < 8; ++i) { float m = c[i] + (p[i] - c[i]) * mm[i]; if (kind == 1) m = tanhf(m); else if (kind == 2) m = sigmoidf_(m); dst[i] = m; }
        }
        __syncthreads();
        float accw[RCH / 4], acca[RCH / 4], accg[RCH / 4];
#pragma unroll
        for (int i = 0; i < RCH / 4; ++i) { accw[i] = 0.f; acca[i] = 0.f; accg[i] = 0.f; }
        for (int i4 = 0; i4 < 16; ++i4) {
            float wv4[4], av4[4];
#pragma unroll
            for (int q = 0; q < 4; ++q) { wv4[q] = w2[(size_t)(4 * i4 + q) * 512 + hc + j]; av4[q] = a2[(size_t)(4 * i4 + q) * 512 + hc + j]; }
#pragma unroll
            for (int tt = 0; tt < RCH / 4; ++tt) { const int t = wv + 4 * tt; if (t < nt) {
                const f32x4 xw = *(const LAS f32x4*)(MIXW + t * 64 + 4 * i4), xa = *(const LAS f32x4*)(MIXA + t * 64 + 4 * i4);
                accw[tt] += (xw.x * wv4[0] + xw.y * wv4[1]) + (xw.z * wv4[2] + xw.w * wv4[3]);
                acca[tt] += (xa.x * av4[0] + xa.y * av4[1]) + (xa.z * av4[2] + xa.w * av4[3]); } }
        }
        for (int i4 = 0; i4 < 32; ++i4) {
            float gv4[4];
#pragma unroll
            for (int q = 0; q < 4; ++q) gv4[q] = g2[(size_t)(4 * i4 + q) * 512 + hc + j];
#pragma unroll
            for (int tt = 0; tt < RCH / 4; ++tt) { const int t = wv + 4 * tt; if (t < nt) {
                const f32x4 xg = *(const LAS f32x4*)(MIXG + t * 128 + 4 * i4);
                accg[tt] += (xg.x * gv4[0] + xg.y * gv4[1]) + (xg.z * gv4[2] + xg.w * gv4[3]); } }
        }
#pragma unroll
        for (int tt = 0; tt < RCH / 4; ++tt) { const int t = wv + 4 * tt; if (t < nt) {
            const float wl = w0j + accw[tt]; const float sg = 1.0f / (1.0f + expf(-wl));
            const float dec = expf(-0.6065306597126334f * sg);
            const float aa = 1.0f / (1.0f + expf(-(a0j + acca[tt])));
            const float kraw = Kb[t * 64 + j]; const float kkr = kraw * rkkj;
            const float ss = wave_sum(kkr * kkr); const float kk = kkr / fmaxf(sqrtf(ss), 1e-12f);
            const float k2 = kraw * (1.0f + (aa - 1.0f) * rkaj);
            const float bon = wave_sum(Rb[t * 64 + j] * k2 * rrkj);
            Wb[t * 64 + j] = dec; KKb[t * 64 + j] = kk; Bb[t * 64 + j] = kk * aa; Kb[t * 64 + j] = k2; Gb[t * 64 + j] = accg[tt];
            if (j == 0) BON[t] = bon; } }
        __syncthreads();
        for (int t = 0; t < nt; ++t) {
            float kk[16], p = 0.f;
#pragma unroll
            for (int i = 0; i < 4; ++i) { const f32x4 x = *(const LAS f32x4*)(KKb + t * 64 + 16 * kq + 4 * i); kk[4 * i] = x.x; kk[4 * i + 1] = x.y; kk[4 * i + 2] = x.z; kk[4 * i + 3] = x.w; }
#pragma unroll
            for (int i = 0; i < 16; ++i) p += S[i] * kk[i];
            p += __shfl_xor(p, 1); p += __shfl_xor(p, 2);
            const float vv = Vb[t * 64 + sv]; float y = 0.f;
#pragma unroll
            for (int i = 0; i < 4; ++i) {
                const f32x4 w = *(const LAS f32x4*)(Wb + t * 64 + 16 * kq + 4 * i), bb = *(const LAS f32x4*)(Bb + t * 64 + 16 * kq + 4 * i), k2 = *(const LAS f32x4*)(Kb + t * 64 + 16 * kq + 4 * i), r = *(const LAS f32x4*)(Rb + t * 64 + 16 * kq + 4 * i);
                S[4 * i + 0] = S[4 * i + 0] * w.x - p * bb.x + vv * k2.x; y += S[4 * i + 0] * r.x;
                S[4 * i + 1] = S[4 * i + 1] * w.y - p * bb.y + vv * k2.y; y += S[4 * i + 1] * r.y;
                S[4 * i + 2] = S[4 * i + 2] * w.z - p * bb.z + vv * k2.z; y += S[4 * i + 2] * r.z;
                S[4 * i + 3] = S[4 * i + 3] * w.w - p * bb.w + vv * k2.w; y += S[4 * i + 3] * r.w;
            }
            y += __shfl_xor(y, 1); y += __shfl_xor(y, 2);
            if (kq == 0) Yb[t * 64 + sv] = y;
        }
        __syncthreads();
#pragma unroll
        for (int tt = 0; tt < RCH / 4; ++tt) { const int t = wv + 4 * tt; if (t < nt) {
            const float y = Yb[t * 64 + j]; const float mean = wave_sum(y) * (1.0f / 64.0f); const float d = y - mean; const float var = wave_sum(d * d) * (1.0f / 64.0f);
            float o = d * rsqrtf(var + R_GN_EPS) * gnwj + gnbj; o += BON[t] * Vb[t * 64 + j]; o *= Gb[t * 64 + j];
            YR[(size_t)(row0 + t0 + t) * NPR + hc + j] = (bf16)f2bf(o); } }
        __syncthreads();
    }
#pragma unroll
    for (int i = 0; i < 4; ++i) *(f32x4*)(Sout + sv * 64 + 16 * kq + 4 * i) = (f32x4){S[4 * i], S[4 * i + 1], S[4 * i + 2], S[4 * i + 3]};
}

constexpr int MCH = 16;
constexpr int MLSTM_LDS = ((MCH + 3) * 128 + 5 * MCH * 128 + MCH * 4 * 128 + 8 * MCH) * 4;
__device__ __forceinline__ void mlstm_seq_item(const Args& a, LAS unsigned char* ldsb, int item) {
    const int tid = threadIdx.x, lane = tid & 63, wv = tid >> 6;
    const bf16* PM = (const bf16*)(a.ws + WS_PM); bf16* YM = (bf16*)(a.ws + WS_YM); const float* GATES = (const float*)(a.ws + WS_GATES);
    const float *convw = a.in[22], *convb = a.in[23], *wq = a.in[24], *wk = a.in[25], *ib = a.in[26], *fb = a.in[27], *gnw = a.in[28], *skip = a.in[29];
    int T, row0, h, sb = -1; float *Cout, *nout, *mout, *convout;
    if (item < 32) { const int b = item >> 2; h = item & 3; T = SEQ; row0 = b * SEQ; Cout = a.out + O_PC + (size_t)item * 16384; nout = a.out + O_PN + (size_t)item * 128; mout = a.out + O_PMM + item; convout = a.out + O_PCONV + (size_t)b * 3 * 512 + h * 128; }
    else { const int it2 = item - 32; sb = it2 >> 2; h = it2 & 3; T = 1; row0 = MP + sb; Cout = a.out + O_SC + (size_t)it2 * 16384; nout = a.out + O_SN + (size_t)it2 * 128; mout = a.out + O_SMM + it2; convout = a.out + O_SCONV + (size_t)sb * 3 * 512 + h * 128; }
    const int hc = h * 128;
    LAS float* XMW = (LAS float*)ldsb;
    LAS float* XC = XMW + (MCH + 3) * 128;
    LAS float* Qb = XC + MCH * 128;
    LAS float* Kb = Qb + MCH * 128;
    LAS float* Vb = Kb + MCH * 128;
    LAS float* Ob = Vb + MCH * 128;
    LAS float* HP = Ob + MCH * 128;
    LAS float* FS = HP + MCH * 512;
    LAS float* IS = FS + MCH;
    LAS float* EM = IS + MCH;
    LAS float* DEN = EM + MCH;
    LAS float* MST = DEN + 2 * MCH;
    const int e = tid & 127, dq = tid >> 7;
    float C[32]; float nreg = 0.f;
    if (sb >= 0) {
        const float* C0 = a.in[4] + (size_t)(item - 32) * 16384;
#pragma unroll
        for (int i = 0; i < 32; ++i) C[i] = C0[(size_t)(32 * dq + i) * 128 + e];
        if (tid < 128) nreg = a.in[5][(size_t)(item - 32) * 128 + tid];
        if (tid == 0) MST[0] = a.in[6][item - 32];
        if (tid < 384) XMW[tid] = a.in[7][(size_t)sb * 3 * 512 + (tid >> 7) * 512 + hc + (tid & 127)];
    } else {
#pragma unroll
        for (int i = 0; i < 32; ++i) C[i] = 0.f;
        if (tid == 0) MST[0] = 0.f;
        if (tid < 384) XMW[tid] = 0.f;
    }
    const float cw0 = convw[0 * 512 + hc + e], cw1 = convw[1 * 512 + hc + e], cw2 = convw[2 * 512 + hc + e], cw3 = convw[3 * 512 + hc + e], cbe = convb[hc + e];
    const float ibh = ib[h], fbh = fb[h];
    __syncthreads();
    for (int t0 = 0; t0 < T; t0 += MCH) {
        const int nt = (T - t0) < MCH ? (T - t0) : MCH;
        for (int t = dq; t < nt; t += 4) { const size_t r = (size_t)(row0 + t0 + t) * NPM;
            XMW[(t + 3) * 128 + e] = bf2f(PM[r + hc + e]); Vb[t * 128 + e] = bf2f(PM[r + 512 + hc + e]); Ob[t * 128 + e] = sigmoidf_(bf2f(PM[r + 1024 + hc + e])); }
        __syncthreads();
        for (int t = dq; t < nt; t += 4) { const float x = cbe + XMW[t * 128 + e] * cw0 + XMW[(t + 1) * 128 + e] * cw1 + XMW[(t + 2) * 128 + e] * cw2 + XMW[(t + 3) * 128 + e] * cw3;
            XC[t * 128 + e] = x / (1.0f + expf(-x)); }
        if (tid == 0) { float m = MST[0];
            for (int t = 0; t < nt; ++t) { const float* g = GATES + (size_t)(row0 + t0 + t) * 8;
                const float li = g[h] + ibh, fr = g[4 + h] + fbh; const float lf = fminf(fr, 0.f) - log1pf(expf(-fabsf(fr)));
                const float mn = fmaxf(lf + m, li); FS[t] = expf(lf + m - mn); IS[t] = expf(li - mn); EM[t] = expf(-mn); m = mn; }
            MST[0] = m; }
        __syncthreads();
        { float aq[MCH / 4], ak[MCH / 4];
#pragma unroll
          for (int i = 0; i < MCH / 4; ++i) { aq[i] = 0.f; ak[i] = 0.f; }
          for (int d4 = 0; d4 < 32; ++d4) {
              float q4[4], k4[4];
#pragma unroll
              for (int q = 0; q < 4; ++q) { q4[q] = wq[(size_t)(hc + 4 * d4 + q) * 128 + e]; k4[q] = wk[(size_t)(hc + 4 * d4 + q) * 128 + e]; }
#pragma unroll
              for (int tt = 0; tt < MCH / 4; ++tt) { const int t = dq + 4 * tt; if (t < nt) { const f32x4 x = *(const LAS f32x4*)(XC + t * 128 + 4 * d4);
                  aq[tt] += (x.x * q4[0] + x.y * q4[1]) + (x.z * q4[2] + x.w * q4[3]); ak[tt] += (x.x * k4[0] + x.y * k4[1]) + (x.z * k4[2] + x.w * k4[3]); } }
          }
#pragma unroll
          for (int tt = 0; tt < MCH / 4; ++tt) { const int t = dq + 4 * tt; if (t < nt) { Qb[t * 128 + e] = aq[tt] * 0.08838834764831845f; Kb[t * 128 + e] = ak[tt]; } }
        }
        __syncthreads();
        for (int t = 0; t < nt; ++t) {
            const float fs = FS[t], is = IS[t]; const float ve = Vb[t * 128 + e] * is; float hp = 0.f;
#pragma unroll
            for (int i = 0; i < 8; ++i) { const f32x4 k = *(const LAS f32x4*)(Kb + t * 128 + 32 * dq + 4 * i), q = *(const LAS f32x4*)(Qb + t * 128 + 32 * dq + 4 * i);
                C[4 * i + 0] = fs * C[4 * i + 0] + k.x * ve; hp += q.x * C[4 * i + 0];
                C[4 * i + 1] = fs * C[4 * i + 1] + k.y * ve; hp += q.y * C[4 * i + 1];
                C[4 * i + 2] = fs * C[4 * i + 2] + k.z * ve; hp += q.z * C[4 * i + 2];
                C[4 * i + 3] = fs * C[4 * i + 3] + k.w * ve; hp += q.w * C[4 * i + 3]; }
            HP[t * 512 + dq * 128 + e] = hp;
            if (tid < 128) { nreg = fs * nreg + is * Kb[t * 128 + tid]; const float dn = wave_sum(Qb[t * 128 + tid] * nreg); if (lane == 0) DEN[t * 2 + wv] = dn; }
        }
        __syncthreads();
        for (int t = wv; t < nt; t += 8) {
            const float den = DEN[t * 2] + DEN[t * 2 + 1]; const float dd = fmaxf(fabsf(den), EM[t]);
            float hv[2];
#pragma unroll
            for (int q = 0; q < 2; ++q) { const int ee = lane + 64 * q; hv[q] = (HP[t * 512 + ee] + HP[t * 512 + 128 + ee] + HP[t * 512 + 256 + ee] + HP[t * 512 + 384 + ee]) / dd; }
            const float mean = wave_sum(hv[0] + hv[1]) * (1.0f / 128.0f); const float d0 = hv[0] - mean, d1 = hv[1] - mean;
            const float var = wave_sum(d0 * d0 + d1 * d1) * (1.0f / 128.0f); const float rs = rsqrtf(var + M_GN_EPS);
#pragma unroll
            for (int q = 0; q < 2; ++q) { const int ee = lane + 64 * q; float o = (q ? d1 : d0) * rs * gnw[hc + ee] + skip[hc + ee] * XC[t * 128 + ee]; o *= Ob[t * 128 + ee];
                YM[(size_t)(row0 + t0 + t) * 512 + hc + ee] = (bf16)f2bf(o); }
        }
        __syncthreads();
        float keep = 0.f; if (tid < 384) keep = XMW[(nt + (tid >> 7)) * 128 + (tid & 127)];
        __syncthreads();
        if (tid < 384) XMW[tid] = keep;
        __syncthreads();
    }
#pragma unroll
    for (int i = 0; i < 32; ++i) Cout[(size_t)(32 * dq + i) * 128 + e] = C[i];
    if (tid < 128) nout[tid] = nreg;
    if (tid == 0) mout[0] = MST[0];
    if (tid < 384) convout[(tid >> 7) * 512 + (tid & 127)] = XMW[tid];
}

__device__ __forceinline__ void final_norm_rows(const Args& a, int gw, int NGW, int lane) {
    const float* ssq = (const float*)(a.ws + WS_SSQ2); const float* gf = a.in[36];
    f32x4 gv[4];
#pragma unroll
    for (int j = 0; j < 4; ++j) gv[j] = ((const f32x4*)gf)[lane + 64 * j];
    for (int row = gw; row < MTOK; row += NGW) { const float rs = rsqrtf(ssq[row] * (1.0f / 1024.0f) + RMS_EPS); f32x4* p = (f32x4*)(a.out + (size_t)row * 1024) + lane;
#pragma unroll
        for (int j = 0; j < 4; ++j) p[64 * j] = p[64 * j] * rs * gv[j]; }
}


typedef short bf16x8 __attribute__((ext_vector_type(8)));
typedef float f32x16 __attribute__((ext_vector_type(16)));
constexpr size_t WS_KT = 49 * MiB + 512 * 1024;
constexpr size_t DO_CTP = 0;
constexpr size_t DO_VT = 40 * MiB;
constexpr size_t DO_UU = 60 * MiB, DO_BCUM = DO_UU + 256 * 1024, DO_PPFX = DO_BCUM + 256 * 1024;
constexpr size_t DO_BL = DO_PPFX + 256 * 1024, DO_PMX = DO_BL + 4096, DO_MPREV = DO_PMX + 4096;
static_assert(DO_MPREV + 4096 <= (size_t)MTOK * DM * 4, "d_out scratch");

typedef float f32x2_t __attribute__((ext_vector_type(2))); typedef __bf16 bf16x2_t __attribute__((ext_vector_type(2)));
__device__ __forceinline__ unsigned cvtpk(float lo, float hi) { f32x2_t v = {lo, hi}; bf16x2_t b = __builtin_convertvector(v, bf16x2_t); return __builtin_bit_cast(unsigned, b); }
__device__ __forceinline__ bf16x8 pack8(float a0, float a1, float a2, float a3, float a4, float a5, float a6, float a7) {
    v4u w; w.x = cvtpk(a0, a1); w.y = cvtpk(a2, a3); w.z = cvtpk(a4, a5); w.w = cvtpk(a6, a7); return __builtin_bit_cast(bf16x8, w); }
__device__ __forceinline__ bf16x8 acc_frag(const f32x16& x, int s2) { return s2 == 0 ? pack8(x[0], x[1], x[2], x[3], x[4], x[5], x[6], x[7]) : pack8(x[8], x[9], x[10], x[11], x[12], x[13], x[14], x[15]); }
__device__ __forceinline__ bf16x8 ld16(const bf16* p) { return __builtin_bit_cast(bf16x8, *(const v4u*)p); }
__device__ __forceinline__ bf16x8 ld8x2(const bf16* p0, const bf16* p1) { const v2u a = *(const v2u*)p0, b = *(const v2u*)p1; v4u w; w.x = a.x; w.y = a.y; w.z = b.x; w.w = b.y; return __builtin_bit_cast(bf16x8, w); }
#define MFMA32(a, b, c) __builtin_amdgcn_mfma_f32_32x32x16_bf16((a), (b), (c), 0, 0, 0)

__device__ __forceinline__ void stage_conv_head(const Args& a, LAS float* CW, int h, int tid, int nthr) {
    for (int i = tid; i < 640; i += nthr) CW[i] = i < 512 ? a.in[22][(size_t)(i >> 7) * 512 + h * 128 + (i & 127)] : a.in[23][h * 128 + (i - 512)];
}
__device__ __forceinline__ void xc8(const bf16* xmcol, int t, int d0, const LAS float* CW, float (&x)[8]) {
    const f32x4 b0 = *(const LAS f32x4*)(CW + 512 + d0), b1 = *(const LAS f32x4*)(CW + 512 + d0 + 4);
    x[0] = b0.x; x[1] = b0.y; x[2] = b0.z; x[3] = b0.w; x[4] = b1.x; x[5] = b1.y; x[6] = b1.z; x[7] = b1.w;
#pragma unroll
    for (int tap = 0; tap < 4; ++tap) { const int tt = t - 3 + tap;
        if (tt >= 0) { const v4u v = *(const v4u*)(xmcol + (size_t)tt * NPM + d0);
            const f32x4 w0 = *(const LAS f32x4*)(CW + tap * 128 + d0), w1 = *(const LAS f32x4*)(CW + tap * 128 + d0 + 4);
            x[0] += bflo(v.x) * w0.x; x[1] += bfhi(v.x) * w0.y; x[2] += bflo(v.y) * w0.z; x[3] += bfhi(v.y) * w0.w;
            x[4] += bflo(v.z) * w1.x; x[5] += bfhi(v.z) * w1.y; x[6] += bflo(v.w) * w1.z; x[7] += bfhi(v.w) * w1.w; } }
#pragma unroll
    for (int i = 0; i < 8; ++i) x[i] = x[i] / (1.0f + __expf(-x[i]));
}
__device__ __forceinline__ bf16x8 xc_frag(const bf16* xmcol, int t, int d0, const LAS float* CW) { float x[8]; xc8(xmcol, t, d0, CW, x); return pack8(x[0], x[1], x[2], x[3], x[4], x[5], x[6], x[7]); }

__device__ __forceinline__ void mlstm_prep_task(const Args& a, int item, int blk, const LAS float* CW, int lane_) {
    int lane = lane_; asm volatile("" : "+v"(lane));
    const int r = lane & 31, hh = lane >> 5, bh = item >> 5, c = item & 31, b = bh >> 2, h = bh & 3, hc = h * 128, row0 = b * SEQ, t0 = c * 64, db = blk & 3, sb = blk >> 2;
    const bf16* PM = (const bf16*)(a.ws + WS_PM); const bf16* xmcol = PM + (size_t)row0 * NPM + hc;
    const bf16* WKT = (const bf16*)(a.ws + WS_WKT) + (size_t)h * 16384;
    bf16* KT = (bf16*)(a.ws + WS_KT) + (size_t)item * 8192; bf16* VT = (bf16*)((unsigned char*)a.out + DO_VT) + (size_t)item * 10240;
    f32x16 acc;
#pragma unroll
    for (int i = 0; i < 16; ++i) acc[i] = 0.f;
#pragma unroll
    for (int ks = 0; ks < 8; ++ks) { const bf16x8 A = ld16(WKT + (size_t)(32 * db + r) * 128 + 16 * ks + 8 * hh); const bf16x8 B = xc_frag(xmcol, t0 + 32 * sb + r, 16 * ks + 8 * hh, CW); acc = MFMA32(A, B, acc); }
#pragma unroll
    for (int reg = 0; reg < 16; ++reg) { const int d = 32 * db + (reg & 3) + 8 * (reg >> 2) + 4 * hh; KT[(size_t)d * 64 + 32 * sb + r] = (bf16)f2bf(acc[reg]); }
    { const bf16* vp = PM + (size_t)(row0 + t0 + 32 * sb + r) * NPM + 512 + hc + 32 * db + 16 * hh; const v4u v0 = *(const v4u*)vp, v1 = *(const v4u*)(vp + 8);
      const unsigned w[8] = {v0.x, v0.y, v0.z, v0.w, v1.x, v1.y, v1.z, v1.w}; bf16* o = VT + (size_t)(32 * db + 16 * hh) * 64 + 32 * sb + r;
#pragma unroll
      for (int i = 0; i < 8; ++i) { o[(size_t)(2 * i) * 64] = (bf16)(w[i] & 0xffffu); o[(size_t)(2 * i + 1) * 64] = (bf16)(w[i] >> 16); } }
#pragma unroll
    for (int i = 0; i < 4; ++i) VT[(size_t)(128 + 4 * blk + i) * 64 + lane] = (blk == 0 && i == 0) ? (bf16)0x3f80u : (bf16)0u;
    if (blk == 1 && c == 31) {
        float* co = a.out + O_PCONV + (size_t)b * 3 * 512 + hc;
        for (int i = lane; i < 384; i += 64) co[(i >> 7) * 512 + (i & 127)] = bf2f(xmcol[(size_t)(SEQ - 3 + (i >> 7)) * NPM + (i & 127)]);
    }
    if (blk == 0) {
        const float* g = (const float*)(a.ws + WS_GATES) + (size_t)(row0 + t0 + lane) * 8;
        const float li = g[h] + a.in[26][h], fr = g[4 + h] + a.in[27][h]; const float lf = fminf(fr, 0.f) - log1pf(expf(-fabsf(fr)));
        float bc = lf;
#pragma unroll
        for (int o = 1; o < 64; o <<= 1) { const float t = __shfl_up(bc, o); if (lane >= o) bc += t; }
        const float u = li - bc; float p = u;
#pragma unroll
        for (int o = 1; o < 64; o <<= 1) { const float t = __shfl_up(p, o); if (lane >= o) p = fmaxf(p, t); }
        float* dof = (float*)a.out; const size_t ti = (size_t)bh * 2048 + t0 + lane;
        dof[DO_UU / 4 + ti] = u; dof[DO_BCUM / 4 + ti] = bc; dof[DO_PPFX / 4 + ti] = p;
        if (lane == 63) { dof[DO_BL / 4 + item] = bc; dof[DO_PMX / 4 + item] = p; }
    }
}

__device__ __forceinline__ void mlstm_scan_task(const Args& a, int bh, int eb, LAS float* WE, int lane) {
    const int r = lane & 31, hh = lane >> 5;
    const float* dof = (const float*)a.out;
    f32x16 CT[4];
#pragma unroll
    for (int cb = 0; cb < 4; ++cb)
#pragma unroll
        for (int i = 0; i < 16; ++i) CT[cb][i] = 0.f;
    float m = 0.f;
    for (int c = 0; c < 32; ++c) {
        const int item = bh * 32 + c;
        const bf16* KT = (const bf16*)(a.ws + WS_KT) + (size_t)item * 8192; const bf16* VT = (const bf16*)((const unsigned char*)a.out + DO_VT) + (size_t)item * 10240;
        bf16* CTP = (bf16*)((unsigned char*)a.out + DO_CTP) + (size_t)item * 20480;
        const float u = dof[DO_UU / 4 + (size_t)bh * 2048 + 64 * c + lane]; const float pmx = dof[DO_PMX / 4 + item], bl = dof[DO_BL / 4 + item];
        const float Mx = fmaxf(m, pmx); const float ge = expf(m - Mx);
        WE[lane] = expf(u - Mx);
#pragma unroll
        for (int cb = 0; cb < 4; ++cb)
#pragma unroll
            for (int reg = 0; reg < 16; ++reg) { CTP[(size_t)(32 * eb + (reg & 3) + 8 * (reg >> 2) + 4 * hh) * 128 + 32 * cb + r] = (bf16)f2bf(CT[cb][reg]); CT[cb][reg] *= ge; }
        if (eb == 0 && lane == 0) ((float*)a.out)[DO_MPREV / 4 + item] = m;
        LDS_WAIT(); asm volatile("" ::: "memory");
#pragma unroll
        for (int ks = 0; ks < 4; ++ks) {
            const v4u av = *(const v4u*)(VT + (size_t)(32 * eb + r) * 64 + 16 * ks + 8 * hh);
            const f32x4 w0 = *(const LAS f32x4*)(WE + 16 * ks + 8 * hh), w1 = *(const LAS f32x4*)(WE + 16 * ks + 8 * hh + 4);
            const bf16x8 A = pack8(bflo(av.x) * w0.x, bfhi(av.x) * w0.y, bflo(av.y) * w0.z, bfhi(av.y) * w0.w, bflo(av.z) * w1.x, bfhi(av.z) * w1.y, bflo(av.w) * w1.z, bfhi(av.w) * w1.w);
#pragma unroll
            for (int cb = 0; cb < 4; ++cb) { const bf16x8 B = ld16(KT + (size_t)(32 * cb + r) * 64 + 16 * ks + 8 * hh); CT[cb] = MFMA32(A, B, CT[cb]); }
        }
        m = bl + Mx;
        LDS_WAIT(); asm volatile("" ::: "memory");
    }
    if (eb < 4) { float* Co = a.out + O_PC + (size_t)bh * 16384;
#pragma unroll
        for (int cb = 0; cb < 4; ++cb)
#pragma unroll
            for (int reg = 0; reg < 16; ++reg) Co[(size_t)(32 * cb + r) * 128 + 32 * eb + (reg & 3) + 8 * (reg >> 2) + 4 * hh] = CT[cb][reg];
    } else if (hh == 0) {
#pragma unroll
        for (int cb = 0; cb < 4; ++cb) a.out[O_PN + (size_t)bh * 128 + 32 * cb + r] = CT[cb][0];
    }
    if (eb == 0 && lane == 0) a.out[O_PMM + bh] = m;
}

__device__ __forceinline__ void mlstm_st_tile(int sb, int tb, const bf16x8 (&XB)[8], const bf16x8 (&QTb)[4][2], const bf16* WKT, const bf16* xmcol, const LAS float* CW, const float* uu, int t0, int tl, float Mt, int r, int hh, bf16x8& o0, bf16x8& o1) {
    f32x16 st;
#pragma unroll
    for (int i = 0; i < 16; ++i) st[i] = 0.f;
#pragma unroll
    for (int db = 0; db < 4; ++db) { f32x16 k;
#pragma unroll
        for (int i = 0; i < 16; ++i) k[i] = 0.f;
#pragma unroll
        for (int ks = 0; ks < 8; ++ks) { const bf16x8 B = (sb == tb) ? XB[ks] : xc_frag(xmcol, t0 + 32 * sb + r, 16 * ks + 8 * hh, CW);
            k = MFMA32(ld16(WKT + (size_t)(32 * db + r) * 128 + 16 * ks + 8 * hh), B, k); if (ks & 1) __builtin_amdgcn_sched_barrier(0); }
        st = MFMA32(acc_frag(k, 0), QTb[db][0], st); st = MFMA32(acc_frag(k, 1), QTb[db][1], st); __builtin_amdgcn_sched_barrier(0); }
#pragma unroll
    for (int g = 0; g < 4; ++g) { const f32x4 u4 = *(const f32x4*)(uu + 32 * sb + 8 * g + 4 * hh);
#pragma unroll
        for (int i = 0; i < 4; ++i) { const int sidx = 32 * sb + 8 * g + 4 * hh + i; st[4 * g + i] = (sidx <= tl) ? st[4 * g + i] * expf(u4[i] - Mt) : 0.f; } }
    o0 = acc_frag(st, 0); o1 = acc_frag(st, 1);
}

__device__ __forceinline__ void mlstm_out_task(const Args& a, int item, int tb, const LAS float* CWall, int lane_) {
    int lane = lane_; asm volatile("" : "+v"(lane));
    const int r = lane & 31, hh = lane >> 5, bh = item >> 5, c = item & 31, b = bh >> 2, h = bh & 3, hc = h * 128, row0 = b * SEQ, t0 = c * 64;
    const bf16* PM = (const bf16*)(a.ws + WS_PM); const bf16* xmcol = PM + (size_t)row0 * NPM + hc; const LAS float* CW = CWall + h * 640;
    const bf16* WQT = (const bf16*)(a.ws + WS_WQT) + (size_t)h * 16384; const bf16* WKT = (const bf16*)(a.ws + WS_WKT) + (size_t)h * 16384;
    const bf16* VT = (const bf16*)((const unsigned char*)a.out + DO_VT) + (size_t)item * 10240; const bf16* CTP = (const bf16*)((const unsigned char*)a.out + DO_CTP) + (size_t)item * 20480;
    const float* dof = (const float*)a.out;
    const int tl = 32 * tb + r, t = t0 + tl;
    bf16x8 XB[8];
#pragma unroll
    for (int ks = 0; ks < 8; ++ks) { XB[ks] = xc_frag(xmcol, t, 16 * ks + 8 * hh, CW); if (ks & 1) __builtin_amdgcn_sched_barrier(0); }
    bf16x8 QTb[4][2];
#pragma unroll
    for (int eb = 0; eb < 4; ++eb) { f32x16 q;
#pragma unroll
        for (int i = 0; i < 16; ++i) q[i] = 0.f;
#pragma unroll
        for (int ks = 0; ks < 8; ++ks) q = MFMA32(ld16(WQT + (size_t)(32 * eb + r) * 128 + 16 * ks + 8 * hh), XB[ks], q);
        QTb[eb][0] = acc_frag(q, 0); QTb[eb][1] = acc_frag(q, 1); __builtin_amdgcn_sched_barrier(0); }
    const float mprev = dof[DO_MPREV / 4 + item], pp = dof[DO_PPFX / 4 + (size_t)bh * 2048 + t], bc = dof[DO_BCUM / 4 + (size_t)bh * 2048 + t];
    const float Mt = fmaxf(mprev, pp), wst = expf(mprev - Mt), em = expf(-bc - Mt);
    bf16x8 STb[2][2];
    mlstm_st_tile(0, tb, XB, QTb, WKT, xmcol, CW, dof + DO_UU / 4 + (size_t)bh * 2048 + t0, t0, tl, Mt, r, hh, STb[0][0], STb[0][1]);
    if (tb == 1) mlstm_st_tile(1, tb, XB, QTb, WKT, xmcol, CW, dof + DO_UU / 4 + (size_t)bh * 2048 + t0, t0, tl, Mt, r, hh, STb[1][0], STb[1][1]);
    else { STb[1][0] = (bf16x8){0, 0, 0, 0, 0, 0, 0, 0}; STb[1][1] = STb[1][0]; }
    auto num_block = [&](int eb, f32x16& nt) {
#pragma unroll
        for (int i = 0; i < 16; ++i) nt[i] = 0.f;
        const bf16* crow = CTP + (size_t)(32 * eb + r) * 128 + 4 * hh;
#pragma unroll
        for (int rb = 0; rb < 4; ++rb) {
#pragma unroll
            for (int s2 = 0; s2 < 2; ++s2) nt = MFMA32(ld8x2(crow + 32 * rb + 16 * s2, crow + 32 * rb + 16 * s2 + 8), QTb[rb][s2], nt);
            if (rb == 1) __builtin_amdgcn_sched_barrier(0); }
#pragma unroll
        for (int i = 0; i < 16; ++i) nt[i] *= wst;
        __builtin_amdgcn_sched_barrier(0);
        const bf16* vrow = VT + (size_t)(32 * eb + r) * 64 + 4 * hh;
#pragma unroll
        for (int s2 = 0; s2 < 2; ++s2) nt = MFMA32(ld8x2(vrow + 16 * s2, vrow + 16 * s2 + 8), STb[0][s2], nt);
        if (tb == 1) {
#pragma unroll
            for (int s2 = 0; s2 < 2; ++s2) nt = MFMA32(ld8x2(vrow + 32 + 16 * s2, vrow + 32 + 16 * s2 + 8), STb[1][s2], nt); }
        __builtin_amdgcn_sched_barrier(0);
    };
    float inv;
    { f32x16 nd; num_block(4, nd); const float den = __shfl(nd[0], r); inv = 1.0f / fmaxf(fabsf(den), em); }
    float s1 = 0.f, s2v = 0.f;
#pragma unroll
    for (int eb = 0; eb < 4; ++eb) { f32x16 nt; num_block(eb, nt);
#pragma unroll
        for (int i = 0; i < 16; ++i) { const float x = nt[i] * inv; s1 += x; s2v += x * x; } }
    s1 += __shfl_xor(s1, 32); s2v += __shfl_xor(s2v, 32);
    const float mean = s1 * (1.0f / 128.0f); const float rs = rsqrtf(fmaxf(s2v * (1.0f / 128.0f) - mean * mean, 0.f) + M_GN_EPS);
    bf16* YM = (bf16*)(a.ws + WS_YM) + (size_t)(row0 + t) * 512 + hc; const bf16* orow = PM + (size_t)(row0 + t) * NPM + 1024 + hc;
    const float* gnw = a.in[28] + hc; const float* skp = a.in[29] + hc;
#pragma unroll
    for (int eb = 0; eb < 4; ++eb) { f32x16 nt; num_block(eb, nt);
#pragma unroll
        for (int g = 0; g < 4; ++g) { const int e0 = 32 * eb + 8 * g + 4 * hh;
            const f32x4 cb4 = *(const LAS f32x4*)(CW + 512 + e0); float x[4] = {cb4.x, cb4.y, cb4.z, cb4.w};
#pragma unroll
            for (int tap = 0; tap < 4; ++tap) { const int tt = t - 3 + tap; if (tt >= 0) { const v2u v = *(const v2u*)(xmcol + (size_t)tt * NPM + e0); const f32x4 w = *(const LAS f32x4*)(CW + tap * 128 + e0);
                x[0] += bflo(v.x) * w.x; x[1] += bfhi(v.x) * w.y; x[2] += bflo(v.y) * w.z; x[3] += bfhi(v.y) * w.w; } }
            const v2u ov = *(const v2u*)(orow + e0); const float og[4] = {bflo(ov.x), bfhi(ov.x), bflo(ov.y), bfhi(ov.y)};
            const f32x4 gw = *(const f32x4*)(gnw + e0), sk = *(const f32x4*)(skp + e0); float o[4];
#pragma unroll
            for (int i = 0; i < 4; ++i) { const float xc = x[i] / (1.0f + __expf(-x[i])); o[i] = ((nt[4 * g + i] * inv - mean) * rs * gw[i] + sk[i] * xc) * sigmoidf_(og[i]); }
            v2u w; w.x = cvtpk(o[0], o[1]); w.y = cvtpk(o[2], o[3]); *(v2u*)(YM + e0) = w; }
        __builtin_amdgcn_sched_barrier(0); }
}

constexpr size_t WS_SPREV = 237 * MiB;
constexpr size_t WS_GL = 253 * MiB, WS_BON = 253 * MiB + 512 * 1024, WS_BND = 254 * MiB;
constexpr size_t DO_DLRT = O_SC * 4, DO_DS = O_SC * 4 + 16 * MiB;
constexpr int RSTR = 144, RSLOT = 64 * RSTR;
constexpr int R1_MISC = 8 * RSLOT, R1_ITEM_LDS = 8 * RSLOT + 6144;
static_assert(2 * R1_ITEM_LDS == 159744, "R1 LDS");

__device__ __forceinline__ int rowidx(int reg, int hh) { return (reg & 3) + 8 * (reg >> 2) + 4 * hh; }
__device__ __forceinline__ bf16x8 ldsfrag(const LAS unsigned char* slot, int row, int k0) { return *(const LAS bf16x8*)(slot + row * RSTR + k0 * 2); }
__device__ __forceinline__ void st_rows(LAS unsigned char* slot, int rb, int cb, const f32x16& x, int r, int hh) {
    LAS unsigned char* bp = slot + (32 * rb + 4 * hh) * RSTR + (32 * cb + r) * 2;
#pragma unroll
    for (int reg = 0; reg < 16; ++reg) *(LAS bf16*)(bp + ((reg & 3) + 8 * (reg >> 2)) * RSTR) = (bf16)f2bf(x[reg]);
}
__device__ __forceinline__ void st_cols(LAS unsigned char* slot, int rb, int cb, const f32x16& x, int r, int hh) {
    LAS unsigned char* bp = slot + (32 * cb + r) * RSTR + (32 * rb + 4 * hh) * 2;
#pragma unroll
    for (int g = 0; g < 4; ++g) { v2u w; w.x = cvtpk(x[4 * g], x[4 * g + 1]); w.y = cvtpk(x[4 * g + 2], x[4 * g + 3]); *(LAS v2u*)(bp + 16 * g) = w; }
}
__device__ __forceinline__ f32x16 zero16() { f32x16 z;
#pragma unroll
    for (int i = 0; i < 16; ++i) z[i] = 0.f;
    return z; }
__device__ __forceinline__ void mix8(const v4u cur, const v4u prv, const float* mu, float (&m)[8]) {
    const f32x4 m0 = *(const f32x4*)mu, m1 = *(const f32x4*)(mu + 4);
    const float c[8] = {bflo(cur.x), bfhi(cur.x), bflo(cur.y), bfhi(cur.y), bflo(cur.z), bfhi(cur.z), bflo(cur.w), bfhi(cur.w)};
    const float p[8] = {bflo(prv.x), bfhi(prv.x), bflo(prv.y), bfhi(prv.y), bflo(prv.z), bfhi(prv.z), bflo(prv.w), bfhi(prv.w)};
    const float mm[8] = {m0.x, m0.y, m0.z, m0.w, m1.x, m1.y, m1.z, m1.w};
#pragma unroll
    for (int i = 0; i < 8; ++i) m[i] = c[i] + (p[i] - c[i]) * mm[i];
}
__device__ __forceinline__ void mix4(const v2u cur, const v2u prv, const float* mu, float (&m)[4]) {
    const f32x4 m0 = *(const f32x4*)mu;
    const float c[4] = {bflo(cur.x), bfhi(cur.x), bflo(cur.y), bfhi(cur.y)}, p[4] = {bflo(prv.x), bfhi(prv.x), bflo(prv.y), bfhi(prv.y)}, mm[4] = {m0.x, m0.y, m0.z, m0.w};
#pragma unroll
    for (int i = 0; i < 4; ++i) m[i] = c[i] + (p[i] - c[i]) * mm[i];
}

__device__ __forceinline__ float tanh_fast(float x) { return 1.0f - 2.0f / (__expf(2.0f * x) + 1.0f); }
__device__ __forceinline__ void rwkv_prep_pair(const Args& a, LAS unsigned char* lds0, int ritem0) {
    int tid_ = threadIdx.x; asm volatile("" : "+v"(tid_));
    const int tid = tid_ & 255, lane = tid & 63, w4 = tid >> 6, r = lane & 31, hh = lane >> 5, half = tid_ >> 8;
    const int ritem = ritem0 + half, bh = ritem >> 5, c = ritem & 31, b = bh >> 3, h = bh & 7, hc = h * 64, row0 = b * SEQ, t0 = c * 64;
    const int p = w4 >> 1, q = w4 & 1;
    LAS unsigned char* L = lds0 + half * R1_ITEM_LDS;
    LAS unsigned char *S0 = L, *S1 = L + RSLOT, *S2 = L + 2 * RSLOT, *S3 = L + 3 * RSLOT, *S4 = L + 4 * RSLOT, *S5 = L + 5 * RSLOT, *S6 = L + 6 * RSLOT, *S7 = L + 7 * RSLOT;
    LAS float* SSX = (LAS float*)(L + R1_MISC);
    LAS float* BONX = SSX + 128;
    LAS float* CUMT = BONX + 128;
    LAS float* CUML = CUMT + 64;
    LAS float* CUMTp = CUMT + 32 * p + 4 * hh; LAS float* CUMLp = CUML + 32 * p + 4 * hh;
    LAS unsigned char* T00T = L + R1_MISC;
    LAS unsigned char* G1T = L + R1_MISC + 2560;
    const bf16* PR = (const bf16*)(a.ws + WS_PR); const bf16* BND = (const bf16*)(a.ws + WS_BND);
    const float* mu = a.in[10];
    const int tl = 32 * q + r; const size_t row = (size_t)(row0 + t0 + tl);
    const bf16* cur = PR + row * NPR;
    const bf16* prv = tl > 0 ? cur - NPR : (c > 0 ? BND + (size_t)(b * 32 + c - 1) * NPR : nullptr);
    f32x16 wl = zero16(), al = zero16();
    {   const bf16* W2T = (const bf16*)(a.ws + WS_LW2T) + (size_t)(hc + 32 * p + r) * 64; const bf16* A2T = (const bf16*)(a.ws + WS_LA2T) + (size_t)(hc + 32 * p + r) * 64;
#pragma unroll
        for (int ks = 0; ks < 4; ++ks) { const int k0 = 16 * ks + 8 * hh; float m[8];
            mix8(*(const v4u*)(cur + 1536 + k0), prv ? *(const v4u*)(prv + 1536 + k0) : (v4u){0u, 0u, 0u, 0u}, mu + 1536 + k0, m);
            wl = MFMA32(ld16(W2T + k0), pack8(tanh_fast(m[0]), tanh_fast(m[1]), tanh_fast(m[2]), tanh_fast(m[3]), tanh_fast(m[4]), tanh_fast(m[5]), tanh_fast(m[6]), tanh_fast(m[7])), wl);
            mix8(*(const v4u*)(cur + 1600 + k0), prv ? *(const v4u*)(prv + 1600 + k0) : (v4u){0u, 0u, 0u, 0u}, mu + 1600 + k0, m);
            al = MFMA32(ld16(A2T + k0), pack8(m[0], m[1], m[2], m[3], m[4], m[5], m[6], m[7]), al); __builtin_amdgcn_sched_barrier(0); }
    }
    f32x16 lw, aa, kx, rx, vx;
    float ssp = 0.f, bonp = 0.f;
#pragma unroll
    for (int g = 0; g < 4; ++g) { const int ch = hc + 32 * p + 8 * g + 4 * hh;
        const f32x4 w04 = *(const f32x4*)(a.in[11] + ch), a04 = *(const f32x4*)(a.in[13] + ch), kk4 = *(const f32x4*)(a.in[16] + ch), ka4 = *(const f32x4*)(a.in[17] + ch), rk4 = *(const f32x4*)(a.in[18] + ch);
        float mr[4], mk[4], mv[4];
        mix4(*(const v2u*)(cur + ch), prv ? *(const v2u*)(prv + ch) : (v2u){0u, 0u}, mu + ch, mr);
        mix4(*(const v2u*)(cur + 512 + ch), prv ? *(const v2u*)(prv + 512 + ch) : (v2u){0u, 0u}, mu + 512 + ch, mk);
        mix4(*(const v2u*)(cur + 1024 + ch), prv ? *(const v2u*)(prv + 1024 + ch) : (v2u){0u, 0u}, mu + 1024 + ch, mv);
#pragma unroll
        for (int i = 0; i < 4; ++i) { const int reg = 4 * g + i;
            lw[reg] = -0.6065306597126334f / (1.0f + __expf(-(w04[i] + wl[reg])));
            const float av = 1.0f / (1.0f + __expf(-(a04[i] + al[reg]))); aa[reg] = av;
            const float kkr = mk[i] * kk4[i]; ssp += kkr * kkr; wl[reg] = kkr;
            const float k2 = mk[i] * (1.0f + (av - 1.0f) * ka4[i]); kx[reg] = k2; rx[reg] = mr[i]; vx[reg] = mv[i];
            bonp += mr[i] * k2 * rk4[i]; }
        __builtin_amdgcn_sched_barrier(0); }
    ssp += __shfl_xor(ssp, 32); bonp += __shfl_xor(bonp, 32);
    if (hh == 0) { SSX[tl * 2 + p] = ssp; BONX[tl * 2 + p] = bonp; }
    st_rows(S6, p, q, vx, r, hh);
    __builtin_amdgcn_sched_barrier(0);
    f32x16 cum = lw;
#pragma unroll
    for (int o = 1; o < 32; o <<= 1) {
#pragma unroll
        for (int reg = 0; reg < 16; ++reg) { const float t = __shfl_up(cum[reg], o, 32); if (r >= o) cum[reg] += t; } }
    if (q == 0 && r == 31) {
#pragma unroll
        for (int reg = 0; reg < 16; ++reg) CUMTp[(reg & 3) + 8 * (reg >> 2)] = cum[reg]; }
    __syncthreads();
    if (q == 1) {
#pragma unroll
        for (int reg = 0; reg < 16; ++reg) cum[reg] += CUMTp[(reg & 3) + 8 * (reg >> 2)];
        if (r == 31) {
#pragma unroll
            for (int reg = 0; reg < 16; ++reg) CUMLp[(reg & 3) + 8 * (reg >> 2)] = cum[reg]; } }
    const float rinv = 1.0f / fmaxf(sqrtf(SSX[tl * 2] + SSX[tl * 2 + 1]), 1e-12f);
    if (p == 0 && hh == 0) ((float*)(a.ws + WS_BON))[row * 8 + h] = BONX[tl * 2] + BONX[tl * 2 + 1];
    f32x16 KeT, RqT;
#pragma unroll
    for (int reg = 0; reg < 16; ++reg) { RqT[reg] = rx[reg] * __expf(cum[reg]); lw[reg] = cum[reg] - lw[reg]; wl[reg] *= rinv; }
    st_cols(S3, p, q, RqT, r, hh);
    __syncthreads();
    __builtin_amdgcn_sched_barrier(0);
    {   f32x16 tmp;
#pragma unroll
        for (int reg = 0; reg < 16; ++reg) tmp[reg] = wl[reg] * __expf(lw[reg]);
        st_cols(S0, p, q, tmp, r, hh); st_rows(S4, p, q, tmp, r, hh);
        __builtin_amdgcn_sched_barrier(0);
#pragma unroll
        for (int reg = 0; reg < 16; ++reg) tmp[reg] = wl[reg] * aa[reg] * __expf(-cum[reg]);
        st_cols(S1, p, q, tmp, r, hh);
        __builtin_amdgcn_sched_barrier(0);
#pragma unroll
        for (int reg = 0; reg < 16; ++reg) tmp[reg] = kx[reg] * __expf(-cum[reg]);
        st_cols(S2, p, q, tmp, r, hh);
        __builtin_amdgcn_sched_barrier(0);
#pragma unroll
        for (int reg = 0; reg < 16; ++reg) { const float e4 = __expf(CUMLp[(reg & 3) + 8 * (reg >> 2)] - cum[reg]); tmp[reg] = wl[reg] * aa[reg] * e4; KeT[reg] = kx[reg] * e4; }
        st_rows(S5, p, q, tmp, r, hh);
        if (q == 0 && r == 0) { float* glp = (float*)(a.ws + WS_GL) + (size_t)ritem * 64 + 32 * p + 4 * hh;
#pragma unroll
            for (int reg = 0; reg < 16; ++reg) glp[(reg & 3) + 8 * (reg >> 2)] = __expf(CUMLp[(reg & 3) + 8 * (reg >> 2)]); }
    }
    __syncthreads();
    __builtin_amdgcn_sched_barrier(0);
    f32x16 NrkT;
    {   f32x16 mkb = zero16(), mkk = zero16(), nrb = zero16(); NrkT = zero16();
        if (!(p == 0 && q == 1)) {
#pragma unroll
            for (int ks = 0; ks < 4; ++ks) { const int k0 = 16 * ks + 8 * hh;
                const bf16x8 kqp = ldsfrag(S0, 32 * p + r, k0), rqp = ldsfrag(S3, 32 * p + r, k0), bdq = ldsfrag(S1, 32 * q + r, k0), kdq = ldsfrag(S2, 32 * q + r, k0);
                mkb = MFMA32(kqp, bdq, mkb); mkk = MFMA32(kqp, kdq, mkk); nrb = MFMA32(rqp, bdq, nrb); }
        }
        if (!(p == 1 && q == 0)) {
#pragma unroll
            for (int ks = 0; ks < 4; ++ks) { const int k0 = 16 * ks + 8 * hh; NrkT = MFMA32(ldsfrag(S2, 32 * p + r, k0), ldsfrag(S3, 32 * q + r, k0), NrkT); }
        }
#pragma unroll
        for (int reg = 0; reg < 16; ++reg) { const int i = 32 * p + rowidx(reg, hh), j = 32 * q + r;
            if (!(j < i)) { mkb[reg] = 0.f; mkk[reg] = 0.f; } if (!(j <= i)) nrb[reg] = 0.f;
            if (!(i <= j)) NrkT[reg] = 0.f; }
        __syncthreads();
#pragma unroll
        for (int reg = 0; reg < 16; ++reg) *(LAS float*)(S0 + ((32 * p + 4 * hh) * 68 + 32 * q + r) * 4 + ((reg & 3) + 8 * (reg >> 2)) * 272) = mkb[reg];
        st_cols(S2, p, q, mkk, r, hh); st_rows(S3, p, q, nrb, r, hh);
    }
    __syncthreads();
    if (w4 < 2) {
        if (lane < 32) { const int i0 = 32 * w4; float tc[32];
#pragma unroll
            for (int i = 0; i < 32; ++i) { float acc = (i == lane) ? 1.0f : 0.0f;
#pragma unroll
                for (int j4 = 0; j4 < (i + 3) / 4; ++j4) { const f32x4 m4 = *(const LAS f32x4*)(S0 + ((i0 + i) * 68 + i0 + 4 * j4) * 4);
                    if (4 * j4 + 0 < i) acc -= m4.x * tc[4 * j4 + 0]; if (4 * j4 + 1 < i) acc -= m4.y * tc[4 * j4 + 1]; if (4 * j4 + 2 < i) acc -= m4.z * tc[4 * j4 + 2]; if (4 * j4 + 3 < i) acc -= m4.w * tc[4 * j4 + 3]; }
                tc[i] = acc; }
#pragma unroll
            for (int i = 0; i < 32; ++i) *(LAS bf16*)(S7 + (i0 + i) * RSTR + (i0 + lane) * 2) = (bf16)f2bf(tc[i]);
            if (w4 == 0) {
#pragma unroll
                for (int i8 = 0; i8 < 4; ++i8) *(LAS bf16x8*)(T00T + lane * 80 + i8 * 16) = pack8(tc[8 * i8], tc[8 * i8 + 1], tc[8 * i8 + 2], tc[8 * i8 + 3], tc[8 * i8 + 4], tc[8 * i8 + 5], tc[8 * i8 + 6], tc[8 * i8 + 7]); }
        }
    } else if (w4 == 2) {
#pragma unroll
        for (int i = 0; i < 16; ++i) *(LAS bf16*)(S7 + (2 * i + hh) * RSTR + (32 + r) * 2) = (bf16)0;
    }
    __syncthreads();
    if (w4 == 1) {
        f32x16 g1 = zero16();
#pragma unroll
        for (int ks = 0; ks < 2; ++ks) { const int k0 = 16 * ks + 8 * hh; const LAS float* mp = (const LAS float*)(S0 + ((32 + r) * 68 + k0) * 4); const f32x4 x0 = *(const LAS f32x4*)mp, x1 = *(const LAS f32x4*)(mp + 4);
            g1 = MFMA32(pack8(x0.x, x0.y, x0.z, x0.w, x1.x, x1.y, x1.z, x1.w), *(const LAS bf16x8*)(T00T + r * 80 + k0 * 2), g1); }
#pragma unroll
        for (int g = 0; g < 4; ++g) { v2u w; w.x = cvtpk(g1[4 * g], g1[4 * g + 1]); w.y = cvtpk(g1[4 * g + 2], g1[4 * g + 3]); *(LAS v2u*)(G1T + r * 80 + (8 * g + 4 * hh) * 2) = w; }
        LDS_WAIT(); asm volatile("" ::: "memory");
        f32x16 t10 = zero16();
#pragma unroll
        for (int ks = 0; ks < 2; ++ks) { const int k0 = 16 * ks + 8 * hh; t10 = MFMA32(ldsfrag(S7, 32 + r, 32 + k0), *(const LAS bf16x8*)(G1T + r * 80 + k0 * 2), t10); }
#pragma unroll
        for (int reg = 0; reg < 16; ++reg) *(LAS bf16*)(S7 + (32 + 4 * hh) * RSTR + r * 2 + ((reg & 3) + 8 * (reg >> 2)) * RSTR) = (bf16)f2bf(-t10[reg]);
    }
    __syncthreads();
    {   f32x16 w1 = zero16(), w2 = zero16();
#pragma unroll
        for (int ks = 0; ks < 4; ++ks) { const int k0 = 16 * ks + 8 * hh; const bf16x8 tq = ldsfrag(S7, 32 * q + r, k0);
            w1 = MFMA32(ldsfrag(S4, 32 * p + r, k0), tq, w1); w2 = MFMA32(ldsfrag(S2, 32 * p + r, k0), tq, w2); }
        __syncthreads();
        st_rows(S0, p, q, w1, r, hh); st_rows(S1, p, q, w2, r, hh);
    }
    __syncthreads();
    {   f32x16 qf = zero16(), dl = zero16(), pv = zero16(), kf = zero16();
#pragma unroll
        for (int ks = 0; ks < 4; ++ks) { const int k0 = 16 * ks + 8 * hh;
            const bf16x8 w1p = ldsfrag(S0, 32 * p + r, k0), w1q = ldsfrag(S0, 32 * q + r, k0), w2p = ldsfrag(S1, 32 * p + r, k0), w2q = ldsfrag(S1, 32 * q + r, k0), nrq = ldsfrag(S3, 32 * q + r, k0), bep = ldsfrag(S5, 32 * p + r, k0);
            qf = MFMA32(w1p, nrq, qf); dl = MFMA32(bep, w1q, dl); pv = MFMA32(w2p, nrq, pv); kf = MFMA32(bep, w2q, kf); }
        bf16* qo = (bf16*)(a.ws + WS_PR) + row * NPR + hc + 32 * p + 4 * hh;
#pragma unroll
        for (int g = 0; g < 4; ++g) { v2u w; w.x = cvtpk(RqT[4 * g] - qf[4 * g], RqT[4 * g + 1] - qf[4 * g + 1]); w.y = cvtpk(RqT[4 * g + 2] - qf[4 * g + 2], RqT[4 * g + 3] - qf[4 * g + 3]); *(v2u*)(qo + 8 * g) = w; }
        bf16* dlo = (bf16*)((unsigned char*)a.out + DO_DLRT) + (size_t)ritem * 4096 + (32 * p + 4 * hh) * 64 + 32 * q + r;
#pragma unroll
        for (int reg = 0; reg < 16; ++reg) { dlo[((reg & 3) + 8 * (reg >> 2)) * 64] = (bf16)f2bf(-dl[reg]); pv[reg] = NrkT[reg] - pv[reg]; kf[reg] = KeT[reg] - kf[reg]; }
        st_cols(S2, p, q, pv, r, hh);
        st_rows(S4, p, q, kf, r, hh);
    }
    __syncthreads();
    {   f32x16 yl = zero16(), ds = zero16();
#pragma unroll
        for (int ks = 0; ks < 4; ++ks) { const int k0 = 16 * ks + 8 * hh; const bf16x8 vp = ldsfrag(S6, 32 * p + r, k0);
            yl = MFMA32(vp, ldsfrag(S2, 32 * q + r, k0), yl); ds = MFMA32(vp, ldsfrag(S4, 32 * q + r, k0), ds); }
        bf16* yo = (bf16*)(a.ws + WS_PR) + row * NPR + 512 + hc + 32 * p + 4 * hh;
#pragma unroll
        for (int g = 0; g < 4; ++g) { v2u w; w.x = cvtpk(yl[4 * g], yl[4 * g + 1]); w.y = cvtpk(yl[4 * g + 2], yl[4 * g + 3]); *(v2u*)(yo + 8 * g) = w; }
        bf16* dso = (bf16*)((unsigned char*)a.out + DO_DS) + (size_t)ritem * 4096 + (32 * p + 4 * hh) * 64 + 32 * q + r;
#pragma unroll
        for (int reg = 0; reg < 16; ++reg) dso[((reg & 3) + 8 * (reg >> 2)) * 64] = (bf16)f2bf(ds[reg]);
    }
    __syncthreads();
}

typedef float f32x4v __attribute__((ext_vector_type(4)));
__device__ __forceinline__ void rwkv_scan_task(const Args& a, int bh, int vq, int lane) {
    const int lc = lane & 15, g = lane >> 4, v = 16 * vq + lc;
    f32x4v ST[4];
#pragma unroll
    for (int ib = 0; ib < 4; ++ib) ST[ib] = (f32x4v){0.f, 0.f, 0.f, 0.f};
    const bf16* DL0 = (const bf16*)((const unsigned char*)a.out + DO_DLRT) + (size_t)bh * 32 * 4096; const bf16* DS0 = (const bf16*)((const unsigned char*)a.out + DO_DS) + (size_t)bh * 32 * 4096;
    const float* GL0 = (const float*)(a.ws + WS_GL) + (size_t)bh * 32 * 64; bf16* SP0 = (bf16*)(a.ws + WS_SPREV) + (size_t)bh * 32 * 4096;
    v2u dl[4][4], ds[4]; float gl[4];
#define R2_LOAD(c_) do { const bf16* DL = DL0 + (size_t)(c_) * 4096; const bf16* DSp = DS0 + (size_t)(c_) * 4096; \
        _Pragma("unroll") for (int ib = 0; ib < 4; ++ib) { _Pragma("unroll") for (int kb = 0; kb < 4; ++kb) dl[ib][kb] = *(const v2u*)(DL + (16 * ib + lc) * 64 + 16 * kb + 4 * g); \
            ds[ib] = *(const v2u*)(DSp + v * 64 + 16 * ib + 4 * g); gl[ib] = GL0[(size_t)(c_) * 64 + 16 * ib + lc]; } } while (0)
    R2_LOAD(0);
    for (int c = 0; c < 32; ++c) {
        bf16* SP = SP0 + (size_t)c * 4096 + v * 64 + 4 * g;
#pragma unroll
        for (int ib = 0; ib < 4; ++ib) { v2u w; w.x = cvtpk(ST[ib][0], ST[ib][1]); w.y = cvtpk(ST[ib][2], ST[ib][3]); *(v2u*)(SP + 16 * ib) = w; }
        float av[4][4][4]; f32x4v nw[4];
#pragma unroll
        for (int ib = 0; ib < 4; ++ib) {
            nw[ib] = (f32x4v){bflo(ds[ib].x), bfhi(ds[ib].x), bflo(ds[ib].y), bfhi(ds[ib].y)};
#pragma unroll
            for (int kb = 0; kb < 4; ++kb) { av[ib][kb][0] = bflo(dl[ib][kb].x); av[ib][kb][1] = bfhi(dl[ib][kb].x); av[ib][kb][2] = bflo(dl[ib][kb].y); av[ib][kb][3] = bfhi(dl[ib][kb].y); }
#pragma unroll
            for (int rr = 0; rr < 4; ++rr) if (lc == 4 * g + rr) av[ib][ib][rr] += gl[ib];
        }
        if (c + 1 < 32) R2_LOAD(c + 1);
#pragma unroll
        for (int kb = 0; kb < 4; ++kb)
#pragma unroll
            for (int rr = 0; rr < 4; ++rr)
#pragma unroll
                for (int ib = 0; ib < 4; ++ib) nw[ib] = __builtin_amdgcn_mfma_f32_16x16x4f32(av[ib][kb][rr], ST[kb][rr], nw[ib], 0, 0, 0);
#pragma unroll
        for (int ib = 0; ib < 4; ++ib) ST[ib] = nw[ib];
    }
#undef R2_LOAD
    float* So = a.out + O_PWKV + (size_t)bh * 4096 + v * 64 + 4 * g;
#pragma unroll
    for (int ib = 0; ib < 4; ++ib) *(f32x4*)(So + 16 * ib) = (f32x4){ST[ib][0], ST[ib][1], ST[ib][2], ST[ib][3]};
}

__device__ __forceinline__ void rwkv_out_task(const Args& a, int ritem, int tb, int lane_) {
    int lane = lane_; asm volatile("" : "+v"(lane));
    const int r = lane & 31, hh = lane >> 5, bh = ritem >> 5, c = ritem & 31, b = bh >> 3, h = bh & 7, hc = h * 64, row0 = b * SEQ, t0 = c * 64, tl = 32 * tb + r;
    const size_t row = (size_t)(row0 + t0 + tl);
    bf16* PRw = (bf16*)(a.ws + WS_PR); const bf16* cur = PRw + row * NPR; const bf16* prv = (t0 + tl) > 0 ? cur - NPR : nullptr;
    const bf16* SP = (const bf16*)(a.ws + WS_SPREV) + (size_t)ritem * 4096; const float* mu = a.in[10];
    f32x16 Y[2] = {zero16(), zero16()};
#pragma unroll
    for (int ks = 0; ks < 4; ++ks) { const int k0 = 16 * ks + 8 * hh; const bf16x8 B = ld16(cur + hc + k0);
        Y[0] = MFMA32(ld16(SP + (size_t)r * 64 + k0), B, Y[0]); Y[1] = MFMA32(ld16(SP + (size_t)(32 + r) * 64 + k0), B, Y[1]); }
    __builtin_amdgcn_sched_barrier(0);
    f32x16 G[2] = {zero16(), zero16()};
    {   const bf16* G2T = (const bf16*)(a.ws + WS_LG2T) + (size_t)(hc + r) * 128;
#pragma unroll
        for (int ks = 0; ks < 8; ++ks) { const int k0 = 16 * ks + 8 * hh; float m[8];
            mix8(*(const v4u*)(cur + 1664 + k0), prv ? *(const v4u*)(prv + 1664 + k0) : (v4u){0u, 0u, 0u, 0u}, mu + 1664 + k0, m);
            const bf16x8 B = pack8(sigmoidf_(m[0]), sigmoidf_(m[1]), sigmoidf_(m[2]), sigmoidf_(m[3]), sigmoidf_(m[4]), sigmoidf_(m[5]), sigmoidf_(m[6]), sigmoidf_(m[7]));
            G[0] = MFMA32(ld16(G2T + k0), B, G[0]); G[1] = MFMA32(ld16(G2T + 32 * 128 + k0), B, G[1]); }
    }
    __builtin_amdgcn_sched_barrier(0);
    float s1 = 0.f;
#pragma unroll
    for (int vb = 0; vb < 2; ++vb)
#pragma unroll
        for (int g = 0; g < 4; ++g) { const v2u y4 = *(const v2u*)(cur + 512 + hc + 32 * vb + 8 * g + 4 * hh);
            Y[vb][4 * g] += bflo(y4.x); Y[vb][4 * g + 1] += bfhi(y4.x); Y[vb][4 * g + 2] += bflo(y4.y); Y[vb][4 * g + 3] += bfhi(y4.y);
            s1 += (Y[vb][4 * g] + Y[vb][4 * g + 1]) + (Y[vb][4 * g + 2] + Y[vb][4 * g + 3]); }
    s1 += __shfl_xor(s1, 32); const float mean = s1 * (1.0f / 64.0f); float s2 = 0.f;
#pragma unroll
    for (int vb = 0; vb < 2; ++vb)
#pragma unroll
        for (int i = 0; i < 16; ++i) { const float d = Y[vb][i] - mean; s2 += d * d; }
    s2 += __shfl_xor(s2, 32); const float rs = rsqrtf(s2 * (1.0f / 64.0f) + R_GN_EPS);
    const float bon = ((const float*)(a.ws + WS_BON))[row * 8 + h];
    bf16* yo = PRw + row * NPR + hc;
#pragma unroll
    for (int vb = 0; vb < 2; ++vb)
#pragma unroll
        for (int g = 0; g < 4; ++g) { const int ch = hc + 32 * vb + 8 * g + 4 * hh; float mv[4];
            mix4(*(const v2u*)(cur + 1024 + ch), prv ? *(const v2u*)(prv + 1024 + ch) : (v2u){0u, 0u}, mu + 1024 + ch, mv);
            const f32x4 gw = *(const f32x4*)(a.in[19] + ch), gb = *(const f32x4*)(a.in[20] + ch); float o[4];
#pragma unroll
            for (int i = 0; i < 4; ++i) o[i] = ((Y[vb][4 * g + i] - mean) * rs * gw[i] + gb[i] + bon * mv[i]) * G[vb][4 * g + i];
            v2u w; w.x = cvtpk(o[0], o[1]); w.y = cvtpk(o[2], o[3]); *(v2u*)(yo + 32 * vb + 8 * g + 4 * hh) = w; }
}

__device__ __forceinline__ unsigned long long rt() { return __builtin_amdgcn_s_memrealtime(); }
#define XB_TMO      128
#define XB_XCNT(j)  (256  + 64 * (j))
#define XB_XSUB(j)  (1280 + 64 * (j))
#define XB_XGEN(j)  (2304 + 64 * (j))
#define XB_TOP      3328
#define XB_TOPGEN   3392
#define XCD_BAR_WORDS 3456
#define XB_SPIN_CAP (1u << 18)

__device__ __forceinline__ unsigned xb_ld(unsigned* p)              { return __hip_atomic_load(p, __ATOMIC_RELAXED, __HIP_MEMORY_SCOPE_AGENT); }
__device__ __forceinline__ unsigned xb_add(unsigned* p, unsigned v) { return __hip_atomic_fetch_add(p, v, __ATOMIC_RELAXED, __HIP_MEMORY_SCOPE_AGENT); }
__device__ __forceinline__ unsigned xb_xcc_id() { return (unsigned)__builtin_amdgcn_s_getreg((3 << 11) | 20) & 0xFu; }
#define XB_SPIN(cond, bar) do { unsigned _sp = 0; while (cond) { __builtin_amdgcn_s_sleep(1); \
    if ((++_sp & 255u) == 0u) { if (xb_ld(&(bar)[XB_TMO])) break; if (_sp > XB_SPIN_CAP) { atomicAdd(&(bar)[XB_TMO], 1u); break; } } } } while (0)

struct XcdBarrier {
    unsigned* bar; unsigned x;
    volatile LAS unsigned* st;
};

__device__ __forceinline__ XcdBarrier xcd_barrier_post(unsigned* bar, volatile LAS unsigned* st) {
    XcdBarrier b; b.bar = bar; b.x = xb_xcc_id(); b.st = st;
    if (threadIdx.x == 0) (void)xb_add(&bar[XB_XCNT(b.x)], 1u);
    return b;
}
__device__ __forceinline__ void xcd_barrier_complete(unsigned* bar, unsigned x, unsigned& nloc, unsigned& nx) {
    const unsigned G = gridDim.x * gridDim.y * gridDim.z;
    unsigned sum, cnt, mine, sp = 0u;
    for (;;) {
        sum = 0u; cnt = 0u; mine = 0u;
#pragma unroll
        for (unsigned j = 0; j < 16; ++j) { const unsigned c = xb_ld(&bar[XB_XCNT(j)]); sum += c; cnt += (c > 0u) ? 1u : 0u; mine = (j == x) ? c : mine; }
        if (sum == G) break;
        __builtin_amdgcn_s_sleep(1);
        if ((++sp & 255u) == 0u) { if (xb_ld(&bar[XB_TMO])) break; if (sp > XB_SPIN_CAP) { atomicAdd(&bar[XB_TMO], 1u); break; } }
    }
    nloc = mine > 0u ? mine : 1u; nx = cnt > 0u ? cnt : 1u;
}

__device__ __forceinline__ void xcd_barrier(const XcdBarrier& b) {
    asm volatile("s_waitcnt vmcnt(0)" ::: "memory");
    __syncthreads();
    if (threadIdx.x == 0) {
        unsigned* bar = b.bar;
        __builtin_amdgcn_s_waitcnt(0);
        unsigned nloc = b.st[0], nx = b.st[1];
        if (nloc == 0u) { xcd_barrier_complete(bar, b.x, nloc, nx); b.st[0] = nloc; b.st[1] = nx; }
        const unsigned old = xb_add(&bar[XB_XSUB(b.x)], 1u);
        const unsigned gen = old / nloc;
        if (old + 1u == (gen + 1u) * nloc) {
            __builtin_amdgcn_fence(__ATOMIC_RELEASE, "agent");
            asm volatile("s_waitcnt vmcnt(0)" ::: "memory");
            const unsigned og = xb_add(&bar[XB_TOP], 1u);
            const unsigned tg = og / nx;
            if (og + 1u == (tg + 1u) * nx) xb_add(&bar[XB_TOPGEN], 1u);
            else XB_SPIN(xb_ld(&bar[XB_TOPGEN]) == tg, bar);
            __builtin_amdgcn_fence(__ATOMIC_ACQUIRE, "agent");
            xb_add(&bar[XB_XGEN(b.x)], 1u);
            asm volatile("s_waitcnt vmcnt(0)" ::: "memory");
        } else {
            XB_SPIN(xb_ld(&bar[XB_XGEN(b.x)]) == gen, bar);
            __builtin_amdgcn_fence(__ATOMIC_ACQUIRE, "agent");
            asm volatile("s_waitcnt vmcnt(0)" ::: "memory");
        }
    }
    __syncthreads();
}


constexpr size_t WS_BAR = 512 * 1024;
constexpr int MISC_OFF = 159744, MEGA_LDS = 160000;
static_assert(2 * RWKV_LDS <= MISC_OFF && MLSTM_LDS <= MISC_OFF && P0_LDS <= MISC_OFF && 2 * R1_ITEM_LDS <= MISC_OFF && GEMM_LDS <= MISC_OFF, "LDS map");

__global__ void __launch_bounds__(NTHR, 2) mega_fwd(Args a) {
    extern __shared__ __attribute__((aligned(16))) unsigned char lds_raw[];
    LAS unsigned char* lds = (LAS unsigned char*)lds_raw;
    volatile LAS unsigned* MISC = (volatile LAS unsigned*)(lds + MISC_OFF);
    const int tid = threadIdx.x, lane = tid & 63, wave = __builtin_amdgcn_readfirstlane(tid >> 6);
    const int G = gridDim.x, bx = blockIdx.x;
    unsigned char* ws = a.ws;
    if (tid < 64) MISC[tid] = 0u;
    __syncthreads();
    XcdBarrier bar = xcd_barrier_post((unsigned*)(ws + WS_BAR), MISC + 8);

    p0_prologue(a, lds, bx * NWAVES + wave, G * NWAVES, lane, wave);
    xcd_barrier(bar);
    { pg8::StaticOrder S; pg8::Gemm g{(const bf16*)(ws + WS_XN), (const bf16*)(ws + WS_WINT), MT, NPROJ, 1024, 1024}; S.init(MT, NPROJ, G, bx);
      pg8::EpiProj E{(bf16*)(ws + WS_PR), (bf16*)(ws + WS_PM), (bf16*)(ws + WS_PG), a.in[31], (bf16*)(ws + WS_BND)}; pg8::gemm_phase<pg8::EpiProj, pg8::StaticOrder, true, true>(lds, g, S, E); }
    xcd_barrier(bar);
    {
        for (int pr = bx; pr < 1024; pr += G) rwkv_prep_pair(a, lds, 2 * pr);
        LAS float* CW = (LAS float*)lds;
        for (int item = bx; item < 1024; item += G) { stage_conv_head(a, CW, (item >> 5) & 3, tid, NTHR); __syncthreads(); mlstm_prep_task(a, item, wave, CW, lane); __syncthreads(); }
    }
    xcd_barrier(bar);
    {
        if (bx < 64) { if (wave < 4) rwkv_scan_task(a, bx, wave, lane); }
        else if (bx < 104) { if (wave < 4) { const int task = (bx - 64) * 4 + wave; mlstm_scan_task(a, task / 5, task % 5, (LAS float*)lds + wave * 64, lane); } }
        else { for (int s = bx - 104; s < 512; s += G - 104) { rwkv_seq_item(a, lds, 64 + 2 * s); __syncthreads(); } }
    }
    xcd_barrier(bar);
    {
        for (int s = bx; s < 512; s += G) { mlstm_seq_item(a, lds, 32 + s); __syncthreads(); }
        LAS float* CWall = (LAS float*)lds;
        for (int hq = 0; hq < 4; ++hq) stage_conv_head(a, CWall + hq * 640, hq, tid, NTHR);
        __syncthreads();
        { const int task = bx * NWAVES + wave; if (task < 2048) mlstm_out_task(a, task >> 1, task & 1, CWall, lane); }
        for (int task = bx * NWAVES + wave; task < 4096; task += G * NWAVES) rwkv_out_task(a, task >> 1, task & 1, lane);
    }
    xcd_barrier(bar);
    { pg8::StaticOrder S; pg8::Gemm g{(const bf16*)(ws + WS_PR), (const bf16*)(ws + WS_UPRT), MT, 1024, 512, NPR}; S.init(MT, 1024, G, bx);
      pg8::EpiUp1 E{a.out, (const bf16*)(ws + WS_PG)}; pg8::gemm_phase<pg8::EpiUp1, pg8::StaticOrder, true, true>(lds, g, S, E); }
    xcd_barrier(bar);
    { pg8::StaticOrder S; pg8::Gemm g{(const bf16*)(ws + WS_YM), (const bf16*)(ws + WS_UPMT), MT, 1024, 512, 512}; S.init(MT, 1024, G, bx);
      pg8::EpiUp2 E{a.out, (const bf16*)(ws + WS_PG), (bf16*)(ws + WS_MERGED)}; pg8::gemm_phase<pg8::EpiUp2, pg8::StaticOrder, true, true>(lds, g, S, E); }
    xcd_barrier(bar);
    { pg8::StaticOrder S; pg8::Gemm g{(const bf16*)(ws + WS_MERGED), (const bf16*)(ws + WS_WOUTT), MT, 1024, 1024, 1024}; S.init(MT, 1024, G, bx);
      pg8::EpiOut E{a.in[0], a.in[1], a.out, (bf16*)(ws + WS_X2B), a.in[33], (float*)(ws + WS_SSQ1)}; pg8::gemm_phase<pg8::EpiOut, pg8::StaticOrder, true, true>(lds, g, S, E); }
    xcd_barrier(bar);
    { pg8::StaticOrder S; pg8::Gemm g{(const bf16*)(ws + WS_X2B), (const bf16*)(ws + WS_W1T), MT, FF, 1024, 1024}; S.init(MT, FF, G, bx);
      pg8::EpiFfn1 E{(bf16*)(ws + WS_H), (const float*)(ws + WS_SSQ1)}; pg8::gemm_phase<pg8::EpiFfn1, pg8::StaticOrder, true, true>(lds, g, S, E); }
    xcd_barrier(bar);
    { pg8::StaticOrder S; pg8::Gemm g{(const bf16*)(ws + WS_H), (const bf16*)(ws + WS_W2T), MT, 1024, FF, FF}; S.init(MT, 1024, G, bx);
      pg8::EpiFfn2 E{a.out, (float*)(ws + WS_SSQ2)}; pg8::gemm_phase<pg8::EpiFfn2, pg8::StaticOrder, true, true>(lds, g, S, E); }
    xcd_barrier(bar);
    final_norm_rows(a, bx * NWAVES + wave, G * NWAVES, lane);
}

extern "C" void kernel_launch(void* const* d_in, const int* in_sizes, int n_in, void* d_out, int out_size, void* d_ws, size_t ws_size, hipStream_t stream) {
    static int grid = 0;
    if (grid == 0) {
        if (n_in != 37 || (size_t)out_size != O_END || ws_size < WS_NEED) { fprintf(stderr, "kernel_launch: unexpected problem: n_in %d out %d ws %zu\n", n_in, out_size, ws_size); grid = -1; return; }
        int dev = 0, cus = 0, per_cu = 0;
        if (hipGetDevice(&dev) != hipSuccess || hipDeviceGetAttribute(&cus, hipDeviceAttributeMultiprocessorCount, dev) != hipSuccess) { fprintf(stderr, "kernel_launch: device query failed\n"); grid = -1; return; }
        if (hipFuncSetAttribute((const void*)mega_fwd, hipFuncAttributeMaxDynamicSharedMemorySize, MEGA_LDS) != hipSuccess) { fprintf(stderr, "kernel_launch: hipFuncSetAttribute failed\n"); grid = -1; return; }
        if (hipOccupancyMaxActiveBlocksPerMultiprocessor(&per_cu, (const void*)mega_fwd, NTHR, MEGA_LDS) != hipSuccess || per_cu < 1) { fprintf(stderr, "kernel_launch: occupancy query reports %d workgroups per CU\n", per_cu); (void)hipGetLastError(); per_cu = 1; }
        if (cus != 256) fprintf(stderr, "kernel_launch: built for a 256-CU device (one workgroup per CU); found %d CUs\n", cus);
        grid = 256;
    }
    if (grid < 0) return;
    if (hipMemsetAsync((char*)d_ws + WS_BAR, 0, 16384, stream) != hipSuccess) { fprintf(stderr, "kernel_launch: memset failed\n"); return; }
    Args a{};
    for (int i = 0; i < 37; ++i) a.in[i] = (const float*)d_in[i];
    a.out = (float*)d_out; a.ws = (unsigned char*)d_ws;
    void* args[] = {&a};
    hipError_t e = hipLaunchCooperativeKernel((const void*)mega_fwd, dim3(grid), dim3(NTHR), args, MEGA_LDS, stream);
    if (e != hipSuccess) fprintf(stderr, "kernel_launch: cooperative launch failed: %s (grid %d)\n", hipGetErrorString(e), grid);
}
```

```cpp
#include <hip/hip_runtime.h>
#include <cstdio>
#include <cstdint>

constexpr int DM = 1024, MP = 16384, MS = 128, MTOK = MP + MS, MT = 16640;
constexpr int SEQ = 2048, NB = 8;
constexpr int NPR = 1792, NPM = 1536, NPG = 2048, NPROJ = NPR + NPM + NPG, INCOLS = 5384, GCOL0 = 3328;
constexpr int RH = 8, RN = 64, RW = 512, MH = 4, MD = 128, MW = 512, FF = 4096;
constexpr float RMS_EPS = 1e-6f, R_GN_EPS = 64e-5f, M_GN_EPS = 1e-5f;

constexpr size_t O_Y = 0;
constexpr size_t O_PSHIFT = (size_t)MTOK * DM;
constexpr size_t O_PWKV = O_PSHIFT + (size_t)NB * DM;
constexpr size_t O_PC = O_PWKV + (size_t)NB * RH * RN * RN;
constexpr size_t O_PN = O_PC + (size_t)NB * MH * MD * MD;
constexpr size_t O_PMM = O_PN + (size_t)NB * MH * MD;
constexpr size_t O_PCONV = O_PMM + (size_t)NB * MH;
constexpr size_t O_SSHIFT = O_PCONV + (size_t)NB * 3 * MW;
constexpr size_t O_SWKV = O_SSHIFT + (size_t)MS * DM;
constexpr size_t O_SC = O_SWKV + (size_t)MS * RH * RN * RN;
constexpr size_t O_SN = O_SC + (size_t)MS * MH * MD * MD;
constexpr size_t O_SMM = O_SN + (size_t)MS * MH * MD;
constexpr size_t O_SCONV = O_SMM + (size_t)MS * MH;
constexpr size_t O_END = O_SCONV + (size_t)MS * 3 * MW;
static_assert(O_END == 30695968, "output size");

constexpr size_t MiB = 1u << 20;
constexpr size_t WS_CTL = 0;
constexpr size_t WS_SSQ1 = 0, WS_SSQ2 = 128 * 1024;
constexpr size_t WS_WINT = 1 * MiB, WS_UPRT = 12 * MiB, WS_UPMT = 13 * MiB, WS_WOUTT = 14 * MiB, WS_W1T = 16 * MiB, WS_W2T = 24 * MiB;
constexpr size_t WS_GATES = 32 * MiB;
constexpr size_t WS_WQT = 32 * MiB + 576 * 1024, WS_WKT = 32 * MiB + 704 * 1024;
constexpr size_t WS_LW2T = 576 * 1024, WS_LA2T = 640 * 1024, WS_LG2T = 704 * 1024;
constexpr size_t WS_XN = 33 * MiB;
constexpr size_t WS_YM = 33 * MiB, WS_X2B = 33 * MiB;
constexpr size_t WS_PR = 66 * MiB;
constexpr size_t WS_PM = 123 * MiB;
constexpr size_t WS_PG = 172 * MiB;
constexpr size_t WS_YR = 237 * MiB;
constexpr size_t WS_MERGED = 66 * MiB;
constexpr size_t WS_UPSCR = 100 * MiB;
constexpr size_t WS_H = 66 * MiB;
constexpr size_t WS_NEED = 256 * MiB;
static_assert(WS_YR + (size_t)MT * 512 * 2 <= WS_NEED && WS_H + (size_t)MT * FF * 2 <= WS_NEED && WS_PG + (size_t)MT * NPG * 2 <= WS_YR && WS_UPSCR + (size_t)MT * DM * 4 <= WS_PG, "ws map");

#define GAS __attribute__((address_space(1)))
#define LAS __attribute__((address_space(3)))
typedef unsigned short bf16;
typedef unsigned v4u __attribute__((ext_vector_type(4)));
typedef unsigned v2u __attribute__((ext_vector_type(2)));
typedef float f32x4 __attribute__((ext_vector_type(4)));
typedef float f32x2 __attribute__((ext_vector_type(2)));
__device__ __forceinline__ unsigned f2bf(float f) { unsigned u = __builtin_bit_cast(unsigned, f); return (u + 0x7fffu + ((u >> 16) & 1u)) >> 16; }
__device__ __forceinline__ unsigned pk2(float lo, float hi) { return f2bf(lo) | (f2bf(hi) << 16); }
__device__ __forceinline__ float bf2f(unsigned b) { return __builtin_bit_cast(float, b << 16); }
__device__ __forceinline__ float bflo(unsigned w) { return __builtin_bit_cast(float, w << 16); }
__device__ __forceinline__ float bfhi(unsigned w) { return __builtin_bit_cast(float, w & 0xffff0000u); }
__device__ __forceinline__ float sigmoidf_(float x) { return 1.0f / (1.0f + __expf(-x)); }
__device__ __forceinline__ float wave_sum(float v) {
#pragma unroll
    for (int o = 1; o < 64; o <<= 1) v += __shfl_xor(v, o);
    return v;
}

namespace pg8 {
#define PG8_LAS __attribute__((address_space(3)))
typedef unsigned short bf16_t;
typedef short bf16x8 __attribute__((ext_vector_type(8)));
typedef float f32x4 __attribute__((ext_vector_type(4)));
typedef unsigned u32x4 __attribute__((ext_vector_type(4)));
constexpr int BM = 256, BK = 64, HALF = 128, HTB = HALF * BK * 2  , STAGE_BYTES = 8 * HTB, NXCD = 8, WGM = 8;

__host__ __device__ __forceinline__ int lds_byte(int r, int c) { const int st = (r >> 4) * 2 + (c >> 5), rr = r & 15, cc = c & 31, ob = rr * 64 + cc * 2; return st * 1024 + (ob ^ (((ob >> 9) & 1) << 5)); }
__host__ __device__ __forceinline__ void stage_rc(int b, int& R, int& C) { const int st = b / 1024, sb = b % 1024, swz = sb ^ (((sb >> 9) & 1) << 5); R = (st >> 1) * 16 + swz / 64; C = (st & 1) * 32 + (swz % 64) / 2; }
__host__ __device__ __forceinline__ int perm32(int rho) { const int n = rho >> 4, i = rho & 15; return 8 * (i >> 2) + 4 * n + (i & 3); }

struct Unit { int pm, pn; };
struct Gemm { const bf16_t* A; const bf16_t* Bt; int M, N, K, lda; };

struct StaticOrder {
    int nM, nN, nwg, G, c;
    __host__ __device__ void init(int M, int N, int G_, int c_) { nM = M / BM; nN = N / BM; nwg = nM * nN; G = G_; c = c_; }
    __host__ __device__ bool next(int i, Unit& u) const {
        const long L = (long)i * G + c; if (L >= nwg) return false;
        int wgid = (int)L; { const int q = nwg / NXCD, r = nwg % NXCD, xcd = wgid % NXCD, off = wgid / NXCD; wgid = (xcd < r ? xcd * (q + 1) : r * (q + 1) + (xcd - r) * q) + off; }
        const int nig = WGM * nN, gid = wgid / nig, fm = gid * WGM, gsz = (nM - fm) < WGM ? (nM - fm) : WGM;
        u.pm = fm + ((wgid % nig) % gsz); u.pn = (wgid % nig) / gsz; return true;
    }
    __device__ __forceinline__ void a_ready(const Unit&) const {}
    __device__ __forceinline__ void done(const Unit&) const {}
};

__device__ __forceinline__ unsigned cvt_pk_bf16(float lo, float hi) { unsigned r; asm volatile("v_cvt_pk_bf16_f32 %0, %1, %2" : "=v"(r) : "v"(lo), "v"(hi)); return r; }
typedef unsigned u32x2 __attribute__((ext_vector_type(2)));
__device__ __forceinline__ float sigm(float x) { return 1.0f / (1.0f + __expf(-x)); }
__device__ __forceinline__ float bf_lo(unsigned w) { return __builtin_bit_cast(float, w << 16); }
__device__ __forceinline__ float bf_hi(unsigned w) { return __builtin_bit_cast(float, w & 0xffff0000u); }

struct EpiProj {
    static constexpr bool PERM = true, AFTER_DRAIN = false;
    bf16_t *PR, *PM, *PG; const float* gate_b; bf16_t* BND;
    __device__ __forceinline__ void operator()(const f32x4 (&acc)[2][2][4][2], const Unit& u, int wr, int wc, int fr, int fq) const {
        int colt = u.pn * BM; bf16_t* base; int ldc; bool gate = false;
        if (colt < 1792) { base = PR; ldc = 1792; } else if (colt < 3328) { base = PM; ldc = 1536; colt -= 1792; } else { base = PG; ldc = 2048; colt -= 3328; gate = true; }
        const int row0 = u.pm * BM + wr * 64 + fr, col0 = colt + wc * 32 + 8 * fq;
        f32x4 bv[2][2];
#pragma unroll
        for (int bj = 0; bj < 2; ++bj)
#pragma unroll
            for (int n = 0; n < 2; ++n) bv[bj][n] = gate ? *(const f32x4*)(gate_b + col0 + bj * HALF + 4 * n) : (f32x4){0.f, 0.f, 0.f, 0.f};
#pragma unroll
        for (int ai = 0; ai < 2; ++ai)
#pragma unroll
            for (int m = 0; m < 4; ++m) { bf16_t* rowp = base + (size_t)(row0 + ai * HALF + m * 16) * ldc + col0;
#pragma unroll
                for (int bj = 0; bj < 2; ++bj) { f32x4 v0 = acc[ai][bj][m][0] + bv[bj][0], v1 = acc[ai][bj][m][1] + bv[bj][1];
                    if (gate) {
#pragma unroll
                        for (int j = 0; j < 4; ++j) { v0[j] = sigm(v0[j]); v1[j] = sigm(v1[j]); } }
                    u32x4 w; w.x = cvt_pk_bf16(v0[0], v0[1]); w.y = cvt_pk_bf16(v0[2], v0[3]); w.z = cvt_pk_bf16(v1[0], v1[1]); w.w = cvt_pk_bf16(v1[2], v1[3]);
                    *(u32x4*)(rowp + bj * HALF) = w;
                    if (m == 3 && fr == 15 && base == PR && u.pm < 64) *(u32x4*)(BND + (size_t)((row0 + ai * HALF + m * 16) >> 6) * 1792 + col0 + bj * HALF) = w; } }
    }
};
struct EpiUp1 {
    static constexpr bool PERM = false, AFTER_DRAIN = false;
    float* SCR; const bf16_t* PG;
    __device__ __forceinline__ void operator()(const f32x4 (&acc)[2][2][4][2], const Unit& u, int wr, int wc, int fr, int fq) const {
        const int row0 = u.pm * BM + wr * 64 + fr, col0 = u.pn * BM + wc * 32 + 4 * fq;
#pragma unroll
        for (int ai = 0; ai < 2; ++ai) {
            if (u.pm * BM + ai * HALF >= 16512) continue;
#pragma unroll
            for (int m = 0; m < 4; ++m) { const size_t row = (size_t)(row0 + ai * HALF + m * 16);
#pragma unroll
                for (int bj = 0; bj < 2; ++bj)
#pragma unroll
                    for (int n = 0; n < 2; ++n) { const int c = col0 + bj * HALF + n * 16; const u32x2 g = *(const u32x2*)(PG + row * 2048 + c);
                        f32x4 v = acc[ai][bj][m][n]; v[0] *= bf_lo(g.x); v[1] *= bf_hi(g.x); v[2] *= bf_lo(g.y); v[3] *= bf_hi(g.y);
                        *(f32x4*)(SCR + row * 1024 + c) = v; } } }
    }
};
struct EpiUp2 {
    static constexpr bool PERM = false, AFTER_DRAIN = false;
    const float* SCR; const bf16_t* PG; bf16_t* MG;
    __device__ __forceinline__ void operator()(const f32x4 (&acc)[2][2][4][2], const Unit& u, int wr, int wc, int fr, int fq) const {
        const int row0 = u.pm * BM + wr * 64 + fr, col0 = u.pn * BM + wc * 32 + 4 * fq;
#pragma unroll
        for (int ai = 0; ai < 2; ++ai) {
            if (u.pm * BM + ai * HALF >= 16512) continue;
#pragma unroll
            for (int m = 0; m < 4; ++m) { const size_t row = (size_t)(row0 + ai * HALF + m * 16);
#pragma unroll
                for (int bj = 0; bj < 2; ++bj)
#pragma unroll
                    for (int n = 0; n < 2; ++n) { const int c = col0 + bj * HALF + n * 16; const u32x2 g = *(const u32x2*)(PG + row * 2048 + 1024 + c);
                        const f32x4 s = *(const f32x4*)(SCR + row * 1024 + c); f32x4 v = acc[ai][bj][m][n];
                        v[0] = s[0] + v[0] * bf_lo(g.x); v[1] = s[1] + v[1] * bf_hi(g.x); v[2] = s[2] + v[2] * bf_lo(g.y); v[3] = s[3] + v[3] * bf_hi(g.y);
                        u32x2 w; w.x = cvt_pk_bf16(v[0], v[1]); w.y = cvt_pk_bf16(v[2], v[3]); *(u32x2*)(MG + row * 1024 + c) = w; } } }
    }
};
struct EpiOut {
    static constexpr bool PERM = false, AFTER_DRAIN = false;
    const float *xp, *xs; float* OUT; bf16_t* X2B; const float* gffn; float* ssq;
    __device__ __forceinline__ void operator()(const f32x4 (&acc)[2][2][4][2], const Unit& u, int wr, int wc, int fr, int fq) const {
        const int row0 = u.pm * BM + wr * 64 + fr, col0 = u.pn * BM + wc * 32 + 4 * fq;
        f32x4 gv[2][2];
#pragma unroll
        for (int bj = 0; bj < 2; ++bj)
#pragma unroll
            for (int n = 0; n < 2; ++n) gv[bj][n] = *(const f32x4*)(gffn + col0 + bj * HALF + n * 16);
#pragma unroll
        for (int ai = 0; ai < 2; ++ai) {
            if (u.pm * BM + ai * HALF >= 16512) continue;
#pragma unroll
            for (int m = 0; m < 4; ++m) { const int row = row0 + ai * HALF + m * 16;
                const float* xin = row < 16384 ? xp + (size_t)row * 1024 : xs + (size_t)(row - 16384) * 1024; float sq = 0.f;
#pragma unroll
                for (int bj = 0; bj < 2; ++bj)
#pragma unroll
                    for (int n = 0; n < 2; ++n) { const int c = col0 + bj * HALF + n * 16; const f32x4 v = *(const f32x4*)(xin + c) + acc[ai][bj][m][n];
                        *(f32x4*)(OUT + (size_t)row * 1024 + c) = v; sq += (v[0] * v[0] + v[1] * v[1]) + (v[2] * v[2] + v[3] * v[3]);
                        const f32x4 h = v * gv[bj][n]; u32x2 w; w.x = cvt_pk_bf16(h[0], h[1]); w.y = cvt_pk_bf16(h[2], h[3]); *(u32x2*)(X2B + (size_t)row * 1024 + c) = w; }
                sq += __shfl_xor(sq, 16); sq += __shfl_xor(sq, 32);
                if (fq == 0) atomicAdd(ssq + row, sq); }
        }
    }
};
struct EpiFfn1 {
    static constexpr bool PERM = true, AFTER_DRAIN = false;
    bf16_t* H; const float* ssq;
    __device__ __forceinline__ void operator()(const f32x4 (&acc)[2][2][4][2], const Unit& u, int wr, int wc, int fr, int fq) const {
        const int row0 = u.pm * BM + wr * 64 + fr, col0 = u.pn * BM + wc * 32 + 8 * fq;
#pragma unroll
        for (int ai = 0; ai < 2; ++ai)
#pragma unroll
            for (int m = 0; m < 4; ++m) { const int row = row0 + ai * HALF + m * 16; const float rs = rsqrtf(ssq[row] * (1.0f / 1024.0f) + 1e-6f);
                bf16_t* rowp = H + (size_t)row * 4096 + col0;
#pragma unroll
                for (int bj = 0; bj < 2; ++bj) { f32x4 v0 = acc[ai][bj][m][0] * rs, v1 = acc[ai][bj][m][1] * rs;
#pragma unroll
                    for (int j = 0; j < 4; ++j) { const float a = fmaxf(v0[j], 0.f), b = fmaxf(v1[j], 0.f); v0[j] = a * a; v1[j] = b * b; }
                    u32x4 w; w.x = cvt_pk_bf16(v0[0], v0[1]); w.y = cvt_pk_bf16(v0[2], v0[3]); w.z = cvt_pk_bf16(v1[0], v1[1]); w.w = cvt_pk_bf16(v1[2], v1[3]);
                    *(u32x4*)(rowp + bj * HALF) = w; } }
    }
};
struct EpiFfn2 {
    static constexpr bool PERM = false, AFTER_DRAIN = false;
    float* OUT; float* ssq;
    __device__ __forceinline__ void operator()(const f32x4 (&acc)[2][2][4][2], const Unit& u, int wr, int wc, int fr, int fq) const {
        const int row0 = u.pm * BM + wr * 64 + fr, col0 = u.pn * BM + wc * 32 + 4 * fq;
#pragma unroll
        for (int ai = 0; ai < 2; ++ai) {
            if (u.pm * BM + ai * HALF >= 16512) continue;
#pragma unroll
            for (int m = 0; m < 4; ++m) { const int row = row0 + ai * HALF + m * 16; float sq = 0.f;
#pragma unroll
                for (int bj = 0; bj < 2; ++bj)
#pragma unroll
                    for (int n = 0; n < 2; ++n) { float* p = OUT + (size_t)row * 1024 + col0 + bj * HALF + n * 16; const f32x4 v = *(const f32x4*)p + acc[ai][bj][m][n];
                        *(f32x4*)p = v; }
                (void)sq; }
        }
    }
};

template <class Epi, class Sched, bool ALIGN_EPI = false, bool SP2 = false>
__device__ __forceinline__ void gemm_phase(PG8_LAS unsigned char* lds, const Gemm g, const Sched& S, const Epi& E) {
    int tid_ = threadIdx.x; asm volatile("" : "+v"(tid_));
    const int tid = tid_, wid = __builtin_amdgcn_readfirstlane(tid >> 6), lane = tid & 63, wr = wid >> 2, wc = wid & 3, fr = lane & 15, fq = lane >> 4;
    const int K = g.K, nt = K / BK;
    unsigned voffA[2], voffB[2];
#pragma unroll
    for (int i = 0; i < 2; ++i) { int R, C; stage_rc(tid * 16 + i * 8192, R, C); const int Rb = Epi::PERM ? ((R & ~31) + perm32(R & 31)) : R;
        voffA[i] = (unsigned)(R * g.lda + C) * 2u; voffB[i] = (unsigned)(Rb * K + C) * 2u; }
    const size_t kstep = (size_t)(BK * 2);
    const size_t hstep = (size_t)HALF * K * 2;
    const size_t tstep = 2 * hstep;
    const size_t hstepA = (size_t)HALF * g.lda * 2, tstepA = 2 * hstepA;
    const unsigned ldsw = (unsigned)wid * 1024u;
    const int aoff = lds_byte(wr * 64 + fr, fq * 8), boff = lds_byte(wc * 32 + fr, fq * 8);
#define PG8_SA(b, h) (((b) * 2 + (h)) * HTB)
#define PG8_SB(b, h) ((4 + (b) * 2 + (h)) * HTB)
#define PG8_STAGE(bufoff, gbase, voff) do { _Pragma("unroll") for (int _i = 0; _i < 2; ++_i) \
        __builtin_amdgcn_global_load_lds((const unsigned*)((const char*)(gbase) + (voff)[_i]), (PG8_LAS unsigned*)(lds + (bufoff) + ldsw + _i * 8192), 16, 0, 0); } while (0)
#define PG8_LDA(dst, b, h) do { _Pragma("unroll") for (int m = 0; m < 4; ++m) _Pragma("unroll") for (int k = 0; k < 2; ++k) dst[m][k] = *(const PG8_LAS bf16x8*)(lds + PG8_SA(b, h) + aoff + m * 2048 + k * 1024); } while (0)
#define PG8_LDB(dst, b, h) do { _Pragma("unroll") for (int n = 0; n < 2; ++n) _Pragma("unroll") for (int k = 0; k < 2; ++k) dst[n][k] = *(const PG8_LAS bf16x8*)(lds + PG8_SB(b, h) + boff + n * 2048 + k * 1024); } while (0)
#define PG8_MMA(ai, bj, At, Bt) do { __builtin_amdgcn_s_setprio(1); _Pragma("unroll") for (int m = 0; m < 4; ++m) _Pragma("unroll") for (int n = 0; n < 2; ++n) _Pragma("unroll") for (int k = 0; k < 2; ++k) \
        acc[ai][bj][m][n] = __builtin_amdgcn_mfma_f32_16x16x32_bf16(Bt[n][k], At[m][k], acc[ai][bj][m][n], 0, 0, 0); __builtin_amdgcn_s_setprio(0); } while (0)
#define PG8_WAIT_V(n) asm volatile("s_waitcnt vmcnt(" #n ")" ::: "memory")
#define PG8_WAIT_L(n) asm volatile("s_waitcnt lgkmcnt(" #n ")" ::: "memory")
#define PG8_BAR __builtin_amdgcn_s_barrier()
#define PG8_SCHED __builtin_amdgcn_sched_barrier(0)
    Unit cur, nxt; int ui = 0;
    if (!S.next(0, cur)) return;
    f32x4 acc[2][2][4][2];
#pragma unroll
    for (int a = 0; a < 2; ++a)
#pragma unroll
        for (int b = 0; b < 2; ++b)
#pragma unroll
            for (int m = 0; m < 4; ++m)
#pragma unroll
                for (int n = 0; n < 2; ++n) acc[a][b][m][n] = (f32x4){0.f, 0.f, 0.f, 0.f};
    bf16x8 At[4][2], B0[2][2], B1[2][2];
    const char* cA = (const char*)g.A + (size_t)cur.pm * tstepA; const char* cB = (const char*)g.Bt + (size_t)cur.pn * tstep;
    S.a_ready(cur);
    if constexpr (SP2) {
        PG8_STAGE(PG8_SB(0, 0), cB, voffB); PG8_STAGE(PG8_SB(0, 1), cB + hstep, voffB); PG8_STAGE(PG8_SA(0, 0), cA, voffA); PG8_STAGE(PG8_SA(0, 1), cA + hstepA, voffA);
        if (wr == 1) PG8_BAR;
        PG8_WAIT_V(2); PG8_BAR;
        PG8_STAGE(PG8_SB(1, 0), cB + kstep, voffB); PG8_STAGE(PG8_SA(1, 0), cA + kstep, voffA); PG8_STAGE(PG8_SB(1, 1), cB + hstep + kstep, voffB);
        PG8_WAIT_V(6); PG8_BAR;
    } else {
        PG8_STAGE(PG8_SB(0, 0), cB, voffB); PG8_STAGE(PG8_SA(0, 0), cA, voffA); PG8_STAGE(PG8_SB(0, 1), cB + hstep, voffB); PG8_STAGE(PG8_SA(0, 1), cA + hstepA, voffA);
        if (wr == 1) PG8_BAR;
        PG8_WAIT_V(4); PG8_BAR;
        PG8_STAGE(PG8_SB(1, 0), cB + kstep, voffB); PG8_STAGE(PG8_SA(1, 0), cA + kstep, voffA); PG8_STAGE(PG8_SB(1, 1), cB + hstep + kstep, voffB);
        PG8_WAIT_V(6); PG8_BAR;
    }
    for (;;) {
        const bool has_next = S.next(ui + 1, nxt);
        const char* nA = has_next ? (const char*)g.A + (size_t)nxt.pm * tstepA : cA; const char* nB = has_next ? (const char*)g.Bt + (size_t)nxt.pn * tstep : cB;
        for (int t = 0; t < nt; t += 2) {
            const bool last = (t == nt - 2);
            const char* a1 = cA + (size_t)(t + 1) * kstep;
            const char* a2 = last ? nA : cA + (size_t)(t + 2) * kstep; const char* b2 = last ? nB : cB + (size_t)(t + 2) * kstep;
            const char* a3 = a2 + kstep; const char* b3 = b2 + kstep;
            if (last && has_next) S.a_ready(nxt);
            if constexpr (SP2) {
            PG8_LDB(B0, 0, 0); PG8_LDB(B1, 0, 1); PG8_SCHED; PG8_LDA(At, 0, 0); PG8_STAGE(PG8_SA(1, 1), a1 + hstepA, voffA);
            PG8_WAIT_V(8); PG8_WAIT_L(0); PG8_BAR; PG8_MMA(0, 0, At, B0); PG8_MMA(0, 1, At, B1); PG8_BAR; PG8_SCHED;
            PG8_LDA(At, 0, 1); PG8_STAGE(PG8_SB(0, 0), b2, voffB); PG8_STAGE(PG8_SB(0, 1), b2 + hstep, voffB); PG8_STAGE(PG8_SA(0, 0), a2, voffA);
            PG8_WAIT_V(8); PG8_WAIT_L(0); PG8_BAR; PG8_MMA(1, 0, At, B0); PG8_MMA(1, 1, At, B1); PG8_BAR; PG8_SCHED;
            PG8_LDB(B0, 1, 0); PG8_LDB(B1, 1, 1); PG8_SCHED; PG8_LDA(At, 1, 0); PG8_STAGE(PG8_SA(0, 1), a2 + hstepA, voffA);
            PG8_WAIT_V(8); PG8_WAIT_L(0); PG8_BAR; PG8_MMA(0, 0, At, B0); PG8_MMA(0, 1, At, B1); PG8_BAR; PG8_SCHED;
            PG8_LDA(At, 1, 1); PG8_STAGE(PG8_SB(1, 0), b3, voffB); PG8_STAGE(PG8_SB(1, 1), b3 + hstep, voffB); PG8_STAGE(PG8_SA(1, 0), a3, voffA);
            PG8_WAIT_V(8); PG8_WAIT_L(0); PG8_BAR; PG8_MMA(1, 0, At, B0); PG8_MMA(1, 1, At, B1); PG8_BAR; PG8_SCHED;
            } else {
            PG8_LDB(B0, 0, 0); PG8_SCHED; PG8_LDA(At, 0, 0); PG8_STAGE(PG8_SA(1, 1), a1 + hstepA, voffA);
            PG8_WAIT_L(8); PG8_BAR; PG8_WAIT_L(0); PG8_MMA(0, 0, At, B0); PG8_BAR; PG8_SCHED;
            PG8_LDB(B1, 0, 1); PG8_STAGE(PG8_SB(0, 0), b2, voffB);
            PG8_BAR; PG8_WAIT_L(0); PG8_MMA(0, 1, At, B1); PG8_BAR;
            PG8_LDA(At, 0, 1); PG8_STAGE(PG8_SA(0, 0), a2, voffA);
            PG8_BAR; PG8_WAIT_L(0); PG8_MMA(1, 0, At, B0); PG8_BAR; PG8_SCHED;
            PG8_STAGE(PG8_SB(0, 1), b2 + hstep, voffB);
            PG8_WAIT_V(6); PG8_BAR; PG8_MMA(1, 1, At, B1); PG8_BAR;
            PG8_LDB(B0, 1, 0); PG8_SCHED; PG8_LDA(At, 1, 0); PG8_STAGE(PG8_SA(0, 1), a2 + hstepA, voffA);
            PG8_WAIT_L(8); PG8_BAR; PG8_WAIT_L(0); PG8_MMA(0, 0, At, B0); PG8_BAR; PG8_SCHED;
            PG8_LDB(B1, 1, 1); PG8_STAGE(PG8_SB(1, 0), b3, voffB);
            PG8_BAR; PG8_WAIT_L(0); PG8_MMA(0, 1, At, B1); PG8_BAR;
            PG8_LDA(At, 1, 1); PG8_STAGE(PG8_SA(1, 0), a3, voffA);
            PG8_BAR; PG8_WAIT_L(0); PG8_MMA(1, 0, At, B0); PG8_BAR; PG8_SCHED;
            PG8_STAGE(PG8_SB(1, 1), b3 + hstep, voffB);
            PG8_WAIT_V(6); PG8_BAR; PG8_MMA(1, 1, At, B1); PG8_BAR;
            }
        }
        if constexpr (ALIGN_EPI) { if (wr == 0) PG8_BAR; }
        if constexpr (!Epi::AFTER_DRAIN) { E(acc, cur, wr, wc, fr, fq); S.done(cur); }
        if (!has_next) break;
#pragma unroll
        for (int a = 0; a < 2; ++a)
#pragma unroll
            for (int b = 0; b < 2; ++b)
#pragma unroll
                for (int m = 0; m < 4; ++m)
#pragma unroll
                    for (int n = 0; n < 2; ++n) acc[a][b][m][n] = (f32x4){0.f, 0.f, 0.f, 0.f};
        cur = nxt; cA = nA; cB = nB; ++ui;
        if constexpr (ALIGN_EPI) { if (wr == 1) PG8_BAR; }
    }
    PG8_WAIT_V(0);
    if constexpr (!ALIGN_EPI) { if (wr == 0) PG8_BAR; }
    PG8_BAR;
    if constexpr (Epi::AFTER_DRAIN) { E.fused(acc, cur, wr, wc, fr, fq, lds, wid, lane); S.done(cur); }
#undef PG8_SA
#undef PG8_SB
#undef PG8_STAGE
#undef PG8_LDA
#undef PG8_LDB
#undef PG8_MMA
#undef PG8_WAIT_V
#undef PG8_WAIT_L
#undef PG8_BAR
#undef PG8_SCHED
}
}

struct Args {
    const float* in[37];
    float* out; unsigned char* ws;
};
constexpr int NWAVES = 8, NTHR = 512;
constexpr int GEMM_LDS = 131072;

#define LDS_WAIT() asm volatile("s_waitcnt lgkmcnt(0)" ::: "memory")

__device__ __forceinline__ void transpose_item(const float* W, int ldw, int nblk, bf16* WT, int ldt, int item, LAS float* scr, int lane, float sc = 1.0f) {
    const int kb = item / nblk, nb = item % nblk, k0 = 64 * kb, n0 = 32 * nb;
#pragma unroll 8
    for (int i = 0; i < 32; ++i) { const int kk = 2 * i + (lane >> 5); scr[kk * 33 + (lane & 31)] = W[(size_t)(k0 + kk) * ldw + n0 + (lane & 31)]; }
    LDS_WAIT(); asm volatile("" ::: "memory");
    const int c = lane & 7;
#pragma unroll
    for (int j = 0; j < 4; ++j) { const int n = (lane >> 3) + 8 * j; const LAS float* s = scr + (8 * c) * 33 + n;
        v4u o; o.x = pk2(s[0 * 33] * sc, s[1 * 33] * sc); o.y = pk2(s[2 * 33] * sc, s[3 * 33] * sc); o.z = pk2(s[4 * 33] * sc, s[5 * 33] * sc); o.w = pk2(s[6 * 33] * sc, s[7 * 33] * sc);
        *(v4u*)(WT + (size_t)(n0 + n) * ldt + k0 + 8 * c) = o; }
    LDS_WAIT(); asm volatile("" ::: "memory");
}

constexpr int P0_LDS = 8 * 64 * 33 * 4 + 8 * 1024 * 4;
__device__ __forceinline__ void p0_prologue(const Args& a, LAS unsigned char* lds, int gw, int NGW, int lane, int wave) {
    unsigned char* ws = a.ws;
    LAS float* scr = (LAS float*)(lds) + wave * (64 * 33);
    LAS float* wg = (LAS float*)(lds + 8 * 64 * 33 * 4);
    const float* w_in = a.in[9];
    for (int i = threadIdx.x; i < 8 * 1024; i += NTHR) { const int k = i >> 3, c = i & 7; wg[c * 1024 + k] = w_in[(size_t)k * INCOLS + GCOL0 + c]; }
    { float* z = (float*)(ws + WS_CTL); for (int i = gw * 64 + lane; i < 65536; i += NGW * 64) z[i] = 0.f; }
    constexpr int I_IN1 = 16 * (3328 / 32), I_IN2 = 16 * (2048 / 32), I_UP = 8 * 32, I_OUT = 16 * 32, I_F1 = 16 * 128, I_F2 = 64 * 32;
    constexpr int I_QK = 8 * 8;
    constexpr int I_LW = 16, I_LG = 32;
    constexpr int NITEMS = I_IN1 + I_IN2 + 2 * I_UP + I_OUT + I_F1 + I_F2 + I_QK + 2 * I_LW + I_LG;
    for (int it = gw; it < NITEMS; it += NGW) {
        int r = it;
        if (r < I_IN1) { transpose_item(w_in, INCOLS, 3328 / 32, (bf16*)(ws + WS_WINT), 1024, r, scr, lane); continue; } r -= I_IN1;
        if (r < I_IN2) { transpose_item(w_in + 3336, INCOLS, 2048 / 32, (bf16*)(ws + WS_WINT) + (size_t)3328 * 1024, 1024, r, scr, lane); continue; } r -= I_IN2;
        if (r < I_UP) { transpose_item(a.in[21], 1024, 32, (bf16*)(ws + WS_UPRT), 512, r, scr, lane); continue; } r -= I_UP;
        if (r < I_UP) { transpose_item(a.in[30], 1024, 32, (bf16*)(ws + WS_UPMT), 512, r, scr, lane); continue; } r -= I_UP;
        if (r < I_OUT) { transpose_item(a.in[32], 1024, 32, (bf16*)(ws + WS_WOUTT), 1024, r, scr, lane); continue; } r -= I_OUT;
        if (r < I_F1) { transpose_item(a.in[34], 4096, 128, (bf16*)(ws + WS_W1T), 1024, r, scr, lane); continue; } r -= I_F1;
        if (r < I_F2) { transpose_item(a.in[35], 1024, 32, (bf16*)(ws + WS_W2T), 4096, r, scr, lane); continue; } r -= I_F2;
        if (r >= I_QK) { r -= I_QK;
            if (r < I_LW) { transpose_item(a.in[12], 512, 16, (bf16*)(ws + WS_LW2T), 64, r, scr, lane); continue; } r -= I_LW;
            if (r < I_LW) { transpose_item(a.in[14], 512, 16, (bf16*)(ws + WS_LA2T), 64, r, scr, lane); continue; } r -= I_LW;
            transpose_item(a.in[15], 512, 16, (bf16*)(ws + WS_LG2T), 128, r, scr, lane); continue; }
        { const int mat = r >> 3, hq = mat & 3, isk = mat >> 2;
          transpose_item((isk ? a.in[25] : a.in[24]) + (size_t)hq * 16384, 128, 4, (bf16*)(ws + (isk ? WS_WKT : WS_WQT)) + (size_t)hq * 16384, 128, r & 7, scr, lane, isk ? 1.0f : 0.08838834764831845f); }
    }
    __syncthreads();
    const float* gmix = a.in[8];
    f32x4 gv[4];
#pragma unroll
    for (int j = 0; j < 4; ++j) gv[j] = ((const f32x4*)gmix)[lane + 64 * j];
    bf16* XN = (bf16*)(ws + WS_XN); float* GATES = (float*)(ws + WS_GATES);
    for (int row = gw; row < MT; row += NGW) {
        unsigned long long* o8 = (unsigned long long*)(XN + (size_t)row * 1024) + lane;
        if (row >= MTOK) {
            const f32x4* xr = (const f32x4*)(a.in[2] + (size_t)(row - MTOK) * 1024) + lane;
#pragma unroll
            for (int j = 0; j < 4; ++j) { const f32x4 v = xr[64 * j]; o8[64 * j] = (unsigned long long)pk2(v.x, v.y) | ((unsigned long long)pk2(v.z, v.w) << 32); }
            continue;
        }
        const f32x4* xr = (const f32x4*)(row < MP ? a.in[0] + (size_t)row * 1024 : a.in[1] + (size_t)(row - MP) * 1024) + lane;
        f32x4 v[4]; float s = 0.f;
#pragma unroll
        for (int j = 0; j < 4; ++j) { v[j] = xr[64 * j]; s += (v[j].x * v[j].x + v[j].y * v[j].y) + (v[j].z * v[j].z + v[j].w * v[j].w); }
        const float rstd = rsqrtf(wave_sum(s) * (1.f / 1024.f) + RMS_EPS);
#pragma unroll
        for (int j = 0; j < 4; ++j) { v[j] = v[j] * rstd * gv[j]; o8[64 * j] = (unsigned long long)pk2(v[j].x, v[j].y) | ((unsigned long long)pk2(v[j].z, v[j].w) << 32); }
        float gsum[8];
#pragma unroll
        for (int c = 0; c < 8; ++c) { float p = 0.f;
#pragma unroll
            for (int j = 0; j < 4; ++j) { const f32x4 w = *(const LAS f32x4*)(wg + c * 1024 + 4 * (lane + 64 * j)); p += (v[j].x * w.x + v[j].y * w.y) + (v[j].z * w.z + v[j].w * w.w); }
            gsum[c] = wave_sum(p); }
        if (lane < 8) { float g = gsum[0];
#pragma unroll
            for (int c = 1; c < 8; ++c) g = (lane == c) ? gsum[c] : g;
            GATES[(size_t)row * 8 + lane] = g; }
        float* so = nullptr;
        if (row >= MP) so = a.out + O_SSHIFT + (size_t)(row - MP) * 1024;
        else if ((row & (SEQ - 1)) == SEQ - 1) so = a.out + O_PSHIFT + (size_t)(row >> 11) * 1024;
        if (so) {
#pragma unroll
            for (int j = 0; j < 4; ++j) ((f32x4*)so)[lane + 64 * j] = v[j]; }
    }
}

constexpr int RCH = 16;
constexpr int RWKV_LDS = (RCH * 256 + 8 * RCH * 64 + RCH) * 4;
__device__ __forceinline__ void rwkv_seq_item(const Args& a, LAS unsigned char* ldsb0, int item0) {
    const int tid = threadIdx.x & 255, lane = tid & 63, wv = tid >> 6; const int item = item0 + (threadIdx.x >> 8);
    LAS unsigned char* ldsb = ldsb0 + (threadIdx.x >> 8) * RWKV_LDS;
    const bf16* PR = (const bf16*)(a.ws + WS_PR); bf16* YR = (bf16*)(a.ws + WS_PR);
    const float *mu = a.in[10], *w0 = a.in[11], *w2 = a.in[12], *a0 = a.in[13], *a2 = a.in[14], *g2 = a.in[15], *rkk = a.in[16], *rka = a.in[17], *rrk = a.in[18], *gnw = a.in[19], *gnb = a.in[20];
    int T, row0, h, prevrow0; const float* S0 = nullptr; float* Sout;
    if (item < 64) { const int b = item >> 3; h = item & 7; T = SEQ; row0 = b * SEQ; prevrow0 = -1; Sout = a.out + O_PWKV + (size_t)item * 4096; }
    else { const int sb = (item - 64) >> 3; h = (item - 64) & 7; T = 1; row0 = MP + sb; prevrow0 = MTOK + sb; S0 = a.in[3] + (size_t)(item - 64) * 4096; Sout = a.out + O_SWKV + (size_t)(item - 64) * 4096; }
    const int hc = h * 64;
    LAS float* MIXW = (LAS float*)ldsb;
    LAS float* MIXA = MIXW + RCH * 64;
    LAS float* MIXG = MIXA + RCH * 64;
    LAS float* Rb = MIXG + RCH * 128;
    LAS float* Kb = Rb + RCH * 64;
    LAS float* Vb = Kb + RCH * 64;
    LAS float* Wb = Vb + RCH * 64;
    LAS float* KKb = Wb + RCH * 64;
    LAS float* Bb = KKb + RCH * 64;
    LAS float* Gb = Bb + RCH * 64;
    LAS float* Yb = Gb + RCH * 64;
    LAS float* BON = Yb + RCH * 64;
    const int sv = tid >> 2, kq = tid & 3;
    float S[16];
    if (S0) {
#pragma unroll
        for (int i = 0; i < 4; ++i) { const f32x4 t = *(const f32x4*)(S0 + sv * 64 + 16 * kq + 4 * i); S[4 * i] = t.x; S[4 * i + 1] = t.y; S[4 * i + 2] = t.z; S[4 * i + 3] = t.w; }
    } else {
#pragma unroll
        for (int i = 0; i < 16; ++i) S[i] = 0.f;
    }
    const int j = lane;
    const float w0j = w0[hc + j], a0j = a0[hc + j], rkkj = rkk[hc + j], rkaj = rka[hc + j], rrkj = rrk[hc + j], gnwj = gnw[hc + j], gnbj = gnb[hc + j];
    for (int t0 = 0; t0 < T; t0 += RCH) {
        const int nt = (T - t0) < RCH ? (T - t0) : RCH;
        for (int it = tid; it < nt * 56; it += 256) {
            const int t = it / 56, g = it % 56;
            int col; LAS float* dst; int kind;
            if (g < 8) { col = hc + 8 * g; dst = Rb + t * 64 + 8 * g; kind = 0; }
            else if (g < 16) { col = 512 + hc + 8 * (g - 8); dst = Kb + t * 64 + 8 * (g - 8); kind = 0; }
            else if (g < 24) { col = 1024 + hc + 8 * (g - 16); dst = Vb + t * 64 + 8 * (g - 16); kind = 0; }
            else if (g < 32) { col = 1536 + 8 * (g - 24); dst = MIXW + t * 64 + 8 * (g - 24); kind = 1; }
            else if (g < 40) { col = 1600 + 8 * (g - 32); dst = MIXA + t * 64 + 8 * (g - 32); kind = 0; }
            else { col = 1664 + 8 * (g - 40); dst = MIXG + t * 128 + 8 * (g - 40); kind = 2; }
            const int tg = t0 + t;
            const v4u cur = *(const v4u*)(PR + (size_t)(row0 + tg) * NPR + col);
            v4u prv = (v4u){0u, 0u, 0u, 0u};
            if (tg > 0) prv = *(const v4u*)(PR + (size_t)(row0 + tg - 1) * NPR + col);
            else if (prevrow0 >= 0) prv = *(const v4u*)(PR + (size_t)prevrow0 * NPR + col);
            const f32x4 m0 = *(const f32x4*)(mu + col), m1 = *(const f32x4*)(mu + col + 4);
            float c[8], p[8], mm[8] = {m0.x, m0.y, m0.z, m0.w, m1.x, m1.y, m1.z, m1.w};
            c[0] = bflo(cur.x); c[1] = bfhi(cur.x); c[2] = bflo(cur.y); c[3] = bfhi(cur.y); c[4] = bflo(cur.z); c[5] = bfhi(cur.z); c[6] = bflo(cur.w); c[7] = bfhi(cur.w);
            p[0] = bflo(prv.x); p[1] = bfhi(prv.x); p[2] = bflo(prv.y); p[3] = bfhi(prv.y); p[4] = bflo(prv.z); p[5] = bfhi(prv.z); p[6] = bflo(prv.w); p[7] = bfhi(prv.w);
#pragma unroll
            for (int i = 0; i < 8; ++i) { float m = c[i] + (p[i] - c[i]) * mm[i]; if (kind == 1) m = tanhf(m); else if (kind == 2) m = sigmoidf_(m); dst[i] = m; }
        }
        __syncthreads();
        float accw[RCH / 4], acca[RCH / 4], accg[RCH / 4];
#pragma unroll
        for (int i = 0; i < RCH / 4; ++i) { accw[i] = 0.f; acca[i] = 0.f; accg[i] = 0.f; }
        for (int i4 = 0; i4 < 16; ++i4) {
            float wv4[4], av4[4];
#pragma unroll
            for (int q = 0; q < 4; ++q) { wv4[q] = w2[(size_t)(4 * i4 + q) * 512 + hc + j]; av4[q] = a2[(size_t)(4 * i4 + q) * 512 + hc + j]; }
#pragma unroll
            for (int tt = 0; tt < RCH / 4; ++tt) { const int t = wv + 4 * tt; if (t < nt) {
                const f32x4 xw = *(const LAS f32x4*)(MIXW + t * 64 + 4 * i4), xa = *(const LAS f32x4*)(MIXA + t * 64 + 4 * i4);
                accw[tt] += (xw.x * wv4[0] + xw.y * wv4[1]) + (xw.z * wv4[2] + xw.w * wv4[3]);
                acca[tt] += (xa.x * av4[0] + xa.y * av4[1]) + (xa.z * av4[2] + xa.w * av4[3]); } }
        }
        for (int i4 = 0; i4 < 32; ++i4) {
            float gv4[4];
#pragma unroll
            for (int q = 0; q < 4; ++q) gv4[q] = g2[(size_t)(4 * i4 + q) * 512 + hc + j];
#pragma unroll
            for (int tt = 0; tt < RCH / 4; ++tt) { const int t = wv + 4 * tt; if (t < nt) {
                const f32x4 xg = *(const LAS f32x4*)(MIXG + t * 128 + 4 * i4);
                accg[tt] += (xg.x * gv4[0] + xg.y * gv4[1]) + (xg.z * gv4[2] + xg.w * gv4[3]); } }
        }
#pragma unroll
        for (int tt = 0; tt < RCH / 4; ++tt) { const int t = wv + 4 * tt; if (t < nt) {
            const float wl = w0j + accw[tt]; const float sg = 1.0f / (1.0f + expf(-wl));
            const float dec = expf(-0.6065306597126334f * sg);
            const float aa = 1.0f / (1.0f + expf(-(a0j + acca[tt])));
            const float kraw = Kb[t * 64 + j]; const float kkr = kraw * rkkj;
            const float ss = wave_sum(kkr * kkr); const float kk = kkr / fmaxf(sqrtf(ss), 1e-12f);
            const float k2 = kraw * (1.0f + (aa - 1.0f) * rkaj);
            const float bon = wave_sum(Rb[t * 64 + j] * k2 * rrkj);
            Wb[t * 64 + j] = dec; KKb[t * 64 + j] = kk; Bb[t * 64 + j] = kk * aa; Kb[t * 64 + j] = k2; Gb[t * 64 + j] = accg[tt];
            if (j == 0) BON[t] = bon; } }
        __syncthreads();
        for (int t = 0; t < nt; ++t) {
            float kk[16], p = 0.f;
#pragma unroll
            for (int i = 0; i < 4; ++i) { const f32x4 x = *(const LAS f32x4*)(KKb + t * 64 + 16 * kq + 4 * i); kk[4 * i] = x.x; kk[4 * i + 1] = x.y; kk[4 * i + 2] = x.z; kk[4 * i + 3] = x.w; }
#pragma unroll
            for (int i = 0; i < 16; ++i) p += S[i] * kk[i];
            p += __shfl_xor(p, 1); p += __shfl_xor(p, 2);
            const float vv = Vb[t * 64 + sv]; float y = 0.f;
#pragma unroll
            for (int i = 0; i < 4; ++i) {
                const f32x4 w = *(const LAS f32x4*)(Wb + t * 64 + 16 * kq + 4 * i), bb = *(const LAS f32x4*)(Bb + t * 64 + 16 * kq + 4 * i), k2 = *(const LAS f32x4*)(Kb + t * 64 + 16 * kq + 4 * i), r = *(const LAS f32x4*)(Rb + t * 64 + 16 * kq + 4 * i);
                S[4 * i + 0] = S[4 * i + 0] * w.x - p * bb.x + vv * k2.x; y += S[4 * i + 0] * r.x;
                S[4 * i + 1] = S[4 * i + 1] * w.y - p * bb.y + vv * k2.y; y += S[4 * i + 1] * r.y;
                S[4 * i + 2] = S[4 * i + 2] * w.z - p * bb.z + vv * k2.z; y += S[4 * i + 2] * r.z;
                S[4 * i + 3] = S[4 * i + 3] * w.w - p * bb.w + vv * k2.w; y += S[4 * i + 3] * r.w;
            }
            y += __shfl_xor(y, 1); y += __shfl_xor(y, 2);
            if (kq == 0) Yb[t * 64 + sv] = y;
        }
        __syncthreads();
#pragma unroll
        for (int tt = 0; tt < RCH / 4; ++tt) { const int t = wv + 4 * tt; if (t < nt) {
            const float y = Yb[t * 64 + j]; const float mean = wave_sum(y) * (1.0f / 64.0f); const float d = y - mean; const float var = wave_sum(d * d) * (1.0f / 64.0f);
            float o = d * rsqrtf(var + R_GN_EPS) * gnwj + gnbj; o += BON[t] * Vb[t * 64 + j]; o *= Gb[t * 64 + j];
            YR[(size_t)(row0 + t0 + t) * NPR + hc + j] = (bf16)f2bf(o); } }
        __syncthreads();
    }
#pragma unroll
    for (int i = 0; i < 4; ++i) *(f32x4*)(Sout + sv * 64 + 16 * kq + 4 * i) = (f32x4){S[4 * i], S[4 * i + 1], S[4 * i + 2], S[4 * i + 3]};
}

constexpr int MCH = 16;
constexpr int MLSTM_LDS = ((MCH + 3) * 128 + 5 * MCH * 128 + MCH * 4 * 128 + 8 * MCH) * 4;
__device__ __forceinline__ void mlstm_seq_item(const Args& a, LAS unsigned char* ldsb, int item) {
    const int tid = threadIdx.x, lane = tid & 63, wv = tid >> 6;
    const bf16* PM = (const bf16*)(a.ws + WS_PM); bf16* YM = (bf16*)(a.ws + WS_YM); const float* GATES = (const float*)(a.ws + WS_GATES);
    const float *convw = a.in[22], *convb = a.in[23], *wq = a.in[24], *wk = a.in[25], *ib = a.in[26], *fb = a.in[27], *gnw = a.in[28], *skip = a.in[29];
    int T, row0, h, sb = -1; float *Cout, *nout, *mout, *convout;
    if (item < 32) { const int b = item >> 2; h = item & 3; T = SEQ; row0 = b * SEQ; Cout = a.out + O_PC + (size_t)item * 16384; nout = a.out + O_PN + (size_t)item * 128; mout = a.out + O_PMM + item; convout = a.out + O_PCONV + (size_t)b * 3 * 512 + h * 128; }
    else { const int it2 = item - 32; sb = it2 >> 2; h = it2 & 3; T = 1; row0 = MP + sb; Cout = a.out + O_SC + (size_t)it2 * 16384; nout = a.out + O_SN + (size_t)it2 * 128; mout = a.out + O_SMM + it2; convout = a.out + O_SCONV + (size_t)sb * 3 * 512 + h * 128; }
    const int hc = h * 128;
    LAS float* XMW = (LAS float*)ldsb;
    LAS float* XC = XMW + (MCH + 3) * 128;
    LAS float* Qb = XC + MCH * 128;
    LAS float* Kb = Qb + MCH * 128;
    LAS float* Vb = Kb + MCH * 128;
    LAS float* Ob = Vb + MCH * 128;
    LAS float* HP = Ob + MCH * 128;
    LAS float* FS = HP + MCH * 512;
    LAS float* IS = FS + MCH;
    LAS float* EM = IS + MCH;
    LAS float* DEN = EM + MCH;
    LAS float* MST = DEN + 2 * MCH;
    const int e = tid & 127, dq = tid >> 7;
    float C[32]; float nreg = 0.f;
    if (sb >= 0) {
        const float* C0 = a.in[4] + (size_t)(item - 32) * 16384;
#pragma unroll
        for (int i = 0; i < 32; ++i) C[i] = C0[(size_t)(32 * dq + i) * 128 + e];
        if (tid < 128) nreg = a.in[5][(size_t)(item - 32) * 128 + tid];
        if (tid == 0) MST[0] = a.in[6][item - 32];
        if (tid < 384) XMW[tid] = a.in[7][(size_t)sb * 3 * 512 + (tid >> 7) * 512 + hc + (tid & 127)];
    } else {
#pragma unroll
        for (int i = 0; i < 32; ++i) C[i] = 0.f;
        if (tid == 0) MST[0] = 0.f;
        if (tid < 384) XMW[tid] = 0.f;
    }
    const float cw0 = convw[0 * 512 + hc + e], cw1 = convw[1 * 512 + hc + e], cw2 = convw[2 * 512 + hc + e], cw3 = convw[3 * 512 + hc + e], cbe = convb[hc + e];
    const float ibh = ib[h], fbh = fb[h];
    __syncthreads();
    for (int t0 = 0; t0 < T; t0 += MCH) {
        const int nt = (T - t0) < MCH ? (T - t0) : MCH;
        for (int t = dq; t < nt; t += 4) { const size_t r = (size_t)(row0 + t0 + t) * NPM;
            XMW[(t + 3) * 128 + e] = bf2f(PM[r + hc + e]); Vb[t * 128 + e] = bf2f(PM[r + 512 + hc + e]); Ob[t * 128 + e] = sigmoidf_(bf2f(PM[r + 1024 + hc + e])); }
        __syncthreads();
        for (int t = dq; t < nt; t += 4) { const float x = cbe + XMW[t * 128 + e] * cw0 + XMW[(t + 1) * 128 + e] * cw1 + XMW[(t + 2) * 128 + e] * cw2 + XMW[(t + 3) * 128 + e] * cw3;
            XC[t * 128 + e] = x / (1.0f + expf(-x)); }
        if (tid == 0) { float m = MST[0];
            for (int t = 0; t < nt; ++t) { const float* g = GATES + (size_t)(row0 + t0 + t) * 8;
                const float li = g[h] + ibh, fr = g[4 + h] + fbh; const float lf = fminf(fr, 0.f) - log1pf(expf(-fabsf(fr)));
                const float mn = fmaxf(lf + m, li); FS[t] = expf(lf + m - mn); IS[t] = expf(li - mn); EM[t] = expf(-mn); m = mn; }
            MST[0] = m; }
        __syncthreads();
        { float aq[MCH / 4], ak[MCH / 4];
#pragma unroll
          for (int i = 0; i < MCH / 4; ++i) { aq[i] = 0.f; ak[i] = 0.f; }
          for (int d4 = 0; d4 < 32; ++d4) {
              float q4[4], k4[4];
#pragma unroll
              for (int q = 0; q < 4; ++q) { q4[q] = wq[(size_t)(hc + 4 * d4 + q) * 128 + e]; k4[q] = wk[(size_t)(hc + 4 * d4 + q) * 128 + e]; }
#pragma unroll
              for (int tt = 0; tt < MCH / 4; ++tt) { const int t = dq + 4 * tt; if (t < nt) { const f32x4 x = *(const LAS f32x4*)(XC + t * 128 + 4 * d4);
                  aq[tt] += (x.x * q4[0] + x.y * q4[1]) + (x.z * q4[2] + x.w * q4[3]); ak[tt] += (x.x * k4[0] + x.y * k4[1]) + (x.z * k4[2] + x.w * k4[3]); } }
          }
#pragma unroll
          for (int tt = 0; tt < MCH / 4; ++tt) { const int t = dq + 4 * tt; if (t < nt) { Qb[t * 128 + e] = aq[tt] * 0.08838834764831845f; Kb[t * 128 + e] = ak[tt]; } }
        }
        __syncthreads();
        for (int t = 0; t < nt; ++t) {
            const float fs = FS[t], is = IS[t]; const float ve = Vb[t * 128 + e] * is; float hp = 0.f;
#pragma unroll
            for (int i = 0; i < 8; ++i) { const f32x4 k = *(const LAS f32x4*)(Kb + t * 128 + 32 * dq + 4 * i), q = *(const LAS f32x4*)(Qb + t * 128 + 32 * dq + 4 * i);
                C[4 * i + 0] = fs * C[4 * i + 0] + k.x * ve; hp += q.x * C[4 * i + 0];
                C[4 * i + 1] = fs * C[4 * i + 1] + k.y * ve; hp += q.y * C[4 * i + 1];
                C[4 * i + 2] = fs * C[4 * i + 2] + k.z * ve; hp += q.z * C[4 * i + 2];
                C[4 * i + 3] = fs * C[4 * i + 3] + k.w * ve; hp += q.w * C[4 * i + 3]; }
            HP[t * 512 + dq * 128 + e] = hp;
            if (tid < 128) { nreg = fs * nreg + is * Kb[t * 128 + tid]; const float dn = wave_sum(Qb[t * 128 + tid] * nreg); if (lane == 0) DEN[t * 2 + wv] = dn; }
        }
        __syncthreads();
        for (int t = wv; t < nt; t += 8) {
            const float den = DEN[t * 2] + DEN[t * 2 + 1]; const float dd = fmaxf(fabsf(den), EM[t]);
            float hv[2];
#pragma unroll
            for (int q = 0; q < 2; ++q) { const int ee = lane + 64 * q; hv[q] = (HP[t * 512 + ee] + HP[t * 512 + 128 + ee] + HP[t * 512 + 256 + ee] + HP[t * 512 + 384 + ee]) / dd; }
            const float mean = wave_sum(hv[0] + hv[1]) * (1.0f / 128.0f); const float d0 = hv[0] - mean, d1 = hv[1] - mean;
            const float var = wave_sum(d0 * d0 + d1 * d1) * (1.0f / 128.0f); const float rs = rsqrtf(var + M_GN_EPS);
#pragma unroll
            for (int q = 0; q < 2; ++q) { const int ee = lane + 64 * q; float o = (q ? d1 : d0) * rs * gnw[hc + ee] + skip[hc + ee] * XC[t * 128 + ee]; o *= Ob[t * 128 + ee];
                YM[(size_t)(row0 + t0 + t) * 512 + hc + ee] = (bf16)f2bf(o); }
        }
        __syncthreads();
        float keep = 0.f; if (tid < 384) keep = XMW[(nt + (tid >> 7)) * 128 + (tid & 127)];
        __syncthreads();
        if (tid < 384) XMW[tid] = keep;
        __syncthreads();
    }
#pragma unroll
    for (int i = 0; i < 32; ++i) Cout[(size_t)(32 * dq + i) * 128 + e] = C[i];
    if (tid < 128) nout[tid] = nreg;
    if (tid == 0) mout[0] = MST[0];
    if (tid < 384) convout[(tid >> 7) * 512 + (tid & 127)] = XMW[tid];
}

__device__ __forceinline__ void final_norm_rows(const Args& a, int gw, int NGW, int lane) {
    const float* gf = a.in[36];
    f32x4 gv[4];
#pragma unroll
    for (int j = 0; j < 4; ++j) gv[j] = ((const f32x4*)gf)[lane + 64 * j];
    for (int row = gw; row < MTOK; row += NGW) { f32x4* p = (f32x4*)(a.out + (size_t)row * 1024) + lane; f32x4 v[4]; float s = 0.f;
#pragma unroll
        for (int j = 0; j < 4; ++j) { v[j] = p[64 * j]; s += (v[j].x * v[j].x + v[j].y * v[j].y) + (v[j].z * v[j].z + v[j].w * v[j].w); }
        const float rs = rsqrtf(wave_sum(s) * (1.0f / 1024.0f) + RMS_EPS);
#pragma unroll
        for (int j = 0; j < 4; ++j) p[64 * j] = v[j] * rs * gv[j]; }
}


typedef short bf16x8 __attribute__((ext_vector_type(8)));
typedef float f32x16 __attribute__((ext_vector_type(16)));
constexpr size_t WS_KT = 49 * MiB + 512 * 1024;
constexpr size_t DO_CTP = 0;
constexpr size_t DO_VT = 40 * MiB;
constexpr size_t DO_UU = 60 * MiB, DO_BCUM = DO_UU + 256 * 1024, DO_PPFX = DO_BCUM + 256 * 1024;
constexpr size_t DO_BL = DO_PPFX + 256 * 1024, DO_PMX = DO_BL + 4096, DO_MPREV = DO_PMX + 4096;
static_assert(DO_MPREV + 4096 <= (size_t)MTOK * DM * 4, "d_out scratch");

typedef float f32x2_t __attribute__((ext_vector_type(2))); typedef __bf16 bf16x2_t __attribute__((ext_vector_type(2)));
__device__ __forceinline__ unsigned cvtpk(float lo, float hi) { f32x2_t v = {lo, hi}; bf16x2_t b = __builtin_convertvector(v, bf16x2_t); return __builtin_bit_cast(unsigned, b); }
__device__ __forceinline__ bf16x8 pack8(float a0, float a1, float a2, float a3, float a4, float a5, float a6, float a7) {
    v4u w; w.x = cvtpk(a0, a1); w.y = cvtpk(a2, a3); w.z = cvtpk(a4, a5); w.w = cvtpk(a6, a7); return __builtin_bit_cast(bf16x8, w); }
__device__ __forceinline__ bf16x8 acc_frag(const f32x16& x, int s2) { return s2 == 0 ? pack8(x[0], x[1], x[2], x[3], x[4], x[5], x[6], x[7]) : pack8(x[8], x[9], x[10], x[11], x[12], x[13], x[14], x[15]); }
__device__ __forceinline__ bf16x8 ld16(const bf16* p) { return __builtin_bit_cast(bf16x8, *(const v4u*)p); }
__device__ __forceinline__ bf16x8 ld8x2(const bf16* p0, const bf16* p1) { const v2u a = *(const v2u*)p0, b = *(const v2u*)p1; v4u w; w.x = a.x; w.y = a.y; w.z = b.x; w.w = b.y; return __builtin_bit_cast(bf16x8, w); }
#define MFMA32(a, b, c) __builtin_amdgcn_mfma_f32_32x32x16_bf16((a), (b), (c), 0, 0, 0)

__device__ __forceinline__ void stage_conv_head(const Args& a, LAS float* CW, int h, int tid, int nthr) {
    for (int i = tid; i < 640; i += nthr) CW[i] = i < 512 ? a.in[22][(size_t)(i >> 7) * 512 + h * 128 + (i & 127)] : a.in[23][h * 128 + (i - 512)];
}
__device__ __forceinline__ void xc8(const bf16* xmcol, int t, int d0, const LAS float* CW, float (&x)[8]) {
    const f32x4 b0 = *(const LAS f32x4*)(CW + 512 + d0), b1 = *(const LAS f32x4*)(CW + 512 + d0 + 4);
    x[0] = b0.x; x[1] = b0.y; x[2] = b0.z; x[3] = b0.w; x[4] = b1.x; x[5] = b1.y; x[6] = b1.z; x[7] = b1.w;
#pragma unroll
    for (int tap = 0; tap < 4; ++tap) { const int tt = t - 3 + tap;
        if (tt >= 0) { const v4u v = *(const v4u*)(xmcol + (size_t)tt * NPM + d0);
            const f32x4 w0 = *(const LAS f32x4*)(CW + tap * 128 + d0), w1 = *(const LAS f32x4*)(CW + tap * 128 + d0 + 4);
            x[0] += bflo(v.x) * w0.x; x[1] += bfhi(v.x) * w0.y; x[2] += bflo(v.y) * w0.z; x[3] += bfhi(v.y) * w0.w;
            x[4] += bflo(v.z) * w1.x; x[5] += bfhi(v.z) * w1.y; x[6] += bflo(v.w) * w1.z; x[7] += bfhi(v.w) * w1.w; } }
#pragma unroll
    for (int i = 0; i < 8; ++i) x[i] = x[i] / (1.0f + __expf(-x[i]));
}
__device__ __forceinline__ bf16x8 xc_frag(const bf16* xmcol, int t, int d0, const LAS float* CW) { float x[8]; xc8(xmcol, t, d0, CW, x); return pack8(x[0], x[1], x[2], x[3], x[4], x[5], x[6], x[7]); }

__device__ __forceinline__ void mlstm_prep_task(const Args& a, int item, int blk, const LAS float* CW, int lane_) {
    int lane = lane_; asm volatile("" : "+v"(lane));
    const int r = lane & 31, hh = lane >> 5, bh = item >> 5, c = item & 31, b = bh >> 2, h = bh & 3, hc = h * 128, row0 = b * SEQ, t0 = c * 64, db = blk & 3, sb = blk >> 2;
    const bf16* PM = (const bf16*)(a.ws + WS_PM); const bf16* xmcol = PM + (size_t)row0 * NPM + hc;
    const bf16* WKT = (const bf16*)(a.ws + WS_WKT) + (size_t)h * 16384;
    bf16* KT = (bf16*)(a.ws + WS_KT) + (size_t)item * 8192; bf16* VT = (bf16*)((unsigned char*)a.out + DO_VT) + (size_t)item * 10240;
    f32x16 acc;
#pragma unroll
    for (int i = 0; i < 16; ++i) acc[i] = 0.f;
#pragma unroll
    for (int ks = 0; ks < 8; ++ks) { const bf16x8 A = ld16(WKT + (size_t)(32 * db + r) * 128 + 16 * ks + 8 * hh); const bf16x8 B = xc_frag(xmcol, t0 + 32 * sb + r, 16 * ks + 8 * hh, CW); acc = MFMA32(A, B, acc); }
#pragma unroll
    for (int reg = 0; reg < 16; ++reg) { const int d = 32 * db + (reg & 3) + 8 * (reg >> 2) + 4 * hh; KT[(size_t)d * 64 + 32 * sb + r] = (bf16)f2bf(acc[reg]); }
    { const bf16* vp = PM + (size_t)(row0 + t0 + 32 * sb + r) * NPM + 512 + hc + 32 * db + 16 * hh; const v4u v0 = *(const v4u*)vp, v1 = *(const v4u*)(vp + 8);
      const unsigned w[8] = {v0.x, v0.y, v0.z, v0.w, v1.x, v1.y, v1.z, v1.w}; bf16* o = VT + (size_t)(32 * db + 16 * hh) * 64 + 32 * sb + r;
#pragma unroll
      for (int i = 0; i < 8; ++i) { o[(size_t)(2 * i) * 64] = (bf16)(w[i] & 0xffffu); o[(size_t)(2 * i + 1) * 64] = (bf16)(w[i] >> 16); } }
#pragma unroll
    for (int i = 0; i < 4; ++i) VT[(size_t)(128 + 4 * blk + i) * 64 + lane] = (blk == 0 && i == 0) ? (bf16)0x3f80u : (bf16)0u;
    if (blk == 1 && c == 31) {
        float* co = a.out + O_PCONV + (size_t)b * 3 * 512 + hc;
        for (int i = lane; i < 384; i += 64) co[(i >> 7) * 512 + (i & 127)] = bf2f(xmcol[(size_t)(SEQ - 3 + (i >> 7)) * NPM + (i & 127)]);
    }
    if (blk == 0) {
        const float* g = (const float*)(a.ws + WS_GATES) + (size_t)(row0 + t0 + lane) * 8;
        const float li = g[h] + a.in[26][h], fr = g[4 + h] + a.in[27][h]; const float lf = fminf(fr, 0.f) - log1pf(expf(-fabsf(fr)));
        float bc = lf;
#pragma unroll
        for (int o = 1; o < 64; o <<= 1) { const float t = __shfl_up(bc, o); if (lane >= o) bc += t; }
        const float u = li - bc; float p = u;
#pragma unroll
        for (int o = 1; o < 64; o <<= 1) { const float t = __shfl_up(p, o); if (lane >= o) p = fmaxf(p, t); }
        float* dof = (float*)a.out; const size_t ti = (size_t)bh * 2048 + t0 + lane;
        dof[DO_UU / 4 + ti] = u; dof[DO_BCUM / 4 + ti] = bc; dof[DO_PPFX / 4 + ti] = p;
        if (lane == 63) { dof[DO_BL / 4 + item] = bc; dof[DO_PMX / 4 + item] = p; }
    }
}

__device__ __forceinline__ void mlstm_scan_task(const Args& a, int bh, int eb, LAS float* WE, int lane) {
    const int r = lane & 31, hh = lane >> 5;
    const float* dof = (const float*)a.out;
    f32x16 CT[4];
#pragma unroll
    for (int cb = 0; cb < 4; ++cb)
#pragma unroll
        for (int i = 0; i < 16; ++i) CT[cb][i] = 0.f;
    float m = 0.f;
    const bf16* KT0 = (const bf16*)(a.ws + WS_KT) + (size_t)bh * 32 * 8192 + (size_t)r * 64 + 8 * hh;
    const bf16* VT0 = (const bf16*)((const unsigned char*)a.out + DO_VT) + (size_t)bh * 32 * 10240 + (size_t)(32 * eb + r) * 64 + 8 * hh;
    bf16* CTP0 = (bf16*)((unsigned char*)a.out + DO_CTP) + (size_t)bh * 32 * 20480 + (size_t)(32 * eb + 4 * hh) * 128 + r;
    v4u Ar[4], Bf[4][4];
#pragma unroll
    for (int ks = 0; ks < 4; ++ks) { Ar[ks] = *(const v4u*)(VT0 + 16 * ks);
#pragma unroll
        for (int cb = 0; cb < 4; ++cb) Bf[ks][cb] = *(const v4u*)(KT0 + (size_t)(32 * cb) * 64 + 16 * ks); }
    float u = dof[DO_UU / 4 + (size_t)bh * 2048 + lane], pmx = dof[DO_PMX / 4 + bh * 32], bl = dof[DO_BL / 4 + bh * 32];
    for (int c = 0; c < 32; ++c) {
        const int item = bh * 32 + c;
        const float Mx = fmaxf(m, pmx); const float ge = __expf(m - Mx);
        WE[lane] = __expf(u - Mx);
        const float mnext = bl + Mx;
        if (c + 1 < 32) { u = dof[DO_UU / 4 + (size_t)bh * 2048 + 64 * (c + 1) + lane]; pmx = dof[DO_PMX / 4 + item + 1]; bl = dof[DO_BL / 4 + item + 1]; }
        bf16* CTP = CTP0 + (size_t)c * 20480;
#pragma unroll
        for (int cb = 0; cb < 4; ++cb)
#pragma unroll
            for (int reg = 0; reg < 16; ++reg) { CTP[((reg & 3) + 8 * (reg >> 2)) * 128 + 32 * cb] = (bf16)f2bf(CT[cb][reg]); CT[cb][reg] *= ge; }
        if (eb == 0 && lane == 0) ((float*)a.out)[DO_MPREV / 4 + item] = m;
        LDS_WAIT(); asm volatile("" ::: "memory");
        const size_t nx = (c + 1 < 32) ? (size_t)(c + 1) : (size_t)c;
#pragma unroll
        for (int ks = 0; ks < 4; ++ks) {
            const v4u av = Ar[ks];
            const f32x4 w0 = *(const LAS f32x4*)(WE + 16 * ks + 8 * hh), w1 = *(const LAS f32x4*)(WE + 16 * ks + 8 * hh + 4);
            const bf16x8 A = pack8(bflo(av.x) * w0.x, bfhi(av.x) * w0.y, bflo(av.y) * w0.z, bfhi(av.y) * w0.w, bflo(av.z) * w1.x, bfhi(av.z) * w1.y, bflo(av.w) * w1.z, bfhi(av.w) * w1.w);
#pragma unroll
            for (int cb = 0; cb < 4; ++cb) CT[cb] = MFMA32(A, __builtin_bit_cast(bf16x8, Bf[ks][cb]), CT[cb]);
            Ar[ks] = *(const v4u*)(VT0 + nx * 10240 + 16 * ks);
#pragma unroll
            for (int cb = 0; cb < 4; ++cb) Bf[ks][cb] = *(const v4u*)(KT0 + nx * 8192 + (size_t)(32 * cb) * 64 + 16 * ks);
        }
        m = mnext;
        LDS_WAIT(); asm volatile("" ::: "memory");
    }
    if (eb < 4) { float* Co = a.out + O_PC + (size_t)bh * 16384;
#pragma unroll
        for (int cb = 0; cb < 4; ++cb)
#pragma unroll
            for (int reg = 0; reg < 16; ++reg) Co[(size_t)(32 * cb + r) * 128 + 32 * eb + (reg & 3) + 8 * (reg >> 2) + 4 * hh] = CT[cb][reg];
    } else if (hh == 0) {
#pragma unroll
        for (int cb = 0; cb < 4; ++cb) a.out[O_PN + (size_t)bh * 128 + 32 * cb + r] = CT[cb][0];
    }
    if (eb == 0 && lane == 0) a.out[O_PMM + bh] = m;
}

__device__ __forceinline__ void mlstm_st_tile(int sb, int tb, const bf16x8 (&XB)[8], const bf16x8 (&QTb)[4][2], const bf16* WKT, const bf16* xmcol, const LAS float* CW, const float* uu, int t0, int tl, float Mt, int r, int hh, bf16x8& o0, bf16x8& o1) {
    f32x16 st;
#pragma unroll
    for (int i = 0; i < 16; ++i) st[i] = 0.f;
#pragma unroll
    for (int db = 0; db < 4; ++db) { f32x16 k;
#pragma unroll
        for (int i = 0; i < 16; ++i) k[i] = 0.f;
#pragma unroll
        for (int ks = 0; ks < 8; ++ks) { const bf16x8 B = (sb == tb) ? XB[ks] : xc_frag(xmcol, t0 + 32 * sb + r, 16 * ks + 8 * hh, CW);
            k = MFMA32(ld16(WKT + (size_t)(32 * db + r) * 128 + 16 * ks + 8 * hh), B, k); if (ks & 1) __builtin_amdgcn_sched_barrier(0); }
        st = MFMA32(acc_frag(k, 0), QTb[db][0], st); st = MFMA32(acc_frag(k, 1), QTb[db][1], st); __builtin_amdgcn_sched_barrier(0); }
#pragma unroll
    for (int g = 0; g < 4; ++g) { const f32x4 u4 = *(const f32x4*)(uu + 32 * sb + 8 * g + 4 * hh);
#pragma unroll
        for (int i = 0; i < 4; ++i) { const int sidx = 32 * sb + 8 * g + 4 * hh + i; st[4 * g + i] = (sidx <= tl) ? st[4 * g + i] * expf(u4[i] - Mt) : 0.f; } }
    o0 = acc_frag(st, 0); o1 = acc_frag(st, 1);
}

__device__ __forceinline__ void mlstm_out_task(const Args& a, int item, int tb, const LAS float* CWall, int lane_) {
    int lane = lane_; asm volatile("" : "+v"(lane));
    const int r = lane & 31, hh = lane >> 5, bh = item >> 5, c = item & 31, b = bh >> 2, h = bh & 3, hc = h * 128, row0 = b * SEQ, t0 = c * 64;
    const bf16* PM = (const bf16*)(a.ws + WS_PM); const bf16* xmcol = PM + (size_t)row0 * NPM + hc; const LAS float* CW = CWall + h * 640;
    const bf16* WQT = (const bf16*)(a.ws + WS_WQT) + (size_t)h * 16384; const bf16* WKT = (const bf16*)(a.ws + WS_WKT) + (size_t)h * 16384;
    const bf16* VT = (const bf16*)((const unsigned char*)a.out + DO_VT) + (size_t)item * 10240; const bf16* CTP = (const bf16*)((const unsigned char*)a.out + DO_CTP) + (size_t)item * 20480;
    const float* dof = (const float*)a.out;
    const int tl = 32 * tb + r, t = t0 + tl;
    bf16x8 XB[8];
#pragma unroll
    for (int ks = 0; ks < 8; ++ks) { XB[ks] = xc_frag(xmcol, t, 16 * ks + 8 * hh, CW); if (ks & 1) __builtin_amdgcn_sched_barrier(0); }
    bf16x8 QTb[4][2];
#pragma unroll
    for (int eb = 0; eb < 4; ++eb) { f32x16 q;
#pragma unroll
        for (int i = 0; i < 16; ++i) q[i] = 0.f;
#pragma unroll
        for (int ks = 0; ks < 8; ++ks) q = MFMA32(ld16(WQT + (size_t)(32 * eb + r) * 128 + 16 * ks + 8 * hh), XB[ks], q);
        QTb[eb][0] = acc_frag(q, 0); QTb[eb][1] = acc_frag(q, 1); __builtin_amdgcn_sched_barrier(0); }
    const float mprev = dof[DO_MPREV / 4 + item], pp = dof[DO_PPFX / 4 + (size_t)bh * 2048 + t], bc = dof[DO_BCUM / 4 + (size_t)bh * 2048 + t];
    const float Mt = fmaxf(mprev, pp), wst = expf(mprev - Mt), em = expf(-bc - Mt);
    bf16x8 STb[2][2];
    mlstm_st_tile(0, tb, XB, QTb, WKT, xmcol, CW, dof + DO_UU / 4 + (size_t)bh * 2048 + t0, t0, tl, Mt, r, hh, STb[0][0], STb[0][1]);
    if (tb == 1) mlstm_st_tile(1, tb, XB, QTb, WKT, xmcol, CW, dof + DO_UU / 4 + (size_t)bh * 2048 + t0, t0, tl, Mt, r, hh, STb[1][0], STb[1][1]);
    else { STb[1][0] = (bf16x8){0, 0, 0, 0, 0, 0, 0, 0}; STb[1][1] = STb[1][0]; }
    auto num_block = [&](int eb, f32x16& nt) {
#pragma unroll
        for (int i = 0; i < 16; ++i) nt[i] = 0.f;
        const bf16* crow = CTP + (size_t)(32 * eb + r) * 128 + 4 * hh;
#pragma unroll
        for (int rb = 0; rb < 4; ++rb) {
#pragma unroll
            for (int s2 = 0; s2 < 2; ++s2) nt = MFMA32(ld8x2(crow + 32 * rb + 16 * s2, crow + 32 * rb + 16 * s2 + 8), QTb[rb][s2], nt);
            if (rb == 1) __builtin_amdgcn_sched_barrier(0); }
#pragma unroll
        for (int i = 0; i < 16; ++i) nt[i] *= wst;
        __builtin_amdgcn_sched_barrier(0);
        const bf16* vrow = VT + (size_t)(32 * eb + r) * 64 + 4 * hh;
#pragma unroll
        for (int s2 = 0; s2 < 2; ++s2) nt = MFMA32(ld8x2(vrow + 16 * s2, vrow + 16 * s2 + 8), STb[0][s2], nt);
        if (tb == 1) {
#pragma unroll
            for (int s2 = 0; s2 < 2; ++s2) nt = MFMA32(ld8x2(vrow + 32 + 16 * s2, vrow + 32 + 16 * s2 + 8), STb[1][s2], nt); }
        __builtin_amdgcn_sched_barrier(0);
    };
    float inv;
    { f32x16 nd; num_block(4, nd); const float den = __shfl(nd[0], r); inv = 1.0f / fmaxf(fabsf(den), em); }
    float s1 = 0.f, s2v = 0.f;
#pragma unroll
    for (int eb = 0; eb < 4; ++eb) { f32x16 nt; num_block(eb, nt);
#pragma unroll
        for (int i = 0; i < 16; ++i) { const float x = nt[i] * inv; s1 += x; s2v += x * x; } }
    s1 += __shfl_xor(s1, 32); s2v += __shfl_xor(s2v, 32);
    const float mean = s1 * (1.0f / 128.0f); const float rs = rsqrtf(fmaxf(s2v * (1.0f / 128.0f) - mean * mean, 0.f) + M_GN_EPS);
    bf16* YM = (bf16*)(a.ws + WS_YM) + (size_t)(row0 + t) * 512 + hc; const bf16* orow = PM + (size_t)(row0 + t) * NPM + 1024 + hc;
    const float* gnw = a.in[28] + hc; const float* skp = a.in[29] + hc;
#pragma unroll
    for (int eb = 0; eb < 4; ++eb) { f32x16 nt; num_block(eb, nt);
#pragma unroll
        for (int g = 0; g < 4; ++g) { const int e0 = 32 * eb + 8 * g + 4 * hh;
            const f32x4 cb4 = *(const LAS f32x4*)(CW + 512 + e0); float x[4] = {cb4.x, cb4.y, cb4.z, cb4.w};
#pragma unroll
            for (int tap = 0; tap < 4; ++tap) { const int tt = t - 3 + tap; if (tt >= 0) { const v2u v = *(const v2u*)(xmcol + (size_t)tt * NPM + e0); const f32x4 w = *(const LAS f32x4*)(CW + tap * 128 + e0);
                x[0] += bflo(v.x) * w.x; x[1] += bfhi(v.x) * w.y; x[2] += bflo(v.y) * w.z; x[3] += bfhi(v.y) * w.w; } }
            const v2u ov = *(const v2u*)(orow + e0); const float og[4] = {bflo(ov.x), bfhi(ov.x), bflo(ov.y), bfhi(ov.y)};
            const f32x4 gw = *(const f32x4*)(gnw + e0), sk = *(const f32x4*)(skp + e0); float o[4];
#pragma unroll
            for (int i = 0; i < 4; ++i) { const float xc = x[i] / (1.0f + __expf(-x[i])); o[i] = ((nt[4 * g + i] * inv - mean) * rs * gw[i] + sk[i] * xc) * sigmoidf_(og[i]); }
            v2u w; w.x = cvtpk(o[0], o[1]); w.y = cvtpk(o[2], o[3]); *(v2u*)(YM + e0) = w; }
        __builtin_amdgcn_sched_barrier(0); }
}


constexpr size_t WS_SPREV = 237 * MiB;
constexpr size_t WS_GL = 253 * MiB, WS_BON = 253 * MiB + 512 * 1024, WS_BND = 254 * MiB;
constexpr size_t DO_DLRT = O_SC * 4, DO_DS = O_SC * 4 + 16 * MiB;
constexpr int RSTR = 144, RSLOT = 64 * RSTR;
constexpr int R1_MISC = 8 * RSLOT, R1_ITEM_LDS = 8 * RSLOT + 6144;
static_assert(2 * R1_ITEM_LDS == 159744, "R1 LDS");

__device__ __forceinline__ int rowidx(int reg, int hh) { return (reg & 3) + 8 * (reg >> 2) + 4 * hh; }
__device__ __forceinline__ bf16x8 ldsfrag(const LAS unsigned char* slot, int row, int k0) { return *(const LAS bf16x8*)(slot + row * RSTR + k0 * 2); }
__device__ __forceinline__ void st_rows(LAS unsigned char* slot, int rb, int cb, const f32x16& x, int r, int hh) {
    LAS unsigned char* bp = slot + (32 * rb + 4 * hh) * RSTR + (32 * cb + r) * 2;
#pragma unroll
    for (int reg = 0; reg < 16; ++reg) *(LAS bf16*)(bp + ((reg & 3) + 8 * (reg >> 2)) * RSTR) = (bf16)f2bf(x[reg]);
}
__device__ __forceinline__ void st_cols(LAS unsigned char* slot, int rb, int cb, const f32x16& x, int r, int hh) {
    LAS unsigned char* bp = slot + (32 * cb + r) * RSTR + (32 * rb + 4 * hh) * 2;
#pragma unroll
    for (int g = 0; g < 4; ++g) { v2u w; w.x = cvtpk(x[4 * g], x[4 * g + 1]); w.y = cvtpk(x[4 * g + 2], x[4 * g + 3]); *(LAS v2u*)(bp + 16 * g) = w; }
}
__device__ __forceinline__ f32x16 zero16() { f32x16 z;
#pragma unroll
    for (int i = 0; i < 16; ++i) z[i] = 0.f;
    return z; }
__device__ __forceinline__ void mix8(const v4u cur, const v4u prv, const float* mu, float (&m)[8]) {
    const f32x4 m0 = *(const f32x4*)mu, m1 = *(const f32x4*)(mu + 4);
    const float c[8] = {bflo(cur.x), bfhi(cur.x), bflo(cur.y), bfhi(cur.y), bflo(cur.z), bfhi(cur.z), bflo(cur.w), bfhi(cur.w)};
    const float p[8] = {bflo(prv.x), bfhi(prv.x), bflo(prv.y), bfhi(prv.y), bflo(prv.z), bfhi(prv.z), bflo(prv.w), bfhi(prv.w)};
    const float mm[8] = {m0.x, m0.y, m0.z, m0.w, m1.x, m1.y, m1.z, m1.w};
#pragma unroll
    for (int i = 0; i < 8; ++i) m[i] = c[i] + (p[i] - c[i]) * mm[i];
}
__device__ __forceinline__ void mix4(const v2u cur, const v2u prv, const float* mu, float (&m)[4]) {
    const f32x4 m0 = *(const f32x4*)mu;
    const float c[4] = {bflo(cur.x), bfhi(cur.x), bflo(cur.y), bfhi(cur.y)}, p[4] = {bflo(prv.x), bfhi(prv.x), bflo(prv.y), bfhi(prv.y)}, mm[4] = {m0.x, m0.y, m0.z, m0.w};
#pragma unroll
    for (int i = 0; i < 4; ++i) m[i] = c[i] + (p[i] - c[i]) * mm[i];
}

__device__ __forceinline__ float tanh_fast(float x) { return 1.0f - 2.0f / (__expf(2.0f * x) + 1.0f); }
__device__ __forceinline__ void rwkv_prep_pair(const Args& a, LAS unsigned char* lds0, int ritem0) {
    int tid_ = threadIdx.x; asm volatile("" : "+v"(tid_));
    const int tid = tid_ & 255, lane = tid & 63, w4 = tid >> 6, r = lane & 31, hh = lane >> 5, half = tid_ >> 8;
    const int ritem = ritem0 + half, bh = ritem >> 5, c = ritem & 31, b = bh >> 3, h = bh & 7, hc = h * 64, row0 = b * SEQ, t0 = c * 64;
    const int p = w4 >> 1, q = w4 & 1;
    LAS unsigned char* L = lds0 + half * R1_ITEM_LDS;
    LAS unsigned char *S0 = L, *S1 = L + RSLOT, *S2 = L + 2 * RSLOT, *S3 = L + 3 * RSLOT, *S4 = L + 4 * RSLOT, *S5 = L + 5 * RSLOT, *S6 = L + 6 * RSLOT, *S7 = L + 7 * RSLOT;
    LAS float* SSX = (LAS float*)(L + R1_MISC);
    LAS float* BONX = SSX + 128;
    LAS float* CUMT = BONX + 128;
    LAS float* CUML = CUMT + 64;
    LAS float* CUMTp = CUMT + 32 * p + 4 * hh; LAS float* CUMLp = CUML + 32 * p + 4 * hh;
    LAS unsigned char* T00T = L + R1_MISC;
    LAS unsigned char* G1T = L + R1_MISC + 2560;
    const bf16* PR = (const bf16*)(a.ws + WS_PR); const bf16* BND = (const bf16*)(a.ws + WS_BND);
    const float* mu = a.in[10];
    const int tl = 32 * q + r; const size_t row = (size_t)(row0 + t0 + tl);
    const bf16* cur = PR + row * NPR;
    const bf16* prv = tl > 0 ? cur - NPR : (c > 0 ? BND + (size_t)(b * 32 + c - 1) * NPR : nullptr);
    f32x16 wl = zero16(), al = zero16();
    {   const bf16* W2T = (const bf16*)(a.ws + WS_LW2T) + (size_t)(hc + 32 * p + r) * 64; const bf16* A2T = (const bf16*)(a.ws + WS_LA2T) + (size_t)(hc + 32 * p + r) * 64;
#pragma unroll
        for (int ks = 0; ks < 4; ++ks) { const int k0 = 16 * ks + 8 * hh; float m[8];
            mix8(*(const v4u*)(cur + 1536 + k0), prv ? *(const v4u*)(prv + 1536 + k0) : (v4u){0u, 0u, 0u, 0u}, mu + 1536 + k0, m);
            wl = MFMA32(ld16(W2T + k0), pack8(tanh_fast(m[0]), tanh_fast(m[1]), tanh_fast(m[2]), tanh_fast(m[3]), tanh_fast(m[4]), tanh_fast(m[5]), tanh_fast(m[6]), tanh_fast(m[7])), wl);
            mix8(*(const v4u*)(cur + 1600 + k0), prv ? *(const v4u*)(prv + 1600 + k0) : (v4u){0u, 0u, 0u, 0u}, mu + 1600 + k0, m);
            al = MFMA32(ld16(A2T + k0), pack8(m[0], m[1], m[2], m[3], m[4], m[5], m[6], m[7]), al); __builtin_amdgcn_sched_barrier(0); }
    }
    f32x16 lw, aa, kx, rx, vx;
    float ssp = 0.f, bonp = 0.f;
#pragma unroll
    for (int g = 0; g < 4; ++g) { const int ch = hc + 32 * p + 8 * g + 4 * hh;
        const f32x4 w04 = *(const f32x4*)(a.in[11] + ch), a04 = *(const f32x4*)(a.in[13] + ch), kk4 = *(const f32x4*)(a.in[16] + ch), ka4 = *(const f32x4*)(a.in[17] + ch), rk4 = *(const f32x4*)(a.in[18] + ch);
        float mr[4], mk[4], mv[4];
        mix4(*(const v2u*)(cur + ch), prv ? *(const v2u*)(prv + ch) : (v2u){0u, 0u}, mu + ch, mr);
        mix4(*(const v2u*)(cur + 512 + ch), prv ? *(const v2u*)(prv + 512 + ch) : (v2u){0u, 0u}, mu + 512 + ch, mk);
        mix4(*(const v2u*)(cur + 1024 + ch), prv ? *(const v2u*)(prv + 1024 + ch) : (v2u){0u, 0u}, mu + 1024 + ch, mv);
#pragma unroll
        for (int i = 0; i < 4; ++i) { const int reg = 4 * g + i;
            lw[reg] = -0.6065306597126334f / (1.0f + __expf(-(w04[i] + wl[reg])));
            const float av = 1.0f / (1.0f + __expf(-(a04[i] + al[reg]))); aa[reg] = av;
            const float kkr = mk[i] * kk4[i]; ssp += kkr * kkr; wl[reg] = kkr;
            const float k2 = mk[i] * (1.0f + (av - 1.0f) * ka4[i]); kx[reg] = k2; rx[reg] = mr[i]; vx[reg] = mv[i];
            bonp += mr[i] * k2 * rk4[i]; }
        __builtin_amdgcn_sched_barrier(0); }
    ssp += __shfl_xor(ssp, 32); bonp += __shfl_xor(bonp, 32);
    if (hh == 0) { SSX[tl * 2 + p] = ssp; BONX[tl * 2 + p] = bonp; }
    st_rows(S6, p, q, vx, r, hh);
    __builtin_amdgcn_sched_barrier(0);
    f32x16 cum = lw;
#pragma unroll
    for (int o = 1; o < 32; o <<= 1) {
#pragma unroll
        for (int reg = 0; reg < 16; ++reg) { const float t = __shfl_up(cum[reg], o, 32); if (r >= o) cum[reg] += t; } }
    if (q == 0 && r == 31) {
#pragma unroll
        for (int reg = 0; reg < 16; ++reg) CUMTp[(reg & 3) + 8 * (reg >> 2)] = cum[reg]; }
    __syncthreads();
    if (q == 1) {
#pragma unroll
        for (int reg = 0; reg < 16; ++reg) cum[reg] += CUMTp[(reg & 3) + 8 * (reg >> 2)];
        if (r == 31) {
#pragma unroll
            for (int reg = 0; reg < 16; ++reg) CUMLp[(reg & 3) + 8 * (reg >> 2)] = cum[reg]; } }
    const float rinv = 1.0f / fmaxf(sqrtf(SSX[tl * 2] + SSX[tl * 2 + 1]), 1e-12f);
    if (p == 0 && hh == 0) ((float*)(a.ws + WS_BON))[row * 8 + h] = BONX[tl * 2] + BONX[tl * 2 + 1];
    f32x16 KeT, RqT;
#pragma unroll
    for (int reg = 0; reg < 16; ++reg) { RqT[reg] = rx[reg] * __expf(cum[reg]); lw[reg] = cum[reg] - lw[reg]; wl[reg] *= rinv; }
    st_cols(S3, p, q, RqT, r, hh);
    __syncthreads();
    __builtin_amdgcn_sched_barrier(0);
    {   f32x16 tmp;
#pragma unroll
        for (int reg = 0; reg < 16; ++reg) tmp[reg] = wl[reg] * __expf(lw[reg]);
        st_cols(S0, p, q, tmp, r, hh); st_rows(S4, p, q, tmp, r, hh);
        __builtin_amdgcn_sched_barrier(0);
#pragma unroll
        for (int reg = 0; reg < 16; ++reg) tmp[reg] = wl[reg] * aa[reg] * __expf(-cum[reg]);
        st_cols(S1, p, q, tmp, r, hh);
        __builtin_amdgcn_sched_barrier(0);
#pragma unroll
        for (int reg = 0; reg < 16; ++reg) tmp[reg] = kx[reg] * __expf(-cum[reg]);
        st_cols(S2, p, q, tmp, r, hh);
        __builtin_amdgcn_sched_barrier(0);
#pragma unroll
        for (int reg = 0; reg < 16; ++reg) { const float e4 = __expf(CUMLp[(reg & 3) + 8 * (reg >> 2)] - cum[reg]); tmp[reg] = wl[reg] * aa[reg] * e4; KeT[reg] = kx[reg] * e4; }
        st_rows(S5, p, q, tmp, r, hh);
        if (q == 0 && r == 0) { float* glp = (float*)(a.ws + WS_GL) + (size_t)ritem * 64 + 32 * p + 4 * hh;
#pragma unroll
            for (int reg = 0; reg < 16; ++reg) glp[(reg & 3) + 8 * (reg >> 2)] = __expf(CUMLp[(reg & 3) + 8 * (reg >> 2)]); }
    }
    __syncthreads();
    __builtin_amdgcn_sched_barrier(0);
    f32x16 NrkT;
    {   f32x16 mkb = zero16(), mkk = zero16(), nrb = zero16(); NrkT = zero16();
        if (!(p == 0 && q == 1)) {
#pragma unroll
            for (int ks = 0; ks < 4; ++ks) { const int k0 = 16 * ks + 8 * hh;
                const bf16x8 kqp = ldsfrag(S0, 32 * p + r, k0), rqp = ldsfrag(S3, 32 * p + r, k0), bdq = ldsfrag(S1, 32 * q + r, k0), kdq = ldsfrag(S2, 32 * q + r, k0);
                mkb = MFMA32(kqp, bdq, mkb); mkk = MFMA32(kqp, kdq, mkk); nrb = MFMA32(rqp, bdq, nrb); }
        }
        if (!(p == 1 && q == 0)) {
#pragma unroll
            for (int ks = 0; ks < 4; ++ks) { const int k0 = 16 * ks + 8 * hh; NrkT = MFMA32(ldsfrag(S2, 32 * p + r, k0), ldsfrag(S3, 32 * q + r, k0), NrkT); }
        }
#pragma unroll
        for (int reg = 0; reg < 16; ++reg) { const int i = 32 * p + rowidx(reg, hh), j = 32 * q + r;
            if (!(j < i)) { mkb[reg] = 0.f; mkk[reg] = 0.f; } if (!(j <= i)) nrb[reg] = 0.f;
            if (!(i <= j)) NrkT[reg] = 0.f; }
        __syncthreads();
#pragma unroll
        for (int reg = 0; reg < 16; ++reg) *(LAS float*)(S0 + ((32 * p + 4 * hh) * 68 + 32 * q + r) * 4 + ((reg & 3) + 8 * (reg >> 2)) * 272) = mkb[reg];
        st_cols(S2, p, q, mkk, r, hh); st_rows(S3, p, q, nrb, r, hh);
    }
    __syncthreads();
    if (w4 < 2) {
        if (lane < 32) { const int i0 = 32 * w4; float tc[32];
#pragma unroll
            for (int i = 0; i < 32; ++i) { float acc = (i == lane) ? 1.0f : 0.0f;
#pragma unroll
                for (int j4 = 0; j4 < (i + 3) / 4; ++j4) { const f32x4 m4 = *(const LAS f32x4*)(S0 + ((i0 + i) * 68 + i0 + 4 * j4) * 4);
                    if (4 * j4 + 0 < i) acc -= m4.x * tc[4 * j4 + 0]; if (4 * j4 + 1 < i) acc -= m4.y * tc[4 * j4 + 1]; if (4 * j4 + 2 < i) acc -= m4.z * tc[4 * j4 + 2]; if (4 * j4 + 3 < i) acc -= m4.w * tc[4 * j4 + 3]; }
                tc[i] = acc; }
#pragma unroll
            for (int i = 0; i < 32; ++i) *(LAS bf16*)(S7 + (i0 + i) * RSTR + (i0 + lane) * 2) = (bf16)f2bf(tc[i]);
            if (w4 == 0) {
#pragma unroll
                for (int i8 = 0; i8 < 4; ++i8) *(LAS bf16x8*)(T00T + lane * 80 + i8 * 16) = pack8(tc[8 * i8], tc[8 * i8 + 1], tc[8 * i8 + 2], tc[8 * i8 + 3], tc[8 * i8 + 4], tc[8 * i8 + 5], tc[8 * i8 + 6], tc[8 * i8 + 7]); }
        }
    } else if (w4 == 2) {
#pragma unroll
        for (int i = 0; i < 16; ++i) *(LAS bf16*)(S7 + (2 * i + hh) * RSTR + (32 + r) * 2) = (bf16)0;
    }
    __syncthreads();
    if (w4 == 1) {
        f32x16 g1 = zero16();
#pragma unroll
        for (int ks = 0; ks < 2; ++ks) { const int k0 = 16 * ks + 8 * hh; const LAS float* mp = (const LAS float*)(S0 + ((32 + r) * 68 + k0) * 4); const f32x4 x0 = *(const LAS f32x4*)mp, x1 = *(const LAS f32x4*)(mp + 4);
            g1 = MFMA32(pack8(x0.x, x0.y, x0.z, x0.w, x1.x, x1.y, x1.z, x1.w), *(const LAS bf16x8*)(T00T + r * 80 + k0 * 2), g1); }
#pragma unroll
        for (int g = 0; g < 4; ++g) { v2u w; w.x = cvtpk(g1[4 * g], g1[4 * g + 1]); w.y = cvtpk(g1[4 * g + 2], g1[4 * g + 3]); *(LAS v2u*)(G1T + r * 80 + (8 * g + 4 * hh) * 2) = w; }
        LDS_WAIT(); asm volatile("" ::: "memory");
        f32x16 t10 = zero16();
#pragma unroll
        for (int ks = 0; ks < 2; ++ks) { const int k0 = 16 * ks + 8 * hh; t10 = MFMA32(ldsfrag(S7, 32 + r, 32 + k0), *(const LAS bf16x8*)(G1T + r * 80 + k0 * 2), t10); }
#pragma unroll
        for (int reg = 0; reg < 16; ++reg) *(LAS bf16*)(S7 + (32 + 4 * hh) * RSTR + r * 2 + ((reg & 3) + 8 * (reg >> 2)) * RSTR) = (bf16)f2bf(-t10[reg]);
    }
    __syncthreads();
    {   f32x16 w1 = zero16(), w2 = zero16();
#pragma unroll
        for (int ks = 0; ks < 4; ++ks) { const int k0 = 16 * ks + 8 * hh; const bf16x8 tq = ldsfrag(S7, 32 * q + r, k0);
            w1 = MFMA32(ldsfrag(S4, 32 * p + r, k0), tq, w1); w2 = MFMA32(ldsfrag(S2, 32 * p + r, k0), tq, w2); }
        __syncthreads();
        st_rows(S0, p, q, w1, r, hh); st_rows(S1, p, q, w2, r, hh);
    }
    __syncthreads();
    {   f32x16 qf = zero16(), dl = zero16(), pv = zero16(), kf = zero16();
#pragma unroll
        for (int ks = 0; ks < 4; ++ks) { const int k0 = 16 * ks + 8 * hh;
            const bf16x8 w1p = ldsfrag(S0, 32 * p + r, k0), w1q = ldsfrag(S0, 32 * q + r, k0), w2p = ldsfrag(S1, 32 * p + r, k0), w2q = ldsfrag(S1, 32 * q + r, k0), nrq = ldsfrag(S3, 32 * q + r, k0), bep = ldsfrag(S5, 32 * p + r, k0);
            qf = MFMA32(w1p, nrq, qf); dl = MFMA32(bep, w1q, dl); pv = MFMA32(w2p, nrq, pv); kf = MFMA32(bep, w2q, kf); }
        bf16* qo = (bf16*)(a.ws + WS_PR) + row * NPR + hc + 32 * p + 4 * hh;
#pragma unroll
        for (int g = 0; g < 4; ++g) { v2u w; w.x = cvtpk(RqT[4 * g] - qf[4 * g], RqT[4 * g + 1] - qf[4 * g + 1]); w.y = cvtpk(RqT[4 * g + 2] - qf[4 * g + 2], RqT[4 * g + 3] - qf[4 * g + 3]); *(v2u*)(qo + 8 * g) = w; }
        bf16* dlo = (bf16*)((unsigned char*)a.out + DO_DLRT) + (size_t)ritem * 4096 + (32 * p + 4 * hh) * 64 + 32 * q + r;
#pragma unroll
        for (int reg = 0; reg < 16; ++reg) { dlo[((reg & 3) + 8 * (reg >> 2)) * 64] = (bf16)f2bf(-dl[reg]); pv[reg] = NrkT[reg] - pv[reg]; kf[reg] = KeT[reg] - kf[reg]; }
        st_cols(S2, p, q, pv, r, hh);
        st_rows(S4, p, q, kf, r, hh);
    }
    __syncthreads();
    {   f32x16 yl = zero16(), ds = zero16();
#pragma unroll
        for (int ks = 0; ks < 4; ++ks) { const int k0 = 16 * ks + 8 * hh; const bf16x8 vp = ldsfrag(S6, 32 * p + r, k0);
            yl = MFMA32(vp, ldsfrag(S2, 32 * q + r, k0), yl); ds = MFMA32(vp, ldsfrag(S4, 32 * q + r, k0), ds); }
        bf16* yo = (bf16*)(a.ws + WS_PR) + row * NPR + 512 + hc + 32 * p + 4 * hh;
#pragma unroll
        for (int g = 0; g < 4; ++g) { v2u w; w.x = cvtpk(yl[4 * g], yl[4 * g + 1]); w.y = cvtpk(yl[4 * g + 2], yl[4 * g + 3]); *(v2u*)(yo + 8 * g) = w; }
        bf16* dso = (bf16*)((unsigned char*)a.out + DO_DS) + (size_t)ritem * 4096 + (32 * p + 4 * hh) * 64 + 32 * q + r;
#pragma unroll
        for (int reg = 0; reg < 16; ++reg) dso[((reg & 3) + 8 * (reg >> 2)) * 64] = (bf16)f2bf(ds[reg]);
    }
    __syncthreads();
}

typedef float f32x4v __attribute__((ext_vector_type(4)));
__device__ __forceinline__ void rwkv_scan_task(const Args& a, int bh, int vq, int lane) {
    const int lc = lane & 15, g = lane >> 4, v = 16 * vq + lc;
    f32x4v ST[4];
#pragma unroll
    for (int ib = 0; ib < 4; ++ib) ST[ib] = (f32x4v){0.f, 0.f, 0.f, 0.f};
    const bf16* DL0 = (const bf16*)((const unsigned char*)a.out + DO_DLRT) + (size_t)bh * 32 * 4096 + (size_t)lc * 64 + 4 * g;
    const bf16* DS0 = (const bf16*)((const unsigned char*)a.out + DO_DS) + (size_t)bh * 32 * 4096 + (size_t)v * 64 + 4 * g;
    const float* GL0 = (const float*)(a.ws + WS_GL) + (size_t)bh * 32 * 64 + 4 * g; bf16* SP0 = (bf16*)(a.ws + WS_SPREV) + (size_t)bh * 32 * 4096 + v * 64 + 4 * g;
    v2u dl[4][2][2], ds[4]; f32x4 gl[4];
#define R2_LOAD(c_) do { const bf16* DL = DL0 + (size_t)(c_) * 4096; \
        _Pragma("unroll") for (int ib = 0; ib < 4; ++ib) { _Pragma("unroll") for (int s = 0; s < 2; ++s) { dl[ib][s][0] = *(const v2u*)(DL + (16 * ib) * 64 + 32 * s); dl[ib][s][1] = *(const v2u*)(DL + (16 * ib) * 64 + 32 * s + 16); } \
            ds[ib] = *(const v2u*)(DS0 + (size_t)(c_) * 4096 + 16 * ib); gl[ib] = *(const f32x4*)(GL0 + (size_t)(c_) * 64 + 16 * ib); } } while (0)
    R2_LOAD(0);
    for (int c = 0; c < 32; ++c) {
        bf16* SP = SP0 + (size_t)c * 4096;
        unsigned hi[4][2], lo[4][2];
#pragma unroll
        for (int ib = 0; ib < 4; ++ib) { hi[ib][0] = cvtpk(ST[ib][0], ST[ib][1]); hi[ib][1] = cvtpk(ST[ib][2], ST[ib][3]);
            v2u w; w.x = hi[ib][0]; w.y = hi[ib][1]; *(v2u*)(SP + 16 * ib) = w;
            lo[ib][0] = cvtpk(ST[ib][0] - bflo(hi[ib][0]), ST[ib][1] - bfhi(hi[ib][0])); lo[ib][1] = cvtpk(ST[ib][2] - bflo(hi[ib][1]), ST[ib][3] - bfhi(hi[ib][1])); }
        bf16x8 Bh[2], Bl[2];
#pragma unroll
        for (int s = 0; s < 2; ++s) { v4u t; t.x = hi[2 * s][0]; t.y = hi[2 * s][1]; t.z = hi[2 * s + 1][0]; t.w = hi[2 * s + 1][1]; Bh[s] = __builtin_bit_cast(bf16x8, t);
            v4u u2; u2.x = lo[2 * s][0]; u2.y = lo[2 * s][1]; u2.z = lo[2 * s + 1][0]; u2.w = lo[2 * s + 1][1]; Bl[s] = __builtin_bit_cast(bf16x8, u2); }
        f32x4v nw[4]; bf16x8 Af[4][2];
#pragma unroll
        for (int ib = 0; ib < 4; ++ib) {
            nw[ib] = (f32x4v){bflo(ds[ib].x) + gl[ib].x * ST[ib][0], bfhi(ds[ib].x) + gl[ib].y * ST[ib][1], bflo(ds[ib].y) + gl[ib].z * ST[ib][2], bfhi(ds[ib].y) + gl[ib].w * ST[ib][3]};
#pragma unroll
            for (int s = 0; s < 2; ++s) { v4u t; t.x = dl[ib][s][0].x; t.y = dl[ib][s][0].y; t.z = dl[ib][s][1].x; t.w = dl[ib][s][1].y; Af[ib][s] = __builtin_bit_cast(bf16x8, t); } }
        if (c + 1 < 32) R2_LOAD(c + 1);
#pragma unroll
        for (int s = 0; s < 2; ++s)
#pragma unroll
            for (int ib = 0; ib < 4; ++ib) { nw[ib] = __builtin_amdgcn_mfma_f32_16x16x32_bf16(Af[ib][s], Bh[s], nw[ib], 0, 0, 0); nw[ib] = __builtin_amdgcn_mfma_f32_16x16x32_bf16(Af[ib][s], Bl[s], nw[ib], 0, 0, 0); }
#pragma unroll
        for (int ib = 0; ib < 4; ++ib) ST[ib] = nw[ib];
    }
#undef R2_LOAD
    float* So = a.out + O_PWKV + (size_t)bh * 4096 + v * 64 + 4 * g;
#pragma unroll
    for (int ib = 0; ib < 4; ++ib) *(f32x4*)(So + 16 * ib) = (f32x4){ST[ib][0], ST[ib][1], ST[ib][2], ST[ib][3]};
}

__device__ __forceinline__ void rwkv_out_task(const Args& a, int ritem, int tb, int lane_) {
    int lane = lane_; asm volatile("" : "+v"(lane));
    const int r = lane & 31, hh = lane >> 5, bh = ritem >> 5, c = ritem & 31, b = bh >> 3, h = bh & 7, hc = h * 64, row0 = b * SEQ, t0 = c * 64, tl = 32 * tb + r;
    const size_t row = (size_t)(row0 + t0 + tl);
    bf16* PRw = (bf16*)(a.ws + WS_PR); const bf16* cur = PRw + row * NPR; const bf16* prv = (t0 + tl) > 0 ? cur - NPR : nullptr;
    const bf16* SP = (const bf16*)(a.ws + WS_SPREV) + (size_t)ritem * 4096; const float* mu = a.in[10];
    f32x16 Y[2] = {zero16(), zero16()};
#pragma unroll
    for (int ks = 0; ks < 4; ++ks) { const int k0 = 16 * ks + 8 * hh; const bf16x8 B = ld16(cur + hc + k0);
        Y[0] = MFMA32(ld16(SP + (size_t)r * 64 + k0), B, Y[0]); Y[1] = MFMA32(ld16(SP + (size_t)(32 + r) * 64 + k0), B, Y[1]); }
    __builtin_amdgcn_sched_barrier(0);
    f32x16 G[2] = {zero16(), zero16()};
    {   const bf16* G2T = (const bf16*)(a.ws + WS_LG2T) + (size_t)(hc + r) * 128;
#pragma unroll
        for (int ks = 0; ks < 8; ++ks) { const int k0 = 16 * ks + 8 * hh; float m[8];
            mix8(*(const v4u*)(cur + 1664 + k0), prv ? *(const v4u*)(prv + 1664 + k0) : (v4u){0u, 0u, 0u, 0u}, mu + 1664 + k0, m);
            const bf16x8 B = pack8(sigmoidf_(m[0]), sigmoidf_(m[1]), sigmoidf_(m[2]), sigmoidf_(m[3]), sigmoidf_(m[4]), sigmoidf_(m[5]), sigmoidf_(m[6]), sigmoidf_(m[7]));
            G[0] = MFMA32(ld16(G2T + k0), B, G[0]); G[1] = MFMA32(ld16(G2T + 32 * 128 + k0), B, G[1]); }
    }
    __builtin_amdgcn_sched_barrier(0);
    float s1 = 0.f;
#pragma unroll
    for (int vb = 0; vb < 2; ++vb)
#pragma unroll
        for (int g = 0; g < 4; ++g) { const v2u y4 = *(const v2u*)(cur + 512 + hc + 32 * vb + 8 * g + 4 * hh);
            Y[vb][4 * g] += bflo(y4.x); Y[vb][4 * g + 1] += bfhi(y4.x); Y[vb][4 * g + 2] += bflo(y4.y); Y[vb][4 * g + 3] += bfhi(y4.y);
            s1 += (Y[vb][4 * g] + Y[vb][4 * g + 1]) + (Y[vb][4 * g + 2] + Y[vb][4 * g + 3]); }
    s1 += __shfl_xor(s1, 32); const float mean = s1 * (1.0f / 64.0f); float s2 = 0.f;
#pragma unroll
    for (int vb = 0; vb < 2; ++vb)
#pragma unroll
        for (int i = 0; i < 16; ++i) { const float d = Y[vb][i] - mean; s2 += d * d; }
    s2 += __shfl_xor(s2, 32); const float rs = rsqrtf(s2 * (1.0f / 64.0f) + R_GN_EPS);
    const float bon = ((const float*)(a.ws + WS_BON))[row * 8 + h];
    bf16* yo = PRw + row * NPR + hc;
#pragma unroll
    for (int vb = 0; vb < 2; ++vb)
#pragma unroll
        for (int g = 0; g < 4; ++g) { const int ch = hc + 32 * vb + 8 * g + 4 * hh; float mv[4];
            mix4(*(const v2u*)(cur + 1024 + ch), prv ? *(const v2u*)(prv + 1024 + ch) : (v2u){0u, 0u}, mu + 1024 + ch, mv);
            const f32x4 gw = *(const f32x4*)(a.in[19] + ch), gb = *(const f32x4*)(a.in[20] + ch); float o[4];
#pragma unroll
            for (int i = 0; i < 4; ++i) o[i] = ((Y[vb][4 * g + i] - mean) * rs * gw[i] + gb[i] + bon * mv[i]) * G[vb][4 * g + i];
            v2u w; w.x = cvtpk(o[0], o[1]); w.y = cvtpk(o[2], o[3]); *(v2u*)(yo + 32 * vb + 8 * g + 4 * hh) = w; }
}


typedef float f32x4m __attribute__((ext_vector_type(4)));
constexpr size_t WS_MERGED_S = 255 * MiB;
#define MFMA16(a, b, c) __builtin_amdgcn_mfma_f32_16x16x32_bf16((a), (b), (c), 0, 0, 0)
template <int KSTEPS>
__device__ __forceinline__ f32x4m skinny_acc(const bf16* ap, const bf16* bp, f32x4m acc) {
#pragma unroll 8
    for (int ks = 0; ks < KSTEPS; ++ks) acc = MFMA16(ld16(ap + 32 * ks), ld16(bp + 32 * ks), acc);
    return acc;
}
__device__ __forceinline__ void sample_up_task(const Args& a, int j, int wave, int lane) {
    const int lc = lane & 15, g = lane >> 4, rowa = MP + 16 * wave + lc, col = 16 * j + lc;
    unsigned char* ws = a.ws;
    f32x4m a1 = {0.f, 0.f, 0.f, 0.f}, a2 = {0.f, 0.f, 0.f, 0.f};
    a1 = skinny_acc<16>((const bf16*)(ws + WS_PR) + (size_t)rowa * NPR + 8 * g, (const bf16*)(ws + WS_UPRT) + (size_t)col * 512 + 8 * g, a1);
    a2 = skinny_acc<16>((const bf16*)(ws + WS_YM) + (size_t)rowa * 512 + 8 * g, (const bf16*)(ws + WS_UPMT) + (size_t)col * 512 + 8 * g, a2);
    const bf16* PG = (const bf16*)(ws + WS_PG); bf16* MG = (bf16*)(ws + WS_MERGED_S) - (size_t)MP * 1024;
#pragma unroll
    for (int rr = 0; rr < 4; ++rr) { const size_t row = (size_t)(MP + 16 * wave + 4 * g + rr);
        MG[row * 1024 + col] = (bf16)f2bf(bf2f(PG[row * 2048 + col]) * a1[rr] + bf2f(PG[row * 2048 + 1024 + col]) * a2[rr]); }
}
__device__ __forceinline__ void sample_out_task(const Args& a, int j, int wave, int lane) {
    const int lc = lane & 15, g = lane >> 4, rowa = MP + 16 * wave + lc, col = 16 * j + lc;
    unsigned char* ws = a.ws;
    f32x4m acc = {0.f, 0.f, 0.f, 0.f};
    acc = skinny_acc<32>((const bf16*)(ws + WS_MERGED_S) + (size_t)(rowa - MP) * 1024 + 8 * g, (const bf16*)(ws + WS_WOUTT) + (size_t)col * 1024 + 8 * g, acc);
    const float gf = a.in[33][col]; bf16* X2B = (bf16*)(ws + WS_X2B); float* ssq = (float*)(ws + WS_SSQ1);
#pragma unroll
    for (int rr = 0; rr < 4; ++rr) { const int rs = 16 * wave + 4 * g + rr; const size_t row = (size_t)(MP + rs);
        const float x2 = a.in[1][(size_t)rs * 1024 + col] + acc[rr];
        a.out[row * 1024 + col] = x2; X2B[row * 1024 + col] = (bf16)f2bf(x2 * gf);
        float sq = x2 * x2; sq += __shfl_xor(sq, 1); sq += __shfl_xor(sq, 2); sq += __shfl_xor(sq, 4); sq += __shfl_xor(sq, 8);
        if (lc == 0) atomicAdd(ssq + row, sq); }
}
__device__ __forceinline__ void sample_ffn1_task(const Args& a, int j, int wave, int lane) {
    const int lc = lane & 15, g = lane >> 4, rowa = MP + 16 * wave + lc, col = 16 * j + lc;
    unsigned char* ws = a.ws;
    f32x4m acc = {0.f, 0.f, 0.f, 0.f};
    acc = skinny_acc<32>((const bf16*)(ws + WS_X2B) + (size_t)rowa * 1024 + 8 * g, (const bf16*)(ws + WS_W1T) + (size_t)col * 1024 + 8 * g, acc);
    const float* ssq = (const float*)(ws + WS_SSQ1); bf16* H = (bf16*)(ws + WS_H);
#pragma unroll
    for (int rr = 0; rr < 4; ++rr) { const size_t row = (size_t)(MP + 16 * wave + 4 * g + rr); const float rs = rsqrtf(ssq[row] * (1.0f / 1024.0f) + RMS_EPS);
        const float v = fmaxf(acc[rr] * rs, 0.f); H[row * 4096 + col] = (bf16)f2bf(v * v); }
}
__device__ __forceinline__ void sample_ffn2_task(const Args& a, int t, int wave, int lane) {
    const int lc = lane & 15, g = lane >> 4, rowa = MP + 16 * wave + lc, j = t >> 2, kq = t & 3, col = 16 * j + lc;
    unsigned char* ws = a.ws;
    f32x4m acc = {0.f, 0.f, 0.f, 0.f};
    acc = skinny_acc<32>((const bf16*)(ws + WS_H) + (size_t)rowa * 4096 + 1024 * kq + 8 * g, (const bf16*)(ws + WS_W2T) + (size_t)col * 4096 + 1024 * kq + 8 * g, acc);
#pragma unroll
    for (int rr = 0; rr < 4; ++rr) atomicAdd(a.out + (size_t)(MP + 16 * wave + 4 * g + rr) * 1024 + col, acc[rr]);
}

__device__ __forceinline__ unsigned long long rt() { return __builtin_amdgcn_s_memrealtime(); }
#define XB_TMO      128
#define XB_XCNT(j)  (256  + 64 * (j))
#define XB_XSUB(j)  (1280 + 64 * (j))
#define XB_XGEN(j)  (2304 + 64 * (j))
#define XB_TOP      3328
#define XB_TOPGEN   3392
#define XCD_BAR_WORDS 3456
#define XB_SPIN_CAP (1u << 18)

__device__ __forceinline__ unsigned xb_ld(unsigned* p)              { return __hip_atomic_load(p, __ATOMIC_RELAXED, __HIP_MEMORY_SCOPE_AGENT); }
__device__ __forceinline__ unsigned xb_add(unsigned* p, unsigned v) { return __hip_atomic_fetch_add(p, v, __ATOMIC_RELAXED, __HIP_MEMORY_SCOPE_AGENT); }
__device__ __forceinline__ unsigned xb_xcc_id() { return (unsigned)__builtin_amdgcn_s_getreg((3 << 11) | 20) & 0xFu; }
#define XB_SPIN(cond, bar) do { unsigned _sp = 0; while (cond) { __builtin_amdgcn_s_sleep(1); \
    if ((++_sp & 255u) == 0u) { if (xb_ld(&(bar)[XB_TMO])) break; if (_sp > XB_SPIN_CAP) { atomicAdd(&(bar)[XB_TMO], 1u); break; } } } } while (0)

struct XcdBarrier {
    unsigned* bar; unsigned x;
    volatile LAS unsigned* st;
};

__device__ __forceinline__ XcdBarrier xcd_barrier_post(unsigned* bar, volatile LAS unsigned* st) {
    XcdBarrier b; b.bar = bar; b.x = xb_xcc_id(); b.st = st;
    if (threadIdx.x == 0) (void)xb_add(&bar[XB_XCNT(b.x)], 1u);
    return b;
}
__device__ __forceinline__ void xcd_barrier_complete(unsigned* bar, unsigned x, unsigned& nloc, unsigned& nx) {
    const unsigned G = gridDim.x * gridDim.y * gridDim.z;
    unsigned sum, cnt, mine, sp = 0u;
    for (;;) {
        sum = 0u; cnt = 0u; mine = 0u;
#pragma unroll
        for (unsigned j = 0; j < 16; ++j) { const unsigned c = xb_ld(&bar[XB_XCNT(j)]); sum += c; cnt += (c > 0u) ? 1u : 0u; mine = (j == x) ? c : mine; }
        if (sum == G) break;
        __builtin_amdgcn_s_sleep(1);
        if ((++sp & 255u) == 0u) { if (xb_ld(&bar[XB_TMO])) break; if (sp > XB_SPIN_CAP) { atomicAdd(&bar[XB_TMO], 1u); break; } }
    }
    nloc = mine > 0u ? mine : 1u; nx = cnt > 0u ? cnt : 1u;
}

__device__ __forceinline__ void xcd_barrier(const XcdBarrier& b) {
    asm volatile("s_waitcnt vmcnt(0)" ::: "memory");
    __syncthreads();
    if (threadIdx.x == 0) {
        unsigned* bar = b.bar;
        __builtin_amdgcn_s_waitcnt(0);
        unsigned nloc = b.st[0], nx = b.st[1];
        if (nloc == 0u) { xcd_barrier_complete(bar, b.x, nloc, nx); b.st[0] = nloc; b.st[1] = nx; }
        const unsigned old = xb_add(&bar[XB_XSUB(b.x)], 1u);
        const unsigned gen = old / nloc;
        if (old + 1u == (gen + 1u) * nloc) {
            __builtin_amdgcn_fence(__ATOMIC_RELEASE, "agent");
            asm volatile("s_waitcnt vmcnt(0)" ::: "memory");
            const unsigned og = xb_add(&bar[XB_TOP], 1u);
            const unsigned tg = og / nx;
            if (og + 1u == (tg + 1u) * nx) xb_add(&bar[XB_TOPGEN], 1u);
            else XB_SPIN(xb_ld(&bar[XB_TOPGEN]) == tg, bar);
            __builtin_amdgcn_fence(__ATOMIC_ACQUIRE, "agent");
            xb_add(&bar[XB_XGEN(b.x)], 1u);
            asm volatile("s_waitcnt vmcnt(0)" ::: "memory");
        } else {
            XB_SPIN(xb_ld(&bar[XB_XGEN(b.x)]) == gen, bar);
            __builtin_amdgcn_fence(__ATOMIC_ACQUIRE, "agent");
            asm volatile("s_waitcnt vmcnt(0)" ::: "memory");
        }
    }
    __syncthreads();
}


constexpr size_t WS_BAR = 512 * 1024;
constexpr int MISC_OFF = 159744, MEGA_LDS = 160000;
static_assert(2 * RWKV_LDS <= MISC_OFF && MLSTM_LDS <= MISC_OFF && P0_LDS <= MISC_OFF && 2 * R1_ITEM_LDS <= MISC_OFF && GEMM_LDS <= MISC_OFF, "LDS map");

__global__ void __launch_bounds__(NTHR, 2) mega_fwd(Args a) {
    extern __shared__ __attribute__((aligned(16))) unsigned char lds_raw[];
    LAS unsigned char* lds = (LAS unsigned char*)lds_raw;
    volatile LAS unsigned* MISC = (volatile LAS unsigned*)(lds + MISC_OFF);
    const int tid = threadIdx.x, lane = tid & 63, wave = __builtin_amdgcn_readfirstlane(tid >> 6);
    const int G = gridDim.x, bx = blockIdx.x;
    unsigned char* ws = a.ws;
    if (tid < 64) MISC[tid] = 0u;
    __syncthreads();
    XcdBarrier bar = xcd_barrier_post((unsigned*)(ws + WS_BAR), MISC + 8);

    p0_prologue(a, lds, bx * NWAVES + wave, G * NWAVES, lane, wave);
    xcd_barrier(bar);
    { pg8::StaticOrder S; pg8::Gemm g{(const bf16*)(ws + WS_XN), (const bf16*)(ws + WS_WINT), MT, NPROJ, 1024, 1024}; S.init(MT, NPROJ, G, bx);
      pg8::EpiProj E{(bf16*)(ws + WS_PR), (bf16*)(ws + WS_PM), (bf16*)(ws + WS_PG), a.in[31], (bf16*)(ws + WS_BND)}; pg8::gemm_phase<pg8::EpiProj, pg8::StaticOrder, true, true>(lds, g, S, E); }
    xcd_barrier(bar);
    {
        for (int pr = bx; pr < 1024; pr += G) rwkv_prep_pair(a, lds, 2 * pr);
        LAS float* CW = (LAS float*)lds;
        for (int item = bx; item < 1024; item += G) { stage_conv_head(a, CW, (item >> 5) & 3, tid, NTHR); __syncthreads(); mlstm_prep_task(a, item, wave, CW, lane); __syncthreads(); }
        for (int s = bx; s < 512; s += G) { rwkv_seq_item(a, lds, 64 + 2 * s); __syncthreads(); }
    }
    xcd_barrier(bar);
    {
        if (wave == 0) rwkv_scan_task(a, bx >> 2, bx & 3, lane);
        else if (wave == 1 && bx < 160) mlstm_scan_task(a, bx / 5, bx % 5, (LAS float*)lds, lane);
    }
    xcd_barrier(bar);
    {
        for (int s = bx; s < 512; s += G) { mlstm_seq_item(a, lds, 32 + s); __syncthreads(); }
        LAS float* CWall = (LAS float*)lds;
        for (int hq = 0; hq < 4; ++hq) stage_conv_head(a, CWall + hq * 640, hq, tid, NTHR);
        __syncthreads();
        { const int task = bx * NWAVES + wave; if (task < 2048) mlstm_out_task(a, task >> 1, task & 1, CWall, lane); }
        for (int task = bx * NWAVES + wave; task < 4096; task += G * NWAVES) rwkv_out_task(a, task >> 1, task & 1, lane);
    }
    xcd_barrier(bar);
    if (bx < 64) sample_up_task(a, bx, wave, lane);
    { pg8::StaticOrder S; pg8::Gemm g{(const bf16*)(ws + WS_PR), (const bf16*)(ws + WS_UPRT), MP, 1024, 512, NPR}; S.init(MP, 1024, G, bx);
      pg8::EpiUp1 E{a.out, (const bf16*)(ws + WS_PG)}; pg8::gemm_phase<pg8::EpiUp1, pg8::StaticOrder, true, true>(lds, g, S, E); }
    xcd_barrier(bar);
    if (bx >= 64 && bx < 128) sample_out_task(a, bx - 64, wave, lane);
    { pg8::StaticOrder S; pg8::Gemm g{(const bf16*)(ws + WS_YM), (const bf16*)(ws + WS_UPMT), MP, 1024, 512, 512}; S.init(MP, 1024, G, bx);
      pg8::EpiUp2 E{a.out, (const bf16*)(ws + WS_PG), (bf16*)(ws + WS_MERGED)}; pg8::gemm_phase<pg8::EpiUp2, pg8::StaticOrder, true, true>(lds, g, S, E); }
    xcd_barrier(bar);
    sample_ffn1_task(a, bx, wave, lane);
    { pg8::StaticOrder S; pg8::Gemm g{(const bf16*)(ws + WS_MERGED), (const bf16*)(ws + WS_WOUTT), MP, 1024, 1024, 1024}; S.init(MP, 1024, G, bx);
      pg8::EpiOut E{a.in[0], a.in[1], a.out, (bf16*)(ws + WS_X2B), a.in[33], (float*)(ws + WS_SSQ1)}; pg8::gemm_phase<pg8::EpiOut, pg8::StaticOrder, true, true>(lds, g, S, E); }
    xcd_barrier(bar);
    sample_ffn2_task(a, bx, wave, lane);
    { pg8::StaticOrder S; pg8::Gemm g{(const bf16*)(ws + WS_X2B), (const bf16*)(ws + WS_W1T), MP, FF, 1024, 1024}; S.init(MP, FF, G, bx);
      pg8::EpiFfn1 E{(bf16*)(ws + WS_H), (const float*)(ws + WS_SSQ1)}; pg8::gemm_phase<pg8::EpiFfn1, pg8::StaticOrder, true, true>(lds, g, S, E); }
    xcd_barrier(bar);
    { pg8::StaticOrder S; pg8::Gemm g{(const bf16*)(ws + WS_H), (const bf16*)(ws + WS_W2T), MP, 1024, FF, FF}; S.init(MP, 1024, G, bx);
      pg8::EpiFfn2 E{a.out, nullptr}; pg8::gemm_phase<pg8::EpiFfn2, pg8::StaticOrder, true, true>(lds, g, S, E); }
    xcd_barrier(bar);
    final_norm_rows(a, bx * NWAVES + wave, G * NWAVES, lane);
}

extern "C" void kernel_launch(void* const* d_in, const int* in_sizes, int n_in, void* d_out, int out_size, void* d_ws, size_t ws_size, hipStream_t stream) {
    static int grid = 0;
    if (grid == 0) {
        if (n_in != 37 || (size_t)out_size != O_END || ws_size < WS_NEED) { fprintf(stderr, "kernel_launch: unexpected problem: n_in %d out %d ws %zu\n", n_in, out_size, ws_size); grid = -1; return; }
        int dev = 0, cus = 0, per_cu = 0;
        if (hipGetDevice(&dev) != hipSuccess || hipDeviceGetAttribute(&cus, hipDeviceAttributeMultiprocessorCount, dev) != hipSuccess) { fprintf(stderr, "kernel_launch: device query failed\n"); grid = -1; return; }
        if (hipFuncSetAttribute((const void*)mega_fwd, hipFuncAttributeMaxDynamicSharedMemorySize, MEGA_LDS) != hipSuccess) { fprintf(stderr, "kernel_launch: hipFuncSetAttribute failed\n"); grid = -1; return; }
        if (hipOccupancyMaxActiveBlocksPerMultiprocessor(&per_cu, (const void*)mega_fwd, NTHR, MEGA_LDS) != hipSuccess || per_cu < 1) { fprintf(stderr, "kernel_launch: occupancy query reports %d workgroups per CU\n", per_cu); (void)hipGetLastError(); per_cu = 1; }
        if (cus != 256) fprintf(stderr, "kernel_launch: built for a 256-CU device (one workgroup per CU); found %d CUs\n", cus);
        grid = 256;
    }
    if (grid < 0) return;
    if (hipMemsetAsync((char*)d_ws + WS_BAR, 0, 16384, stream) != hipSuccess) { fprintf(stderr, "kernel_launch: memset failed\n"); return; }
    Args a{};
    for (int i = 0; i < 37; ++i) a.in[i] = (const float*)d_in[i];
    a.out = (float*)d_out; a.ws = (unsigned char*)d_ws;
    void* args[] = {&a};
    hipError_t e = hipLaunchCooperativeKernel((const void*)mega_fwd, dim3(grid), dim3(NTHR), args, MEGA_LDS, stream);
    if (e != hipSuccess) fprintf(stderr, "kernel_launch: cooperative launch failed: %s (grid %d)\n", hipGetErrorString(e), grid);
}
```

```cpp
#include <hip/hip_runtime.h>
#include <cstdio>
#include <cstdint>

constexpr int DM = 1024, MP = 16384, MS = 128, MTOK = MP + MS, MT = 16640;
constexpr int SEQ = 2048, NB = 8;
constexpr int NPR = 1792, NPM = 1536, NPG = 2048, NPROJ = NPR + NPM + NPG, INCOLS = 5384, GCOL0 = 3328;
constexpr int RH = 8, RN = 64, RW = 512, MH = 4, MD = 128, MW = 512, FF = 4096;
constexpr float RMS_EPS = 1e-6f, R_GN_EPS = 64e-5f, M_GN_EPS = 1e-5f;

constexpr size_t O_Y = 0;
constexpr size_t O_PSHIFT = (size_t)MTOK * DM;
constexpr size_t O_PWKV = O_PSHIFT + (size_t)NB * DM;
constexpr size_t O_PC = O_PWKV + (size_t)NB * RH * RN * RN;
constexpr size_t O_PN = O_PC + (size_t)NB * MH * MD * MD;
constexpr size_t O_PMM = O_PN + (size_t)NB * MH * MD;
constexpr size_t O_PCONV = O_PMM + (size_t)NB * MH;
constexpr size_t O_SSHIFT = O_PCONV + (size_t)NB * 3 * MW;
constexpr size_t O_SWKV = O_SSHIFT + (size_t)MS * DM;
constexpr size_t O_SC = O_SWKV + (size_t)MS * RH * RN * RN;
constexpr size_t O_SN = O_SC + (size_t)MS * MH * MD * MD;
constexpr size_t O_SMM = O_SN + (size_t)MS * MH * MD;
constexpr size_t O_SCONV = O_SMM + (size_t)MS * MH;
constexpr size_t O_END = O_SCONV + (size_t)MS * 3 * MW;
static_assert(O_END == 30695968, "output size");

constexpr size_t MiB = 1u << 20;
constexpr size_t WS_CTL = 0;
constexpr size_t WS_SSQ1 = 0, WS_SSQ2 = 128 * 1024;
constexpr size_t WS_WINT = 1 * MiB, WS_UPRT = 12 * MiB, WS_UPMT = 13 * MiB, WS_WOUTT = 14 * MiB, WS_W1T = 16 * MiB, WS_W2T = 24 * MiB;
constexpr size_t WS_GATES = 32 * MiB;
constexpr size_t WS_WQT = 32 * MiB + 576 * 1024, WS_WKT = 32 * MiB + 704 * 1024;
constexpr size_t WS_LW2T = 576 * 1024, WS_LA2T = 640 * 1024, WS_LG2T = 704 * 1024;
constexpr size_t WS_XN = 33 * MiB;
constexpr size_t WS_YM = 33 * MiB, WS_X2B = 33 * MiB;
constexpr size_t WS_YRM = 33 * MiB;
constexpr size_t WS_YMS = 255 * MiB + 512 * 1024;
constexpr size_t WS_PR = 66 * MiB;
constexpr size_t WS_PM = 123 * MiB;
constexpr size_t WS_PG = 172 * MiB;
constexpr size_t WS_YR = 237 * MiB;
constexpr size_t WS_MERGED = 66 * MiB;
constexpr size_t WS_UPSCR = 100 * MiB;
constexpr size_t WS_H = 66 * MiB;
constexpr size_t WS_NEED = 256 * MiB;
static_assert(WS_YR + (size_t)MT * 512 * 2 <= WS_NEED && WS_H + (size_t)MT * FF * 2 <= WS_NEED && WS_PG + (size_t)MT * NPG * 2 <= WS_YR && WS_UPSCR + (size_t)MT * DM * 4 <= WS_PG, "ws map");

#define GAS __attribute__((address_space(1)))
#define LAS __attribute__((address_space(3)))
typedef unsigned short bf16;
typedef unsigned v4u __attribute__((ext_vector_type(4)));
typedef unsigned v2u __attribute__((ext_vector_type(2)));
typedef float f32x4 __attribute__((ext_vector_type(4)));
typedef float f32x2 __attribute__((ext_vector_type(2)));
__device__ __forceinline__ unsigned f2bf(float f) { unsigned u = __builtin_bit_cast(unsigned, f); return (u + 0x7fffu + ((u >> 16) & 1u)) >> 16; }
__device__ __forceinline__ unsigned pk2(float lo, float hi) { return f2bf(lo) | (f2bf(hi) << 16); }
__device__ __forceinline__ float bf2f(unsigned b) { return __builtin_bit_cast(float, b << 16); }
__device__ __forceinline__ float bflo(unsigned w) { return __builtin_bit_cast(float, w << 16); }
__device__ __forceinline__ float bfhi(unsigned w) { return __builtin_bit_cast(float, w & 0xffff0000u); }
__device__ __forceinline__ float sigmoidf_(float x) { return 1.0f / (1.0f + __expf(-x)); }
__device__ __forceinline__ float wave_sum(float v) {
#pragma unroll
    for (int o = 1; o < 64; o <<= 1) v += __shfl_xor(v, o);
    return v;
}

namespace pg8 {
#define PG8_LAS __attribute__((address_space(3)))
typedef unsigned short bf16_t;
typedef short bf16x8 __attribute__((ext_vector_type(8)));
typedef float f32x4 __attribute__((ext_vector_type(4)));
typedef unsigned u32x4 __attribute__((ext_vector_type(4)));
constexpr int BM = 256, BK = 64, HALF = 128, HTB = HALF * BK * 2  , STAGE_BYTES = 8 * HTB, NXCD = 8, WGM = 8;

__host__ __device__ __forceinline__ int lds_byte(int r, int c) { const int st = (r >> 4) * 2 + (c >> 5), rr = r & 15, cc = c & 31, ob = rr * 64 + cc * 2; return st * 1024 + (ob ^ (((ob >> 9) & 1) << 5)); }
__host__ __device__ __forceinline__ void stage_rc(int b, int& R, int& C) { const int st = b / 1024, sb = b % 1024, swz = sb ^ (((sb >> 9) & 1) << 5); R = (st >> 1) * 16 + swz / 64; C = (st & 1) * 32 + (swz % 64) / 2; }
__host__ __device__ __forceinline__ int perm32(int rho) { const int n = rho >> 4, i = rho & 15; return 8 * (i >> 2) + 4 * n + (i & 3); }

struct Unit { int pm, pn, z; };
struct Gemm { const bf16_t* A; const bf16_t* Bt; int M, N, K, lda, ldb, zoff; };

struct StaticOrder {
    int nM, nN, nwg, G, c;
    __host__ __device__ void init(int M, int N, int G_, int c_) { nM = M / BM; nN = N / BM; nwg = nM * nN; G = G_; c = c_; }
    __host__ __device__ bool next(int i, Unit& u) const {
        const long L = (long)i * G + c; if (L >= nwg) return false;
        int wgid = (int)L; { const int q = nwg / NXCD, r = nwg % NXCD, xcd = wgid % NXCD, off = wgid / NXCD; wgid = (xcd < r ? xcd * (q + 1) : r * (q + 1) + (xcd - r) * q) + off; }
        const int nig = WGM * nN, gid = wgid / nig, fm = gid * WGM, gsz = (nM - fm) < WGM ? (nM - fm) : WGM;
        u.pm = fm + ((wgid % nig) % gsz); u.pn = (wgid % nig) / gsz; u.z = 0; return true;
    }
    __device__ __forceinline__ void a_ready(const Unit&) const {}
    __device__ __forceinline__ void done(const Unit&) const {}
};

struct PairOrder : StaticOrder {
    __host__ __device__ bool next(int i, Unit& u) const { if (i >= 2) return false; const bool ok = StaticOrder::next(0, u); u.z = i; return ok; }
};
__device__ __forceinline__ unsigned cvt_pk_bf16(float lo, float hi) { unsigned r; asm volatile("v_cvt_pk_bf16_f32 %0, %1, %2" : "=v"(r) : "v"(lo), "v"(hi)); return r; }
typedef unsigned u32x2 __attribute__((ext_vector_type(2)));
__device__ __forceinline__ float sigm(float x) { return 1.0f / (1.0f + __expf(-x)); }
__device__ __forceinline__ float bf_lo(unsigned w) { return __builtin_bit_cast(float, w << 16); }
__device__ __forceinline__ float bf_hi(unsigned w) { return __builtin_bit_cast(float, w & 0xffff0000u); }

struct EpiProj {
    static constexpr bool PERM = true, AFTER_DRAIN = false; static constexpr int MIDK = 0;
    bf16_t *PR, *PM, *PG; const float* gate_b; bf16_t* BND;
    __device__ __forceinline__ void operator()(const f32x4 (&acc)[2][2][4][2], const Unit& u, int wr, int wc, int fr, int fq) const {
        int colt = u.pn * BM; bf16_t* base; int ldc; bool gate = false;
        if (colt < 1792) { base = PR; ldc = 1792; } else if (colt < 3328) { base = PM; ldc = 1536; colt -= 1792; } else { base = PG; ldc = 2048; colt -= 3328; gate = true; }
        const int row0 = u.pm * BM + wr * 64 + fr, col0 = colt + wc * 32 + 8 * fq;
        f32x4 bv[2][2];
#pragma unroll
        for (int bj = 0; bj < 2; ++bj)
#pragma unroll
            for (int n = 0; n < 2; ++n) bv[bj][n] = gate ? *(const f32x4*)(gate_b + col0 + bj * HALF + 4 * n) : (f32x4){0.f, 0.f, 0.f, 0.f};
#pragma unroll
        for (int ai = 0; ai < 2; ++ai)
#pragma unroll
            for (int m = 0; m < 4; ++m) { bf16_t* rowp = base + (size_t)(row0 + ai * HALF + m * 16) * ldc + col0;
#pragma unroll
                for (int bj = 0; bj < 2; ++bj) { f32x4 v0 = acc[ai][bj][m][0] + bv[bj][0], v1 = acc[ai][bj][m][1] + bv[bj][1];
                    if (gate) {
#pragma unroll
                        for (int j = 0; j < 4; ++j) { v0[j] = sigm(v0[j]); v1[j] = sigm(v1[j]); } }
                    u32x4 w; w.x = cvt_pk_bf16(v0[0], v0[1]); w.y = cvt_pk_bf16(v0[2], v0[3]); w.z = cvt_pk_bf16(v1[0], v1[1]); w.w = cvt_pk_bf16(v1[2], v1[3]);
                    *(u32x4*)(rowp + bj * HALF) = w;
                    if (m == 3 && fr == 15 && base == PR && u.pm < 64) *(u32x4*)(BND + (size_t)((row0 + ai * HALF + m * 16) >> 6) * 1792 + col0 + bj * HALF) = w; } }
    }
};
struct EpiUp1 {
    static constexpr bool PERM = false, AFTER_DRAIN = false; static constexpr int MIDK = 0;
    float* SCR; const bf16_t* PG;
    __device__ __forceinline__ void operator()(const f32x4 (&acc)[2][2][4][2], const Unit& u, int wr, int wc, int fr, int fq) const {
        const int row0 = u.pm * BM + wr * 64 + fr, col0 = u.pn * BM + wc * 32 + 4 * fq;
#pragma unroll
        for (int ai = 0; ai < 2; ++ai) {
            if (u.pm * BM + ai * HALF >= 16512) continue;
#pragma unroll
            for (int m = 0; m < 4; ++m) { const size_t row = (size_t)(row0 + ai * HALF + m * 16);
#pragma unroll
                for (int bj = 0; bj < 2; ++bj)
#pragma unroll
                    for (int n = 0; n < 2; ++n) { const int c = col0 + bj * HALF + n * 16; const u32x2 g = *(const u32x2*)(PG + row * 2048 + c);
                        f32x4 v = acc[ai][bj][m][n]; v[0] *= bf_lo(g.x); v[1] *= bf_hi(g.x); v[2] *= bf_lo(g.y); v[3] *= bf_hi(g.y);
                        *(f32x4*)(SCR + row * 1024 + c) = v; } } }
    }
};
struct EpiUp2 {
    static constexpr bool PERM = false, AFTER_DRAIN = false; static constexpr int MIDK = 0;
    const float* SCR; const bf16_t* PG; bf16_t* MG;
    __device__ __forceinline__ void operator()(const f32x4 (&acc)[2][2][4][2], const Unit& u, int wr, int wc, int fr, int fq) const {
        const int row0 = u.pm * BM + wr * 64 + fr, col0 = u.pn * BM + wc * 32 + 4 * fq;
#pragma unroll
        for (int ai = 0; ai < 2; ++ai) {
            if (u.pm * BM + ai * HALF >= 16512) continue;
#pragma unroll
            for (int m = 0; m < 4; ++m) { const size_t row = (size_t)(row0 + ai * HALF + m * 16);
#pragma unroll
                for (int bj = 0; bj < 2; ++bj)
#pragma unroll
                    for (int n = 0; n < 2; ++n) { const int c = col0 + bj * HALF + n * 16; const u32x2 g = *(const u32x2*)(PG + row * 2048 + 1024 + c);
                        const f32x4 s = *(const f32x4*)(SCR + row * 1024 + c); f32x4 v = acc[ai][bj][m][n];
                        v[0] = s[0] + v[0] * bf_lo(g.x); v[1] = s[1] + v[1] * bf_hi(g.x); v[2] = s[2] + v[2] * bf_lo(g.y); v[3] = s[3] + v[3] * bf_hi(g.y);
                        u32x2 w; w.x = cvt_pk_bf16(v[0], v[1]); w.y = cvt_pk_bf16(v[2], v[3]); *(u32x2*)(MG + row * 1024 + c) = w; } } }
    }
};
struct EpiUpZ {
    static constexpr bool PERM = false, AFTER_DRAIN = false; static constexpr int MIDK = 0;
    float* SCR; const bf16_t* PG; bf16_t* MG;
    __device__ __forceinline__ void operator()(const f32x4 (&acc)[2][2][4][2], const Unit& u, int wr, int wc, int fr, int fq) const {
        const int row0 = u.pm * BM + wr * 64 + fr, col0 = u.pn * BM + wc * 32 + 4 * fq;
#pragma unroll
        for (int ai = 0; ai < 2; ++ai)
#pragma unroll
            for (int m = 0; m < 4; ++m) { const size_t row = (size_t)(row0 + ai * HALF + m * 16);
#pragma unroll
                for (int bj = 0; bj < 2; ++bj)
#pragma unroll
                    for (int n = 0; n < 2; ++n) { const int c = col0 + bj * HALF + n * 16; const u32x2 g = *(const u32x2*)(PG + row * 2048 + u.z * 1024 + c); f32x4 v = acc[ai][bj][m][n];
                        v[0] *= bf_lo(g.x); v[1] *= bf_hi(g.x); v[2] *= bf_lo(g.y); v[3] *= bf_hi(g.y);
                        if (u.z == 0) *(f32x4*)(SCR + row * 1024 + c) = v;
                        else { v = v + *(const f32x4*)(SCR + row * 1024 + c); u32x2 w; w.x = cvt_pk_bf16(v[0], v[1]); w.y = cvt_pk_bf16(v[2], v[3]); *(u32x2*)(MG + row * 1024 + c) = w; } } }
    }
};
struct EpiOut {
    static constexpr bool PERM = false, AFTER_DRAIN = false; static constexpr int MIDK = 0;
    const float *xp, *xs; float* OUT; bf16_t* X2B; const float* gffn; float* ssq;
    __device__ __forceinline__ void operator()(const f32x4 (&acc)[2][2][4][2], const Unit& u, int wr, int wc, int fr, int fq) const {
        const int row0 = u.pm * BM + wr * 64 + fr, col0 = u.pn * BM + wc * 32 + 4 * fq;
        f32x4 gv[2][2];
#pragma unroll
        for (int bj = 0; bj < 2; ++bj)
#pragma unroll
            for (int n = 0; n < 2; ++n) gv[bj][n] = *(const f32x4*)(gffn + col0 + bj * HALF + n * 16);
#pragma unroll
        for (int ai = 0; ai < 2; ++ai) {
            if (u.pm * BM + ai * HALF >= 16512) continue;
#pragma unroll
            for (int m = 0; m < 4; ++m) { const int row = row0 + ai * HALF + m * 16;
                const float* xin = row < 16384 ? xp + (size_t)row * 1024 : xs + (size_t)(row - 16384) * 1024; float sq = 0.f;
#pragma unroll
                for (int bj = 0; bj < 2; ++bj)
#pragma unroll
                    for (int n = 0; n < 2; ++n) { const int c = col0 + bj * HALF + n * 16; const f32x4 v = *(const f32x4*)(xin + c) + acc[ai][bj][m][n];
                        *(f32x4*)(OUT + (size_t)row * 1024 + c) = v; sq += (v[0] * v[0] + v[1] * v[1]) + (v[2] * v[2] + v[3] * v[3]);
                        const f32x4 h = v * gv[bj][n]; u32x2 w; w.x = cvt_pk_bf16(h[0], h[1]); w.y = cvt_pk_bf16(h[2], h[3]); *(u32x2*)(X2B + (size_t)row * 1024 + c) = w; }
                sq += __shfl_xor(sq, 16); sq += __shfl_xor(sq, 32);
                if (fq == 0) atomicAdd(ssq + row, sq); }
        }
    }
};
struct EpiFfn1 {
    static constexpr bool PERM = true, AFTER_DRAIN = false; static constexpr int MIDK = 0;
    bf16_t* H; const float* ssq;
    __device__ __forceinline__ void operator()(const f32x4 (&acc)[2][2][4][2], const Unit& u, int wr, int wc, int fr, int fq) const {
        const int row0 = u.pm * BM + wr * 64 + fr, col0 = u.pn * BM + wc * 32 + 8 * fq;
#pragma unroll
        for (int ai = 0; ai < 2; ++ai)
#pragma unroll
            for (int m = 0; m < 4; ++m) { const int row = row0 + ai * HALF + m * 16; const float rs = rsqrtf(ssq[row] * (1.0f / 1024.0f) + 1e-6f);
                bf16_t* rowp = H + (size_t)row * 4096 + col0;
#pragma unroll
                for (int bj = 0; bj < 2; ++bj) { f32x4 v0 = acc[ai][bj][m][0] * rs, v1 = acc[ai][bj][m][1] * rs;
#pragma unroll
                    for (int j = 0; j < 4; ++j) { const float a = fmaxf(v0[j], 0.f), b = fmaxf(v1[j], 0.f); v0[j] = a * a; v1[j] = b * b; }
                    u32x4 w; w.x = cvt_pk_bf16(v0[0], v0[1]); w.y = cvt_pk_bf16(v0[2], v0[3]); w.z = cvt_pk_bf16(v1[0], v1[1]); w.w = cvt_pk_bf16(v1[2], v1[3]);
                    *(u32x4*)(rowp + bj * HALF) = w; } }
    }
};
struct EpiFfn2 {
    static constexpr bool PERM = false, AFTER_DRAIN = false; static constexpr int MIDK = 0;
    float* OUT; float* ssq;
    __device__ __forceinline__ void operator()(const f32x4 (&acc)[2][2][4][2], const Unit& u, int wr, int wc, int fr, int fq) const {
        const int row0 = u.pm * BM + wr * 64 + fr, col0 = u.pn * BM + wc * 32 + 4 * fq;
#pragma unroll
        for (int ai = 0; ai < 2; ++ai) {
            if (u.pm * BM + ai * HALF >= 16512) continue;
#pragma unroll
            for (int m = 0; m < 4; ++m) { const int row = row0 + ai * HALF + m * 16; float sq = 0.f;
#pragma unroll
                for (int bj = 0; bj < 2; ++bj)
#pragma unroll
                    for (int n = 0; n < 2; ++n) { float* p = OUT + (size_t)row * 1024 + col0 + bj * HALF + n * 16; const f32x4 v = *(const f32x4*)p + acc[ai][bj][m][n];
                        *(f32x4*)p = v; }
                (void)sq; }
        }
    }
};

template <class Epi, class Sched, bool ALIGN_EPI = false, bool SP2 = false>
__device__ __forceinline__ void gemm_phase(PG8_LAS unsigned char* lds, const Gemm g, const Sched& S, const Epi& E) {
    int tid_ = threadIdx.x; asm volatile("" : "+v"(tid_));
    const int tid = tid_, wid = __builtin_amdgcn_readfirstlane(tid >> 6), lane = tid & 63, wr = wid >> 2, wc = wid & 3, fr = lane & 15, fq = lane >> 4;
    const int K = g.K, nt = K / BK;
    unsigned voffA[2], voffB[2];
#pragma unroll
    for (int i = 0; i < 2; ++i) { int R, C; stage_rc(tid * 16 + i * 8192, R, C); const int Rb = Epi::PERM ? ((R & ~31) + perm32(R & 31)) : R;
        voffA[i] = (unsigned)(R * g.lda + C) * 2u; voffB[i] = (unsigned)(Rb * g.ldb + C) * 2u; }
    const size_t kstep = (size_t)(BK * 2);
    const size_t hstep = (size_t)HALF * g.ldb * 2;
    const size_t tstep = 2 * hstep;
    const size_t hstepA = (size_t)HALF * g.lda * 2, tstepA = 2 * hstepA;
    const unsigned ldsw = (unsigned)wid * 1024u;
    const int aoff = lds_byte(wr * 64 + fr, fq * 8), boff = lds_byte(wc * 32 + fr, fq * 8);
#define PG8_SA(b, h) (((b) * 2 + (h)) * HTB)
#define PG8_SB(b, h) ((4 + (b) * 2 + (h)) * HTB)
#define PG8_STAGE(bufoff, gbase, voff) do { _Pragma("unroll") for (int _i = 0; _i < 2; ++_i) \
        __builtin_amdgcn_global_load_lds((const unsigned*)((const char*)(gbase) + (voff)[_i]), (PG8_LAS unsigned*)(lds + (bufoff) + ldsw + _i * 8192), 16, 0, 0); } while (0)
#define PG8_LDA(dst, b, h) do { _Pragma("unroll") for (int m = 0; m < 4; ++m) _Pragma("unroll") for (int k = 0; k < 2; ++k) dst[m][k] = *(const PG8_LAS bf16x8*)(lds + PG8_SA(b, h) + aoff + m * 2048 + k * 1024); } while (0)
#define PG8_LDB(dst, b, h) do { _Pragma("unroll") for (int n = 0; n < 2; ++n) _Pragma("unroll") for (int k = 0; k < 2; ++k) dst[n][k] = *(const PG8_LAS bf16x8*)(lds + PG8_SB(b, h) + boff + n * 2048 + k * 1024); } while (0)
#define PG8_MMA(ai, bj, At, Bt) do { __builtin_amdgcn_s_setprio(1); _Pragma("unroll") for (int m = 0; m < 4; ++m) _Pragma("unroll") for (int n = 0; n < 2; ++n) _Pragma("unroll") for (int k = 0; k < 2; ++k) \
        acc[ai][bj][m][n] = __builtin_amdgcn_mfma_f32_16x16x32_bf16(Bt[n][k], At[m][k], acc[ai][bj][m][n], 0, 0, 0); __builtin_amdgcn_s_setprio(0); } while (0)
#define PG8_WAIT_V(n) asm volatile("s_waitcnt vmcnt(" #n ")" ::: "memory")
#define PG8_WAIT_L(n) asm volatile("s_waitcnt lgkmcnt(" #n ")" ::: "memory")
#define PG8_BAR __builtin_amdgcn_s_barrier()
#define PG8_SCHED __builtin_amdgcn_sched_barrier(0)
    Unit cur, nxt; int ui = 0;
    if (!S.next(0, cur)) return;
    f32x4 acc[2][2][4][2];
#pragma unroll
    for (int a = 0; a < 2; ++a)
#pragma unroll
        for (int b = 0; b < 2; ++b)
#pragma unroll
            for (int m = 0; m < 4; ++m)
#pragma unroll
                for (int n = 0; n < 2; ++n) acc[a][b][m][n] = (f32x4){0.f, 0.f, 0.f, 0.f};
    bf16x8 At[4][2], B0[2][2], B1[2][2];
    const size_t zb = (size_t)g.zoff * 2;
    const char* cA = (const char*)g.A + (size_t)cur.pm * tstepA + cur.z * zb; const char* cB = (const char*)g.Bt + (size_t)cur.pn * tstep + cur.z * zb;
    S.a_ready(cur);
    if constexpr (SP2) {
        PG8_STAGE(PG8_SB(0, 0), cB, voffB); PG8_STAGE(PG8_SB(0, 1), cB + hstep, voffB); PG8_STAGE(PG8_SA(0, 0), cA, voffA); PG8_STAGE(PG8_SA(0, 1), cA + hstepA, voffA);
        if (wr == 1) PG8_BAR;
        PG8_WAIT_V(2); PG8_BAR;
        PG8_STAGE(PG8_SB(1, 0), cB + kstep, voffB); PG8_STAGE(PG8_SA(1, 0), cA + kstep, voffA); PG8_STAGE(PG8_SB(1, 1), cB + hstep + kstep, voffB);
        PG8_WAIT_V(6); PG8_BAR;
    } else {
        PG8_STAGE(PG8_SB(0, 0), cB, voffB); PG8_STAGE(PG8_SA(0, 0), cA, voffA); PG8_STAGE(PG8_SB(0, 1), cB + hstep, voffB); PG8_STAGE(PG8_SA(0, 1), cA + hstepA, voffA);
        if (wr == 1) PG8_BAR;
        PG8_WAIT_V(4); PG8_BAR;
        PG8_STAGE(PG8_SB(1, 0), cB + kstep, voffB); PG8_STAGE(PG8_SA(1, 0), cA + kstep, voffA); PG8_STAGE(PG8_SB(1, 1), cB + hstep + kstep, voffB);
        PG8_WAIT_V(6); PG8_BAR;
    }
    for (;;) {
        const bool has_next = S.next(ui + 1, nxt);
        const char* nA = has_next ? (const char*)g.A + (size_t)nxt.pm * tstepA + nxt.z * zb : cA; const char* nB = has_next ? (const char*)g.Bt + (size_t)nxt.pn * tstep + nxt.z * zb : cB;
        for (int t = 0; t < nt; t += 2) {
            const bool last = (t == nt - 2);
            const char* a1 = cA + (size_t)(t + 1) * kstep;
            const char* a2 = last ? nA : cA + (size_t)(t + 2) * kstep; const char* b2 = last ? nB : cB + (size_t)(t + 2) * kstep;
            const char* a3 = a2 + kstep; const char* b3 = b2 + kstep;
            if (last && has_next) S.a_ready(nxt);
            if constexpr (SP2) {
            PG8_LDB(B0, 0, 0); PG8_LDB(B1, 0, 1); PG8_SCHED; PG8_LDA(At, 0, 0); PG8_STAGE(PG8_SA(1, 1), a1 + hstepA, voffA);
            PG8_WAIT_V(8); PG8_WAIT_L(0); PG8_BAR; PG8_MMA(0, 0, At, B0); PG8_MMA(0, 1, At, B1); PG8_BAR; PG8_SCHED;
            PG8_LDA(At, 0, 1); PG8_STAGE(PG8_SB(0, 0), b2, voffB); PG8_STAGE(PG8_SB(0, 1), b2 + hstep, voffB); PG8_STAGE(PG8_SA(0, 0), a2, voffA);
            PG8_WAIT_V(8); PG8_WAIT_L(0); PG8_BAR; PG8_MMA(1, 0, At, B0); PG8_MMA(1, 1, At, B1); PG8_BAR; PG8_SCHED;
            PG8_LDB(B0, 1, 0); PG8_LDB(B1, 1, 1); PG8_SCHED; PG8_LDA(At, 1, 0); PG8_STAGE(PG8_SA(0, 1), a2 + hstepA, voffA);
            PG8_WAIT_V(8); PG8_WAIT_L(0); PG8_BAR; PG8_MMA(0, 0, At, B0); PG8_MMA(0, 1, At, B1); PG8_BAR; PG8_SCHED;
            PG8_LDA(At, 1, 1); PG8_STAGE(PG8_SB(1, 0), b3, voffB); PG8_STAGE(PG8_SB(1, 1), b3 + hstep, voffB); PG8_STAGE(PG8_SA(1, 0), a3, voffA);
            PG8_WAIT_V(8); PG8_WAIT_L(0); PG8_BAR; PG8_MMA(1, 0, At, B0); PG8_MMA(1, 1, At, B1); PG8_BAR; PG8_SCHED;
            } else {
            PG8_LDB(B0, 0, 0); PG8_SCHED; PG8_LDA(At, 0, 0); PG8_STAGE(PG8_SA(1, 1), a1 + hstepA, voffA);
            PG8_WAIT_L(8); PG8_BAR; PG8_WAIT_L(0); PG8_MMA(0, 0, At, B0); PG8_BAR; PG8_SCHED;
            PG8_LDB(B1, 0, 1); PG8_STAGE(PG8_SB(0, 0), b2, voffB);
            PG8_BAR; PG8_WAIT_L(0); PG8_MMA(0, 1, At, B1); PG8_BAR;
            PG8_LDA(At, 0, 1); PG8_STAGE(PG8_SA(0, 0), a2, voffA);
            PG8_BAR; PG8_WAIT_L(0); PG8_MMA(1, 0, At, B0); PG8_BAR; PG8_SCHED;
            PG8_STAGE(PG8_SB(0, 1), b2 + hstep, voffB);
            PG8_WAIT_V(6); PG8_BAR; PG8_MMA(1, 1, At, B1); PG8_BAR;
            PG8_LDB(B0, 1, 0); PG8_SCHED; PG8_LDA(At, 1, 0); PG8_STAGE(PG8_SA(0, 1), a2 + hstepA, voffA);
            PG8_WAIT_L(8); PG8_BAR; PG8_WAIT_L(0); PG8_MMA(0, 0, At, B0); PG8_BAR; PG8_SCHED;
            PG8_LDB(B1, 1, 1); PG8_STAGE(PG8_SB(1, 0), b3, voffB);
            PG8_BAR; PG8_WAIT_L(0); PG8_MMA(0, 1, At, B1); PG8_BAR;
            PG8_LDA(At, 1, 1); PG8_STAGE(PG8_SA(1, 0), a3, voffA);
            PG8_BAR; PG8_WAIT_L(0); PG8_MMA(1, 0, At, B0); PG8_BAR; PG8_SCHED;
            PG8_STAGE(PG8_SB(1, 1), b3 + hstep, voffB);
            PG8_WAIT_V(6); PG8_BAR; PG8_MMA(1, 1, At, B1); PG8_BAR;
            }
        }
        if constexpr (ALIGN_EPI) { if (wr == 0) PG8_BAR; }
        if constexpr (!Epi::AFTER_DRAIN) { E(acc, cur, wr, wc, fr, fq); S.done(cur); }
        if (!has_next) break;
#pragma unroll
        for (int a = 0; a < 2; ++a)
#pragma unroll
            for (int b = 0; b < 2; ++b)
#pragma unroll
                for (int m = 0; m < 4; ++m)
#pragma unroll
                    for (int n = 0; n < 2; ++n) acc[a][b][m][n] = (f32x4){0.f, 0.f, 0.f, 0.f};
        cur = nxt; cA = nA; cB = nB; ++ui;
        if constexpr (ALIGN_EPI) { if (wr == 1) PG8_BAR; }
    }
    PG8_WAIT_V(0);
    if constexpr (!ALIGN_EPI) { if (wr == 0) PG8_BAR; }
    PG8_BAR;
    if constexpr (Epi::AFTER_DRAIN) { E.fused(acc, cur, wr, wc, fr, fq, lds, wid, lane); S.done(cur); }
#undef PG8_SA
#undef PG8_SB
#undef PG8_STAGE
#undef PG8_LDA
#undef PG8_LDB
#undef PG8_MMA
#undef PG8_WAIT_V
#undef PG8_WAIT_L
#undef PG8_BAR
#undef PG8_SCHED
}
}

struct Args {
    const float* in[37];
    float* out; unsigned char* ws;
};
constexpr int NWAVES = 8, NTHR = 512;
constexpr int GEMM_LDS = 131072;

#define LDS_WAIT() asm volatile("s_waitcnt lgkmcnt(0)" ::: "memory")

__device__ __forceinline__ void transpose_item(const float* W, int ldw, int nblk, bf16* WT, int ldt, int item, LAS float* scr, int lane, float sc = 1.0f) {
    const int kb = item / nblk, nb = item % nblk, k0 = 64 * kb, n0 = 32 * nb;
#pragma unroll 8
    for (int i = 0; i < 32; ++i) { const int kk = 2 * i + (lane >> 5); scr[kk * 33 + (lane & 31)] = W[(size_t)(k0 + kk) * ldw + n0 + (lane & 31)]; }
    LDS_WAIT(); asm volatile("" ::: "memory");
    const int c = lane & 7;
#pragma unroll
    for (int j = 0; j < 4; ++j) { const int n = (lane >> 3) + 8 * j; const LAS float* s = scr + (8 * c) * 33 + n;
        v4u o; o.x = pk2(s[0 * 33] * sc, s[1 * 33] * sc); o.y = pk2(s[2 * 33] * sc, s[3 * 33] * sc); o.z = pk2(s[4 * 33] * sc, s[5 * 33] * sc); o.w = pk2(s[6 * 33] * sc, s[7 * 33] * sc);
        *(v4u*)(WT + (size_t)(n0 + n) * ldt + k0 + 8 * c) = o; }
    LDS_WAIT(); asm volatile("" ::: "memory");
}

__device__ __forceinline__ void ffn_weights_convert(const Args& a, int wi, int nw, LAS float* scr, int lane) {
    for (int it = wi; it < 4096; it += nw) {
        if (it < 2048) transpose_item(a.in[34], 4096, 128, (bf16*)(a.ws + WS_W1T), 1024, it, scr, lane);
        else transpose_item(a.in[35], 1024, 32, (bf16*)(a.ws + WS_W2T), 4096, it - 2048, scr, lane); }
}
constexpr int P0_LDS = 8 * 64 * 33 * 4 + 8 * 1024 * 4;
__device__ __forceinline__ void p0_prologue(const Args& a, LAS unsigned char* lds, int gw, int NGW, int lane, int wave) {
    unsigned char* ws = a.ws;
    LAS float* scr = (LAS float*)(lds) + wave * (64 * 33);
    LAS float* wg = (LAS float*)(lds + 8 * 64 * 33 * 4);
    const float* w_in = a.in[9];
    for (int i = threadIdx.x; i < 8 * 1024; i += NTHR) { const int k = i >> 3, c = i & 7; wg[c * 1024 + k] = w_in[(size_t)k * INCOLS + GCOL0 + c]; }
    { float* z = (float*)(ws + WS_CTL); for (int i = gw * 64 + lane; i < 65536; i += NGW * 64) z[i] = 0.f; }
    constexpr int I_IN1 = 16 * (3328 / 32), I_IN2 = 16 * (2048 / 32), I_UP = 8 * 32, I_OUT = 16 * 32, I_F1 = 16 * 128, I_F2 = 64 * 32;
    constexpr int I_QK = 8 * 8;
    constexpr int I_LW = 16, I_LG = 32;
    constexpr int NITEMS = I_IN1 + I_IN2 + 2 * I_UP + I_OUT + I_F1 + I_F2 + I_QK + 2 * I_LW + I_LG;
    for (int it = gw; it < NITEMS; it += NGW) {
        int r = it;
        if (r < I_IN1) { transpose_item(w_in, INCOLS, 3328 / 32, (bf16*)(ws + WS_WINT), 1024, r, scr, lane); continue; } r -= I_IN1;
        if (r < I_IN2) { transpose_item(w_in + 3336, INCOLS, 2048 / 32, (bf16*)(ws + WS_WINT) + (size_t)3328 * 1024, 1024, r, scr, lane); continue; } r -= I_IN2;
        if (r < I_UP) { transpose_item(a.in[21], 1024, 32, (bf16*)(ws + WS_UPRT), 1024, r, scr, lane); continue; } r -= I_UP;
        if (r < I_UP) { transpose_item(a.in[30], 1024, 32, (bf16*)(ws + WS_UPRT) + 512, 1024, r, scr, lane); continue; } r -= I_UP;
        if (r < I_OUT) { transpose_item(a.in[32], 1024, 32, (bf16*)(ws + WS_WOUTT), 1024, r, scr, lane); continue; } r -= I_OUT;
        if (r < I_F1 + I_F2) continue;
        r -= I_F1 + I_F2;
        if (r >= I_QK) { r -= I_QK;
            if (r < I_LW) { transpose_item(a.in[12], 512, 16, (bf16*)(ws + WS_LW2T), 64, r, scr, lane); continue; } r -= I_LW;
            if (r < I_LW) { transpose_item(a.in[14], 512, 16, (bf16*)(ws + WS_LA2T), 64, r, scr, lane); continue; } r -= I_LW;
            transpose_item(a.in[15], 512, 16, (bf16*)(ws + WS_LG2T), 128, r, scr, lane); continue; }
        { const int mat = r >> 3, hq = mat & 3, isk = mat >> 2;
          transpose_item((isk ? a.in[25] : a.in[24]) + (size_t)hq * 16384, 128, 4, (bf16*)(ws + (isk ? WS_WKT : WS_WQT)) + (size_t)hq * 16384, 128, r & 7, scr, lane, isk ? 1.0f : 0.08838834764831845f); }
    }
    __syncthreads();
    const float* gmix = a.in[8];
    f32x4 gv[4];
#pragma unroll
    for (int j = 0; j < 4; ++j) gv[j] = ((const f32x4*)gmix)[lane + 64 * j];
    bf16* XN = (bf16*)(ws + WS_XN); float* GATES = (float*)(ws + WS_GATES);
    for (int row = gw; row < MT; row += NGW) {
        unsigned long long* o8 = (unsigned long long*)(XN + (size_t)row * 1024) + lane;
        if (row >= MTOK) {
            const f32x4* xr = (const f32x4*)(a.in[2] + (size_t)(row - MTOK) * 1024) + lane;
#pragma unroll
            for (int j = 0; j < 4; ++j) { const f32x4 v = xr[64 * j]; o8[64 * j] = (unsigned long long)pk2(v.x, v.y) | ((unsigned long long)pk2(v.z, v.w) << 32); }
            continue;
        }
        const f32x4* xr = (const f32x4*)(row < MP ? a.in[0] + (size_t)row * 1024 : a.in[1] + (size_t)(row - MP) * 1024) + lane;
        f32x4 v[4]; float s = 0.f;
#pragma unroll
        for (int j = 0; j < 4; ++j) { v[j] = xr[64 * j]; s += (v[j].x * v[j].x + v[j].y * v[j].y) + (v[j].z * v[j].z + v[j].w * v[j].w); }
        const float rstd = rsqrtf(wave_sum(s) * (1.f / 1024.f) + RMS_EPS);
#pragma unroll
        for (int j = 0; j < 4; ++j) { v[j] = v[j] * rstd * gv[j]; o8[64 * j] = (unsigned long long)pk2(v[j].x, v[j].y) | ((unsigned long long)pk2(v[j].z, v[j].w) << 32); }
        float gsum[8];
#pragma unroll
        for (int c = 0; c < 8; ++c) { float p = 0.f;
#pragma unroll
            for (int j = 0; j < 4; ++j) { const f32x4 w = *(const LAS f32x4*)(wg + c * 1024 + 4 * (lane + 64 * j)); p += (v[j].x * w.x + v[j].y * w.y) + (v[j].z * w.z + v[j].w * w.w); }
            gsum[c] = wave_sum(p); }
        if (lane < 8) { float g = gsum[0];
#pragma unroll
            for (int c = 1; c < 8; ++c) g = (lane == c) ? gsum[c] : g;
            GATES[(size_t)row * 8 + lane] = g; }
        float* so = nullptr;
        if (row >= MP) so = a.out + O_SSHIFT + (size_t)(row - MP) * 1024;
        else if ((row & (SEQ - 1)) == SEQ - 1) so = a.out + O_PSHIFT + (size_t)(row >> 11) * 1024;
        if (so) {
#pragma unroll
            for (int j = 0; j < 4; ++j) ((f32x4*)so)[lane + 64 * j] = v[j]; }
    }
}

constexpr int RCH = 16;
constexpr int RWKV_LDS = (RCH * 256 + 8 * RCH * 64 + RCH) * 4;
__device__ __forceinline__ void rwkv_seq_item(const Args& a, LAS unsigned char* ldsb0, int item0) {
    const int tid = threadIdx.x & 255, lane = tid & 63, wv = tid >> 6; const int item = item0 + (threadIdx.x >> 8);
    LAS unsigned char* ldsb = ldsb0 + (threadIdx.x >> 8) * RWKV_LDS;
    const bf16* PR = (const bf16*)(a.ws + WS_PR); bf16* YR = (bf16*)(a.ws + WS_PR);
    const float *mu = a.in[10], *w0 = a.in[11], *w2 = a.in[12], *a0 = a.in[13], *a2 = a.in[14], *g2 = a.in[15], *rkk = a.in[16], *rka = a.in[17], *rrk = a.in[18], *gnw = a.in[19], *gnb = a.in[20];
    int T, row0, h, prevrow0; const float* S0 = nullptr; float* Sout;
    if (item < 64) { const int b = item >> 3; h = item & 7; T = SEQ; row0 = b * SEQ; prevrow0 = -1; Sout = a.out + O_PWKV + (size_t)item * 4096; }
    else { const int sb = (item - 64) >> 3; h = (item - 64) & 7; T = 1; row0 = MP + sb; prevrow0 = MTOK + sb; S0 = a.in[3] + (size_t)(item - 64) * 4096; Sout = a.out + O_SWKV + (size_t)(item - 64) * 4096; }
    const int hc = h * 64;
    LAS float* MIXW = (LAS float*)ldsb;
    LAS float* MIXA = MIXW + RCH * 64;
    LAS float* MIXG = MIXA + RCH * 64;
    LAS float* Rb = MIXG + RCH * 128;
    LAS float* Kb = Rb + RCH * 64;
    LAS float* Vb = Kb + RCH * 64;
    LAS float* Wb = Vb + RCH * 64;
    LAS float* KKb = Wb + RCH * 64;
    LAS float* Bb = KKb + RCH * 64;
    LAS float* Gb = Bb + RCH * 64;
    LAS float* Yb = Gb + RCH * 64;
    LAS float* BON = Yb + RCH * 64;
    const int sv = tid >> 2, kq = tid & 3;
    float S[16];
    if (S0) {
#pragma unroll
        for (int i = 0; i < 4; ++i) { const f32x4 t = *(const f32x4*)(S0 + sv * 64 + 16 * kq + 4 * i); S[4 * i] = t.x; S[4 * i + 1] = t.y; S[4 * i + 2] = t.z; S[4 * i + 3] = t.w; }
    } else {
#pragma unroll
        for (int i = 0; i < 16; ++i) S[i] = 0.f;
    }
    const int j = lane;
    const float w0j = w0[hc + j], a0j = a0[hc + j], rkkj = rkk[hc + j], rkaj = rka[hc + j], rrkj = rrk[hc + j], gnwj = gnw[hc + j], gnbj = gnb[hc + j];
    for (int t0 = 0; t0 < T; t0 += RCH) {
        const int nt = (T - t0) < RCH ? (T - t0) : RCH;
        for (int it = tid; it < nt * 56; it += 256) {
            const int t = it / 56, g = it % 56;
            int col; LAS float* dst; int kind;
            if (g < 8) { col = hc + 8 * g; dst = Rb + t * 64 + 8 * g; kind = 0; }
            else if (g < 16) { col = 512 + hc + 8 * (g - 8); dst = Kb + t * 64 + 8 * (g - 8); kind = 0; }
            else if (g < 24) { col = 1024 + hc + 8 * (g - 16); dst = Vb + t * 64 + 8 * (g - 16); kind = 0; }
            else if (g < 32) { col = 1536 + 8 * (g - 24); dst = MIXW + t * 64 + 8 * (g - 24); kind = 1; }
            else if (g < 40) { col = 1600 + 8 * (g - 32); dst = MIXA + t * 64 + 8 * (g - 32); kind = 0; }
            else { col = 1664 + 8 * (g - 40); dst = MIXG + t * 128 + 8 * (g - 40); kind = 2; }
            const int tg = t0 + t;
            const v4u cur = *(const v4u*)(PR + (size_t)(row0 + tg) * NPR + col);
            v4u prv = (v4u){0u, 0u, 0u, 0u};
            if (tg > 0) prv = *(const v4u*)(PR + (size_t)(row0 + tg - 1) * NPR + col);
            else if (prevrow0 >= 0) prv = *(const v4u*)(PR + (size_t)prevrow0 * NPR + col);
            const f32x4 m0 = *(const f32x4*)(mu + col), m1 = *(const f32x4*)(mu + col + 4);
            float c[8], p[8], mm[8] = {m0.x, m0.y, m0.z, m0.w, m1.x, m1.y, m1.z, m1.w};
            c[0] = bflo(cur.x); c[1] = bfhi(cur.x); c[2] = bflo(cur.y); c[3] = bfhi(cur.y); c[4] = bflo(cur.z); c[5] = bfhi(cur.z); c[6] = bflo(cur.w); c[7] = bfhi(cur.w);
            p[0] = bflo(prv.x); p[1] = bfhi(prv.x); p[2] = bflo(prv.y); p[3] = bfhi(prv.y); p[4] = bflo(prv.z); p[5] = bfhi(prv.z); p[6] = bflo(prv.w); p[7] = bfhi(prv.w);
#pragma unroll
            for (int i = 0; i < 8; ++i) { float m = c[i] + (p[i] - c[i]) * mm[i]; if (kind == 1) m = tanhf(m); else if (kind == 2) m = sigmoidf_(m); dst[i] = m; }
        }
        __syncthreads();
        float accw[RCH / 4], acca[RCH / 4], accg[RCH / 4];
#pragma unroll
        for (int i = 0; i < RCH / 4; ++i) { accw[i] = 0.f; acca[i] = 0.f; accg[i] = 0.f; }
        for (int i4 = 0; i4 < 16; ++i4) {
            float wv4[4], av4[4];
#pragma unroll
            for (int q = 0; q < 4; ++q) { wv4[q] = w2[(size_t)(4 * i4 + q) * 512 + hc + j]; av4[q] = a2[(size_t)(4 * i4 + q) * 512 + hc + j]; }
#pragma unroll
            for (int tt = 0; tt < RCH / 4; ++tt) { const int t = wv + 4 * tt; if (t < nt) {
                const f32x4 xw = *(const LAS f32x4*)(MIXW + t * 64 + 4 * i4), xa = *(const LAS f32x4*)(MIXA + t * 64 + 4 * i4);
                accw[tt] += (xw.x * wv4[0] + xw.y * wv4[1]) + (xw.z * wv4[2] + xw.w * wv4[3]);
                acca[tt] += (xa.x * av4[0] + xa.y * av4[1]) + (xa.z * av4[2] + xa.w * av4[3]); } }
        }
        for (int i4 = 0; i4 < 32; ++i4) {
            float gv4[4];
#pragma unroll
            for (int q = 0; q < 4; ++q) gv4[q] = g2[(size_t)(4 * i4 + q) * 512 + hc + j];
#pragma unroll
            for (int tt = 0; tt < RCH / 4; ++tt) { const int t = wv + 4 * tt; if (t < nt) {
                const f32x4 xg = *(const LAS f32x4*)(MIXG + t * 128 + 4 * i4);
                accg[tt] += (xg.x * gv4[0] + xg.y * gv4[1]) + (xg.z * gv4[2] + xg.w * gv4[3]); } }
        }
#pragma unroll
        for (int tt = 0; tt < RCH / 4; ++tt) { const int t = wv + 4 * tt; if (t < nt) {
            const float wl = w0j + accw[tt]; const float sg = 1.0f / (1.0f + expf(-wl));
            const float dec = expf(-0.6065306597126334f * sg);
            const float aa = 1.0f / (1.0f + expf(-(a0j + acca[tt])));
            const float kraw = Kb[t * 64 + j]; const float kkr = kraw * rkkj;
            const float ss = wave_sum(kkr * kkr); const float kk = kkr / fmaxf(sqrtf(ss), 1e-12f);
            const float k2 = kraw * (1.0f + (aa - 1.0f) * rkaj);
            const float bon = wave_sum(Rb[t * 64 + j] * k2 * rrkj);
            Wb[t * 64 + j] = dec; KKb[t * 64 + j] = kk; Bb[t * 64 + j] = kk * aa; Kb[t * 64 + j] = k2; Gb[t * 64 + j] = accg[tt];
            if (j == 0) BON[t] = bon; } }
        __syncthreads();
        for (int t = 0; t < nt; ++t) {
            float kk[16], p = 0.f;
#pragma unroll
            for (int i = 0; i < 4; ++i) { const f32x4 x = *(const LAS f32x4*)(KKb + t * 64 + 16 * kq + 4 * i); kk[4 * i] = x.x; kk[4 * i + 1] = x.y; kk[4 * i + 2] = x.z; kk[4 * i + 3] = x.w; }
#pragma unroll
            for (int i = 0; i < 16; ++i) p += S[i] * kk[i];
            p += __shfl_xor(p, 1); p += __shfl_xor(p, 2);
            const float vv = Vb[t * 64 + sv]; float y = 0.f;
#pragma unroll
            for (int i = 0; i < 4; ++i) {
                const f32x4 w = *(const LAS f32x4*)(Wb + t * 64 + 16 * kq + 4 * i), bb = *(const LAS f32x4*)(Bb + t * 64 + 16 * kq + 4 * i), k2 = *(const LAS f32x4*)(Kb + t * 64 + 16 * kq + 4 * i), r = *(const LAS f32x4*)(Rb + t * 64 + 16 * kq + 4 * i);
                S[4 * i + 0] = S[4 * i + 0] * w.x - p * bb.x + vv * k2.x; y += S[4 * i + 0] * r.x;
                S[4 * i + 1] = S[4 * i + 1] * w.y - p * bb.y + vv * k2.y; y += S[4 * i + 1] * r.y;
                S[4 * i + 2] = S[4 * i + 2] * w.z - p * bb.z + vv * k2.z; y += S[4 * i + 2] * r.z;
                S[4 * i + 3] = S[4 * i + 3] * w.w - p * bb.w + vv * k2.w; y += S[4 * i + 3] * r.w;
            }
            y += __shfl_xor(y, 1); y += __shfl_xor(y, 2);
            if (kq == 0) Yb[t * 64 + sv] = y;
        }
        __syncthreads();
#pragma unroll
        for (int tt = 0; tt < RCH / 4; ++tt) { const int t = wv + 4 * tt; if (t < nt) {
            const float y = Yb[t * 64 + j]; const float mean = wave_sum(y) * (1.0f / 64.0f); const float d = y - mean; const float var = wave_sum(d * d) * (1.0f / 64.0f);
            float o = d * rsqrtf(var + R_GN_EPS) * gnwj + gnbj; o += BON[t] * Vb[t * 64 + j]; o *= Gb[t * 64 + j];
            YR[(size_t)(row0 + t0 + t) * NPR + hc + j] = (bf16)f2bf(o); } }
        __syncthreads();
    }
#pragma unroll
    for (int i = 0; i < 4; ++i) *(f32x4*)(Sout + sv * 64 + 16 * kq + 4 * i) = (f32x4){S[4 * i], S[4 * i + 1], S[4 * i + 2], S[4 * i + 3]};
}

constexpr int MCH = 16;
constexpr int MLSTM_LDS = ((MCH + 3) * 128 + 5 * MCH * 128 + MCH * 4 * 128 + 8 * MCH) * 4;
__device__ __forceinline__ void mlstm_seq_item(const Args& a, LAS unsigned char* ldsb, int item) {
    const int tid = threadIdx.x, lane = tid & 63, wv = tid >> 6;
    const bf16* PM = (const bf16*)(a.ws + WS_PM); bf16* YM = item < 32 ? (bf16*)(a.ws + WS_YM) : (bf16*)(a.ws + WS_YMS) - (size_t)MP * 512; const float* GATES = (const float*)(a.ws + WS_GATES);
    const float *convw = a.in[22], *convb = a.in[23], *wq = a.in[24], *wk = a.in[25], *ib = a.in[26], *fb = a.in[27], *gnw = a.in[28], *skip = a.in[29];
    int T, row0, h, sb = -1; float *Cout, *nout, *mout, *convout;
    if (item < 32) { const int b = item >> 2; h = item & 3; T = SEQ; row0 = b * SEQ; Cout = a.out + O_PC + (size_t)item * 16384; nout = a.out + O_PN + (size_t)item * 128; mout = a.out + O_PMM + item; convout = a.out + O_PCONV + (size_t)b * 3 * 512 + h * 128; }
    else { const int it2 = item - 32; sb = it2 >> 2; h = it2 & 3; T = 1; row0 = MP + sb; Cout = a.out + O_SC + (size_t)it2 * 16384; nout = a.out + O_SN + (size_t)it2 * 128; mout = a.out + O_SMM + it2; convout = a.out + O_SCONV + (size_t)sb * 3 * 512 + h * 128; }
    const int hc = h * 128;
    LAS float* XMW = (LAS float*)ldsb;
    LAS float* XC = XMW + (MCH + 3) * 128;
    LAS float* Qb = XC + MCH * 128;
    LAS float* Kb = Qb + MCH * 128;
    LAS float* Vb = Kb + MCH * 128;
    LAS float* Ob = Vb + MCH * 128;
    LAS float* HP = Ob + MCH * 128;
    LAS float* FS = HP + MCH * 512;
    LAS float* IS = FS + MCH;
    LAS float* EM = IS + MCH;
    LAS float* DEN = EM + MCH;
    LAS float* MST = DEN + 2 * MCH;
    const int e = tid & 127, dq = tid >> 7;
    float C[32]; float nreg = 0.f;
    if (sb >= 0) {
        const float* C0 = a.in[4] + (size_t)(item - 32) * 16384;
#pragma unroll
        for (int i = 0; i < 32; ++i) C[i] = C0[(size_t)(32 * dq + i) * 128 + e];
        if (tid < 128) nreg = a.in[5][(size_t)(item - 32) * 128 + tid];
        if (tid == 0) MST[0] = a.in[6][item - 32];
        if (tid < 384) XMW[tid] = a.in[7][(size_t)sb * 3 * 512 + (tid >> 7) * 512 + hc + (tid & 127)];
    } else {
#pragma unroll
        for (int i = 0; i < 32; ++i) C[i] = 0.f;
        if (tid == 0) MST[0] = 0.f;
        if (tid < 384) XMW[tid] = 0.f;
    }
    const float cw0 = convw[0 * 512 + hc + e], cw1 = convw[1 * 512 + hc + e], cw2 = convw[2 * 512 + hc + e], cw3 = convw[3 * 512 + hc + e], cbe = convb[hc + e];
    const float ibh = ib[h], fbh = fb[h];
    __syncthreads();
    for (int t0 = 0; t0 < T; t0 += MCH) {
        const int nt = (T - t0) < MCH ? (T - t0) : MCH;
        for (int t = dq; t < nt; t += 4) { const size_t r = (size_t)(row0 + t0 + t) * NPM;
            XMW[(t + 3) * 128 + e] = bf2f(PM[r + hc + e]); Vb[t * 128 + e] = bf2f(PM[r + 512 + hc + e]); Ob[t * 128 + e] = sigmoidf_(bf2f(PM[r + 1024 + hc + e])); }
        __syncthreads();
        for (int t = dq; t < nt; t += 4) { const float x = cbe + XMW[t * 128 + e] * cw0 + XMW[(t + 1) * 128 + e] * cw1 + XMW[(t + 2) * 128 + e] * cw2 + XMW[(t + 3) * 128 + e] * cw3;
            XC[t * 128 + e] = x / (1.0f + expf(-x)); }
        if (tid == 0) { float m = MST[0];
            for (int t = 0; t < nt; ++t) { const float* g = GATES + (size_t)(row0 + t0 + t) * 8;
                const float li = g[h] + ibh, fr = g[4 + h] + fbh; const float lf = fminf(fr, 0.f) - log1pf(expf(-fabsf(fr)));
                const float mn = fmaxf(lf + m, li); FS[t] = expf(lf + m - mn); IS[t] = expf(li - mn); EM[t] = expf(-mn); m = mn; }
            MST[0] = m; }
        __syncthreads();
        { float aq[MCH / 4], ak[MCH / 4];
#pragma unroll
          for (int i = 0; i < MCH / 4; ++i) { aq[i] = 0.f; ak[i] = 0.f; }
          for (int d4 = 0; d4 < 32; ++d4) {
              float q4[4], k4[4];
#pragma unroll
              for (int q = 0; q < 4; ++q) { q4[q] = wq[(size_t)(hc + 4 * d4 + q) * 128 + e]; k4[q] = wk[(size_t)(hc + 4 * d4 + q) * 128 + e]; }
#pragma unroll
              for (int tt = 0; tt < MCH / 4; ++tt) { const int t = dq + 4 * tt; if (t < nt) { const f32x4 x = *(const LAS f32x4*)(XC + t * 128 + 4 * d4);
                  aq[tt] += (x.x * q4[0] + x.y * q4[1]) + (x.z * q4[2] + x.w * q4[3]); ak[tt] += (x.x * k4[0] + x.y * k4[1]) + (x.z * k4[2] + x.w * k4[3]); } }
          }
#pragma unroll
          for (int tt = 0; tt < MCH / 4; ++tt) { const int t = dq + 4 * tt; if (t < nt) { Qb[t * 128 + e] = aq[tt] * 0.08838834764831845f; Kb[t * 128 + e] = ak[tt]; } }
        }
        __syncthreads();
        for (int t = 0; t < nt; ++t) {
            const float fs = FS[t], is = IS[t]; const float ve = Vb[t * 128 + e] * is; float hp = 0.f;
#pragma unroll
            for (int i = 0; i < 8; ++i) { const f32x4 k = *(const LAS f32x4*)(Kb + t * 128 + 32 * dq + 4 * i), q = *(const LAS f32x4*)(Qb + t * 128 + 32 * dq + 4 * i);
                C[4 * i + 0] = fs * C[4 * i + 0] + k.x * ve; hp += q.x * C[4 * i + 0];
                C[4 * i + 1] = fs * C[4 * i + 1] + k.y * ve; hp += q.y * C[4 * i + 1];
                C[4 * i + 2] = fs * C[4 * i + 2] + k.z * ve; hp += q.z * C[4 * i + 2];
                C[4 * i + 3] = fs * C[4 * i + 3] + k.w * ve; hp += q.w * C[4 * i + 3]; }
            HP[t * 512 + dq * 128 + e] = hp;
            if (tid < 128) { nreg = fs * nreg + is * Kb[t * 128 + tid]; const float dn = wave_sum(Qb[t * 128 + tid] * nreg); if (lane == 0) DEN[t * 2 + wv] = dn; }
        }
        __syncthreads();
        for (int t = wv; t < nt; t += 8) {
            const float den = DEN[t * 2] + DEN[t * 2 + 1]; const float dd = fmaxf(fabsf(den), EM[t]);
            float hv[2];
#pragma unroll
            for (int q = 0; q < 2; ++q) { const int ee = lane + 64 * q; hv[q] = (HP[t * 512 + ee] + HP[t * 512 + 128 + ee] + HP[t * 512 + 256 + ee] + HP[t * 512 + 384 + ee]) / dd; }
            const float mean = wave_sum(hv[0] + hv[1]) * (1.0f / 128.0f); const float d0 = hv[0] - mean, d1 = hv[1] - mean;
            const float var = wave_sum(d0 * d0 + d1 * d1) * (1.0f / 128.0f); const float rs = rsqrtf(var + M_GN_EPS);
#pragma unroll
            for (int q = 0; q < 2; ++q) { const int ee = lane + 64 * q; float o = (q ? d1 : d0) * rs * gnw[hc + ee] + skip[hc + ee] * XC[t * 128 + ee]; o *= Ob[t * 128 + ee];
                YM[(size_t)(row0 + t0 + t) * 512 + hc + ee] = (bf16)f2bf(o); }
        }
        __syncthreads();
        float keep = 0.f; if (tid < 384) keep = XMW[(nt + (tid >> 7)) * 128 + (tid & 127)];
        __syncthreads();
        if (tid < 384) XMW[tid] = keep;
        __syncthreads();
    }
#pragma unroll
    for (int i = 0; i < 32; ++i) Cout[(size_t)(32 * dq + i) * 128 + e] = C[i];
    if (tid < 128) nout[tid] = nreg;
    if (tid == 0) mout[0] = MST[0];
    if (tid < 384) convout[(tid >> 7) * 512 + (tid & 127)] = XMW[tid];
}

__device__ __forceinline__ void final_norm_rows(const Args& a, int gw, int NGW, int lane) {
    const float* gf = a.in[36];
    f32x4 gv[4];
#pragma unroll
    for (int j = 0; j < 4; ++j) gv[j] = ((const f32x4*)gf)[lane + 64 * j];
    for (int row = gw; row < MTOK; row += NGW) { f32x4* p = (f32x4*)(a.out + (size_t)row * 1024) + lane; f32x4 v[4]; float s = 0.f;
#pragma unroll
        for (int j = 0; j < 4; ++j) { v[j] = p[64 * j]; s += (v[j].x * v[j].x + v[j].y * v[j].y) + (v[j].z * v[j].z + v[j].w * v[j].w); }
        const float rs = rsqrtf(wave_sum(s) * (1.0f / 1024.0f) + RMS_EPS);
#pragma unroll
        for (int j = 0; j < 4; ++j) p[64 * j] = v[j] * rs * gv[j]; }
}


typedef short bf16x8 __attribute__((ext_vector_type(8)));
typedef float f32x16 __attribute__((ext_vector_type(16)));
constexpr size_t WS_KT = 49 * MiB + 512 * 1024;
constexpr size_t DO_CTP = 0;
constexpr size_t DO_VT = 40 * MiB;
constexpr size_t DO_UU = 60 * MiB, DO_BCUM = DO_UU + 256 * 1024, DO_PPFX = DO_BCUM + 256 * 1024;
constexpr size_t DO_BL = DO_PPFX + 256 * 1024, DO_PMX = DO_BL + 4096, DO_MPREV = DO_PMX + 4096;
static_assert(DO_MPREV + 4096 <= (size_t)MTOK * DM * 4, "d_out scratch");

typedef float f32x2_t __attribute__((ext_vector_type(2))); typedef __bf16 bf16x2_t __attribute__((ext_vector_type(2)));
__device__ __forceinline__ unsigned cvtpk(float lo, float hi) { f32x2_t v = {lo, hi}; bf16x2_t b = __builtin_convertvector(v, bf16x2_t); return __builtin_bit_cast(unsigned, b); }
__device__ __forceinline__ bf16x8 pack8(float a0, float a1, float a2, float a3, float a4, float a5, float a6, float a7) {
    v4u w; w.x = cvtpk(a0, a1); w.y = cvtpk(a2, a3); w.z = cvtpk(a4, a5); w.w = cvtpk(a6, a7); return __builtin_bit_cast(bf16x8, w); }
__device__ __forceinline__ bf16x8 acc_frag(const f32x16& x, int s2) { return s2 == 0 ? pack8(x[0], x[1], x[2], x[3], x[4], x[5], x[6], x[7]) : pack8(x[8], x[9], x[10], x[11], x[12], x[13], x[14], x[15]); }
__device__ __forceinline__ bf16x8 ld16(const bf16* p) { return __builtin_bit_cast(bf16x8, *(const v4u*)p); }
__device__ __forceinline__ bf16x8 ld8x2(const bf16* p0, const bf16* p1) { const v2u a = *(const v2u*)p0, b = *(const v2u*)p1; v4u w; w.x = a.x; w.y = a.y; w.z = b.x; w.w = b.y; return __builtin_bit_cast(bf16x8, w); }
#define MFMA32(a, b, c) __builtin_amdgcn_mfma_f32_32x32x16_bf16((a), (b), (c), 0, 0, 0)

__device__ __forceinline__ void stage_conv_head(const Args& a, LAS float* CW, int h, int tid, int nthr) {
    for (int i = tid; i < 640; i += nthr) CW[i] = i < 512 ? a.in[22][(size_t)(i >> 7) * 512 + h * 128 + (i & 127)] : a.in[23][h * 128 + (i - 512)];
}
__device__ __forceinline__ void xc8(const bf16* xmcol, int t, int d0, const LAS float* CW, float (&x)[8]) {
    const f32x4 b0 = *(const LAS f32x4*)(CW + 512 + d0), b1 = *(const LAS f32x4*)(CW + 512 + d0 + 4);
    x[0] = b0.x; x[1] = b0.y; x[2] = b0.z; x[3] = b0.w; x[4] = b1.x; x[5] = b1.y; x[6] = b1.z; x[7] = b1.w;
#pragma unroll
    for (int tap = 0; tap < 4; ++tap) { const int tt = t - 3 + tap;
        if (tt >= 0) { const v4u v = *(const v4u*)(xmcol + (size_t)tt * NPM + d0);
            const f32x4 w0 = *(const LAS f32x4*)(CW + tap * 128 + d0), w1 = *(const LAS f32x4*)(CW + tap * 128 + d0 + 4);
            x[0] += bflo(v.x) * w0.x; x[1] += bfhi(v.x) * w0.y; x[2] += bflo(v.y) * w0.z; x[3] += bfhi(v.y) * w0.w;
            x[4] += bflo(v.z) * w1.x; x[5] += bfhi(v.z) * w1.y; x[6] += bflo(v.w) * w1.z; x[7] += bfhi(v.w) * w1.w; } }
#pragma unroll
    for (int i = 0; i < 8; ++i) x[i] = x[i] / (1.0f + __expf(-x[i]));
}
__device__ __forceinline__ bf16x8 xc_frag(const bf16* xmcol, int t, int d0, const LAS float* CW) { float x[8]; xc8(xmcol, t, d0, CW, x); return pack8(x[0], x[1], x[2], x[3], x[4], x[5], x[6], x[7]); }

__device__ __forceinline__ void mlstm_prep_task(const Args& a, int item, int blk, const LAS float* CW, int lane_) {
    int lane = lane_; asm volatile("" : "+v"(lane));
    const int r = lane & 31, hh = lane >> 5, bh = item >> 5, c = item & 31, b = bh >> 2, h = bh & 3, hc = h * 128, row0 = b * SEQ, t0 = c * 64, db = blk & 3, sb = blk >> 2;
    const bf16* PM = (const bf16*)(a.ws + WS_PM); const bf16* xmcol = PM + (size_t)row0 * NPM + hc;
    const bf16* WKT = (const bf16*)(a.ws + WS_WKT) + (size_t)h * 16384;
    bf16* KT = (bf16*)(a.ws + WS_KT) + (size_t)item * 8192; bf16* VT = (bf16*)((unsigned char*)a.out + DO_VT) + (size_t)item * 10240;
    f32x16 acc;
#pragma unroll
    for (int i = 0; i < 16; ++i) acc[i] = 0.f;
#pragma unroll
    for (int ks = 0; ks < 8; ++ks) { const bf16x8 A = ld16(WKT + (size_t)(32 * db + r) * 128 + 16 * ks + 8 * hh); const bf16x8 B = xc_frag(xmcol, t0 + 32 * sb + r, 16 * ks + 8 * hh, CW); acc = MFMA32(A, B, acc); }
#pragma unroll
    for (int reg = 0; reg < 16; reg += 2) { const unsigned w = cvtpk(acc[reg], acc[reg + 1]); bf16* kp = KT + (size_t)(32 * db + 4 * hh) * 64 + 32 * sb + r;
        kp[((reg & 3) + 8 * (reg >> 2)) * 64] = (bf16)(w & 0xffffu); kp[(((reg + 1) & 3) + 8 * ((reg + 1) >> 2)) * 64] = (bf16)(w >> 16); }
    { const bf16* vp = PM + (size_t)(row0 + t0 + 32 * sb + r) * NPM + 512 + hc + 32 * db + 16 * hh; const v4u v0 = *(const v4u*)vp, v1 = *(const v4u*)(vp + 8);
      const unsigned w[8] = {v0.x, v0.y, v0.z, v0.w, v1.x, v1.y, v1.z, v1.w}; bf16* o = VT + (size_t)(32 * db + 16 * hh) * 64 + 32 * sb + r;
#pragma unroll
      for (int i = 0; i < 8; ++i) { o[(size_t)(2 * i) * 64] = (bf16)(w[i] & 0xffffu); o[(size_t)(2 * i + 1) * 64] = (bf16)(w[i] >> 16); } }
#pragma unroll
    for (int i = 0; i < 4; ++i) VT[(size_t)(128 + 4 * blk + i) * 64 + lane] = (blk == 0 && i == 0) ? (bf16)0x3f80u : (bf16)0u;
    if (blk == 1 && c == 31) {
        float* co = a.out + O_PCONV + (size_t)b * 3 * 512 + hc;
        for (int i = lane; i < 384; i += 64) co[(i >> 7) * 512 + (i & 127)] = bf2f(xmcol[(size_t)(SEQ - 3 + (i >> 7)) * NPM + (i & 127)]);
    }
    if (blk == 0) {
        const float* g = (const float*)(a.ws + WS_GATES) + (size_t)(row0 + t0 + lane) * 8;
        const float li = g[h] + a.in[26][h], fr = g[4 + h] + a.in[27][h]; const float lf = fminf(fr, 0.f) - log1pf(expf(-fabsf(fr)));
        float bc = lf;
#pragma unroll
        for (int o = 1; o < 64; o <<= 1) { const float t = __shfl_up(bc, o); if (lane >= o) bc += t; }
        const float u = li - bc; float p = u;
#pragma unroll
        for (int o = 1; o < 64; o <<= 1) { const float t = __shfl_up(p, o); if (lane >= o) p = fmaxf(p, t); }
        float* dof = (float*)a.out; const size_t ti = (size_t)bh * 2048 + t0 + lane;
        dof[DO_UU / 4 + ti] = u; dof[DO_BCUM / 4 + ti] = bc; dof[DO_PPFX / 4 + ti] = p;
        if (lane == 63) { dof[DO_BL / 4 + item] = bc; dof[DO_PMX / 4 + item] = p; }
    }
}

__device__ __forceinline__ void mlstm_scan_task(const Args& a, int bh, int eb, LAS float* WE, int lane) {
    const int r = lane & 31, hh = lane >> 5;
    const float* dof = (const float*)a.out;
    f32x16 CT[4];
#pragma unroll
    for (int cb = 0; cb < 4; ++cb)
#pragma unroll
        for (int i = 0; i < 16; ++i) CT[cb][i] = 0.f;
    float m = 0.f;
    const bf16* KT0 = (const bf16*)(a.ws + WS_KT) + (size_t)bh * 32 * 8192 + (size_t)r * 64 + 8 * hh;
    const bf16* VT0 = (const bf16*)((const unsigned char*)a.out + DO_VT) + (size_t)bh * 32 * 10240 + (size_t)(32 * eb + r) * 64 + 8 * hh;
    bf16* CTP0 = (bf16*)((unsigned char*)a.out + DO_CTP) + (size_t)bh * 32 * 20480 + (size_t)(32 * eb + 4 * hh) * 128 + r;
    v4u Ar[4], Bf[4][4];
#pragma unroll
    for (int ks = 0; ks < 4; ++ks) { Ar[ks] = *(const v4u*)(VT0 + 16 * ks);
#pragma unroll
        for (int cb = 0; cb < 4; ++cb) Bf[ks][cb] = *(const v4u*)(KT0 + (size_t)(32 * cb) * 64 + 16 * ks); }
    float u = dof[DO_UU / 4 + (size_t)bh * 2048 + lane], pmx = dof[DO_PMX / 4 + bh * 32], bl = dof[DO_BL / 4 + bh * 32];
    for (int c = 0; c < 32; ++c) {
        const int item = bh * 32 + c;
        const float Mx = fmaxf(m, pmx); const float ge = __expf(m - Mx);
        WE[lane] = __expf(u - Mx);
        const float mnext = bl + Mx;
        if (c + 1 < 32) { u = dof[DO_UU / 4 + (size_t)bh * 2048 + 64 * (c + 1) + lane]; pmx = dof[DO_PMX / 4 + item + 1]; bl = dof[DO_BL / 4 + item + 1]; }
        bf16* CTP = CTP0 + (size_t)c * 20480;
#pragma unroll
        for (int cb = 0; cb < 4; ++cb)
#pragma unroll
            for (int reg = 0; reg < 16; reg += 2) { const unsigned w = cvtpk(CT[cb][reg], CT[cb][reg + 1]);
                CTP[((reg & 3) + 8 * (reg >> 2)) * 128 + 32 * cb] = (bf16)(w & 0xffffu); CTP[(((reg + 1) & 3) + 8 * ((reg + 1) >> 2)) * 128 + 32 * cb] = (bf16)(w >> 16);
                CT[cb][reg] *= ge; CT[cb][reg + 1] *= ge; }
        if (eb == 0 && lane == 0) ((float*)a.out)[DO_MPREV / 4 + item] = m;
        LDS_WAIT(); asm volatile("" ::: "memory");
        const size_t nx = (c + 1 < 32) ? (size_t)(c + 1) : (size_t)c;
#pragma unroll
        for (int ks = 0; ks < 4; ++ks) {
            const v4u av = Ar[ks];
            const f32x4 w0 = *(const LAS f32x4*)(WE + 16 * ks + 8 * hh), w1 = *(const LAS f32x4*)(WE + 16 * ks + 8 * hh + 4);
            const bf16x8 A = pack8(bflo(av.x) * w0.x, bfhi(av.x) * w0.y, bflo(av.y) * w0.z, bfhi(av.y) * w0.w, bflo(av.z) * w1.x, bfhi(av.z) * w1.y, bflo(av.w) * w1.z, bfhi(av.w) * w1.w);
#pragma unroll
            for (int cb = 0; cb < 4; ++cb) CT[cb] = MFMA32(A, __builtin_bit_cast(bf16x8, Bf[ks][cb]), CT[cb]);
            Ar[ks] = *(const v4u*)(VT0 + nx * 10240 + 16 * ks);
#pragma unroll
            for (int cb = 0; cb < 4; ++cb) Bf[ks][cb] = *(const v4u*)(KT0 + nx * 8192 + (size_t)(32 * cb) * 64 + 16 * ks);
        }
        m = mnext;
        LDS_WAIT(); asm volatile("" ::: "memory");
    }
    if (eb < 4) { float* Co = a.out + O_PC + (size_t)bh * 16384;
#pragma unroll
        for (int cb = 0; cb < 4; ++cb)
#pragma unroll
            for (int reg = 0; reg < 16; ++reg) Co[(size_t)(32 * cb + r) * 128 + 32 * eb + (reg & 3) + 8 * (reg >> 2) + 4 * hh] = CT[cb][reg];
    } else if (hh == 0) {
#pragma unroll
        for (int cb = 0; cb < 4; ++cb) a.out[O_PN + (size_t)bh * 128 + 32 * cb + r] = CT[cb][0];
    }
    if (eb == 0 && lane == 0) a.out[O_PMM + bh] = m;
}

constexpr int M3_WSTR = 272;
constexpr int M3_WQ = 0, M3_WK = 128 * M3_WSTR, M3_CW = 2 * 128 * M3_WSTR, M3_GN = M3_CW + 2560, M3_SK = M3_GN + 512, M3_XB = M3_SK + 512, M3_LDS = M3_XB + 8 * 8192;
__device__ __forceinline__ void mlstm_out_stage(const Args& a, LAS unsigned char* L, int h, int tid) {
    const bf16* WQT = (const bf16*)(a.ws + WS_WQT) + (size_t)h * 16384; const bf16* WKT = (const bf16*)(a.ws + WS_WKT) + (size_t)h * 16384;
    for (int i = tid; i < 2048; i += NTHR) { const int row = i >> 4, ch = i & 15;
        *(LAS v4u*)(L + M3_WQ + row * M3_WSTR + ch * 16) = *(const v4u*)(WQT + row * 128 + ch * 8);
        *(LAS v4u*)(L + M3_WK + row * M3_WSTR + ch * 16) = *(const v4u*)(WKT + row * 128 + ch * 8); }
    stage_conv_head(a, (LAS float*)(L + M3_CW), h, tid, NTHR);
    for (int i = tid; i < 128; i += NTHR) { ((LAS float*)(L + M3_GN))[i] = a.in[28][h * 128 + i]; ((LAS float*)(L + M3_SK))[i] = a.in[29][h * 128 + i]; }
}
__device__ __forceinline__ bf16x8 m3_wfrag(const LAS unsigned char* W, int row, int k0) { return *(const LAS bf16x8*)(W + row * M3_WSTR + k0 * 2); }
__device__ __forceinline__ void mlstm_st_tile(int sb, int tb, const bf16x8 (&XB)[8], const bf16x8 (&QTb)[4][2], const LAS unsigned char* WK, const bf16* xmcol, const LAS float* CW, const float* uu, int t0, int tl, float Mt, int r, int hh, bf16x8& o0, bf16x8& o1) {
    f32x16 st;
#pragma unroll
    for (int i = 0; i < 16; ++i) st[i] = 0.f;
#pragma unroll
    for (int db = 0; db < 4; ++db) { f32x16 k;
#pragma unroll
        for (int i = 0; i < 16; ++i) k[i] = 0.f;
#pragma unroll
        for (int ks = 0; ks < 8; ++ks) { const bf16x8 B = (sb == tb) ? XB[ks] : xc_frag(xmcol, t0 + 32 * sb + r, 16 * ks + 8 * hh, CW);
            k = MFMA32(m3_wfrag(WK, 32 * db + r, 16 * ks + 8 * hh), B, k); if (ks & 1) __builtin_amdgcn_sched_barrier(0); }
        st = MFMA32(acc_frag(k, 0), QTb[db][0], st); st = MFMA32(acc_frag(k, 1), QTb[db][1], st); __builtin_amdgcn_sched_barrier(0); }
#pragma unroll
    for (int g = 0; g < 4; ++g) { const f32x4 u4 = *(const f32x4*)(uu + 32 * sb + 8 * g + 4 * hh);
#pragma unroll
        for (int i = 0; i < 4; ++i) { const int sidx = 32 * sb + 8 * g + 4 * hh + i; st[4 * g + i] = (sidx <= tl) ? st[4 * g + i] * expf(u4[i] - Mt) : 0.f; } }
    o0 = acc_frag(st, 0); o1 = acc_frag(st, 1);
}

__device__ __forceinline__ void mlstm_out_task(const Args& a, int item, int tb, LAS unsigned char* L, int lane_) {
    int lane = lane_; asm volatile("" : "+v"(lane));
    const int r = lane & 31, hh = lane >> 5, bh = item >> 5, c = item & 31, b = bh >> 2, h = bh & 3, hc = h * 128, row0 = b * SEQ, t0 = c * 64;
    const bf16* PM = (const bf16*)(a.ws + WS_PM); const bf16* xmcol = PM + (size_t)row0 * NPM + hc; const LAS float* CW = (const LAS float*)(L + M3_CW);
    const LAS unsigned char* WQ = L + M3_WQ; const LAS unsigned char* WK = L + M3_WK;
    const bf16* VT = (const bf16*)((const unsigned char*)a.out + DO_VT) + (size_t)item * 10240; const bf16* CTP = (const bf16*)((const unsigned char*)a.out + DO_CTP) + (size_t)item * 20480;
    const float* dof = (const float*)a.out;
    const int tl = 32 * tb + r, t = t0 + tl;
    bf16x8 XB[8];
#pragma unroll
    for (int ks = 0; ks < 8; ++ks) { XB[ks] = xc_frag(xmcol, t, 16 * ks + 8 * hh, CW); if (ks & 1) __builtin_amdgcn_sched_barrier(0); }
    bf16x8 QTb[4][2];
#pragma unroll
    for (int eb = 0; eb < 4; ++eb) { f32x16 q;
#pragma unroll
        for (int i = 0; i < 16; ++i) q[i] = 0.f;
#pragma unroll
        for (int ks = 0; ks < 8; ++ks) q = MFMA32(m3_wfrag(WQ, 32 * eb + r, 16 * ks + 8 * hh), XB[ks], q);
        QTb[eb][0] = acc_frag(q, 0); QTb[eb][1] = acc_frag(q, 1); __builtin_amdgcn_sched_barrier(0); }
    const float mprev = dof[DO_MPREV / 4 + item], pp = dof[DO_PPFX / 4 + (size_t)bh * 2048 + t], bc = dof[DO_BCUM / 4 + (size_t)bh * 2048 + t];
    const float Mt = fmaxf(mprev, pp), wst = expf(mprev - Mt), em = expf(-bc - Mt);
    bf16x8 STb[2][2];
    mlstm_st_tile(0, tb, XB, QTb, WK, xmcol, CW, dof + DO_UU / 4 + (size_t)bh * 2048 + t0, t0, tl, Mt, r, hh, STb[0][0], STb[0][1]);
    if (tb == 1) mlstm_st_tile(1, tb, XB, QTb, WK, xmcol, CW, dof + DO_UU / 4 + (size_t)bh * 2048 + t0, t0, tl, Mt, r, hh, STb[1][0], STb[1][1]);
    else { STb[1][0] = (bf16x8){0, 0, 0, 0, 0, 0, 0, 0}; STb[1][1] = STb[1][0]; }
    LAS unsigned char* xbp = (LAS unsigned char*)L + M3_XB + (__builtin_amdgcn_readfirstlane(threadIdx.x >> 6)) * 8192 + lane * 16;
#pragma unroll
    for (int ks = 0; ks < 8; ++ks) *(LAS bf16x8*)(xbp + ks * 1024) = XB[ks];
    __builtin_amdgcn_sched_barrier(0);
    auto num_block = [&](int eb, f32x16& nt) {
#pragma unroll
        for (int i = 0; i < 16; ++i) nt[i] = 0.f;
        const bf16* crow = CTP + (size_t)(32 * eb + r) * 128 + 4 * hh;
#pragma unroll
        for (int rb = 0; rb < 4; ++rb) {
#pragma unroll
            for (int s2 = 0; s2 < 2; ++s2) nt = MFMA32(ld8x2(crow + 32 * rb + 16 * s2, crow + 32 * rb + 16 * s2 + 8), QTb[rb][s2], nt);
            if (rb == 1) __builtin_amdgcn_sched_barrier(0); }
#pragma unroll
        for (int i = 0; i < 16; ++i) nt[i] *= wst;
        __builtin_amdgcn_sched_barrier(0);
        const bf16* vrow = VT + (size_t)(32 * eb + r) * 64 + 4 * hh;
#pragma unroll
        for (int s2 = 0; s2 < 2; ++s2) nt = MFMA32(ld8x2(vrow + 16 * s2, vrow + 16 * s2 + 8), STb[0][s2], nt);
        if (tb == 1) {
#pragma unroll
            for (int s2 = 0; s2 < 2; ++s2) nt = MFMA32(ld8x2(vrow + 32 + 16 * s2, vrow + 32 + 16 * s2 + 8), STb[1][s2], nt); }
        __builtin_amdgcn_sched_barrier(0);
    };
    float inv;
    { f32x16 nd; num_block(4, nd); const float den = __shfl(nd[0], r); inv = 1.0f / fmaxf(fabsf(den), em); }
    f32x16 NT[4];
#pragma unroll
    for (int eb = 0; eb < 4; ++eb) num_block(eb, NT[eb]);
    float s1 = 0.f;
#pragma unroll
    for (int eb = 0; eb < 4; ++eb)
#pragma unroll
        for (int i = 0; i < 16; ++i) { NT[eb][i] *= inv; s1 += NT[eb][i]; }
    s1 += __shfl_xor(s1, 32); const float mean = s1 * (1.0f / 128.0f); float s2v = 0.f;
#pragma unroll
    for (int eb = 0; eb < 4; ++eb)
#pragma unroll
        for (int i = 0; i < 16; ++i) { const float d = NT[eb][i] - mean; s2v += d * d; }
    s2v += __shfl_xor(s2v, 32); const float rs = rsqrtf(s2v * (1.0f / 128.0f) + M_GN_EPS);
    bf16* YM = (bf16*)(a.ws + WS_YRM) + (size_t)(row0 + t) * 1024 + 512 + hc; const bf16* orow = PM + (size_t)(row0 + t) * NPM + 1024 + hc;
    const LAS float* gnw = (const LAS float*)(L + M3_GN); const LAS float* skp = (const LAS float*)(L + M3_SK);
    bf16x8 idf[2];
#pragma unroll
    for (int ksl = 0; ksl < 2; ++ksl) { v4u id; const int kb0 = 16 * ksl + 8 * hh;
        id.x = (r == kb0 ? 0x3f80u : 0u) | (r == kb0 + 1 ? 0x3f800000u : 0u); id.y = (r == kb0 + 2 ? 0x3f80u : 0u) | (r == kb0 + 3 ? 0x3f800000u : 0u);
        id.z = (r == kb0 + 4 ? 0x3f80u : 0u) | (r == kb0 + 5 ? 0x3f800000u : 0u); id.w = (r == kb0 + 6 ? 0x3f80u : 0u) | (r == kb0 + 7 ? 0x3f800000u : 0u);
        idf[ksl] = __builtin_bit_cast(bf16x8, id); }
#pragma unroll
    for (int eb = 0; eb < 4; ++eb) { f32x16 xt;
#pragma unroll
        for (int i = 0; i < 16; ++i) xt[i] = 0.f;
        xt = MFMA32(idf[0], *(const LAS bf16x8*)(xbp + (2 * eb) * 1024), xt); xt = MFMA32(idf[1], *(const LAS bf16x8*)(xbp + (2 * eb + 1) * 1024), xt);
#pragma unroll
        for (int g = 0; g < 4; ++g) { const int e0 = 32 * eb + 8 * g + 4 * hh;
            const v2u ov = *(const v2u*)(orow + e0); const float og[4] = {bflo(ov.x), bfhi(ov.x), bflo(ov.y), bfhi(ov.y)};
            const f32x4 gw = *(const LAS f32x4*)(gnw + e0), sk = *(const LAS f32x4*)(skp + e0); float o[4];
#pragma unroll
            for (int i = 0; i < 4; ++i) o[i] = ((NT[eb][4 * g + i] - mean) * rs * gw[i] + sk[i] * xt[4 * g + i]) * sigmoidf_(og[i]);
            v2u w; w.x = cvtpk(o[0], o[1]); w.y = cvtpk(o[2], o[3]); *(v2u*)(YM + e0) = w; }
        __builtin_amdgcn_sched_barrier(0); }
}

constexpr size_t WS_SPREV = 237 * MiB;
constexpr size_t WS_GL = 253 * MiB, WS_BON = 253 * MiB + 512 * 1024, WS_BND = 254 * MiB;
constexpr size_t DO_DLRT = O_SC * 4, DO_DS = O_SC * 4 + 16 * MiB;
constexpr int RSTR = 144, RSLOT = 64 * RSTR;
constexpr int R1_MISC = 8 * RSLOT, R1_ITEM_LDS = 8 * RSLOT + 6144;
static_assert(2 * R1_ITEM_LDS == 159744, "R1 LDS");

__device__ __forceinline__ int rowidx(int reg, int hh) { return (reg & 3) + 8 * (reg >> 2) + 4 * hh; }
__device__ __forceinline__ bf16x8 ldsfrag(const LAS unsigned char* slot, int row, int k0) { return *(const LAS bf16x8*)(slot + row * RSTR + k0 * 2); }
__device__ __forceinline__ void st_rows(LAS unsigned char* slot, int rb, int cb, const f32x16& x, int r, int hh) {
    LAS unsigned char* bp = slot + (32 * rb + 4 * hh) * RSTR + (32 * cb + r) * 2;
#pragma unroll
    for (int reg = 0; reg < 16; reg += 2) { const unsigned w = cvtpk(x[reg], x[reg + 1]);
        *(LAS bf16*)(bp + ((reg & 3) + 8 * (reg >> 2)) * RSTR) = (bf16)(w & 0xffffu); *(LAS bf16*)(bp + (((reg + 1) & 3) + 8 * ((reg + 1) >> 2)) * RSTR) = (bf16)(w >> 16); }
}
__device__ __forceinline__ void st_cols(LAS unsigned char* slot, int rb, int cb, const f32x16& x, int r, int hh) {
    LAS unsigned char* bp = slot + (32 * cb + r) * RSTR + (32 * rb + 4 * hh) * 2;
#pragma unroll
    for (int g = 0; g < 4; ++g) { v2u w; w.x = cvtpk(x[4 * g], x[4 * g + 1]); w.y = cvtpk(x[4 * g + 2], x[4 * g + 3]); *(LAS v2u*)(bp + 16 * g) = w; }
}
__device__ __forceinline__ f32x16 zero16() { f32x16 z;
#pragma unroll
    for (int i = 0; i < 16; ++i) z[i] = 0.f;
    return z; }
__device__ __forceinline__ void mix8(const v4u cur, const v4u prv, const float* mu, float (&m)[8]) {
    const f32x4 m0 = *(const f32x4*)mu, m1 = *(const f32x4*)(mu + 4);
    const float c[8] = {bflo(cur.x), bfhi(cur.x), bflo(cur.y), bfhi(cur.y), bflo(cur.z), bfhi(cur.z), bflo(cur.w), bfhi(cur.w)};
    const float p[8] = {bflo(prv.x), bfhi(prv.x), bflo(prv.y), bfhi(prv.y), bflo(prv.z), bfhi(prv.z), bflo(prv.w), bfhi(prv.w)};
    const float mm[8] = {m0.x, m0.y, m0.z, m0.w, m1.x, m1.y, m1.z, m1.w};
#pragma unroll
    for (int i = 0; i < 8; ++i) m[i] = c[i] + (p[i] - c[i]) * mm[i];
}
__device__ __forceinline__ void mix4(const v2u cur, const v2u prv, const float* mu, float (&m)[4]) {
    const f32x4 m0 = *(const f32x4*)mu;
    const float c[4] = {bflo(cur.x), bfhi(cur.x), bflo(cur.y), bfhi(cur.y)}, p[4] = {bflo(prv.x), bfhi(prv.x), bflo(prv.y), bfhi(prv.y)}, mm[4] = {m0.x, m0.y, m0.z, m0.w};
#pragma unroll
    for (int i = 0; i < 4; ++i) m[i] = c[i] + (p[i] - c[i]) * mm[i];
}

__device__ __forceinline__ float tanh_fast(float x) { return 1.0f - 2.0f / (__expf(2.0f * x) + 1.0f); }
__device__ __forceinline__ void rwkv_prep_pair(const Args& a, LAS unsigned char* lds0, int ritem0, bool dry = false) {
    int tid_ = threadIdx.x; asm volatile("" : "+v"(tid_));
    const int tid = tid_ & 255, lane = tid & 63, w4 = tid >> 6, r = lane & 31, hh = lane >> 5, half = tid_ >> 8;
    const int ritem = ritem0 + half, bh = ritem >> 5, c = ritem & 31, b = bh >> 3, h = bh & 7, hc = h * 64, row0 = b * SEQ, t0 = c * 64;
    const int p = w4 >> 1, q = w4 & 1;
    LAS unsigned char* L = lds0 + half * R1_ITEM_LDS;
    LAS unsigned char *S0 = L, *S1 = L + RSLOT, *S2 = L + 2 * RSLOT, *S3 = L + 3 * RSLOT, *S4 = L + 4 * RSLOT, *S5 = L + 5 * RSLOT, *S6 = L + 6 * RSLOT, *S7 = L + 7 * RSLOT;
    LAS float* SSX = (LAS float*)(L + R1_MISC);
    LAS float* BONX = SSX + 128;
    LAS float* CUMT = BONX + 128;
    LAS float* CUML = CUMT + 64;
    LAS float* CUMTp = CUMT + 32 * p + 4 * hh; LAS float* CUMLp = CUML + 32 * p + 4 * hh;
    LAS unsigned char* T00T = L + R1_MISC;
    LAS unsigned char* G1T = L + R1_MISC + 2560;
    const bf16* PR = (const bf16*)(a.ws + WS_PR); const bf16* BND = (const bf16*)(a.ws + WS_BND);
    const float* mu = a.in[10];
    constexpr int RAWS = 656;
    {   const int segcol[5] = {hc, 512 + hc, 1024 + hc, 1536, 1600};
        for (int ci = tid; ci < 65 * 40; ci += 256) { const int trow = ci / 40, sc = ci - trow * 40, seg = sc >> 3, part = sc & 7;
            v4u v = (v4u){0u, 0u, 0u, 0u};
            const int col = (seg == 0 ? hc : seg == 1 ? 512 + hc : seg == 2 ? 1024 + hc : seg == 3 ? 1536 : 1600) + part * 8;
            if (trow > 0) v = *(const v4u*)(PR + (size_t)(row0 + t0 + trow - 1) * NPR + col);
            else if (c > 0) v = *(const v4u*)(BND + (size_t)(b * 32 + c - 1) * NPR + col);
            *(LAS v4u*)(L + trow * RAWS + seg * 128 + part * 16) = v; }
        (void)segcol;
    }
    __syncthreads();
    const int tl = 32 * q + r; const size_t row = (size_t)(row0 + t0 + tl);
    const LAS unsigned char* rcur = L + (tl + 1) * RAWS; const LAS unsigned char* rprv = L + tl * RAWS;
    f32x16 wl = zero16(), al = zero16();
    {   const bf16* W2T = (const bf16*)(a.ws + WS_LW2T) + (size_t)(hc + 32 * p + r) * 64; const bf16* A2T = (const bf16*)(a.ws + WS_LA2T) + (size_t)(hc + 32 * p + r) * 64;
#pragma unroll
        for (int ks = 0; ks < 4; ++ks) { const int k0 = 16 * ks + 8 * hh; float m[8];
            mix8(*(const LAS v4u*)(rcur + 384 + k0 * 2), *(const LAS v4u*)(rprv + 384 + k0 * 2), mu + 1536 + k0, m);
            wl = MFMA32(ld16(W2T + k0), pack8(tanh_fast(m[0]), tanh_fast(m[1]), tanh_fast(m[2]), tanh_fast(m[3]), tanh_fast(m[4]), tanh_fast(m[5]), tanh_fast(m[6]), tanh_fast(m[7])), wl);
            mix8(*(const LAS v4u*)(rcur + 512 + k0 * 2), *(const LAS v4u*)(rprv + 512 + k0 * 2), mu + 1600 + k0, m);
            al = MFMA32(ld16(A2T + k0), pack8(m[0], m[1], m[2], m[3], m[4], m[5], m[6], m[7]), al); __builtin_amdgcn_sched_barrier(0); }
    }
    f32x16 lw, aa, kx, rx, vx;
    float ssp = 0.f, bonp = 0.f;
#pragma unroll
    for (int g = 0; g < 4; ++g) { const int ch = hc + 32 * p + 8 * g + 4 * hh; const int cl = (32 * p + 8 * g + 4 * hh) * 2;
        const f32x4 w04 = *(const f32x4*)(a.in[11] + ch), a04 = *(const f32x4*)(a.in[13] + ch), kk4 = *(const f32x4*)(a.in[16] + ch), ka4 = *(const f32x4*)(a.in[17] + ch), rk4 = *(const f32x4*)(a.in[18] + ch);
        float mr[4], mk[4], mv[4];
        mix4(*(const LAS v2u*)(rcur + cl), *(const LAS v2u*)(rprv + cl), mu + ch, mr);
        mix4(*(const LAS v2u*)(rcur + 128 + cl), *(const LAS v2u*)(rprv + 128 + cl), mu + 512 + ch, mk);
        mix4(*(const LAS v2u*)(rcur + 256 + cl), *(const LAS v2u*)(rprv + 256 + cl), mu + 1024 + ch, mv);
#pragma unroll
        for (int i = 0; i < 4; ++i) { const int reg = 4 * g + i;
            lw[reg] = -0.6065306597126334f / (1.0f + __expf(-(w04[i] + wl[reg])));
            const float av = 1.0f / (1.0f + __expf(-(a04[i] + al[reg]))); aa[reg] = av;
            const float kkr = mk[i] * kk4[i]; ssp += kkr * kkr; wl[reg] = kkr;
            const float k2 = mk[i] * (1.0f + (av - 1.0f) * ka4[i]); kx[reg] = k2; rx[reg] = mr[i]; vx[reg] = mv[i];
            bonp += mr[i] * k2 * rk4[i]; }
        __builtin_amdgcn_sched_barrier(0); }
    ssp += __shfl_xor(ssp, 32); bonp += __shfl_xor(bonp, 32);
    if (hh == 0) { SSX[tl * 2 + p] = ssp; BONX[tl * 2 + p] = bonp; }
    st_rows(S6, p, q, vx, r, hh);
    __builtin_amdgcn_sched_barrier(0);
    f32x16 cum = lw;
#pragma unroll
    for (int o = 1; o < 32; o <<= 1) {
#pragma unroll
        for (int reg = 0; reg < 16; ++reg) { const float t = __shfl_up(cum[reg], o, 32); if (r >= o) cum[reg] += t; } }
    if (q == 0 && r == 31) {
#pragma unroll
        for (int reg = 0; reg < 16; ++reg) CUMTp[(reg & 3) + 8 * (reg >> 2)] = cum[reg]; }
    __syncthreads();
    if (q == 1) {
#pragma unroll
        for (int reg = 0; reg < 16; ++reg) cum[reg] += CUMTp[(reg & 3) + 8 * (reg >> 2)];
        if (r == 31) {
#pragma unroll
            for (int reg = 0; reg < 16; ++reg) CUMLp[(reg & 3) + 8 * (reg >> 2)] = cum[reg]; } }
    const float rinv = 1.0f / fmaxf(sqrtf(SSX[tl * 2] + SSX[tl * 2 + 1]), 1e-12f);
    if (p == 0 && hh == 0 && !dry) ((float*)(a.ws + WS_BON))[row * 8 + h] = BONX[tl * 2] + BONX[tl * 2 + 1];
    f32x16 KeT, RqT;
#pragma unroll
    for (int reg = 0; reg < 16; ++reg) { RqT[reg] = rx[reg] * __expf(cum[reg]); lw[reg] = cum[reg] - lw[reg]; wl[reg] *= rinv; }
    st_cols(S3, p, q, RqT, r, hh);
    __syncthreads();
    __builtin_amdgcn_sched_barrier(0);
    {   f32x16 tmp;
#pragma unroll
        for (int reg = 0; reg < 16; ++reg) tmp[reg] = wl[reg] * __expf(lw[reg]);
        st_cols(S0, p, q, tmp, r, hh); st_rows(S4, p, q, tmp, r, hh);
        __builtin_amdgcn_sched_barrier(0);
#pragma unroll
        for (int reg = 0; reg < 16; ++reg) tmp[reg] = wl[reg] * aa[reg] * __expf(-cum[reg]);
        st_cols(S1, p, q, tmp, r, hh);
        __builtin_amdgcn_sched_barrier(0);
#pragma unroll
        for (int reg = 0; reg < 16; ++reg) tmp[reg] = kx[reg] * __expf(-cum[reg]);
        st_cols(S2, p, q, tmp, r, hh);
        __builtin_amdgcn_sched_barrier(0);
#pragma unroll
        for (int reg = 0; reg < 16; ++reg) { const float e4 = __expf(CUMLp[(reg & 3) + 8 * (reg >> 2)] - cum[reg]); tmp[reg] = wl[reg] * aa[reg] * e4; KeT[reg] = kx[reg] * e4; }
        st_rows(S5, p, q, tmp, r, hh);
        if (q == 0 && r == 0 && !dry) { float* glp = (float*)(a.ws + WS_GL) + (size_t)ritem * 64 + 32 * p + 4 * hh;
#pragma unroll
            for (int reg = 0; reg < 16; ++reg) glp[(reg & 3) + 8 * (reg >> 2)] = __expf(CUMLp[(reg & 3) + 8 * (reg >> 2)]); }
    }
    __syncthreads();
    __builtin_amdgcn_sched_barrier(0);
    f32x16 NrkT;
    {   f32x16 mkb = zero16(), mkk = zero16(), nrb = zero16(); NrkT = zero16();
        if (!(p == 0 && q == 1)) {
#pragma unroll
            for (int ks = 0; ks < 4; ++ks) { const int k0 = 16 * ks + 8 * hh;
                const bf16x8 kqp = ldsfrag(S0, 32 * p + r, k0), rqp = ldsfrag(S3, 32 * p + r, k0), bdq = ldsfrag(S1, 32 * q + r, k0), kdq = ldsfrag(S2, 32 * q + r, k0);
                mkb = MFMA32(kqp, bdq, mkb); mkk = MFMA32(kqp, kdq, mkk); nrb = MFMA32(rqp, bdq, nrb); }
        }
        if (!(p == 1 && q == 0)) {
#pragma unroll
            for (int ks = 0; ks < 4; ++ks) { const int k0 = 16 * ks + 8 * hh; NrkT = MFMA32(ldsfrag(S2, 32 * p + r, k0), ldsfrag(S3, 32 * q + r, k0), NrkT); }
        }
#pragma unroll
        for (int reg = 0; reg < 16; ++reg) { const int i = 32 * p + rowidx(reg, hh), j = 32 * q + r;
            if (!(j < i)) { mkb[reg] = 0.f; mkk[reg] = 0.f; } if (!(j <= i)) nrb[reg] = 0.f;
            if (!(i <= j)) NrkT[reg] = 0.f; }
        __syncthreads();
#pragma unroll
        for (int reg = 0; reg < 16; ++reg) *(LAS float*)(S0 + ((32 * p + 4 * hh) * 68 + 32 * q + r) * 4 + ((reg & 3) + 8 * (reg >> 2)) * 272) = mkb[reg];
        st_cols(S2, p, q, mkk, r, hh); st_rows(S3, p, q, nrb, r, hh);
    }
    __syncthreads();
    if (w4 < 2) {
        if (lane < 32) { const int i0 = 32 * w4; float tc[32];
#pragma unroll
            for (int i = 0; i < 32; ++i) { float acc = (i == lane) ? 1.0f : 0.0f;
#pragma unroll
                for (int j4 = 0; j4 < (i + 3) / 4; ++j4) { const f32x4 m4 = *(const LAS f32x4*)(S0 + ((i0 + i) * 68 + i0 + 4 * j4) * 4);
                    if (4 * j4 + 0 < i) acc -= m4.x * tc[4 * j4 + 0]; if (4 * j4 + 1 < i) acc -= m4.y * tc[4 * j4 + 1]; if (4 * j4 + 2 < i) acc -= m4.z * tc[4 * j4 + 2]; if (4 * j4 + 3 < i) acc -= m4.w * tc[4 * j4 + 3]; }
                tc[i] = acc; }
#pragma unroll
            for (int i = 0; i < 32; ++i) *(LAS bf16*)(S7 + (i0 + i) * RSTR + (i0 + lane) * 2) = (bf16)f2bf(tc[i]);
            if (w4 == 0) {
#pragma unroll
                for (int i8 = 0; i8 < 4; ++i8) *(LAS bf16x8*)(T00T + lane * 80 + i8 * 16) = pack8(tc[8 * i8], tc[8 * i8 + 1], tc[8 * i8 + 2], tc[8 * i8 + 3], tc[8 * i8 + 4], tc[8 * i8 + 5], tc[8 * i8 + 6], tc[8 * i8 + 7]); }
        }
    } else if (w4 == 2) {
#pragma unroll
        for (int i = 0; i < 16; ++i) *(LAS bf16*)(S7 + (2 * i + hh) * RSTR + (32 + r) * 2) = (bf16)0;
    }
    __syncthreads();
    if (w4 == 1) {
        f32x16 g1 = zero16();
#pragma unroll
        for (int ks = 0; ks < 2; ++ks) { const int k0 = 16 * ks + 8 * hh; const LAS float* mp = (const LAS float*)(S0 + ((32 + r) * 68 + k0) * 4); const f32x4 x0 = *(const LAS f32x4*)mp, x1 = *(const LAS f32x4*)(mp + 4);
            g1 = MFMA32(pack8(x0.x, x0.y, x0.z, x0.w, x1.x, x1.y, x1.z, x1.w), *(const LAS bf16x8*)(T00T + r * 80 + k0 * 2), g1); }
#pragma unroll
        for (int g = 0; g < 4; ++g) { v2u w; w.x = cvtpk(g1[4 * g], g1[4 * g + 1]); w.y = cvtpk(g1[4 * g + 2], g1[4 * g + 3]); *(LAS v2u*)(G1T + r * 80 + (8 * g + 4 * hh) * 2) = w; }
        LDS_WAIT(); asm volatile("" ::: "memory");
        f32x16 t10 = zero16();
#pragma unroll
        for (int ks = 0; ks < 2; ++ks) { const int k0 = 16 * ks + 8 * hh; t10 = MFMA32(ldsfrag(S7, 32 + r, 32 + k0), *(const LAS bf16x8*)(G1T + r * 80 + k0 * 2), t10); }
#pragma unroll
        for (int reg = 0; reg < 16; ++reg) *(LAS bf16*)(S7 + (32 + 4 * hh) * RSTR + r * 2 + ((reg & 3) + 8 * (reg >> 2)) * RSTR) = (bf16)f2bf(-t10[reg]);
    }
    __syncthreads();
    {   f32x16 w1 = zero16(), w2 = zero16();
#pragma unroll
        for (int ks = 0; ks < 4; ++ks) { const int k0 = 16 * ks + 8 * hh; const bf16x8 tq = ldsfrag(S7, 32 * q + r, k0);
            w1 = MFMA32(ldsfrag(S4, 32 * p + r, k0), tq, w1); w2 = MFMA32(ldsfrag(S2, 32 * p + r, k0), tq, w2); }
        __syncthreads();
        st_rows(S0, p, q, w1, r, hh); st_rows(S1, p, q, w2, r, hh);
    }
    __syncthreads();
    {   f32x16 qf = zero16(), dl = zero16(), pv = zero16(), kf = zero16();
#pragma unroll
        for (int ks = 0; ks < 4; ++ks) { const int k0 = 16 * ks + 8 * hh;
            const bf16x8 w1p = ldsfrag(S0, 32 * p + r, k0), w1q = ldsfrag(S0, 32 * q + r, k0), w2p = ldsfrag(S1, 32 * p + r, k0), w2q = ldsfrag(S1, 32 * q + r, k0), nrq = ldsfrag(S3, 32 * q + r, k0), bep = ldsfrag(S5, 32 * p + r, k0);
            qf = MFMA32(w1p, nrq, qf); dl = MFMA32(bep, w1q, dl); pv = MFMA32(w2p, nrq, pv); kf = MFMA32(bep, w2q, kf); }
        bf16* qo = (bf16*)(a.ws + WS_PR) + row * NPR + hc + 32 * p + 4 * hh;
        if (!dry)
#pragma unroll
        for (int g = 0; g < 4; ++g) { v2u w; w.x = cvtpk(RqT[4 * g] - qf[4 * g], RqT[4 * g + 1] - qf[4 * g + 1]); w.y = cvtpk(RqT[4 * g + 2] - qf[4 * g + 2], RqT[4 * g + 3] - qf[4 * g + 3]); *(v2u*)(qo + 8 * g) = w; }
        bf16* dlo = (bf16*)((unsigned char*)a.out + DO_DLRT) + (size_t)ritem * 4096 + (32 * p + 4 * hh) * 64 + 32 * q + r;
#pragma unroll
        for (int reg = 0; reg < 16; ++reg) { if (!dry) dlo[((reg & 3) + 8 * (reg >> 2)) * 64] = (bf16)f2bf(-dl[reg]); pv[reg] = NrkT[reg] - pv[reg]; kf[reg] = KeT[reg] - kf[reg]; }
        st_cols(S2, p, q, pv, r, hh);
        st_rows(S4, p, q, kf, r, hh);
    }
    __syncthreads();
    {   f32x16 yl = zero16(), ds = zero16();
#pragma unroll
        for (int ks = 0; ks < 4; ++ks) { const int k0 = 16 * ks + 8 * hh; const bf16x8 vp = ldsfrag(S6, 32 * p + r, k0);
            yl = MFMA32(vp, ldsfrag(S2, 32 * q + r, k0), yl); ds = MFMA32(vp, ldsfrag(S4, 32 * q + r, k0), ds); }
        bf16* yo = (bf16*)(a.ws + WS_PR) + row * NPR + 512 + hc + 32 * p + 4 * hh;
        if (!dry)
#pragma unroll
        for (int g = 0; g < 4; ++g) { v2u w; w.x = cvtpk(yl[4 * g], yl[4 * g + 1]); w.y = cvtpk(yl[4 * g + 2], yl[4 * g + 3]); *(v2u*)(yo + 8 * g) = w; }
        bf16* dso = (bf16*)((unsigned char*)a.out + DO_DS) + (size_t)ritem * 4096 + (32 * p + 4 * hh) * 64 + 32 * q + r;
#pragma unroll
        for (int reg = 0; reg < 16; ++reg) if (!dry) dso[((reg & 3) + 8 * (reg >> 2)) * 64] = (bf16)f2bf(ds[reg]);
    }
    __syncthreads();
}

typedef float f32x4v __attribute__((ext_vector_type(4)));
__device__ __forceinline__ void rwkv_scan_task(const Args& a, int bh, int vq, int lane) {
    const int lc = lane & 15, g = lane >> 4, v = 16 * vq + lc;
    f32x4v ST[4];
#pragma unroll
    for (int ib = 0; ib < 4; ++ib) ST[ib] = (f32x4v){0.f, 0.f, 0.f, 0.f};
    const bf16* DL0 = (const bf16*)((const unsigned char*)a.out + DO_DLRT) + (size_t)bh * 32 * 4096 + (size_t)lc * 64 + 4 * g;
    const bf16* DS0 = (const bf16*)((const unsigned char*)a.out + DO_DS) + (size_t)bh * 32 * 4096 + (size_t)v * 64 + 4 * g;
    const float* GL0 = (const float*)(a.ws + WS_GL) + (size_t)bh * 32 * 64 + 4 * g; bf16* SP0 = (bf16*)(a.ws + WS_SPREV) + (size_t)bh * 32 * 4096 + v * 64 + 4 * g;
    v2u dl[4][2][2], ds[4]; f32x4 gl[4];
#define R2_LOAD(c_) do { const bf16* DL = DL0 + (size_t)(c_) * 4096; \
        _Pragma("unroll") for (int ib = 0; ib < 4; ++ib) { _Pragma("unroll") for (int s = 0; s < 2; ++s) { dl[ib][s][0] = *(const v2u*)(DL + (16 * ib) * 64 + 32 * s); dl[ib][s][1] = *(const v2u*)(DL + (16 * ib) * 64 + 32 * s + 16); } \
            ds[ib] = *(const v2u*)(DS0 + (size_t)(c_) * 4096 + 16 * ib); gl[ib] = *(const f32x4*)(GL0 + (size_t)(c_) * 64 + 16 * ib); } } while (0)
    R2_LOAD(0);
    for (int c = 0; c < 32; ++c) {
        bf16* SP = SP0 + (size_t)c * 4096;
        unsigned hi[4][2], lo[4][2];
#pragma unroll
        for (int ib = 0; ib < 4; ++ib) { hi[ib][0] = cvtpk(ST[ib][0], ST[ib][1]); hi[ib][1] = cvtpk(ST[ib][2], ST[ib][3]);
            v2u w; w.x = hi[ib][0]; w.y = hi[ib][1]; *(v2u*)(SP + 16 * ib) = w;
            lo[ib][0] = cvtpk(ST[ib][0] - bflo(hi[ib][0]), ST[ib][1] - bfhi(hi[ib][0])); lo[ib][1] = cvtpk(ST[ib][2] - bflo(hi[ib][1]), ST[ib][3] - bfhi(hi[ib][1])); }
        bf16x8 Bh[2], Bl[2];
#pragma unroll
        for (int s = 0; s < 2; ++s) { v4u t; t.x = hi[2 * s][0]; t.y = hi[2 * s][1]; t.z = hi[2 * s + 1][0]; t.w = hi[2 * s + 1][1]; Bh[s] = __builtin_bit_cast(bf16x8, t);
            v4u u2; u2.x = lo[2 * s][0]; u2.y = lo[2 * s][1]; u2.z = lo[2 * s + 1][0]; u2.w = lo[2 * s + 1][1]; Bl[s] = __builtin_bit_cast(bf16x8, u2); }
        f32x4v nw[4]; bf16x8 Af[4][2];
#pragma unroll
        for (int ib = 0; ib < 4; ++ib) {
            nw[ib] = (f32x4v){bflo(ds[ib].x) + gl[ib].x * ST[ib][0], bfhi(ds[ib].x) + gl[ib].y * ST[ib][1], bflo(ds[ib].y) + gl[ib].z * ST[ib][2], bfhi(ds[ib].y) + gl[ib].w * ST[ib][3]};
#pragma unroll
            for (int s = 0; s < 2; ++s) { v4u t; t.x = dl[ib][s][0].x; t.y = dl[ib][s][0].y; t.z = dl[ib][s][1].x; t.w = dl[ib][s][1].y; Af[ib][s] = __builtin_bit_cast(bf16x8, t); } }
        if (c + 1 < 32) R2_LOAD(c + 1);
#pragma unroll
        for (int s = 0; s < 2; ++s)
#pragma unroll
            for (int ib = 0; ib < 4; ++ib) { nw[ib] = __builtin_amdgcn_mfma_f32_16x16x32_bf16(Af[ib][s], Bh[s], nw[ib], 0, 0, 0); nw[ib] = __builtin_amdgcn_mfma_f32_16x16x32_bf16(Af[ib][s], Bl[s], nw[ib], 0, 0, 0); }
#pragma unroll
        for (int ib = 0; ib < 4; ++ib) ST[ib] = nw[ib];
    }
#undef R2_LOAD
    float* So = a.out + O_PWKV + (size_t)bh * 4096 + v * 64 + 4 * g;
#pragma unroll
    for (int ib = 0; ib < 4; ++ib) *(f32x4*)(So + 16 * ib) = (f32x4){ST[ib][0], ST[ib][1], ST[ib][2], ST[ib][3]};
}

__device__ __forceinline__ void rwkv_out_task(const Args& a, int ritem, int tb, int lane_, bool dry = false) {
    int lane = lane_; asm volatile("" : "+v"(lane));
    const int r = lane & 31, hh = lane >> 5, bh = ritem >> 5, c = ritem & 31, b = bh >> 3, h = bh & 7, hc = h * 64, row0 = b * SEQ, t0 = c * 64, tl = 32 * tb + r;
    const size_t row = (size_t)(row0 + t0 + tl);
    bf16* PRw = (bf16*)(a.ws + WS_PR); const bf16* cur = PRw + row * NPR; const bf16* prv = (t0 + tl) > 0 ? cur - NPR : nullptr;
    const bf16* SP = (const bf16*)(a.ws + WS_SPREV) + (size_t)ritem * 4096; const float* mu = a.in[10];
    f32x16 Y[2] = {zero16(), zero16()};
#pragma unroll
    for (int ks = 0; ks < 4; ++ks) { const int k0 = 16 * ks + 8 * hh; const bf16x8 B = ld16(cur + hc + k0);
        Y[0] = MFMA32(ld16(SP + (size_t)r * 64 + k0), B, Y[0]); Y[1] = MFMA32(ld16(SP + (size_t)(32 + r) * 64 + k0), B, Y[1]); }
    __builtin_amdgcn_sched_barrier(0);
    f32x16 G[2] = {zero16(), zero16()};
    {   const bf16* G2T = (const bf16*)(a.ws + WS_LG2T) + (size_t)(hc + r) * 128;
#pragma unroll
        for (int ks = 0; ks < 8; ++ks) { const int k0 = 16 * ks + 8 * hh; float m[8];
            mix8(*(const v4u*)(cur + 1664 + k0), prv ? *(const v4u*)(prv + 1664 + k0) : (v4u){0u, 0u, 0u, 0u}, mu + 1664 + k0, m);
            const bf16x8 B = pack8(sigmoidf_(m[0]), sigmoidf_(m[1]), sigmoidf_(m[2]), sigmoidf_(m[3]), sigmoidf_(m[4]), sigmoidf_(m[5]), sigmoidf_(m[6]), sigmoidf_(m[7]));
            G[0] = MFMA32(ld16(G2T + k0), B, G[0]); G[1] = MFMA32(ld16(G2T + 32 * 128 + k0), B, G[1]); }
    }
    __builtin_amdgcn_sched_barrier(0);
    float s1 = 0.f;
#pragma unroll
    for (int vb = 0; vb < 2; ++vb)
#pragma unroll
        for (int g = 0; g < 4; ++g) { const v2u y4 = *(const v2u*)(cur + 512 + hc + 32 * vb + 8 * g + 4 * hh);
            Y[vb][4 * g] += bflo(y4.x); Y[vb][4 * g + 1] += bfhi(y4.x); Y[vb][4 * g + 2] += bflo(y4.y); Y[vb][4 * g + 3] += bfhi(y4.y);
            s1 += (Y[vb][4 * g] + Y[vb][4 * g + 1]) + (Y[vb][4 * g + 2] + Y[vb][4 * g + 3]); }
    s1 += __shfl_xor(s1, 32); const float mean = s1 * (1.0f / 64.0f); float s2 = 0.f;
#pragma unroll
    for (int vb = 0; vb < 2; ++vb)
#pragma unroll
        for (int i = 0; i < 16; ++i) { const float d = Y[vb][i] - mean; s2 += d * d; }
    s2 += __shfl_xor(s2, 32); const float rs = rsqrtf(s2 * (1.0f / 64.0f) + R_GN_EPS);
    const float bon = ((const float*)(a.ws + WS_BON))[row * 8 + h];
    bf16* yo = (bf16*)(a.ws + WS_YRM) + row * 1024 + hc;
#pragma unroll
    for (int vb = 0; vb < 2; ++vb)
#pragma unroll
        for (int g = 0; g < 4; ++g) { const int ch = hc + 32 * vb + 8 * g + 4 * hh; float mv[4];
            mix4(*(const v2u*)(cur + 1024 + ch), prv ? *(const v2u*)(prv + 1024 + ch) : (v2u){0u, 0u}, mu + 1024 + ch, mv);
            const f32x4 gw = *(const f32x4*)(a.in[19] + ch), gb = *(const f32x4*)(a.in[20] + ch); float o[4];
#pragma unroll
            for (int i = 0; i < 4; ++i) o[i] = ((Y[vb][4 * g + i] - mean) * rs * gw[i] + gb[i] + bon * mv[i]) * G[vb][4 * g + i];
            v2u w; w.x = cvtpk(o[0], o[1]); w.y = cvtpk(o[2], o[3]); if (!dry) *(v2u*)(yo + 32 * vb + 8 * g + 4 * hh) = w; }
}


typedef float f32x4m __attribute__((ext_vector_type(4)));
constexpr size_t WS_MERGED_S = 255 * MiB;
#define MFMA16(a, b, c) __builtin_amdgcn_mfma_f32_16x16x32_bf16((a), (b), (c), 0, 0, 0)
template <int KSTEPS>
__device__ __forceinline__ f32x4m skinny_acc(const bf16* ap, const bf16* bp, f32x4m acc) {
#pragma unroll 8
    for (int ks = 0; ks < KSTEPS; ++ks) acc = MFMA16(ld16(ap + 32 * ks), ld16(bp + 32 * ks), acc);
    return acc;
}
__device__ __forceinline__ void sample_up_task(const Args& a, int j, int wave, int lane) {
    const int lc = lane & 15, g = lane >> 4, rowa = MP + 16 * wave + lc, col = 16 * j + lc;
    unsigned char* ws = a.ws;
    f32x4m a1 = {0.f, 0.f, 0.f, 0.f}, a2 = {0.f, 0.f, 0.f, 0.f};
    a1 = skinny_acc<16>((const bf16*)(ws + WS_PR) + (size_t)rowa * NPR + 8 * g, (const bf16*)(ws + WS_UPRT) + (size_t)col * 1024 + 8 * g, a1);
    a2 = skinny_acc<16>((const bf16*)(ws + WS_YMS) + (size_t)(rowa - MP) * 512 + 8 * g, (const bf16*)(ws + WS_UPRT) + (size_t)col * 1024 + 512 + 8 * g, a2);
    const bf16* PG = (const bf16*)(ws + WS_PG); bf16* MG = (bf16*)(ws + WS_MERGED_S) - (size_t)MP * 1024;
#pragma unroll
    for (int rr = 0; rr < 4; ++rr) { const size_t row = (size_t)(MP + 16 * wave + 4 * g + rr);
        MG[row * 1024 + col] = (bf16)f2bf(bf2f(PG[row * 2048 + col]) * a1[rr] + bf2f(PG[row * 2048 + 1024 + col]) * a2[rr]); }
}
__device__ __forceinline__ void sample_out_task(const Args& a, int j, int wave, int lane) {
    const int lc = lane & 15, g = lane >> 4, rowa = MP + 16 * wave + lc, col = 16 * j + lc;
    unsigned char* ws = a.ws;
    f32x4m acc = {0.f, 0.f, 0.f, 0.f};
    acc = skinny_acc<32>((const bf16*)(ws + WS_MERGED_S) + (size_t)(rowa - MP) * 1024 + 8 * g, (const bf16*)(ws + WS_WOUTT) + (size_t)col * 1024 + 8 * g, acc);
    const float gf = a.in[33][col]; bf16* X2B = (bf16*)(ws + WS_X2B); float* ssq = (float*)(ws + WS_SSQ1);
#pragma unroll
    for (int rr = 0; rr < 4; ++rr) { const int rs = 16 * wave + 4 * g + rr; const size_t row = (size_t)(MP + rs);
        const float x2 = a.in[1][(size_t)rs * 1024 + col] + acc[rr];
        a.out[row * 1024 + col] = x2; X2B[row * 1024 + col] = (bf16)f2bf(x2 * gf);
        float sq = x2 * x2; sq += __shfl_xor(sq, 1); sq += __shfl_xor(sq, 2); sq += __shfl_xor(sq, 4); sq += __shfl_xor(sq, 8);
        if (lc == 0) atomicAdd(ssq + row, sq); }
}
__device__ __forceinline__ void sample_ffn1_task(const Args& a, int j, int wave, int lane) {
    const int lc = lane & 15, g = lane >> 4, rowa = MP + 16 * wave + lc, col = 16 * j + lc;
    unsigned char* ws = a.ws;
    f32x4m acc = {0.f, 0.f, 0.f, 0.f};
    acc = skinny_acc<32>((const bf16*)(ws + WS_X2B) + (size_t)rowa * 1024 + 8 * g, (const bf16*)(ws + WS_W1T) + (size_t)col * 1024 + 8 * g, acc);
    const float* ssq = (const float*)(ws + WS_SSQ1); bf16* H = (bf16*)(ws + WS_H);
#pragma unroll
    for (int rr = 0; rr < 4; ++rr) { const size_t row = (size_t)(MP + 16 * wave + 4 * g + rr); const float rs = rsqrtf(ssq[row] * (1.0f / 1024.0f) + RMS_EPS);
        const float v = fmaxf(acc[rr] * rs, 0.f); H[row * 4096 + col] = (bf16)f2bf(v * v); }
}
__device__ __forceinline__ void sample_ffn2_task(const Args& a, int t, int wave, int lane) {
    const int lc = lane & 15, g = lane >> 4, rowa = MP + 16 * wave + lc, j = t >> 2, kq = t & 3, col = 16 * j + lc;
    unsigned char* ws = a.ws;
    f32x4m acc = {0.f, 0.f, 0.f, 0.f};
    acc = skinny_acc<32>((const bf16*)(ws + WS_H) + (size_t)rowa * 4096 + 1024 * kq + 8 * g, (const bf16*)(ws + WS_W2T) + (size_t)col * 4096 + 1024 * kq + 8 * g, acc);
#pragma unroll
    for (int rr = 0; rr < 4; ++rr) atomicAdd(a.out + (size_t)(MP + 16 * wave + 4 * g + rr) * 1024 + col, acc[rr]);
}

__device__ __forceinline__ unsigned long long rt() { return __builtin_amdgcn_s_memrealtime(); }
#define XB_TMO      128
#define XB_XCNT(j)  (256  + 64 * (j))
#define XB_XSUB(j)  (1280 + 64 * (j))
#define XB_XGEN(j)  (2304 + 64 * (j))
#define XB_TOP      3328
#define XB_TOPGEN   3392
#define XCD_BAR_WORDS 3456
#define XB_SPIN_CAP (1u << 18)

__device__ __forceinline__ unsigned xb_ld(unsigned* p)              { return __hip_atomic_load(p, __ATOMIC_RELAXED, __HIP_MEMORY_SCOPE_AGENT); }
__device__ __forceinline__ unsigned xb_add(unsigned* p, unsigned v) { return __hip_atomic_fetch_add(p, v, __ATOMIC_RELAXED, __HIP_MEMORY_SCOPE_AGENT); }
__device__ __forceinline__ unsigned xb_xcc_id() { return (unsigned)__builtin_amdgcn_s_getreg((3 << 11) | 20) & 0xFu; }
#define XB_SPIN(cond, bar) do { unsigned _sp = 0; while (cond) { __builtin_amdgcn_s_sleep(1); \
    if ((++_sp & 255u) == 0u) { if (xb_ld(&(bar)[XB_TMO])) break; if (_sp > XB_SPIN_CAP) { atomicAdd(&(bar)[XB_TMO], 1u); break; } } } } while (0)

struct XcdBarrier {
    unsigned* bar; unsigned x;
    volatile LAS unsigned* st;
};

__device__ __forceinline__ XcdBarrier xcd_barrier_post(unsigned* bar, volatile LAS unsigned* st) {
    XcdBarrier b; b.bar = bar; b.x = xb_xcc_id(); b.st = st;
    if (threadIdx.x == 0) (void)xb_add(&bar[XB_XCNT(b.x)], 1u);
    return b;
}
__device__ __forceinline__ void xcd_barrier_complete(unsigned* bar, unsigned x, unsigned& nloc, unsigned& nx) {
    const unsigned G = gridDim.x * gridDim.y * gridDim.z;
    unsigned sum, cnt, mine, sp = 0u;
    for (;;) {
        sum = 0u; cnt = 0u; mine = 0u;
#pragma unroll
        for (unsigned j = 0; j < 16; ++j) { const unsigned c = xb_ld(&bar[XB_XCNT(j)]); sum += c; cnt += (c > 0u) ? 1u : 0u; mine = (j == x) ? c : mine; }
        if (sum == G) break;
        __builtin_amdgcn_s_sleep(1);
        if ((++sp & 255u) == 0u) { if (xb_ld(&bar[XB_TMO])) break; if (sp > XB_SPIN_CAP) { atomicAdd(&bar[XB_TMO], 1u); break; } }
    }
    nloc = mine > 0u ? mine : 1u; nx = cnt > 0u ? cnt : 1u;
}

__device__ __forceinline__ void xcd_barrier(const XcdBarrier& b) {
    asm volatile("s_waitcnt vmcnt(0)" ::: "memory");
    __syncthreads();
    if (threadIdx.x == 0) {
        unsigned* bar = b.bar;
        __builtin_amdgcn_s_waitcnt(0);
        unsigned nloc = b.st[0], nx = b.st[1];
        if (nloc == 0u) { xcd_barrier_complete(bar, b.x, nloc, nx); b.st[0] = nloc; b.st[1] = nx; }
        const unsigned old = xb_add(&bar[XB_XSUB(b.x)], 1u);
        const unsigned gen = old / nloc;
        if (old + 1u == (gen + 1u) * nloc) {
            __builtin_amdgcn_fence(__ATOMIC_RELEASE, "agent");
            asm volatile("s_waitcnt vmcnt(0)" ::: "memory");
            const unsigned og = xb_add(&bar[XB_TOP], 1u);
            const unsigned tg = og / nx;
            if (og + 1u == (tg + 1u) * nx) xb_add(&bar[XB_TOPGEN], 1u);
            else XB_SPIN(xb_ld(&bar[XB_TOPGEN]) == tg, bar);
            __builtin_amdgcn_fence(__ATOMIC_ACQUIRE, "agent");
            xb_add(&bar[XB_XGEN(b.x)], 1u);
            asm volatile("s_waitcnt vmcnt(0)" ::: "memory");
        } else {
            XB_SPIN(xb_ld(&bar[XB_XGEN(b.x)]) == gen, bar);
            __builtin_amdgcn_fence(__ATOMIC_ACQUIRE, "agent");
            asm volatile("s_waitcnt vmcnt(0)" ::: "memory");
        }
    }
    __syncthreads();
}


constexpr size_t WS_BAR = 512 * 1024;
constexpr int MISC_OFF = 159744, MEGA_LDS = 160000;
static_assert(2 * RWKV_LDS <= MISC_OFF && MLSTM_LDS <= MISC_OFF && P0_LDS <= MISC_OFF && 2 * R1_ITEM_LDS <= MISC_OFF && GEMM_LDS <= MISC_OFF, "LDS map");

__global__ void __launch_bounds__(NTHR, 2) mega_fwd(Args a) {
    extern __shared__ __attribute__((aligned(16))) unsigned char lds_raw[];
    LAS unsigned char* lds = (LAS unsigned char*)lds_raw;
    volatile LAS unsigned* MISC = (volatile LAS unsigned*)(lds + MISC_OFF);
    const int tid = threadIdx.x, lane = tid & 63, wave = __builtin_amdgcn_readfirstlane(tid >> 6);
    const int G = gridDim.x, bx = blockIdx.x;
    unsigned char* ws = a.ws;
    if (tid < 64) MISC[tid] = 0u;
    __syncthreads();
    XcdBarrier bar = xcd_barrier_post((unsigned*)(ws + WS_BAR), MISC + 8);

    p0_prologue(a, lds, bx * NWAVES + wave, G * NWAVES, lane, wave);
    xcd_barrier(bar);
    { pg8::StaticOrder S; pg8::Gemm g{(const bf16*)(ws + WS_XN), (const bf16*)(ws + WS_WINT), MT, NPROJ, 1024, 1024, 1024, 0}; S.init(MT, NPROJ, G, bx);
      pg8::EpiProj E{(bf16*)(ws + WS_PR), (bf16*)(ws + WS_PM), (bf16*)(ws + WS_PG), a.in[31], (bf16*)(ws + WS_BND)}; pg8::gemm_phase<pg8::EpiProj, pg8::StaticOrder, true, true>(lds, g, S, E); }
    xcd_barrier(bar);
    {
        for (int pr = bx; pr < 1024; pr += G) rwkv_prep_pair(a, lds, 2 * pr);
        LAS float* CW = (LAS float*)lds;
        for (int item = bx; item < 1024; item += G) { stage_conv_head(a, CW, (item >> 5) & 3, tid, NTHR); __syncthreads(); mlstm_prep_task(a, item, wave, CW, lane); __syncthreads(); }
        for (int s = bx; s < 512; s += G) { rwkv_seq_item(a, lds, 64 + 2 * s); __syncthreads(); }
    }
    xcd_barrier(bar);
    {
        if (wave == 0) rwkv_scan_task(a, bx >> 2, bx & 3, lane);
        else if (wave == 1 && bx < 160) mlstm_scan_task(a, bx / 5, bx % 5, (LAS float*)lds, lane);
        else if (wave >= 2) ffn_weights_convert(a, bx * 6 + (wave - 2), G * 6, (LAS float*)(lds + 4096) + (wave - 2) * (64 * 33), lane);
    }
    xcd_barrier(bar);
    {
        for (int s = bx; s < 512; s += G) { mlstm_seq_item(a, lds, 32 + s); __syncthreads(); }
        mlstm_out_stage(a, lds, bx & 3, tid);
        __syncthreads();
        { const int tq = (bx >> 2) * NWAVES + wave, hq = bx & 3; const int item = ((tq >> 6) * 4 + hq) * 32 + ((tq >> 1) & 31); mlstm_out_task(a, item, tq & 1, lds, lane); }
        for (int task = bx * NWAVES + wave; task < 4096; task += G * NWAVES) rwkv_out_task(a, task >> 1, task & 1, lane);
    }
    xcd_barrier(bar);
    if (bx < 64) sample_up_task(a, bx, wave, lane);
    { pg8::PairOrder S; pg8::Gemm g{(const bf16*)(ws + WS_YRM), (const bf16*)(ws + WS_UPRT), MP, 1024, 512, 1024, 1024, 512}; S.init(MP, 1024, G, bx);
      pg8::EpiUpZ E{a.out, (const bf16*)(ws + WS_PG), (bf16*)(ws + WS_MERGED)}; pg8::gemm_phase<pg8::EpiUpZ, pg8::PairOrder, true, true>(lds, g, S, E); }
    xcd_barrier(bar);
    if (bx < 64) sample_out_task(a, bx, wave, lane);
    { pg8::StaticOrder S; pg8::Gemm g{(const bf16*)(ws + WS_MERGED), (const bf16*)(ws + WS_WOUTT), MP, 1024, 1024, 1024, 1024, 0}; S.init(MP, 1024, G, bx);
      pg8::EpiOut E{a.in[0], a.in[1], a.out, (bf16*)(ws + WS_X2B), a.in[33], (float*)(ws + WS_SSQ1)}; pg8::gemm_phase<pg8::EpiOut, pg8::StaticOrder, true, true>(lds, g, S, E); }
    xcd_barrier(bar);
    sample_ffn1_task(a, bx, wave, lane);
    { pg8::StaticOrder S; pg8::Gemm g{(const bf16*)(ws + WS_X2B), (const bf16*)(ws + WS_W1T), MP, FF, 1024, 1024, 1024, 0}; S.init(MP, FF, G, bx);
      pg8::EpiFfn1 E{(bf16*)(ws + WS_H), (const float*)(ws + WS_SSQ1)}; pg8::gemm_phase<pg8::EpiFfn1, pg8::StaticOrder, true, true>(lds, g, S, E); }
    xcd_barrier(bar);
    sample_ffn2_task(a, bx, wave, lane);
    { pg8::StaticOrder S; pg8::Gemm g{(const bf16*)(ws + WS_H), (const bf16*)(ws + WS_W2T), MP, 1024, FF, FF, FF, 0}; S.init(MP, 1024, G, bx);
      pg8::EpiFfn2 E{a.out, nullptr}; pg8::gemm_phase<pg8::EpiFfn2, pg8::StaticOrder, true, true>(lds, g, S, E); }
    xcd_barrier(bar);
    final_norm_rows(a, bx * NWAVES + wave, G * NWAVES, lane);
}

extern "C" void kernel_launch(void* const* d_in, const int* in_sizes, int n_in, void* d_out, int out_size, void* d_ws, size_t ws_size, hipStream_t stream) {
    static int grid = 0;
    if (grid == 0) {
        if (n_in != 37 || (size_t)out_size != O_END || ws_size < WS_NEED) { fprintf(stderr, "kernel_launch: unexpected problem: n_in %d out %d ws %zu\n", n_in, out_size, ws_size); grid = -1; return; }
        int dev = 0, cus = 0, per_cu = 0;
        if (hipGetDevice(&dev) != hipSuccess || hipDeviceGetAttribute(&cus, hipDeviceAttributeMultiprocessorCount, dev) != hipSuccess) { fprintf(stderr, "kernel_launch: device query failed\n"); grid = -1; return; }
        if (hipFuncSetAttribute((const void*)mega_fwd, hipFuncAttributeMaxDynamicSharedMemorySize, MEGA_LDS) != hipSuccess) { fprintf(stderr, "kernel_launch: hipFuncSetAttribute failed\n"); grid = -1; return; }
        if (hipOccupancyMaxActiveBlocksPerMultiprocessor(&per_cu, (const void*)mega_fwd, NTHR, MEGA_LDS) != hipSuccess || per_cu < 1) { fprintf(stderr, "kernel_launch: occupancy query reports %d workgroups per CU\n", per_cu); (void)hipGetLastError(); per_cu = 1; }
        if (cus != 256) fprintf(stderr, "kernel_launch: built for a 256-CU device (one workgroup per CU); found %d CUs\n", cus);
        grid = 256;
    }
    if (grid < 0) return;
    if (hipMemsetAsync((char*)d_ws + WS_BAR, 0, 16384, stream) != hipSuccess) { fprintf(stderr, "kernel_launch: memset failed\n"); return; }
    Args a{};
    for (int i = 0; i < 37; ++i) a.in[i] = (const float*)d_in[i];
    a.out = (float*)d_out; a.ws = (unsigned char*)d_ws;
    void* args[] = {&a};
    hipError_t e = hipLaunchCooperativeKernel((const void*)mega_fwd, dim3(grid), dim3(NTHR), args, MEGA_LDS, stream);
    if (e != hipSuccess) fprintf(stderr, "kernel_launch: cooperative launch failed: %s (grid %d)\n", hipGetErrorString(e), grid);
}
```

```cpp
#include <hip/hip_runtime.h>
#include <cstdio>
#include <cstdint>

constexpr int DM = 1024, MP = 16384, MS = 128, MTOK = MP + MS, MT = 16640;
constexpr int SEQ = 2048, NB = 8;
constexpr int NPR = 1792, NPM = 1536, NPG = 2048, NPROJ = NPR + NPM + NPG, INCOLS = 5384, GCOL0 = 3328;
constexpr int RH = 8, RN = 64, RW = 512, MH = 4, MD = 128, MW = 512, FF = 4096;
constexpr float RMS_EPS = 1e-6f, R_GN_EPS = 64e-5f, M_GN_EPS = 1e-5f;

constexpr size_t O_Y = 0;
constexpr size_t O_PSHIFT = (size_t)MTOK * DM;
constexpr size_t O_PWKV = O_PSHIFT + (size_t)NB * DM;
constexpr size_t O_PC = O_PWKV + (size_t)NB * RH * RN * RN;
constexpr size_t O_PN = O_PC + (size_t)NB * MH * MD * MD;
constexpr size_t O_PMM = O_PN + (size_t)NB * MH * MD;
constexpr size_t O_PCONV = O_PMM + (size_t)NB * MH;
constexpr size_t O_SSHIFT = O_PCONV + (size_t)NB * 3 * MW;
constexpr size_t O_SWKV = O_SSHIFT + (size_t)MS * DM;
constexpr size_t O_SC = O_SWKV + (size_t)MS * RH * RN * RN;
constexpr size_t O_SN = O_SC + (size_t)MS * MH * MD * MD;
constexpr size_t O_SMM = O_SN + (size_t)MS * MH * MD;
constexpr size_t O_SCONV = O_SMM + (size_t)MS * MH;
constexpr size_t O_END = O_SCONV + (size_t)MS * 3 * MW;
static_assert(O_END == 30695968, "output size");

constexpr size_t MiB = 1u << 20;
constexpr size_t WS_CTL = 0;
constexpr size_t WS_SSQ1 = 0, WS_SSQ2 = 128 * 1024;
constexpr size_t WS_WINT = 1 * MiB, WS_UPRT = 12 * MiB, WS_UPMT = 13 * MiB, WS_WOUTT = 14 * MiB, WS_W1T = 16 * MiB, WS_W2T = 24 * MiB;
constexpr size_t WS_GATES = 32 * MiB;
constexpr size_t WS_WQT = 32 * MiB + 576 * 1024, WS_WKT = 32 * MiB + 704 * 1024;
constexpr size_t WS_LW2T = 576 * 1024, WS_LA2T = 640 * 1024, WS_LG2T = 704 * 1024;
constexpr size_t WS_XN = 33 * MiB;
constexpr size_t WS_YM = 33 * MiB, WS_X2B = 33 * MiB;
constexpr size_t WS_YRM = 33 * MiB;
constexpr size_t WS_YMS = 255 * MiB + 512 * 1024;
constexpr size_t WS_PR = 66 * MiB;
constexpr size_t WS_PM = 123 * MiB;
constexpr size_t WS_PG = 172 * MiB;
constexpr size_t WS_YR = 237 * MiB;
constexpr size_t WS_MERGED = 66 * MiB;
constexpr size_t WS_UPSCR = 100 * MiB;
constexpr size_t WS_H = 66 * MiB;
constexpr size_t WS_NEED = 256 * MiB;
static_assert(WS_YR + (size_t)MT * 512 * 2 <= WS_NEED && WS_H + (size_t)MT * FF * 2 <= WS_NEED && WS_PG + (size_t)MT * NPG * 2 <= WS_YR && WS_UPSCR + (size_t)MT * DM * 4 <= WS_PG, "ws map");

#define GAS __attribute__((address_space(1)))
#define LAS __attribute__((address_space(3)))
typedef unsigned short bf16;
typedef unsigned v4u __attribute__((ext_vector_type(4)));
typedef unsigned v2u __attribute__((ext_vector_type(2)));
typedef float f32x4 __attribute__((ext_vector_type(4)));
typedef float f32x2 __attribute__((ext_vector_type(2)));
__device__ __forceinline__ unsigned f2bf(float f) { unsigned u = __builtin_bit_cast(unsigned, f); return (u + 0x7fffu + ((u >> 16) & 1u)) >> 16; }
__device__ __forceinline__ unsigned pk2(float lo, float hi) { return f2bf(lo) | (f2bf(hi) << 16); }
__device__ __forceinline__ float bf2f(unsigned b) { return __builtin_bit_cast(float, b << 16); }
__device__ __forceinline__ float bflo(unsigned w) { return __builtin_bit_cast(float, w << 16); }
__device__ __forceinline__ float bfhi(unsigned w) { return __builtin_bit_cast(float, w & 0xffff0000u); }
__device__ __forceinline__ float sigmoidf_(float x) { return 1.0f / (1.0f + __expf(-x)); }
__device__ __forceinline__ float wave_sum(float v) {
#pragma unroll
    for (int o = 1; o < 64; o <<= 1) v += __shfl_xor(v, o);
    return v;
}

namespace pg8 {
#define PG8_LAS __attribute__((address_space(3)))
typedef unsigned short bf16_t;
typedef short bf16x8 __attribute__((ext_vector_type(8)));
typedef float f32x4 __attribute__((ext_vector_type(4)));
typedef unsigned u32x4 __attribute__((ext_vector_type(4)));
constexpr int BM = 256, BK = 64, HALF = 128, HTB = HALF * BK * 2  , STAGE_BYTES = 8 * HTB, NXCD = 8, WGM = 8;

__host__ __device__ __forceinline__ int lds_byte(int r, int c) { const int st = (r >> 4) * 2 + (c >> 5), rr = r & 15, cc = c & 31, ob = rr * 64 + cc * 2; return st * 1024 + (ob ^ (((ob >> 9) & 1) << 5)); }
__host__ __device__ __forceinline__ void stage_rc(int b, int& R, int& C) { const int st = b / 1024, sb = b % 1024, swz = sb ^ (((sb >> 9) & 1) << 5); R = (st >> 1) * 16 + swz / 64; C = (st & 1) * 32 + (swz % 64) / 2; }
__host__ __device__ __forceinline__ int perm32(int rho) { const int n = rho >> 4, i = rho & 15; return 8 * (i >> 2) + 4 * n + (i & 3); }

struct Unit { int pm, pn, z; };
struct Gemm { const bf16_t* A; const bf16_t* Bt; int M, N, K, lda, ldb, zoff; };

struct StaticOrder {
    int nM, nN, nwg, G, c;
    __host__ __device__ void init(int M, int N, int G_, int c_) { nM = M / BM; nN = N / BM; nwg = nM * nN; G = G_; c = c_; }
    __host__ __device__ bool next(int i, Unit& u) const {
        const long L = (long)i * G + c; if (L >= nwg) return false;
        int wgid = (int)L; { const int q = nwg / NXCD, r = nwg % NXCD, xcd = wgid % NXCD, off = wgid / NXCD; wgid = (xcd < r ? xcd * (q + 1) : r * (q + 1) + (xcd - r) * q) + off; }
        const int nig = WGM * nN, gid = wgid / nig, fm = gid * WGM, gsz = (nM - fm) < WGM ? (nM - fm) : WGM;
        u.pm = fm + ((wgid % nig) % gsz); u.pn = (wgid % nig) / gsz; u.z = 0; return true;
    }
    __device__ __forceinline__ void a_ready(const Unit&) const {}
    __device__ __forceinline__ void done(const Unit&) const {}
};

struct PairOrder : StaticOrder {
    __host__ __device__ bool next(int i, Unit& u) const { if (i >= 2) return false; const bool ok = StaticOrder::next(0, u); u.z = i; return ok; }
};
__device__ __forceinline__ unsigned cvt_pk_bf16(float lo, float hi) { unsigned r; asm volatile("v_cvt_pk_bf16_f32 %0, %1, %2" : "=v"(r) : "v"(lo), "v"(hi)); return r; }
typedef unsigned u32x2 __attribute__((ext_vector_type(2)));
__device__ __forceinline__ float sigm(float x) { return 1.0f / (1.0f + __expf(-x)); }
__device__ __forceinline__ float bf_lo(unsigned w) { return __builtin_bit_cast(float, w << 16); }
__device__ __forceinline__ float bf_hi(unsigned w) { return __builtin_bit_cast(float, w & 0xffff0000u); }

struct EpiProj {
    static constexpr bool PERM = true, AFTER_DRAIN = false; static constexpr int MIDK = 0;
    bf16_t *PR, *PM, *PG; const float* gate_b; bf16_t* BND;
    __device__ __forceinline__ void operator()(const f32x4 (&acc)[2][2][4][2], const Unit& u, int wr, int wc, int fr, int fq) const {
        int colt = u.pn * BM; bf16_t* base; int ldc; bool gate = false;
        if (colt < 1792) { base = PR; ldc = 1792; } else if (colt < 3328) { base = PM; ldc = 1536; colt -= 1792; } else { base = PG; ldc = 2048; colt -= 3328; gate = true; }
        const int row0 = u.pm * BM + wr * 64 + fr, col0 = colt + wc * 32 + 8 * fq;
        f32x4 bv[2][2];
#pragma unroll
        for (int bj = 0; bj < 2; ++bj)
#pragma unroll
            for (int n = 0; n < 2; ++n) bv[bj][n] = gate ? *(const f32x4*)(gate_b + col0 + bj * HALF + 4 * n) : (f32x4){0.f, 0.f, 0.f, 0.f};
#pragma unroll
        for (int ai = 0; ai < 2; ++ai)
#pragma unroll
            for (int m = 0; m < 4; ++m) { bf16_t* rowp = base + (size_t)(row0 + ai * HALF + m * 16) * ldc + col0;
#pragma unroll
                for (int bj = 0; bj < 2; ++bj) { f32x4 v0 = acc[ai][bj][m][0] + bv[bj][0], v1 = acc[ai][bj][m][1] + bv[bj][1];
                    if (gate) {
#pragma unroll
                        for (int j = 0; j < 4; ++j) { v0[j] = sigm(v0[j]); v1[j] = sigm(v1[j]); } }
                    u32x4 w; w.x = cvt_pk_bf16(v0[0], v0[1]); w.y = cvt_pk_bf16(v0[2], v0[3]); w.z = cvt_pk_bf16(v1[0], v1[1]); w.w = cvt_pk_bf16(v1[2], v1[3]);
                    *(u32x4*)(rowp + bj * HALF) = w;
                    if (m == 3 && fr == 15 && base == PR && u.pm < 64) *(u32x4*)(BND + (size_t)((row0 + ai * HALF + m * 16) >> 6) * 1792 + col0 + bj * HALF) = w; } }
    }
};
struct EpiUp1 {
    static constexpr bool PERM = false, AFTER_DRAIN = false; static constexpr int MIDK = 0;
    float* SCR; const bf16_t* PG;
    __device__ __forceinline__ void operator()(const f32x4 (&acc)[2][2][4][2], const Unit& u, int wr, int wc, int fr, int fq) const {
        const int row0 = u.pm * BM + wr * 64 + fr, col0 = u.pn * BM + wc * 32 + 4 * fq;
#pragma unroll
        for (int ai = 0; ai < 2; ++ai) {
            if (u.pm * BM + ai * HALF >= 16512) continue;
#pragma unroll
            for (int m = 0; m < 4; ++m) { const size_t row = (size_t)(row0 + ai * HALF + m * 16);
#pragma unroll
                for (int bj = 0; bj < 2; ++bj)
#pragma unroll
                    for (int n = 0; n < 2; ++n) { const int c = col0 + bj * HALF + n * 16; const u32x2 g = *(const u32x2*)(PG + row * 2048 + c);
                        f32x4 v = acc[ai][bj][m][n]; v[0] *= bf_lo(g.x); v[1] *= bf_hi(g.x); v[2] *= bf_lo(g.y); v[3] *= bf_hi(g.y);
                        *(f32x4*)(SCR + row * 1024 + c) = v; } } }
    }
};
struct EpiUp2 {
    static constexpr bool PERM = false, AFTER_DRAIN = false; static constexpr int MIDK = 0;
    const float* SCR; const bf16_t* PG; bf16_t* MG;
    __device__ __forceinline__ void operator()(const f32x4 (&acc)[2][2][4][2], const Unit& u, int wr, int wc, int fr, int fq) const {
        const int row0 = u.pm * BM + wr * 64 + fr, col0 = u.pn * BM + wc * 32 + 4 * fq;
#pragma unroll
        for (int ai = 0; ai < 2; ++ai) {
            if (u.pm * BM + ai * HALF >= 16512) continue;
#pragma unroll
            for (int m = 0; m < 4; ++m) { const size_t row = (size_t)(row0 + ai * HALF + m * 16);
#pragma unroll
                for (int bj = 0; bj < 2; ++bj)
#pragma unroll
                    for (int n = 0; n < 2; ++n) { const int c = col0 + bj * HALF + n * 16; const u32x2 g = *(const u32x2*)(PG + row * 2048 + 1024 + c);
                        const f32x4 s = *(const f32x4*)(SCR + row * 1024 + c); f32x4 v = acc[ai][bj][m][n];
                        v[0] = s[0] + v[0] * bf_lo(g.x); v[1] = s[1] + v[1] * bf_hi(g.x); v[2] = s[2] + v[2] * bf_lo(g.y); v[3] = s[3] + v[3] * bf_hi(g.y);
                        u32x2 w; w.x = cvt_pk_bf16(v[0], v[1]); w.y = cvt_pk_bf16(v[2], v[3]); *(u32x2*)(MG + row * 1024 + c) = w; } } }
    }
};
struct EpiUpZ {
    static constexpr bool PERM = false, AFTER_DRAIN = false; static constexpr int MIDK = 0;
    float* SCR; const bf16_t* PG; bf16_t* MG;
    __device__ __forceinline__ void operator()(const f32x4 (&acc)[2][2][4][2], const Unit& u, int wr, int wc, int fr, int fq) const {
        const int row0 = u.pm * BM + wr * 64 + fr, col0 = u.pn * BM + wc * 32 + 4 * fq;
#pragma unroll
        for (int ai = 0; ai < 2; ++ai)
#pragma unroll
            for (int m = 0; m < 4; ++m) { const size_t row = (size_t)(row0 + ai * HALF + m * 16);
#pragma unroll
                for (int bj = 0; bj < 2; ++bj)
#pragma unroll
                    for (int n = 0; n < 2; ++n) { const int c = col0 + bj * HALF + n * 16; const u32x2 g = *(const u32x2*)(PG + row * 2048 + u.z * 1024 + c); f32x4 v = acc[ai][bj][m][n];
                        v[0] *= bf_lo(g.x); v[1] *= bf_hi(g.x); v[2] *= bf_lo(g.y); v[3] *= bf_hi(g.y);
                        if (u.z == 0) *(f32x4*)(SCR + row * 1024 + c) = v;
                        else { v = v + *(const f32x4*)(SCR + row * 1024 + c); u32x2 w; w.x = cvt_pk_bf16(v[0], v[1]); w.y = cvt_pk_bf16(v[2], v[3]); *(u32x2*)(MG + row * 1024 + c) = w; } } }
    }
};
struct EpiOut {
    static constexpr bool PERM = false, AFTER_DRAIN = false; static constexpr int MIDK = 0;
    const float *xp, *xs; float* OUT; bf16_t* X2B; const float* gffn; float* ssq;
    __device__ __forceinline__ void operator()(const f32x4 (&acc)[2][2][4][2], const Unit& u, int wr, int wc, int fr, int fq) const {
        const int row0 = u.pm * BM + wr * 64 + fr, col0 = u.pn * BM + wc * 32 + 4 * fq;
        f32x4 gv[2][2];
#pragma unroll
        for (int bj = 0; bj < 2; ++bj)
#pragma unroll
            for (int n = 0; n < 2; ++n) gv[bj][n] = *(const f32x4*)(gffn + col0 + bj * HALF + n * 16);
#pragma unroll
        for (int ai = 0; ai < 2; ++ai) {
            if (u.pm * BM + ai * HALF >= 16512) continue;
#pragma unroll
            for (int m = 0; m < 4; ++m) { const int row = row0 + ai * HALF + m * 16;
                const float* xin = row < 16384 ? xp + (size_t)row * 1024 : xs + (size_t)(row - 16384) * 1024; float sq = 0.f;
#pragma unroll
                for (int bj = 0; bj < 2; ++bj)
#pragma unroll
                    for (int n = 0; n < 2; ++n) { const int c = col0 + bj * HALF + n * 16; const f32x4 v = *(const f32x4*)(xin + c) + acc[ai][bj][m][n];
                        *(f32x4*)(OUT + (size_t)row * 1024 + c) = v; sq += (v[0] * v[0] + v[1] * v[1]) + (v[2] * v[2] + v[3] * v[3]);
                        const f32x4 h = v * gv[bj][n]; u32x2 w; w.x = cvt_pk_bf16(h[0], h[1]); w.y = cvt_pk_bf16(h[2], h[3]); *(u32x2*)(X2B + (size_t)row * 1024 + c) = w; }
                sq += __shfl_xor(sq, 16); sq += __shfl_xor(sq, 32);
                if (fq == 0) atomicAdd(ssq + row, sq); }
        }
    }
};
struct EpiFfn1 {
    static constexpr bool PERM = true, AFTER_DRAIN = false; static constexpr int MIDK = 0;
    bf16_t* H; const float* ssq;
    __device__ __forceinline__ void operator()(const f32x4 (&acc)[2][2][4][2], const Unit& u, int wr, int wc, int fr, int fq) const {
        const int row0 = u.pm * BM + wr * 64 + fr, col0 = u.pn * BM + wc * 32 + 8 * fq;
#pragma unroll
        for (int ai = 0; ai < 2; ++ai)
#pragma unroll
            for (int m = 0; m < 4; ++m) { const int row = row0 + ai * HALF + m * 16; const float rs = rsqrtf(ssq[row] * (1.0f / 1024.0f) + 1e-6f);
                bf16_t* rowp = H + (size_t)row * 4096 + col0;
#pragma unroll
                for (int bj = 0; bj < 2; ++bj) { f32x4 v0 = acc[ai][bj][m][0] * rs, v1 = acc[ai][bj][m][1] * rs;
#pragma unroll
                    for (int j = 0; j < 4; ++j) { const float a = fmaxf(v0[j], 0.f), b = fmaxf(v1[j], 0.f); v0[j] = a * a; v1[j] = b * b; }
                    u32x4 w; w.x = cvt_pk_bf16(v0[0], v0[1]); w.y = cvt_pk_bf16(v0[2], v0[3]); w.z = cvt_pk_bf16(v1[0], v1[1]); w.w = cvt_pk_bf16(v1[2], v1[3]);
                    *(u32x4*)(rowp + bj * HALF) = w; } }
    }
};
struct EpiFfn2 {
    static constexpr bool PERM = false, AFTER_DRAIN = false; static constexpr int MIDK = 0;
    float* OUT; float* ssq;
    __device__ __forceinline__ void operator()(const f32x4 (&acc)[2][2][4][2], const Unit& u, int wr, int wc, int fr, int fq) const {
        const int row0 = u.pm * BM + wr * 64 + fr, col0 = u.pn * BM + wc * 32 + 4 * fq;
#pragma unroll
        for (int ai = 0; ai < 2; ++ai) {
            if (u.pm * BM + ai * HALF >= 16512) continue;
#pragma unroll
            for (int m = 0; m < 4; ++m) { const int row = row0 + ai * HALF + m * 16; float sq = 0.f;
#pragma unroll
                for (int bj = 0; bj < 2; ++bj)
#pragma unroll
                    for (int n = 0; n < 2; ++n) { float* p = OUT + (size_t)row * 1024 + col0 + bj * HALF + n * 16; const f32x4 v = *(const f32x4*)p + acc[ai][bj][m][n];
                        *(f32x4*)p = v; }
                (void)sq; }
        }
    }
};

template <class Epi, class Sched, bool ALIGN_EPI = false, bool SP2 = false>
__device__ __forceinline__ void gemm_phase(PG8_LAS unsigned char* lds, const Gemm g, const Sched& S, const Epi& E) {
    int tid_ = threadIdx.x; asm volatile("" : "+v"(tid_));
    const int tid = tid_, wid = __builtin_amdgcn_readfirstlane(tid >> 6), lane = tid & 63, wr = wid >> 2, wc = wid & 3, fr = lane & 15, fq = lane >> 4;
    const int K = g.K, nt = K / BK;
    unsigned voffA[2], voffB[2];
#pragma unroll
    for (int i = 0; i < 2; ++i) { int R, C; stage_rc(tid * 16 + i * 8192, R, C); const int Rb = Epi::PERM ? ((R & ~31) + perm32(R & 31)) : R;
        voffA[i] = (unsigned)(R * g.lda + C) * 2u; voffB[i] = (unsigned)(Rb * g.ldb + C) * 2u; }
    const size_t kstep = (size_t)(BK * 2);
    const size_t hstep = (size_t)HALF * g.ldb * 2;
    const size_t tstep = 2 * hstep;
    const size_t hstepA = (size_t)HALF * g.lda * 2, tstepA = 2 * hstepA;
    const unsigned ldsw = (unsigned)wid * 1024u;
    const int aoff = lds_byte(wr * 64 + fr, fq * 8), boff = lds_byte(wc * 32 + fr, fq * 8);
#define PG8_SA(b, h) (((b) * 2 + (h)) * HTB)
#define PG8_SB(b, h) ((4 + (b) * 2 + (h)) * HTB)
#define PG8_STAGE(bufoff, gbase, voff) do { _Pragma("unroll") for (int _i = 0; _i < 2; ++_i) \
        __builtin_amdgcn_global_load_lds((const unsigned*)((const char*)(gbase) + (voff)[_i]), (PG8_LAS unsigned*)(lds + (bufoff) + ldsw + _i * 8192), 16, 0, 0); } while (0)
#define PG8_LDA(dst, b, h) do { _Pragma("unroll") for (int m = 0; m < 4; ++m) _Pragma("unroll") for (int k = 0; k < 2; ++k) dst[m][k] = *(const PG8_LAS bf16x8*)(lds + PG8_SA(b, h) + aoff + m * 2048 + k * 1024); } while (0)
#define PG8_LDB(dst, b, h) do { _Pragma("unroll") for (int n = 0; n < 2; ++n) _Pragma("unroll") for (int k = 0; k < 2; ++k) dst[n][k] = *(const PG8_LAS bf16x8*)(lds + PG8_SB(b, h) + boff + n * 2048 + k * 1024); } while (0)
#define PG8_MMA(ai, bj, At, Bt) do { __builtin_amdgcn_s_setprio(1); _Pragma("unroll") for (int m = 0; m < 4; ++m) _Pragma("unroll") for (int n = 0; n < 2; ++n) _Pragma("unroll") for (int k = 0; k < 2; ++k) \
        acc[ai][bj][m][n] = __builtin_amdgcn_mfma_f32_16x16x32_bf16(Bt[n][k], At[m][k], acc[ai][bj][m][n], 0, 0, 0); __builtin_amdgcn_s_setprio(0); } while (0)
#define PG8_WAIT_V(n) asm volatile("s_waitcnt vmcnt(" #n ")" ::: "memory")
#define PG8_WAIT_L(n) asm volatile("s_waitcnt lgkmcnt(" #n ")" ::: "memory")
#define PG8_BAR __builtin_amdgcn_s_barrier()
#define PG8_SCHED __builtin_amdgcn_sched_barrier(0)
    Unit cur, nxt; int ui = 0;
    if (!S.next(0, cur)) return;
    f32x4 acc[2][2][4][2];
#pragma unroll
    for (int a = 0; a < 2; ++a)
#pragma unroll
        for (int b = 0; b < 2; ++b)
#pragma unroll
            for (int m = 0; m < 4; ++m)
#pragma unroll
                for (int n = 0; n < 2; ++n) acc[a][b][m][n] = (f32x4){0.f, 0.f, 0.f, 0.f};
    bf16x8 At[4][2], B0[2][2], B1[2][2];
    const size_t zb = (size_t)g.zoff * 2;
    const char* cA = (const char*)g.A + (size_t)cur.pm * tstepA + cur.z * zb; const char* cB = (const char*)g.Bt + (size_t)cur.pn * tstep + cur.z * zb;
    S.a_ready(cur);
    if constexpr (SP2) {
        PG8_STAGE(PG8_SB(0, 0), cB, voffB); PG8_STAGE(PG8_SB(0, 1), cB + hstep, voffB); PG8_STAGE(PG8_SA(0, 0), cA, voffA); PG8_STAGE(PG8_SA(0, 1), cA + hstepA, voffA);
        if (wr == 1) PG8_BAR;
        PG8_WAIT_V(2); PG8_BAR;
        PG8_STAGE(PG8_SB(1, 0), cB + kstep, voffB); PG8_STAGE(PG8_SA(1, 0), cA + kstep, voffA); PG8_STAGE(PG8_SB(1, 1), cB + hstep + kstep, voffB);
        PG8_WAIT_V(6); PG8_BAR;
    } else {
        PG8_STAGE(PG8_SB(0, 0), cB, voffB); PG8_STAGE(PG8_SA(0, 0), cA, voffA); PG8_STAGE(PG8_SB(0, 1), cB + hstep, voffB); PG8_STAGE(PG8_SA(0, 1), cA + hstepA, voffA);
        if (wr == 1) PG8_BAR;
        PG8_WAIT_V(4); PG8_BAR;
        PG8_STAGE(PG8_SB(1, 0), cB + kstep, voffB); PG8_STAGE(PG8_SA(1, 0), cA + kstep, voffA); PG8_STAGE(PG8_SB(1, 1), cB + hstep + kstep, voffB);
        PG8_WAIT_V(6); PG8_BAR;
    }
    for (;;) {
        const bool has_next = S.next(ui + 1, nxt);
        const char* nA = has_next ? (const char*)g.A + (size_t)nxt.pm * tstepA + nxt.z * zb : cA; const char* nB = has_next ? (const char*)g.Bt + (size_t)nxt.pn * tstep + nxt.z * zb : cB;
        for (int t = 0; t < nt; t += 2) {
            const bool last = (t == nt - 2);
            const char* a1 = cA + (size_t)(t + 1) * kstep;
            const char* a2 = last ? nA : cA + (size_t)(t + 2) * kstep; const char* b2 = last ? nB : cB + (size_t)(t + 2) * kstep;
            const char* a3 = a2 + kstep; const char* b3 = b2 + kstep;
            if (last && has_next) S.a_ready(nxt);
            if constexpr (SP2) {
            PG8_LDB(B0, 0, 0); PG8_LDB(B1, 0, 1); PG8_SCHED; PG8_LDA(At, 0, 0); PG8_STAGE(PG8_SA(1, 1), a1 + hstepA, voffA);
            PG8_WAIT_V(8); PG8_WAIT_L(0); PG8_BAR; PG8_MMA(0, 0, At, B0); PG8_MMA(0, 1, At, B1); PG8_BAR; PG8_SCHED;
            PG8_LDA(At, 0, 1); PG8_STAGE(PG8_SB(0, 0), b2, voffB); PG8_STAGE(PG8_SB(0, 1), b2 + hstep, voffB); PG8_STAGE(PG8_SA(0, 0), a2, voffA);
            PG8_WAIT_V(8); PG8_WAIT_L(0); PG8_BAR; PG8_MMA(1, 0, At, B0); PG8_MMA(1, 1, At, B1); PG8_BAR; PG8_SCHED;
            PG8_LDB(B0, 1, 0); PG8_LDB(B1, 1, 1); PG8_SCHED; PG8_LDA(At, 1, 0); PG8_STAGE(PG8_SA(0, 1), a2 + hstepA, voffA);
            PG8_WAIT_V(8); PG8_WAIT_L(0); PG8_BAR; PG8_MMA(0, 0, At, B0); PG8_MMA(0, 1, At, B1); PG8_BAR; PG8_SCHED;
            PG8_LDA(At, 1, 1); PG8_STAGE(PG8_SB(1, 0), b3, voffB); PG8_STAGE(PG8_SB(1, 1), b3 + hstep, voffB); PG8_STAGE(PG8_SA(1, 0), a3, voffA);
            PG8_WAIT_V(8); PG8_WAIT_L(0); PG8_BAR; PG8_MMA(1, 0, At, B0); PG8_MMA(1, 1, At, B1); PG8_BAR; PG8_SCHED;
            } else {
            PG8_LDB(B0, 0, 0); PG8_SCHED; PG8_LDA(At, 0, 0); PG8_STAGE(PG8_SA(1, 1), a1 + hstepA, voffA);
            PG8_WAIT_L(8); PG8_BAR; PG8_WAIT_L(0); PG8_MMA(0, 0, At, B0); PG8_BAR; PG8_SCHED;
            PG8_LDB(B1, 0, 1); PG8_STAGE(PG8_SB(0, 0), b2, voffB);
            PG8_BAR; PG8_WAIT_L(0); PG8_MMA(0, 1, At, B1); PG8_BAR;
            PG8_LDA(At, 0, 1); PG8_STAGE(PG8_SA(0, 0), a2, voffA);
            PG8_BAR; PG8_WAIT_L(0); PG8_MMA(1, 0, At, B0); PG8_BAR; PG8_SCHED;
            PG8_STAGE(PG8_SB(0, 1), b2 + hstep, voffB);
            PG8_WAIT_V(6); PG8_BAR; PG8_MMA(1, 1, At, B1); PG8_BAR;
            PG8_LDB(B0, 1, 0); PG8_SCHED; PG8_LDA(At, 1, 0); PG8_STAGE(PG8_SA(0, 1), a2 + hstepA, voffA);
            PG8_WAIT_L(8); PG8_BAR; PG8_WAIT_L(0); PG8_MMA(0, 0, At, B0); PG8_BAR; PG8_SCHED;
            PG8_LDB(B1, 1, 1); PG8_STAGE(PG8_SB(1, 0), b3, voffB);
            PG8_BAR; PG8_WAIT_L(0); PG8_MMA(0, 1, At, B1); PG8_BAR;
            PG8_LDA(At, 1, 1); PG8_STAGE(PG8_SA(1, 0), a3, voffA);
            PG8_BAR; PG8_WAIT_L(0); PG8_MMA(1, 0, At, B0); PG8_BAR; PG8_SCHED;
            PG8_STAGE(PG8_SB(1, 1), b3 + hstep, voffB);
            PG8_WAIT_V(6); PG8_BAR; PG8_MMA(1, 1, At, B1); PG8_BAR;
            }
        }
        if constexpr (ALIGN_EPI) { if (wr == 0) PG8_BAR; }
        if constexpr (!Epi::AFTER_DRAIN) { E(acc, cur, wr, wc, fr, fq); S.done(cur); }
        if (!has_next) break;
#pragma unroll
        for (int a = 0; a < 2; ++a)
#pragma unroll
            for (int b = 0; b < 2; ++b)
#pragma unroll
                for (int m = 0; m < 4; ++m)
#pragma unroll
                    for (int n = 0; n < 2; ++n) acc[a][b][m][n] = (f32x4){0.f, 0.f, 0.f, 0.f};
        cur = nxt; cA = nA; cB = nB; ++ui;
        if constexpr (ALIGN_EPI) { if (wr == 1) PG8_BAR; }
    }
    PG8_WAIT_V(0);
    if constexpr (!ALIGN_EPI) { if (wr == 0) PG8_BAR; }
    PG8_BAR;
    if constexpr (Epi::AFTER_DRAIN) { E.fused(acc, cur, wr, wc, fr, fq, lds, wid, lane); S.done(cur); }
#undef PG8_SA
#undef PG8_SB
#undef PG8_STAGE
#undef PG8_LDA
#undef PG8_LDB
#undef PG8_MMA
#undef PG8_WAIT_V
#undef PG8_WAIT_L
#undef PG8_BAR
#undef PG8_SCHED
}
}

struct Args {
    const float* in[37];
    float* out; unsigned char* ws;
};
constexpr int NWAVES = 8, NTHR = 512;
constexpr int GEMM_LDS = 131072;

#define LDS_WAIT() asm volatile("s_waitcnt lgkmcnt(0)" ::: "memory")

__device__ __forceinline__ void transpose_item(const float* W, int ldw, int nblk, bf16* WT, int ldt, int item, LAS float* scr, int lane, float sc = 1.0f) {
    const int kb = item / nblk, nb = item % nblk, k0 = 64 * kb, n0 = 32 * nb;
#pragma unroll 8
    for (int i = 0; i < 32; ++i) { const int kk = 2 * i + (lane >> 5); scr[kk * 33 + (lane & 31)] = W[(size_t)(k0 + kk) * ldw + n0 + (lane & 31)]; }
    LDS_WAIT(); asm volatile("" ::: "memory");
    const int c = lane & 7;
#pragma unroll
    for (int j = 0; j < 4; ++j) { const int n = (lane >> 3) + 8 * j; const LAS float* s = scr + (8 * c) * 33 + n;
        v4u o; o.x = pk2(s[0 * 33] * sc, s[1 * 33] * sc); o.y = pk2(s[2 * 33] * sc, s[3 * 33] * sc); o.z = pk2(s[4 * 33] * sc, s[5 * 33] * sc); o.w = pk2(s[6 * 33] * sc, s[7 * 33] * sc);
        *(v4u*)(WT + (size_t)(n0 + n) * ldt + k0 + 8 * c) = o; }
    LDS_WAIT(); asm volatile("" ::: "memory");
}

__device__ __forceinline__ void ffn_weights_convert(const Args& a, int wi, int nw, LAS float* scr, int lane) {
    for (int it = wi; it < 4096; it += nw) {
        if (it < 2048) transpose_item(a.in[34], 4096, 128, (bf16*)(a.ws + WS_W1T), 1024, it, scr, lane);
        else transpose_item(a.in[35], 1024, 32, (bf16*)(a.ws + WS_W2T), 4096, it - 2048, scr, lane); }
}
constexpr int P0_LDS = 8 * 64 * 33 * 4 + 8 * 1024 * 4;
__device__ __forceinline__ void p0_prologue(const Args& a, LAS unsigned char* lds, int gw, int NGW, int lane, int wave) {
    unsigned char* ws = a.ws;
    LAS float* scr = (LAS float*)(lds) + wave * (64 * 33);
    LAS float* wg = (LAS float*)(lds + 8 * 64 * 33 * 4);
    const float* w_in = a.in[9];
    for (int i = threadIdx.x; i < 8 * 1024; i += NTHR) { const int k = i >> 3, c = i & 7; wg[c * 1024 + k] = w_in[(size_t)k * INCOLS + GCOL0 + c]; }
    { float* z = (float*)(ws + WS_CTL); for (int i = gw * 64 + lane; i < 65536; i += NGW * 64) z[i] = 0.f; }
    constexpr int I_IN1 = 16 * (3328 / 32), I_IN2 = 16 * (2048 / 32), I_UP = 8 * 32, I_OUT = 16 * 32, I_F1 = 16 * 128, I_F2 = 64 * 32;
    constexpr int I_QK = 8 * 8;
    constexpr int I_LW = 16, I_LG = 32;
    constexpr int NITEMS = I_IN1 + I_IN2 + 2 * I_UP + I_OUT + I_F1 + I_F2 + I_QK + 2 * I_LW + I_LG;
    for (int it = gw; it < NITEMS; it += NGW) {
        int r = it;
        if (r < I_IN1) { transpose_item(w_in, INCOLS, 3328 / 32, (bf16*)(ws + WS_WINT), 1024, r, scr, lane); continue; } r -= I_IN1;
        if (r < I_IN2) { transpose_item(w_in + 3336, INCOLS, 2048 / 32, (bf16*)(ws + WS_WINT) + (size_t)3328 * 1024, 1024, r, scr, lane); continue; } r -= I_IN2;
        if (r < I_UP) { transpose_item(a.in[21], 1024, 32, (bf16*)(ws + WS_UPRT), 1024, r, scr, lane); continue; } r -= I_UP;
        if (r < I_UP) { transpose_item(a.in[30], 1024, 32, (bf16*)(ws + WS_UPRT) + 512, 1024, r, scr, lane); continue; } r -= I_UP;
        if (r < I_OUT) { transpose_item(a.in[32], 1024, 32, (bf16*)(ws + WS_WOUTT), 1024, r, scr, lane); continue; } r -= I_OUT;
        if (r < I_F1 + I_F2) continue;
        r -= I_F1 + I_F2;
        if (r >= I_QK) { r -= I_QK;
            if (r < I_LW) { transpose_item(a.in[12], 512, 16, (bf16*)(ws + WS_LW2T), 64, r, scr, lane); continue; } r -= I_LW;
            if (r < I_LW) { transpose_item(a.in[14], 512, 16, (bf16*)(ws + WS_LA2T), 64, r, scr, lane); continue; } r -= I_LW;
            transpose_item(a.in[15], 512, 16, (bf16*)(ws + WS_LG2T), 128, r, scr, lane); continue; }
        { const int mat = r >> 3, hq = mat & 3, isk = mat >> 2;
          transpose_item((isk ? a.in[25] : a.in[24]) + (size_t)hq * 16384, 128, 4, (bf16*)(ws + (isk ? WS_WKT : WS_WQT)) + (size_t)hq * 16384, 128, r & 7, scr, lane, isk ? 1.0f : 0.08838834764831845f); }
    }
    __syncthreads();
    const float* gmix = a.in[8];
    f32x4 gv[4];
#pragma unroll
    for (int j = 0; j < 4; ++j) gv[j] = ((const f32x4*)gmix)[lane + 64 * j];
    bf16* XN = (bf16*)(ws + WS_XN); float* GATES = (float*)(ws + WS_GATES);
    for (int row = gw; row < MT; row += NGW) {
        unsigned long long* o8 = (unsigned long long*)(XN + (size_t)row * 1024) + lane;
        if (row >= MTOK) {
            const f32x4* xr = (const f32x4*)(a.in[2] + (size_t)(row - MTOK) * 1024) + lane;
#pragma unroll
            for (int j = 0; j < 4; ++j) { const f32x4 v = xr[64 * j]; o8[64 * j] = (unsigned long long)pk2(v.x, v.y) | ((unsigned long long)pk2(v.z, v.w) << 32); }
            continue;
        }
        const f32x4* xr = (const f32x4*)(row < MP ? a.in[0] + (size_t)row * 1024 : a.in[1] + (size_t)(row - MP) * 1024) + lane;
        f32x4 v[4]; float s = 0.f;
#pragma unroll
        for (int j = 0; j < 4; ++j) { v[j] = xr[64 * j]; s += (v[j].x * v[j].x + v[j].y * v[j].y) + (v[j].z * v[j].z + v[j].w * v[j].w); }
        const float rstd = rsqrtf(wave_sum(s) * (1.f / 1024.f) + RMS_EPS);
#pragma unroll
        for (int j = 0; j < 4; ++j) { v[j] = v[j] * rstd * gv[j]; o8[64 * j] = (unsigned long long)pk2(v[j].x, v[j].y) | ((unsigned long long)pk2(v[j].z, v[j].w) << 32); }
        float gsum[8];
#pragma unroll
        for (int c = 0; c < 8; ++c) { float p = 0.f;
#pragma unroll
            for (int j = 0; j < 4; ++j) { const f32x4 w = *(const LAS f32x4*)(wg + c * 1024 + 4 * (lane + 64 * j)); p += (v[j].x * w.x + v[j].y * w.y) + (v[j].z * w.z + v[j].w * w.w); }
            gsum[c] = wave_sum(p); }
        if (lane < 8) { float g = gsum[0];
#pragma unroll
            for (int c = 1; c < 8; ++c) g = (lane == c) ? gsum[c] : g;
            GATES[(size_t)row * 8 + lane] = g; }
        float* so = nullptr;
        if (row >= MP) so = a.out + O_SSHIFT + (size_t)(row - MP) * 1024;
        else if ((row & (SEQ - 1)) == SEQ - 1) so = a.out + O_PSHIFT + (size_t)(row >> 11) * 1024;
        if (so) {
#pragma unroll
            for (int j = 0; j < 4; ++j) ((f32x4*)so)[lane + 64 * j] = v[j]; }
    }
}

constexpr int RCH = 16;
constexpr int RWKV_LDS = (RCH * 256 + 8 * RCH * 64 + RCH) * 4;
__device__ __forceinline__ void rwkv_seq_item(const Args& a, LAS unsigned char* ldsb0, int item0) {
    const int tid = threadIdx.x & 255, lane = tid & 63, wv = tid >> 6; const int item = item0 + (threadIdx.x >> 8);
    LAS unsigned char* ldsb = ldsb0 + (threadIdx.x >> 8) * RWKV_LDS;
    const bf16* PR = (const bf16*)(a.ws + WS_PR); bf16* YR = (bf16*)(a.ws + WS_PR);
    const float *mu = a.in[10], *w0 = a.in[11], *w2 = a.in[12], *a0 = a.in[13], *a2 = a.in[14], *g2 = a.in[15], *rkk = a.in[16], *rka = a.in[17], *rrk = a.in[18], *gnw = a.in[19], *gnb = a.in[20];
    int T, row0, h, prevrow0; const float* S0 = nullptr; float* Sout;
    if (item < 64) { const int b = item >> 3; h = item & 7; T = SEQ; row0 = b * SEQ; prevrow0 = -1; Sout = a.out + O_PWKV + (size_t)item * 4096; }
    else { const int sb = (item - 64) >> 3; h = (item - 64) & 7; T = 1; row0 = MP + sb; prevrow0 = MTOK + sb; S0 = a.in[3] + (size_t)(item - 64) * 4096; Sout = a.out + O_SWKV + (size_t)(item - 64) * 4096; }
    const int hc = h * 64;
    LAS float* MIXW = (LAS float*)ldsb;
    LAS float* MIXA = MIXW + RCH * 64;
    LAS float* MIXG = MIXA + RCH * 64;
    LAS float* Rb = MIXG + RCH * 128;
    LAS float* Kb = Rb + RCH * 64;
    LAS float* Vb = Kb + RCH * 64;
    LAS float* Wb = Vb + RCH * 64;
    LAS float* KKb = Wb + RCH * 64;
    LAS float* Bb = KKb + RCH * 64;
    LAS float* Gb = Bb + RCH * 64;
    LAS float* Yb = Gb + RCH * 64;
    LAS float* BON = Yb + RCH * 64;
    const int sv = tid >> 2, kq = tid & 3;
    float S[16];
    if (S0) {
#pragma unroll
        for (int i = 0; i < 4; ++i) { const f32x4 t = *(const f32x4*)(S0 + sv * 64 + 16 * kq + 4 * i); S[4 * i] = t.x; S[4 * i + 1] = t.y; S[4 * i + 2] = t.z; S[4 * i + 3] = t.w; }
    } else {
#pragma unroll
        for (int i = 0; i < 16; ++i) S[i] = 0.f;
    }
    const int j = lane;
    const float w0j = w0[hc + j], a0j = a0[hc + j], rkkj = rkk[hc + j], rkaj = rka[hc + j], rrkj = rrk[hc + j], gnwj = gnw[hc + j], gnbj = gnb[hc + j];
    for (int t0 = 0; t0 < T; t0 += RCH) {
        const int nt = (T - t0) < RCH ? (T - t0) : RCH;
        for (int it = tid; it < nt * 56; it += 256) {
            const int t = it / 56, g = it % 56;
            int col; LAS float* dst; int kind;
            if (g < 8) { col = hc + 8 * g; dst = Rb + t * 64 + 8 * g; kind = 0; }
            else if (g < 16) { col = 512 + hc + 8 * (g - 8); dst = Kb + t * 64 + 8 * (g - 8); kind = 0; }
            else if (g < 24) { col = 1024 + hc + 8 * (g - 16); dst = Vb + t * 64 + 8 * (g - 16); kind = 0; }
            else if (g < 32) { col = 1536 + 8 * (g - 24); dst = MIXW + t * 64 + 8 * (g - 24); kind = 1; }
            else if (g < 40) { col = 1600 + 8 * (g - 32); dst = MIXA + t * 64 + 8 * (g - 32); kind = 0; }
            else { col = 1664 + 8 * (g - 40); dst = MIXG + t * 128 + 8 * (g - 40); kind = 2; }
            const int tg = t0 + t;
            const v4u cur = *(const v4u*)(PR + (size_t)(row0 + tg) * NPR + col);
            v4u prv = (v4u){0u, 0u, 0u, 0u};
            if (tg > 0) prv = *(const v4u*)(PR + (size_t)(row0 + tg - 1) * NPR + col);
            else if (prevrow0 >= 0) prv = *(const v4u*)(PR + (size_t)prevrow0 * NPR + col);
            const f32x4 m0 = *(const f32x4*)(mu + col), m1 = *(const f32x4*)(mu + col + 4);
            float c[8], p[8], mm[8] = {m0.x, m0.y, m0.z, m0.w, m1.x, m1.y, m1.z, m1.w};
            c[0] = bflo(cur.x); c[1] = bfhi(cur.x); c[2] = bflo(cur.y); c[3] = bfhi(cur.y); c[4] = bflo(cur.z); c[5] = bfhi(cur.z); c[6] = bflo(cur.w); c[7] = bfhi(cur.w);
            p[0] = bflo(prv.x); p[1] = bfhi(prv.x); p[2] = bflo(prv.y); p[3] = bfhi(prv.y); p[4] = bflo(prv.z); p[5] = bfhi(prv.z); p[6] = bflo(prv.w); p[7] = bfhi(prv.w);
#pragma unroll
            for (int i = 0; i < 8; ++i) { float m = c[i] + (p[i] - c[i]) * mm[i]; if (kind == 1) m = tanhf(m); else if (kind == 2) m = sigmoidf_(m); dst[i] = m; }
        }
        __syncthreads();
        float accw[RCH / 4], acca[RCH / 4], accg[RCH / 4];
#pragma unroll
        for (int i = 0; i < RCH / 4; ++i) { accw[i] = 0.f; acca[i] = 0.f; accg[i] = 0.f; }
        for (int i4 = 0; i4 < 16; ++i4) {
            float wv4[4], av4[4];
#pragma unroll
            for (int q = 0; q < 4; ++q) { wv4[q] = w2[(size_t)(4 * i4 + q) * 512 + hc + j]; av4[q] = a2[(size_t)(4 * i4 + q) * 512 + hc + j]; }
#pragma unroll
            for (int tt = 0; tt < RCH / 4; ++tt) { const int t = wv + 4 * tt; if (t < nt) {
                const f32x4 xw = *(const LAS f32x4*)(MIXW + t * 64 + 4 * i4), xa = *(const LAS f32x4*)(MIXA + t * 64 + 4 * i4);
                accw[tt] += (xw.x * wv4[0] + xw.y * wv4[1]) + (xw.z * wv4[2] + xw.w * wv4[3]);
                acca[tt] += (xa.x * av4[0] + xa.y * av4[1]) + (xa.z * av4[2] + xa.w * av4[3]); } }
        }
        for (int i4 = 0; i4 < 32; ++i4) {
            float gv4[4];
#pragma unroll
            for (int q = 0; q < 4; ++q) gv4[q] = g2[(size_t)(4 * i4 + q) * 512 + hc + j];
#pragma unroll
            for (int tt = 0; tt < RCH / 4; ++tt) { const int t = wv + 4 * tt; if (t < nt) {
                const f32x4 xg = *(const LAS f32x4*)(MIXG + t * 128 + 4 * i4);
                accg[tt] += (xg.x * gv4[0] + xg.y * gv4[1]) + (xg.z * gv4[2] + xg.w * gv4[3]); } }
        }
#pragma unroll
        for (int tt = 0; tt < RCH / 4; ++tt) { const int t = wv + 4 * tt; if (t < nt) {
            const float wl = w0j + accw[tt]; const float sg = 1.0f / (1.0f + expf(-wl));
            const float dec = expf(-0.6065306597126334f * sg);
            const float aa = 1.0f / (1.0f + expf(-(a0j + acca[tt])));
            const float kraw = Kb[t * 64 + j]; const float kkr = kraw * rkkj;
            const float ss = wave_sum(kkr * kkr); const float kk = kkr / fmaxf(sqrtf(ss), 1e-12f);
            const float k2 = kraw * (1.0f + (aa - 1.0f) * rkaj);
            const float bon = wave_sum(Rb[t * 64 + j] * k2 * rrkj);
            Wb[t * 64 + j] = dec; KKb[t * 64 + j] = kk; Bb[t * 64 + j] = kk * aa; Kb[t * 64 + j] = k2; Gb[t * 64 + j] = accg[tt];
            if (j == 0) BON[t] = bon; } }
        __syncthreads();
        for (int t = 0; t < nt; ++t) {
            float kk[16], p = 0.f;
#pragma unroll
            for (int i = 0; i < 4; ++i) { const f32x4 x = *(const LAS f32x4*)(KKb + t * 64 + 16 * kq + 4 * i); kk[4 * i] = x.x; kk[4 * i + 1] = x.y; kk[4 * i + 2] = x.z; kk[4 * i + 3] = x.w; }
#pragma unroll
            for (int i = 0; i < 16; ++i) p += S[i] * kk[i];
            p += __shfl_xor(p, 1); p += __shfl_xor(p, 2);
            const float vv = Vb[t * 64 + sv]; float y = 0.f;
#pragma unroll
            for (int i = 0; i < 4; ++i) {
                const f32x4 w = *(const LAS f32x4*)(Wb + t * 64 + 16 * kq + 4 * i), bb = *(const LAS f32x4*)(Bb + t * 64 + 16 * kq + 4 * i), k2 = *(const LAS f32x4*)(Kb + t * 64 + 16 * kq + 4 * i), r = *(const LAS f32x4*)(Rb + t * 64 + 16 * kq + 4 * i);
                S[4 * i + 0] = S[4 * i + 0] * w.x - p * bb.x + vv * k2.x; y += S[4 * i + 0] * r.x;
                S[4 * i + 1] = S[4 * i + 1] * w.y - p * bb.y + vv * k2.y; y += S[4 * i + 1] * r.y;
                S[4 * i + 2] = S[4 * i + 2] * w.z - p * bb.z + vv * k2.z; y += S[4 * i + 2] * r.z;
                S[4 * i + 3] = S[4 * i + 3] * w.w - p * bb.w + vv * k2.w; y += S[4 * i + 3] * r.w;
            }
            y += __shfl_xor(y, 1); y += __shfl_xor(y, 2);
            if (kq == 0) Yb[t * 64 + sv] = y;
        }
        __syncthreads();
#pragma unroll
        for (int tt = 0; tt < RCH / 4; ++tt) { const int t = wv + 4 * tt; if (t < nt) {
            const float y = Yb[t * 64 + j]; const float mean = wave_sum(y) * (1.0f / 64.0f); const float d = y - mean; const float var = wave_sum(d * d) * (1.0f / 64.0f);
            float o = d * rsqrtf(var + R_GN_EPS) * gnwj + gnbj; o += BON[t] * Vb[t * 64 + j]; o *= Gb[t * 64 + j];
            YR[(size_t)(row0 + t0 + t) * NPR + hc + j] = (bf16)f2bf(o); } }
        __syncthreads();
    }
#pragma unroll
    for (int i = 0; i < 4; ++i) *(f32x4*)(Sout + sv * 64 + 16 * kq + 4 * i) = (f32x4){S[4 * i], S[4 * i + 1], S[4 * i + 2], S[4 * i + 3]};
}

constexpr int MCH = 16;
constexpr int MLSTM_LDS = ((MCH + 3) * 128 + 5 * MCH * 128 + MCH * 4 * 128 + 8 * MCH) * 4;
__device__ __forceinline__ void mlstm_seq_item(const Args& a, LAS unsigned char* ldsb, int item) {
    const int tid = threadIdx.x, lane = tid & 63, wv = tid >> 6;
    const bf16* PM = (const bf16*)(a.ws + WS_PM); bf16* YM = item < 32 ? (bf16*)(a.ws + WS_YM) : (bf16*)(a.ws + WS_YMS) - (size_t)MP * 512; const float* GATES = (const float*)(a.ws + WS_GATES);
    const float *convw = a.in[22], *convb = a.in[23], *wq = a.in[24], *wk = a.in[25], *ib = a.in[26], *fb = a.in[27], *gnw = a.in[28], *skip = a.in[29];
    int T, row0, h, sb = -1; float *Cout, *nout, *mout, *convout;
    if (item < 32) { const int b = item >> 2; h = item & 3; T = SEQ; row0 = b * SEQ; Cout = a.out + O_PC + (size_t)item * 16384; nout = a.out + O_PN + (size_t)item * 128; mout = a.out + O_PMM + item; convout = a.out + O_PCONV + (size_t)b * 3 * 512 + h * 128; }
    else { const int it2 = item - 32; sb = it2 >> 2; h = it2 & 3; T = 1; row0 = MP + sb; Cout = a.out + O_SC + (size_t)it2 * 16384; nout = a.out + O_SN + (size_t)it2 * 128; mout = a.out + O_SMM + it2; convout = a.out + O_SCONV + (size_t)sb * 3 * 512 + h * 128; }
    const int hc = h * 128;
    LAS float* XMW = (LAS float*)ldsb;
    LAS float* XC = XMW + (MCH + 3) * 128;
    LAS float* Qb = XC + MCH * 128;
    LAS float* Kb = Qb + MCH * 128;
    LAS float* Vb = Kb + MCH * 128;
    LAS float* Ob = Vb + MCH * 128;
    LAS float* HP = Ob + MCH * 128;
    LAS float* FS = HP + MCH * 512;
    LAS float* IS = FS + MCH;
    LAS float* EM = IS + MCH;
    LAS float* DEN = EM + MCH;
    LAS float* MST = DEN + 2 * MCH;
    const int e = tid & 127, dq = tid >> 7;
    float C[32]; float nreg = 0.f;
    if (sb >= 0) {
        const float* C0 = a.in[4] + (size_t)(item - 32) * 16384;
#pragma unroll
        for (int i = 0; i < 32; ++i) C[i] = C0[(size_t)(32 * dq + i) * 128 + e];
        if (tid < 128) nreg = a.in[5][(size_t)(item - 32) * 128 + tid];
        if (tid == 0) MST[0] = a.in[6][item - 32];
        if (tid < 384) XMW[tid] = a.in[7][(size_t)sb * 3 * 512 + (tid >> 7) * 512 + hc + (tid & 127)];
    } else {
#pragma unroll
        for (int i = 0; i < 32; ++i) C[i] = 0.f;
        if (tid == 0) MST[0] = 0.f;
        if (tid < 384) XMW[tid] = 0.f;
    }
    const float cw0 = convw[0 * 512 + hc + e], cw1 = convw[1 * 512 + hc + e], cw2 = convw[2 * 512 + hc + e], cw3 = convw[3 * 512 + hc + e], cbe = convb[hc + e];
    const float ibh = ib[h], fbh = fb[h];
    __syncthreads();
    for (int t0 = 0; t0 < T; t0 += MCH) {
        const int nt = (T - t0) < MCH ? (T - t0) : MCH;
        for (int t = dq; t < nt; t += 4) { const size_t r = (size_t)(row0 + t0 + t) * NPM;
            XMW[(t + 3) * 128 + e] = bf2f(PM[r + hc + e]); Vb[t * 128 + e] = bf2f(PM[r + 512 + hc + e]); Ob[t * 128 + e] = sigmoidf_(bf2f(PM[r + 1024 + hc + e])); }
        __syncthreads();
        for (int t = dq; t < nt; t += 4) { const float x = cbe + XMW[t * 128 + e] * cw0 + XMW[(t + 1) * 128 + e] * cw1 + XMW[(t + 2) * 128 + e] * cw2 + XMW[(t + 3) * 128 + e] * cw3;
            XC[t * 128 + e] = x / (1.0f + expf(-x)); }
        if (tid == 0) { float m = MST[0];
            for (int t = 0; t < nt; ++t) { const float* g = GATES + (size_t)(row0 + t0 + t) * 8;
                const float li = g[h] + ibh, fr = g[4 + h] + fbh; const float lf = fminf(fr, 0.f) - log1pf(expf(-fabsf(fr)));
                const float mn = fmaxf(lf + m, li); FS[t] = expf(lf + m - mn); IS[t] = expf(li - mn); EM[t] = expf(-mn); m = mn; }
            MST[0] = m; }
        __syncthreads();
        { float aq[MCH / 4], ak[MCH / 4];
#pragma unroll
          for (int i = 0; i < MCH / 4; ++i) { aq[i] = 0.f; ak[i] = 0.f; }
          for (int d4 = 0; d4 < 32; ++d4) {
              float q4[4], k4[4];
#pragma unroll
              for (int q = 0; q < 4; ++q) { q4[q] = wq[(size_t)(hc + 4 * d4 + q) * 128 + e]; k4[q] = wk[(size_t)(hc + 4 * d4 + q) * 128 + e]; }
#pragma unroll
              for (int tt = 0; tt < MCH / 4; ++tt) { const int t = dq + 4 * tt; if (t < nt) { const f32x4 x = *(const LAS f32x4*)(XC + t * 128 + 4 * d4);
                  aq[tt] += (x.x * q4[0] + x.y * q4[1]) + (x.z * q4[2] + x.w * q4[3]); ak[tt] += (x.x * k4[0] + x.y * k4[1]) + (x.z * k4[2] + x.w * k4[3]); } }
          }
#pragma unroll
          for (int tt = 0; tt < MCH / 4; ++tt) { const int t = dq + 4 * tt; if (t < nt) { Qb[t * 128 + e] = aq[tt] * 0.08838834764831845f; Kb[t * 128 + e] = ak[tt]; } }
        }
        __syncthreads();
        for (int t = 0; t < nt; ++t) {
            const float fs = FS[t], is = IS[t]; const float ve = Vb[t * 128 + e] * is; float hp = 0.f;
#pragma unroll
            for (int i = 0; i < 8; ++i) { const f32x4 k = *(const LAS f32x4*)(Kb + t * 128 + 32 * dq + 4 * i), q = *(const LAS f32x4*)(Qb + t * 128 + 32 * dq + 4 * i);
                C[4 * i + 0] = fs * C[4 * i + 0] + k.x * ve; hp += q.x * C[4 * i + 0];
                C[4 * i + 1] = fs * C[4 * i + 1] + k.y * ve; hp += q.y * C[4 * i + 1];
                C[4 * i + 2] = fs * C[4 * i + 2] + k.z * ve; hp += q.z * C[4 * i + 2];
                C[4 * i + 3] = fs * C[4 * i + 3] + k.w * ve; hp += q.w * C[4 * i + 3]; }
            HP[t * 512 + dq * 128 + e] = hp;
            if (tid < 128) { nreg = fs * nreg + is * Kb[t * 128 + tid]; const float dn = wave_sum(Qb[t * 128 + tid] * nreg); if (lane == 0) DEN[t * 2 + wv] = dn; }
        }
        __syncthreads();
        for (int t = wv; t < nt; t += 8) {
            const float den = DEN[t * 2] + DEN[t * 2 + 1]; const float dd = fmaxf(fabsf(den), EM[t]);
            float hv[2];
#pragma unroll
            for (int q = 0; q < 2; ++q) { const int ee = lane + 64 * q; hv[q] = (HP[t * 512 + ee] + HP[t * 512 + 128 + ee] + HP[t * 512 + 256 + ee] + HP[t * 512 + 384 + ee]) / dd; }
            const float mean = wave_sum(hv[0] + hv[1]) * (1.0f / 128.0f); const float d0 = hv[0] - mean, d1 = hv[1] - mean;
            const float var = wave_sum(d0 * d0 + d1 * d1) * (1.0f / 128.0f); const float rs = rsqrtf(var + M_GN_EPS);
#pragma unroll
            for (int q = 0; q < 2; ++q) { const int ee = lane + 64 * q; float o = (q ? d1 : d0) * rs * gnw[hc + ee] + skip[hc + ee] * XC[t * 128 + ee]; o *= Ob[t * 128 + ee];
                YM[(size_t)(row0 + t0 + t) * 512 + hc + ee] = (bf16)f2bf(o); }
        }
        __syncthreads();
        float keep = 0.f; if (tid < 384) keep = XMW[(nt + (tid >> 7)) * 128 + (tid & 127)];
        __syncthreads();
        if (tid < 384) XMW[tid] = keep;
        __syncthreads();
    }
#pragma unroll
    for (int i = 0; i < 32; ++i) Cout[(size_t)(32 * dq + i) * 128 + e] = C[i];
    if (tid < 128) nout[tid] = nreg;
    if (tid == 0) mout[0] = MST[0];
    if (tid < 384) convout[(tid >> 7) * 512 + (tid & 127)] = XMW[tid];
}

__device__ __forceinline__ void final_norm_rows(const Args& a, int gw, int NGW, int lane) {
    const float* gf = a.in[36];
    f32x4 gv[4];
#pragma unroll
    for (int j = 0; j < 4; ++j) gv[j] = ((const f32x4*)gf)[lane + 64 * j];
    for (int row = gw; row < MTOK; row += NGW) { f32x4* p = (f32x4*)(a.out + (size_t)row * 1024) + lane; f32x4 v[4]; float s = 0.f;
#pragma unroll
        for (int j = 0; j < 4; ++j) { v[j] = p[64 * j]; s += (v[j].x * v[j].x + v[j].y * v[j].y) + (v[j].z * v[j].z + v[j].w * v[j].w); }
        const float rs = rsqrtf(wave_sum(s) * (1.0f / 1024.0f) + RMS_EPS);
#pragma unroll
        for (int j = 0; j < 4; ++j) p[64 * j] = v[j] * rs * gv[j]; }
}


typedef short bf16x8 __attribute__((ext_vector_type(8)));
typedef float f32x16 __attribute__((ext_vector_type(16)));
__device__ __forceinline__ int perm16(int x) { return (x & ~15) | (((x >> 2) & 1) << 3) | (((x >> 3) & 1) << 2) | (x & 3); }
constexpr size_t WS_KT = 49 * MiB + 512 * 1024;
constexpr size_t DO_CTP = 0;
constexpr size_t DO_VT = 40 * MiB;
constexpr size_t DO_UU = 60 * MiB, DO_BCUM = DO_UU + 256 * 1024, DO_PPFX = DO_BCUM + 256 * 1024;
constexpr size_t DO_BL = DO_PPFX + 256 * 1024, DO_PMX = DO_BL + 4096, DO_MPREV = DO_PMX + 4096;
static_assert(DO_MPREV + 4096 <= (size_t)MTOK * DM * 4, "d_out scratch");

typedef float f32x2_t __attribute__((ext_vector_type(2))); typedef __bf16 bf16x2_t __attribute__((ext_vector_type(2)));
__device__ __forceinline__ unsigned cvtpk(float lo, float hi) { f32x2_t v = {lo, hi}; bf16x2_t b = __builtin_convertvector(v, bf16x2_t); return __builtin_bit_cast(unsigned, b); }
__device__ __forceinline__ bf16x8 pack8(float a0, float a1, float a2, float a3, float a4, float a5, float a6, float a7) {
    v4u w; w.x = cvtpk(a0, a1); w.y = cvtpk(a2, a3); w.z = cvtpk(a4, a5); w.w = cvtpk(a6, a7); return __builtin_bit_cast(bf16x8, w); }
__device__ __forceinline__ bf16x8 acc_frag(const f32x16& x, int s2) { return s2 == 0 ? pack8(x[0], x[1], x[2], x[3], x[4], x[5], x[6], x[7]) : pack8(x[8], x[9], x[10], x[11], x[12], x[13], x[14], x[15]); }
__device__ __forceinline__ bf16x8 ld16(const bf16* p) { return __builtin_bit_cast(bf16x8, *(const v4u*)p); }
__device__ __forceinline__ bf16x8 ld8x2(const bf16* p0, const bf16* p1) { const v2u a = *(const v2u*)p0, b = *(const v2u*)p1; v4u w; w.x = a.x; w.y = a.y; w.z = b.x; w.w = b.y; return __builtin_bit_cast(bf16x8, w); }
#define MFMA32(a, b, c) __builtin_amdgcn_mfma_f32_32x32x16_bf16((a), (b), (c), 0, 0, 0)

__device__ __forceinline__ void stage_conv_head(const Args& a, LAS float* CW, int h, int tid, int nthr) {
    for (int i = tid; i < 640; i += nthr) CW[i] = i < 512 ? a.in[22][(size_t)(i >> 7) * 512 + h * 128 + (i & 127)] : a.in[23][h * 128 + (i - 512)];
}
__device__ __forceinline__ void xc8(const bf16* xmcol, int t, int d0, const LAS float* CW, float (&x)[8]) {
    const f32x4 b0 = *(const LAS f32x4*)(CW + 512 + d0), b1 = *(const LAS f32x4*)(CW + 512 + d0 + 4);
    x[0] = b0.x; x[1] = b0.y; x[2] = b0.z; x[3] = b0.w; x[4] = b1.x; x[5] = b1.y; x[6] = b1.z; x[7] = b1.w;
#pragma unroll
    for (int tap = 0; tap < 4; ++tap) { const int tt = t - 3 + tap;
        if (tt >= 0) { const v4u v = *(const v4u*)(xmcol + (size_t)tt * NPM + d0);
            const f32x4 w0 = *(const LAS f32x4*)(CW + tap * 128 + d0), w1 = *(const LAS f32x4*)(CW + tap * 128 + d0 + 4);
            x[0] += bflo(v.x) * w0.x; x[1] += bfhi(v.x) * w0.y; x[2] += bflo(v.y) * w0.z; x[3] += bfhi(v.y) * w0.w;
            x[4] += bflo(v.z) * w1.x; x[5] += bfhi(v.z) * w1.y; x[6] += bflo(v.w) * w1.z; x[7] += bfhi(v.w) * w1.w; } }
#pragma unroll
    for (int i = 0; i < 8; ++i) x[i] = x[i] / (1.0f + __expf(-x[i]));
}
__device__ __forceinline__ bf16x8 xc_frag(const bf16* xmcol, int t, int d0, const LAS float* CW) { float x[8]; xc8(xmcol, t, d0, CW, x); return pack8(x[0], x[1], x[2], x[3], x[4], x[5], x[6], x[7]); }

constexpr int M1_XSTR = 272;
constexpr int M1_XM = 0, M1_XC = 67 * M1_XSTR + 208, M1_CW = M1_XC + 64 * M1_XSTR, M1_LDS = M1_CW + 2560;
static_assert(M1_XC % 16 == 0 && M1_CW % 16 == 0, "M1 LDS alignment");
__device__ __forceinline__ void mlstm_prep_stage(const Args& a, LAS unsigned char* L, int item, int tid) {
    const int bh = item >> 5, c = item & 31, b = bh >> 2, h = bh & 3, hc = h * 128, row0 = b * SEQ, t0 = c * 64;
    const bf16* PM = (const bf16*)(a.ws + WS_PM);
    stage_conv_head(a, (LAS float*)(L + M1_CW), h, tid, NTHR);
    for (int i = tid; i < 67 * 16; i += NTHR) { const int rw = i >> 4, ch = i & 15, tt = t0 - 3 + rw;
        *(LAS v4u*)(L + M1_XM + rw * M1_XSTR + ch * 16) = tt >= 0 ? *(const v4u*)(PM + (size_t)(row0 + tt) * NPM + hc + 8 * ch) : (v4u){0u, 0u, 0u, 0u}; }
}
__device__ __forceinline__ void mlstm_prep_xc(LAS unsigned char* L, int tid) {
    const int t = tid >> 3, d0 = (tid & 7) * 16; const LAS float* CW = (const LAS float*)(L + M1_CW);
#pragma unroll
    for (int hf = 0; hf < 2; ++hf) { const int d = d0 + 8 * hf;
        const f32x4 b0 = *(const LAS f32x4*)(CW + 512 + d), b1 = *(const LAS f32x4*)(CW + 512 + d + 4); float x[8] = {b0.x, b0.y, b0.z, b0.w, b1.x, b1.y, b1.z, b1.w};
#pragma unroll
        for (int tap = 0; tap < 4; ++tap) { const v4u v = *(const LAS v4u*)(L + M1_XM + (t + tap) * M1_XSTR + d * 2);
            const f32x4 w0 = *(const LAS f32x4*)(CW + tap * 128 + d), w1 = *(const LAS f32x4*)(CW + tap * 128 + d + 4);
            x[0] += bflo(v.x) * w0.x; x[1] += bfhi(v.x) * w0.y; x[2] += bflo(v.y) * w0.z; x[3] += bfhi(v.y) * w0.w; x[4] += bflo(v.z) * w1.x; x[5] += bfhi(v.z) * w1.y; x[6] += bflo(v.w) * w1.z; x[7] += bfhi(v.w) * w1.w; }
#pragma unroll
        for (int i = 0; i < 8; ++i) x[i] = x[i] / (1.0f + __expf(-x[i]));
        *(LAS bf16x8*)(L + M1_XC + t * M1_XSTR + d * 2) = pack8(x[0], x[1], x[2], x[3], x[4], x[5], x[6], x[7]); }
}
__device__ __forceinline__ void mlstm_prep_task(const Args& a, int item, int blk, const LAS unsigned char* L, int lane_) {
    int lane = lane_; asm volatile("" : "+v"(lane));
    const int r = lane & 31, hh = lane >> 5, bh = item >> 5, c = item & 31, b = bh >> 2, h = bh & 3, hc = h * 128, row0 = b * SEQ, t0 = c * 64, db = blk & 3, sb = blk >> 2;
    const bf16* PM = (const bf16*)(a.ws + WS_PM); const bf16* xmcol = PM + (size_t)row0 * NPM + hc;
    const bf16* WKT = (const bf16*)(a.ws + WS_WKT) + (size_t)h * 16384;
    bf16* KT = (bf16*)(a.ws + WS_KT) + (size_t)item * 8192; bf16* VT = (bf16*)((unsigned char*)a.out + DO_VT) + (size_t)item * 10240;
    f32x16 acc;
#pragma unroll
    for (int i = 0; i < 16; ++i) acc[i] = 0.f;
#pragma unroll
    for (int ks = 0; ks < 8; ++ks) acc = MFMA32(ld16(WKT + (size_t)(32 * db + r) * 128 + 16 * ks + 8 * hh), *(const LAS bf16x8*)(L + M1_XC + (32 * sb + r) * M1_XSTR + (16 * ks + 8 * hh) * 2), acc);
#pragma unroll
    for (int reg = 0; reg < 16; reg += 2) { const unsigned w = cvtpk(acc[reg], acc[reg + 1]); bf16* kp = KT + (size_t)(32 * db + 4 * hh) * 64 + perm16(32 * sb + r);
        kp[((reg & 3) + 8 * (reg >> 2)) * 64] = (bf16)(w & 0xffffu); kp[(((reg + 1) & 3) + 8 * ((reg + 1) >> 2)) * 64] = (bf16)(w >> 16); }
    { const bf16* vp = PM + (size_t)(row0 + t0 + 32 * sb + r) * NPM + 512 + hc + 32 * db + 16 * hh; const v4u v0 = *(const v4u*)vp, v1 = *(const v4u*)(vp + 8);
      const unsigned w[8] = {v0.x, v0.y, v0.z, v0.w, v1.x, v1.y, v1.z, v1.w}; bf16* o = VT + (size_t)(32 * db + 16 * hh) * 64 + perm16(32 * sb + r);
#pragma unroll
      for (int i = 0; i < 8; ++i) { o[(size_t)(2 * i) * 64] = (bf16)(w[i] & 0xffffu); o[(size_t)(2 * i + 1) * 64] = (bf16)(w[i] >> 16); } }
#pragma unroll
    for (int i = 0; i < 4; ++i) VT[(size_t)(128 + 4 * blk + i) * 64 + lane] = (blk == 0 && i == 0) ? (bf16)0x3f80u : (bf16)0u;
    if (blk == 1 && c == 31) {
        float* co = a.out + O_PCONV + (size_t)b * 3 * 512 + hc;
        for (int i = lane; i < 384; i += 64) co[(i >> 7) * 512 + (i & 127)] = bf2f(xmcol[(size_t)(SEQ - 3 + (i >> 7)) * NPM + (i & 127)]);
    }
    if (blk == 0) {
        const float* g = (const float*)(a.ws + WS_GATES) + (size_t)(row0 + t0 + lane) * 8;
        const float li = g[h] + a.in[26][h], fr = g[4 + h] + a.in[27][h]; const float lf = fminf(fr, 0.f) - log1pf(expf(-fabsf(fr)));
        float bc = lf;
#pragma unroll
        for (int o = 1; o < 64; o <<= 1) { const float t = __shfl_up(bc, o); if (lane >= o) bc += t; }
        const float u = li - bc; float p = u;
#pragma unroll
        for (int o = 1; o < 64; o <<= 1) { const float t = __shfl_up(p, o); if (lane >= o) p = fmaxf(p, t); }
        float* dof = (float*)a.out; const size_t ti = (size_t)bh * 2048 + t0 + lane;
        dof[DO_UU / 4 + ti] = u; dof[DO_BCUM / 4 + ti] = bc; dof[DO_PPFX / 4 + ti] = p;
        if (lane == 63) { dof[DO_BL / 4 + item] = bc; dof[DO_PMX / 4 + item] = p; }
    }
}

__device__ __forceinline__ void mlstm_scan_task(const Args& a, int bh, int eb, LAS float* WE, int lane) {
    const int r = lane & 31, hh = lane >> 5;
    const float* dof = (const float*)a.out;
    f32x16 CT[4];
#pragma unroll
    for (int cb = 0; cb < 4; ++cb)
#pragma unroll
        for (int i = 0; i < 16; ++i) CT[cb][i] = 0.f;
    float m = 0.f;
    const bf16* KT0 = (const bf16*)(a.ws + WS_KT) + (size_t)bh * 32 * 8192 + (size_t)r * 64 + 8 * hh;
    const bf16* VT0 = (const bf16*)((const unsigned char*)a.out + DO_VT) + (size_t)bh * 32 * 10240 + (size_t)(32 * eb + r) * 64 + 8 * hh;
    bf16* CTP0 = (bf16*)((unsigned char*)a.out + DO_CTP) + (size_t)bh * 32 * 20480 + (size_t)(32 * eb + 4 * hh) * 128 + perm16(r);
    v4u Ar[4], Bf[4][4];
#pragma unroll
    for (int ks = 0; ks < 4; ++ks) { Ar[ks] = *(const v4u*)(VT0 + 16 * ks);
#pragma unroll
        for (int cb = 0; cb < 4; ++cb) Bf[ks][cb] = *(const v4u*)(KT0 + (size_t)(32 * cb) * 64 + 16 * ks); }
    float u = dof[DO_UU / 4 + (size_t)bh * 2048 + lane], pmx = dof[DO_PMX / 4 + bh * 32], bl = dof[DO_BL / 4 + bh * 32];
    for (int c = 0; c < 32; ++c) {
        const int item = bh * 32 + c;
        const float Mx = fmaxf(m, pmx); const float ge = __expf(m - Mx);
        WE[perm16(lane)] = __expf(u - Mx);
        const float mnext = bl + Mx;
        if (c + 1 < 32) { u = dof[DO_UU / 4 + (size_t)bh * 2048 + 64 * (c + 1) + lane]; pmx = dof[DO_PMX / 4 + item + 1]; bl = dof[DO_BL / 4 + item + 1]; }
        bf16* CTP = CTP0 + (size_t)c * 20480;
#pragma unroll
        for (int cb = 0; cb < 4; ++cb)
#pragma unroll
            for (int reg = 0; reg < 16; reg += 2) { const unsigned w = cvtpk(CT[cb][reg], CT[cb][reg + 1]);
                CTP[((reg & 3) + 8 * (reg >> 2)) * 128 + 32 * cb] = (bf16)(w & 0xffffu); CTP[(((reg + 1) & 3) + 8 * ((reg + 1) >> 2)) * 128 + 32 * cb] = (bf16)(w >> 16);
                CT[cb][reg] *= ge; CT[cb][reg + 1] *= ge; }
        if (eb == 0 && lane == 0) ((float*)a.out)[DO_MPREV / 4 + item] = m;
        LDS_WAIT(); asm volatile("" ::: "memory");
        const size_t nx = (c + 1 < 32) ? (size_t)(c + 1) : (size_t)c;
#pragma unroll
        for (int ks = 0; ks < 4; ++ks) {
            const v4u av = Ar[ks];
            const f32x4 w0 = *(const LAS f32x4*)(WE + 16 * ks + 8 * hh), w1 = *(const LAS f32x4*)(WE + 16 * ks + 8 * hh + 4);
            const bf16x8 A = pack8(bflo(av.x) * w0.x, bfhi(av.x) * w0.y, bflo(av.y) * w0.z, bfhi(av.y) * w0.w, bflo(av.z) * w1.x, bfhi(av.z) * w1.y, bflo(av.w) * w1.z, bfhi(av.w) * w1.w);
#pragma unroll
            for (int cb = 0; cb < 4; ++cb) CT[cb] = MFMA32(A, __builtin_bit_cast(bf16x8, Bf[ks][cb]), CT[cb]);
            Ar[ks] = *(const v4u*)(VT0 + nx * 10240 + 16 * ks);
#pragma unroll
            for (int cb = 0; cb < 4; ++cb) Bf[ks][cb] = *(const v4u*)(KT0 + nx * 8192 + (size_t)(32 * cb) * 64 + 16 * ks);
        }
        m = mnext;
        LDS_WAIT(); asm volatile("" ::: "memory");
    }
    if (eb < 4) { float* Co = a.out + O_PC + (size_t)bh * 16384;
#pragma unroll
        for (int cb = 0; cb < 4; ++cb)
#pragma unroll
            for (int reg = 0; reg < 16; ++reg) Co[(size_t)(32 * cb + r) * 128 + 32 * eb + (reg & 3) + 8 * (reg >> 2) + 4 * hh] = CT[cb][reg];
    } else if (hh == 0) {
#pragma unroll
        for (int cb = 0; cb < 4; ++cb) a.out[O_PN + (size_t)bh * 128 + 32 * cb + r] = CT[cb][0];
    }
    if (eb == 0 && lane == 0) a.out[O_PMM + bh] = m;
}

constexpr int M3_WSTR = 272;
constexpr int M3_XMT = 18432;
constexpr int M3_WQ = 0, M3_WK = 128 * M3_WSTR, M3_CW = 2 * 128 * M3_WSTR, M3_GN = M3_CW + 2560, M3_SK = M3_GN + 512, M3_XM = M3_SK + 512, M3_LDS = M3_XM + 4 * M3_XMT;
static_assert(M3_LDS <= 159744 && M3_XM % 16 == 0, "M3 LDS");
__device__ __forceinline__ void mlstm_out_stage(const Args& a, LAS unsigned char* L, int h, int tid) {
    const bf16* WQT = (const bf16*)(a.ws + WS_WQT) + (size_t)h * 16384; const bf16* WKT = (const bf16*)(a.ws + WS_WKT) + (size_t)h * 16384;
    for (int i = tid; i < 2048; i += NTHR) { const int row = i >> 4, ch = i & 15;
        *(LAS v4u*)(L + M3_WQ + row * M3_WSTR + ch * 16) = *(const v4u*)(WQT + row * 128 + ch * 8);
        *(LAS v4u*)(L + M3_WK + row * M3_WSTR + ch * 16) = *(const v4u*)(WKT + row * 128 + ch * 8); }
    stage_conv_head(a, (LAS float*)(L + M3_CW), h, tid, NTHR);
    for (int i = tid; i < 128; i += NTHR) { ((LAS float*)(L + M3_GN))[i] = a.in[28][h * 128 + i]; ((LAS float*)(L + M3_SK))[i] = a.in[29][h * 128 + i]; }
}
__device__ __forceinline__ void mlstm_out_stage_xm(const Args& a, LAS unsigned char* L, int h, int tq0, int tid) {
    const bf16* PM = (const bf16*)(a.ws + WS_PM);
    for (int id = tid; id < 4 * 67 * 16; id += NTHR) { const int ti = id / (67 * 16), rem = id - ti * (67 * 16), rw = rem >> 4, ch = rem & 15;
        const int tq = tq0 + 2 * ti, b = tq >> 6, c = (tq >> 1) & 31, tt = 64 * c - 3 + rw;
        *(LAS v4u*)(L + M3_XM + ti * M3_XMT + rw * M1_XSTR + ch * 16) = tt >= 0 ? *(const v4u*)(PM + (size_t)(b * SEQ + tt) * NPM + h * 128 + 8 * ch) : (v4u){0u, 0u, 0u, 0u}; }
}
__device__ __forceinline__ bf16x8 xc_frag_lds(const LAS unsigned char* XM, int tloc, int d0, const LAS float* CW) {
    const f32x4 b0 = *(const LAS f32x4*)(CW + 512 + d0), b1 = *(const LAS f32x4*)(CW + 512 + d0 + 4); float x[8] = {b0.x, b0.y, b0.z, b0.w, b1.x, b1.y, b1.z, b1.w};
#pragma unroll
    for (int tap = 0; tap < 4; ++tap) { const v4u v = *(const LAS v4u*)(XM + (tloc + tap) * M1_XSTR + d0 * 2);
        const f32x4 w0 = *(const LAS f32x4*)(CW + tap * 128 + d0), w1 = *(const LAS f32x4*)(CW + tap * 128 + d0 + 4);
        x[0] += bflo(v.x) * w0.x; x[1] += bfhi(v.x) * w0.y; x[2] += bflo(v.y) * w0.z; x[3] += bfhi(v.y) * w0.w; x[4] += bflo(v.z) * w1.x; x[5] += bfhi(v.z) * w1.y; x[6] += bflo(v.w) * w1.z; x[7] += bfhi(v.w) * w1.w; }
#pragma unroll
    for (int i = 0; i < 8; ++i) x[i] = x[i] / (1.0f + __expf(-x[i]));
    return pack8(x[0], x[1], x[2], x[3], x[4], x[5], x[6], x[7]);
}
__device__ __forceinline__ bf16x8 m3_wfrag(const LAS unsigned char* W, int row, int k0) { return *(const LAS bf16x8*)(W + row * M3_WSTR + k0 * 2); }
__device__ __forceinline__ void mlstm_st_tile(int sb, int tb, const bf16x8 (&XB)[8], const bf16x8 (&QTb)[4][2], const LAS unsigned char* WK, const LAS unsigned char* XM, const LAS float* CW, const float* uu, int t0, int tl, float Mt, int r, int hh, bf16x8& o0, bf16x8& o1) {
    f32x16 st;
#pragma unroll
    for (int i = 0; i < 16; ++i) st[i] = 0.f;
#pragma unroll
    for (int db = 0; db < 4; ++db) { f32x16 k;
#pragma unroll
        for (int i = 0; i < 16; ++i) k[i] = 0.f;
#pragma unroll
        for (int ks = 0; ks < 8; ++ks) { const bf16x8 B = (sb == tb) ? XB[ks] : xc_frag_lds(XM, 32 * sb + r, 16 * ks + 8 * hh, CW);
            k = MFMA32(m3_wfrag(WK, 32 * db + r, 16 * ks + 8 * hh), B, k); if (ks & 1) __builtin_amdgcn_sched_barrier(0); }
        st = MFMA32(acc_frag(k, 0), QTb[db][0], st); st = MFMA32(acc_frag(k, 1), QTb[db][1], st); __builtin_amdgcn_sched_barrier(0); }
#pragma unroll
    for (int g = 0; g < 4; ++g) { const f32x4 u4 = *(const f32x4*)(uu + 32 * sb + 8 * g + 4 * hh);
#pragma unroll
        for (int i = 0; i < 4; ++i) { const int sidx = 32 * sb + 8 * g + 4 * hh + i; st[4 * g + i] = (sidx <= tl) ? st[4 * g + i] * expf(u4[i] - Mt) : 0.f; } }
    o0 = acc_frag(st, 0); o1 = acc_frag(st, 1);
}

__device__ __forceinline__ void mlstm_out_task(const Args& a, int item, int tb, LAS unsigned char* L, int wave, int lane_) {
    int lane = lane_; asm volatile("" : "+v"(lane));
    LAS unsigned char* XM = L + M3_XM + (wave >> 1) * M3_XMT;
    const int r = lane & 31, hh = lane >> 5, bh = item >> 5, c = item & 31, b = bh >> 2, h = bh & 3, hc = h * 128, row0 = b * SEQ, t0 = c * 64;
    const bf16* PM = (const bf16*)(a.ws + WS_PM); const bf16* xmcol = PM + (size_t)row0 * NPM + hc; const LAS float* CW = (const LAS float*)(L + M3_CW);
    const LAS unsigned char* WQ = L + M3_WQ; const LAS unsigned char* WK = L + M3_WK;
    const bf16* VT = (const bf16*)((const unsigned char*)a.out + DO_VT) + (size_t)item * 10240; const bf16* CTP = (const bf16*)((const unsigned char*)a.out + DO_CTP) + (size_t)item * 20480;
    const float* dof = (const float*)a.out;
    const int tl = 32 * tb + r, t = t0 + tl;
    bf16x8 XB[8];
#pragma unroll
    for (int ks = 0; ks < 8; ++ks) { XB[ks] = xc_frag_lds(XM, tl, 16 * ks + 8 * hh, CW); if (ks & 1) __builtin_amdgcn_sched_barrier(0); }
    bf16x8 QTb[4][2];
#pragma unroll
    for (int eb = 0; eb < 4; ++eb) { f32x16 q;
#pragma unroll
        for (int i = 0; i < 16; ++i) q[i] = 0.f;
#pragma unroll
        for (int ks = 0; ks < 8; ++ks) q = MFMA32(m3_wfrag(WQ, 32 * eb + r, 16 * ks + 8 * hh), XB[ks], q);
        QTb[eb][0] = acc_frag(q, 0); QTb[eb][1] = acc_frag(q, 1); __builtin_amdgcn_sched_barrier(0); }
    const float mprev = dof[DO_MPREV / 4 + item], pp = dof[DO_PPFX / 4 + (size_t)bh * 2048 + t], bc = dof[DO_BCUM / 4 + (size_t)bh * 2048 + t];
    const float Mt = fmaxf(mprev, pp), wst = expf(mprev - Mt), em = expf(-bc - Mt);
    bf16x8 STb[2][2];
    mlstm_st_tile(0, tb, XB, QTb, WK, XM, CW, dof + DO_UU / 4 + (size_t)bh * 2048 + t0, t0, tl, Mt, r, hh, STb[0][0], STb[0][1]);
    if (tb == 1) mlstm_st_tile(1, tb, XB, QTb, WK, XM, CW, dof + DO_UU / 4 + (size_t)bh * 2048 + t0, t0, tl, Mt, r, hh, STb[1][0], STb[1][1]);
    else { STb[1][0] = (bf16x8){0, 0, 0, 0, 0, 0, 0, 0}; STb[1][1] = STb[1][0]; }
    __syncthreads();
    LAS unsigned char* xbp = XM + (wave & 1) * 8192 + lane * 16;
#pragma unroll
    for (int ks = 0; ks < 8; ++ks) *(LAS bf16x8*)(xbp + ks * 1024) = XB[ks];
    __builtin_amdgcn_sched_barrier(0);
    auto num_block = [&](int eb, f32x16& nt) {
#pragma unroll
        for (int i = 0; i < 16; ++i) nt[i] = 0.f;
        const bf16* crow = CTP + (size_t)(32 * eb + r) * 128 + 8 * hh;
#pragma unroll
        for (int rb = 0; rb < 4; ++rb) {
#pragma unroll
            for (int s2 = 0; s2 < 2; ++s2) nt = MFMA32(ld16(crow + 32 * rb + 16 * s2), QTb[rb][s2], nt);
            if (rb == 1) __builtin_amdgcn_sched_barrier(0); }
#pragma unroll
        for (int i = 0; i < 16; ++i) nt[i] *= wst;
        __builtin_amdgcn_sched_barrier(0);
        const bf16* vrow = VT + (size_t)(32 * eb + r) * 64 + 8 * hh;
#pragma unroll
        for (int s2 = 0; s2 < 2; ++s2) nt = MFMA32(ld16(vrow + 16 * s2), STb[0][s2], nt);
        if (tb == 1) {
#pragma unroll
            for (int s2 = 0; s2 < 2; ++s2) nt = MFMA32(ld16(vrow + 32 + 16 * s2), STb[1][s2], nt); }
        __builtin_amdgcn_sched_barrier(0);
    };
    float inv;
    { f32x16 nd; num_block(4, nd); const float den = __shfl(nd[0], r); inv = 1.0f / fmaxf(fabsf(den), em); }
    f32x16 NT[4];
#pragma unroll
    for (int eb = 0; eb < 4; ++eb) num_block(eb, NT[eb]);
    float s1 = 0.f;
#pragma unroll
    for (int eb = 0; eb < 4; ++eb)
#pragma unroll
        for (int i = 0; i < 16; ++i) { NT[eb][i] *= inv; s1 += NT[eb][i]; }
    s1 += __shfl_xor(s1, 32); const float mean = s1 * (1.0f / 128.0f); float s2v = 0.f;
#pragma unroll
    for (int eb = 0; eb < 4; ++eb)
#pragma unroll
        for (int i = 0; i < 16; ++i) { const float d = NT[eb][i] - mean; s2v += d * d; }
    s2v += __shfl_xor(s2v, 32); const float rs = rsqrtf(s2v * (1.0f / 128.0f) + M_GN_EPS);
    bf16* YM = (bf16*)(a.ws + WS_YRM) + (size_t)(row0 + t) * 1024 + 512 + hc; const bf16* orow = PM + (size_t)(row0 + t) * NPM + 1024 + hc;
    const LAS float* gnw = (const LAS float*)(L + M3_GN); const LAS float* skp = (const LAS float*)(L + M3_SK);
    bf16x8 idf[2];
#pragma unroll
    for (int ksl = 0; ksl < 2; ++ksl) { v4u id; const int kb0 = 16 * ksl + 8 * hh;
        id.x = (r == kb0 ? 0x3f80u : 0u) | (r == kb0 + 1 ? 0x3f800000u : 0u); id.y = (r == kb0 + 2 ? 0x3f80u : 0u) | (r == kb0 + 3 ? 0x3f800000u : 0u);
        id.z = (r == kb0 + 4 ? 0x3f80u : 0u) | (r == kb0 + 5 ? 0x3f800000u : 0u); id.w = (r == kb0 + 6 ? 0x3f80u : 0u) | (r == kb0 + 7 ? 0x3f800000u : 0u);
        idf[ksl] = __builtin_bit_cast(bf16x8, id); }
#pragma unroll
    for (int eb = 0; eb < 4; ++eb) { f32x16 xt;
#pragma unroll
        for (int i = 0; i < 16; ++i) xt[i] = 0.f;
        xt = MFMA32(idf[0], *(const LAS bf16x8*)(xbp + (2 * eb) * 1024), xt); xt = MFMA32(idf[1], *(const LAS bf16x8*)(xbp + (2 * eb + 1) * 1024), xt);
#pragma unroll
        for (int g = 0; g < 4; ++g) { const int e0 = 32 * eb + 8 * g + 4 * hh;
            const v2u ov = *(const v2u*)(orow + e0); const float og[4] = {bflo(ov.x), bfhi(ov.x), bflo(ov.y), bfhi(ov.y)};
            const f32x4 gw = *(const LAS f32x4*)(gnw + e0), sk = *(const LAS f32x4*)(skp + e0); float o[4];
#pragma unroll
            for (int i = 0; i < 4; ++i) o[i] = ((NT[eb][4 * g + i] - mean) * rs * gw[i] + sk[i] * xt[4 * g + i]) * sigmoidf_(og[i]);
            v2u w; w.x = cvtpk(o[0], o[1]); w.y = cvtpk(o[2], o[3]); *(v2u*)(YM + e0) = w; }
        __builtin_amdgcn_sched_barrier(0); }
}

constexpr size_t WS_SPREV = 237 * MiB;
constexpr size_t WS_GL = 253 * MiB, WS_BON = 253 * MiB + 512 * 1024, WS_BND = 254 * MiB;
constexpr size_t DO_DLRT = O_SC * 4, DO_DS = O_SC * 4 + 16 * MiB;
constexpr int RSTR = 144, RSLOT = 64 * RSTR;
constexpr int R1_MISC = 8 * RSLOT, R1_ITEM_LDS = 8 * RSLOT + 6144;
static_assert(2 * R1_ITEM_LDS == 159744, "R1 LDS");

__device__ __forceinline__ int rowidx(int reg, int hh) { return (reg & 3) + 8 * (reg >> 2) + 4 * hh; }
__device__ __forceinline__ bf16x8 ldsfrag(const LAS unsigned char* slot, int row, int k0) { return *(const LAS bf16x8*)(slot + row * RSTR + k0 * 2); }
__device__ __forceinline__ void st_rows(LAS unsigned char* slot, int rb, int cb, const f32x16& x, int r, int hh) {
    LAS unsigned char* bp = slot + (32 * rb + 4 * hh) * RSTR + (32 * cb + r) * 2;
#pragma unroll
    for (int reg = 0; reg < 16; reg += 2) { const unsigned w = cvtpk(x[reg], x[reg + 1]);
        *(LAS bf16*)(bp + ((reg & 3) + 8 * (reg >> 2)) * RSTR) = (bf16)(w & 0xffffu); *(LAS bf16*)(bp + (((reg + 1) & 3) + 8 * ((reg + 1) >> 2)) * RSTR) = (bf16)(w >> 16); }
}
__device__ __forceinline__ void st_cols(LAS unsigned char* slot, int rb, int cb, const f32x16& x, int r, int hh) {
    LAS unsigned char* bp = slot + (32 * cb + r) * RSTR + (32 * rb + 4 * hh) * 2;
#pragma unroll
    for (int g = 0; g < 4; ++g) { v2u w; w.x = cvtpk(x[4 * g], x[4 * g + 1]); w.y = cvtpk(x[4 * g + 2], x[4 * g + 3]); *(LAS v2u*)(bp + 16 * g) = w; }
}
__device__ __forceinline__ f32x16 zero16() { f32x16 z;
#pragma unroll
    for (int i = 0; i < 16; ++i) z[i] = 0.f;
    return z; }
__device__ __forceinline__ void mix8(const v4u cur, const v4u prv, const float* mu, float (&m)[8]) {
    const f32x4 m0 = *(const f32x4*)mu, m1 = *(const f32x4*)(mu + 4);
    const float c[8] = {bflo(cur.x), bfhi(cur.x), bflo(cur.y), bfhi(cur.y), bflo(cur.z), bfhi(cur.z), bflo(cur.w), bfhi(cur.w)};
    const float p[8] = {bflo(prv.x), bfhi(prv.x), bflo(prv.y), bfhi(prv.y), bflo(prv.z), bfhi(prv.z), bflo(prv.w), bfhi(prv.w)};
    const float mm[8] = {m0.x, m0.y, m0.z, m0.w, m1.x, m1.y, m1.z, m1.w};
#pragma unroll
    for (int i = 0; i < 8; ++i) m[i] = c[i] + (p[i] - c[i]) * mm[i];
}
__device__ __forceinline__ void mix4(const v2u cur, const v2u prv, const float* mu, float (&m)[4]) {
    const f32x4 m0 = *(const f32x4*)mu;
    const float c[4] = {bflo(cur.x), bfhi(cur.x), bflo(cur.y), bfhi(cur.y)}, p[4] = {bflo(prv.x), bfhi(prv.x), bflo(prv.y), bfhi(prv.y)}, mm[4] = {m0.x, m0.y, m0.z, m0.w};
#pragma unroll
    for (int i = 0; i < 4; ++i) m[i] = c[i] + (p[i] - c[i]) * mm[i];
}

__device__ __forceinline__ float tanh_fast(float x) { return 1.0f - 2.0f / (__expf(2.0f * x) + 1.0f); }
__device__ __forceinline__ void rwkv_prep_pair(const Args& a, LAS unsigned char* lds0, int ritem0, bool dry = false) {
    int tid_ = threadIdx.x; asm volatile("" : "+v"(tid_));
    const int tid = tid_ & 255, lane = tid & 63, w4 = tid >> 6, r = lane & 31, hh = lane >> 5, half = tid_ >> 8;
    const int ritem = ritem0 + half, bh = ritem >> 5, c = ritem & 31, b = bh >> 3, h = bh & 7, hc = h * 64, row0 = b * SEQ, t0 = c * 64;
    const int p = w4 >> 1, q = w4 & 1;
    LAS unsigned char* L = lds0 + half * R1_ITEM_LDS;
    LAS unsigned char *S0 = L, *S1 = L + RSLOT, *S2 = L + 2 * RSLOT, *S3 = L + 3 * RSLOT, *S4 = L + 4 * RSLOT, *S5 = L + 5 * RSLOT, *S6 = L + 6 * RSLOT, *S7 = L + 7 * RSLOT;
    LAS float* SSX = (LAS float*)(L + R1_MISC);
    LAS float* BONX = SSX + 128;
    LAS float* CUMT = BONX + 128;
    LAS float* CUML = CUMT + 64;
    LAS float* CUMTp = CUMT + 32 * p + 4 * hh; LAS float* CUMLp = CUML + 32 * p + 4 * hh;
    LAS unsigned char* T00T = L + R1_MISC;
    LAS unsigned char* G1T = L + R1_MISC + 2560;
    const bf16* PR = (const bf16*)(a.ws + WS_PR); const bf16* BND = (const bf16*)(a.ws + WS_BND);
    const float* mu = a.in[10];
    constexpr int RAWS = 656;
    {   const int segcol[5] = {hc, 512 + hc, 1024 + hc, 1536, 1600};
        for (int ci = tid; ci < 65 * 40; ci += 256) { const int trow = ci / 40, sc = ci - trow * 40, seg = sc >> 3, part = sc & 7;
            v4u v = (v4u){0u, 0u, 0u, 0u};
            const int col = (seg == 0 ? hc : seg == 1 ? 512 + hc : seg == 2 ? 1024 + hc : seg == 3 ? 1536 : 1600) + part * 8;
            if (trow > 0) v = *(const v4u*)(PR + (size_t)(row0 + t0 + trow - 1) * NPR + col);
            else if (c > 0) v = *(const v4u*)(BND + (size_t)(b * 32 + c - 1) * NPR + col);
            *(LAS v4u*)(L + trow * RAWS + seg * 128 + part * 16) = v; }
        (void)segcol;
    }
    __syncthreads();
    const int tl = 32 * q + r; const size_t row = (size_t)(row0 + t0 + tl);
    const LAS unsigned char* rcur = L + (tl + 1) * RAWS; const LAS unsigned char* rprv = L + tl * RAWS;
    f32x16 wl = zero16(), al = zero16();
    {   const bf16* W2T = (const bf16*)(a.ws + WS_LW2T) + (size_t)(hc + 32 * p + r) * 64; const bf16* A2T = (const bf16*)(a.ws + WS_LA2T) + (size_t)(hc + 32 * p + r) * 64;
#pragma unroll
        for (int ks = 0; ks < 4; ++ks) { const int k0 = 16 * ks + 8 * hh; float m[8];
            mix8(*(const LAS v4u*)(rcur + 384 + k0 * 2), *(const LAS v4u*)(rprv + 384 + k0 * 2), mu + 1536 + k0, m);
            wl = MFMA32(ld16(W2T + k0), pack8(tanh_fast(m[0]), tanh_fast(m[1]), tanh_fast(m[2]), tanh_fast(m[3]), tanh_fast(m[4]), tanh_fast(m[5]), tanh_fast(m[6]), tanh_fast(m[7])), wl);
            mix8(*(const LAS v4u*)(rcur + 512 + k0 * 2), *(const LAS v4u*)(rprv + 512 + k0 * 2), mu + 1600 + k0, m);
            al = MFMA32(ld16(A2T + k0), pack8(m[0], m[1], m[2], m[3], m[4], m[5], m[6], m[7]), al); __builtin_amdgcn_sched_barrier(0); }
    }
    f32x16 lw, aa, kx, rx, vx;
    float ssp = 0.f, bonp = 0.f;
#pragma unroll
    for (int g = 0; g < 4; ++g) { const int ch = hc + 32 * p + 8 * g + 4 * hh; const int cl = (32 * p + 8 * g + 4 * hh) * 2;
        const f32x4 w04 = *(const f32x4*)(a.in[11] + ch), a04 = *(const f32x4*)(a.in[13] + ch), kk4 = *(const f32x4*)(a.in[16] + ch), ka4 = *(const f32x4*)(a.in[17] + ch), rk4 = *(const f32x4*)(a.in[18] + ch);
        float mr[4], mk[4], mv[4];
        mix4(*(const LAS v2u*)(rcur + cl), *(const LAS v2u*)(rprv + cl), mu + ch, mr);
        mix4(*(const LAS v2u*)(rcur + 128 + cl), *(const LAS v2u*)(rprv + 128 + cl), mu + 512 + ch, mk);
        mix4(*(const LAS v2u*)(rcur + 256 + cl), *(const LAS v2u*)(rprv + 256 + cl), mu + 1024 + ch, mv);
#pragma unroll
        for (int i = 0; i < 4; ++i) { const int reg = 4 * g + i;
            lw[reg] = -0.6065306597126334f / (1.0f + __expf(-(w04[i] + wl[reg])));
            const float av = 1.0f / (1.0f + __expf(-(a04[i] + al[reg]))); aa[reg] = av;
            const float kkr = mk[i] * kk4[i]; ssp += kkr * kkr; wl[reg] = kkr;
            const float k2 = mk[i] * (1.0f + (av - 1.0f) * ka4[i]); kx[reg] = k2; rx[reg] = mr[i]; vx[reg] = mv[i];
            bonp += mr[i] * k2 * rk4[i]; }
        __builtin_amdgcn_sched_barrier(0); }
    ssp += __shfl_xor(ssp, 32); bonp += __shfl_xor(bonp, 32);
    if (hh == 0) { SSX[tl * 2 + p] = ssp; BONX[tl * 2 + p] = bonp; }
    st_rows(S6, p, q, vx, r, hh);
    __builtin_amdgcn_sched_barrier(0);
    f32x16 cum = lw;
#pragma unroll
    for (int o = 1; o < 32; o <<= 1) {
#pragma unroll
        for (int reg = 0; reg < 16; ++reg) { const float t = __shfl_up(cum[reg], o, 32); if (r >= o) cum[reg] += t; } }
    if (q == 0 && r == 31) {
#pragma unroll
        for (int reg = 0; reg < 16; ++reg) CUMTp[(reg & 3) + 8 * (reg >> 2)] = cum[reg]; }
    __syncthreads();
    if (q == 1) {
#pragma unroll
        for (int reg = 0; reg < 16; ++reg) cum[reg] += CUMTp[(reg & 3) + 8 * (reg >> 2)];
        if (r == 31) {
#pragma unroll
            for (int reg = 0; reg < 16; ++reg) CUMLp[(reg & 3) + 8 * (reg >> 2)] = cum[reg]; } }
    const float rinv = 1.0f / fmaxf(sqrtf(SSX[tl * 2] + SSX[tl * 2 + 1]), 1e-12f);
    if (p == 0 && hh == 0 && !dry) ((float*)(a.ws + WS_BON))[row * 8 + h] = BONX[tl * 2] + BONX[tl * 2 + 1];
    f32x16 KeT, RqT;
#pragma unroll
    for (int reg = 0; reg < 16; ++reg) { RqT[reg] = rx[reg] * __expf(cum[reg]); lw[reg] = cum[reg] - lw[reg]; wl[reg] *= rinv; }
    st_cols(S3, p, q, RqT, r, hh);
    __syncthreads();
    __builtin_amdgcn_sched_barrier(0);
    {   f32x16 tmp;
#pragma unroll
        for (int reg = 0; reg < 16; ++reg) tmp[reg] = wl[reg] * __expf(lw[reg]);
        st_cols(S0, p, q, tmp, r, hh); st_rows(S4, p, q, tmp, r, hh);
        __builtin_amdgcn_sched_barrier(0);
#pragma unroll
        for (int reg = 0; reg < 16; ++reg) tmp[reg] = wl[reg] * aa[reg] * __expf(-cum[reg]);
        st_cols(S1, p, q, tmp, r, hh);
        __builtin_amdgcn_sched_barrier(0);
#pragma unroll
        for (int reg = 0; reg < 16; ++reg) tmp[reg] = kx[reg] * __expf(-cum[reg]);
        st_cols(S2, p, q, tmp, r, hh);
        __builtin_amdgcn_sched_barrier(0);
#pragma unroll
        for (int reg = 0; reg < 16; ++reg) { const float e4 = __expf(CUMLp[(reg & 3) + 8 * (reg >> 2)] - cum[reg]); tmp[reg] = wl[reg] * aa[reg] * e4; KeT[reg] = kx[reg] * e4; }
        st_rows(S5, p, q, tmp, r, hh);
        if (q == 0 && r == 0 && !dry) { float* glp = (float*)(a.ws + WS_GL) + (size_t)ritem * 64 + 32 * p + 4 * hh;
#pragma unroll
            for (int reg = 0; reg < 16; ++reg) glp[(reg & 3) + 8 * (reg >> 2)] = __expf(CUMLp[(reg & 3) + 8 * (reg >> 2)]); }
    }
    __syncthreads();
    __builtin_amdgcn_sched_barrier(0);
    f32x16 NrkT;
    {   f32x16 mkb = zero16(), mkk = zero16(), nrb = zero16(); NrkT = zero16();
        if (!(p == 0 && q == 1)) {
#pragma unroll
            for (int ks = 0; ks < 4; ++ks) { const int k0 = 16 * ks + 8 * hh;
                const bf16x8 kqp = ldsfrag(S0, 32 * p + r, k0), rqp = ldsfrag(S3, 32 * p + r, k0), bdq = ldsfrag(S1, 32 * q + r, k0), kdq = ldsfrag(S2, 32 * q + r, k0);
                mkb = MFMA32(kqp, bdq, mkb); mkk = MFMA32(kqp, kdq, mkk); nrb = MFMA32(rqp, bdq, nrb); }
        }
        if (!(p == 1 && q == 0)) {
#pragma unroll
            for (int ks = 0; ks < 4; ++ks) { const int k0 = 16 * ks + 8 * hh; NrkT = MFMA32(ldsfrag(S2, 32 * p + r, k0), ldsfrag(S3, 32 * q + r, k0), NrkT); }
        }
#pragma unroll
        for (int reg = 0; reg < 16; ++reg) { const int i = 32 * p + rowidx(reg, hh), j = 32 * q + r;
            if (!(j < i)) { mkb[reg] = 0.f; mkk[reg] = 0.f; } if (!(j <= i)) nrb[reg] = 0.f;
            if (!(i <= j)) NrkT[reg] = 0.f; }
        __syncthreads();
#pragma unroll
        for (int reg = 0; reg < 16; ++reg) *(LAS float*)(S0 + ((32 * p + 4 * hh) * 68 + 32 * q + r) * 4 + ((reg & 3) + 8 * (reg >> 2)) * 272) = mkb[reg];
        st_cols(S2, p, q, mkk, r, hh); st_rows(S3, p, q, nrb, r, hh);
    }
    __syncthreads();
    if (w4 < 2) {
        if (lane < 32) { const int i0 = 32 * w4; float tc[32];
#pragma unroll
            for (int i = 0; i < 32; ++i) { float acc = (i == lane) ? 1.0f : 0.0f;
#pragma unroll
                for (int j4 = 0; j4 < (i + 3) / 4; ++j4) { const f32x4 m4 = *(const LAS f32x4*)(S0 + ((i0 + i) * 68 + i0 + 4 * j4) * 4);
                    if (4 * j4 + 0 < i) acc -= m4.x * tc[4 * j4 + 0]; if (4 * j4 + 1 < i) acc -= m4.y * tc[4 * j4 + 1]; if (4 * j4 + 2 < i) acc -= m4.z * tc[4 * j4 + 2]; if (4 * j4 + 3 < i) acc -= m4.w * tc[4 * j4 + 3]; }
                tc[i] = acc; }
#pragma unroll
            for (int i = 0; i < 32; ++i) *(LAS bf16*)(S7 + (i0 + i) * RSTR + (i0 + lane) * 2) = (bf16)f2bf(tc[i]);
            if (w4 == 0) {
#pragma unroll
                for (int i8 = 0; i8 < 4; ++i8) *(LAS bf16x8*)(T00T + lane * 80 + i8 * 16) = pack8(tc[8 * i8], tc[8 * i8 + 1], tc[8 * i8 + 2], tc[8 * i8 + 3], tc[8 * i8 + 4], tc[8 * i8 + 5], tc[8 * i8 + 6], tc[8 * i8 + 7]); }
        }
    } else if (w4 == 2) {
#pragma unroll
        for (int i = 0; i < 16; ++i) *(LAS bf16*)(S7 + (2 * i + hh) * RSTR + (32 + r) * 2) = (bf16)0;
    }
    __syncthreads();
    if (w4 == 1) {
        f32x16 g1 = zero16();
#pragma unroll
        for (int ks = 0; ks < 2; ++ks) { const int k0 = 16 * ks + 8 * hh; const LAS float* mp = (const LAS float*)(S0 + ((32 + r) * 68 + k0) * 4); const f32x4 x0 = *(const LAS f32x4*)mp, x1 = *(const LAS f32x4*)(mp + 4);
            g1 = MFMA32(pack8(x0.x, x0.y, x0.z, x0.w, x1.x, x1.y, x1.z, x1.w), *(const LAS bf16x8*)(T00T + r * 80 + k0 * 2), g1); }
#pragma unroll
        for (int g = 0; g < 4; ++g) { v2u w; w.x = cvtpk(g1[4 * g], g1[4 * g + 1]); w.y = cvtpk(g1[4 * g + 2], g1[4 * g + 3]); *(LAS v2u*)(G1T + r * 80 + (8 * g + 4 * hh) * 2) = w; }
        LDS_WAIT(); asm volatile("" ::: "memory");
        f32x16 t10 = zero16();
#pragma unroll
        for (int ks = 0; ks < 2; ++ks) { const int k0 = 16 * ks + 8 * hh; t10 = MFMA32(ldsfrag(S7, 32 + r, 32 + k0), *(const LAS bf16x8*)(G1T + r * 80 + k0 * 2), t10); }
#pragma unroll
        for (int reg = 0; reg < 16; ++reg) *(LAS bf16*)(S7 + (32 + 4 * hh) * RSTR + r * 2 + ((reg & 3) + 8 * (reg >> 2)) * RSTR) = (bf16)f2bf(-t10[reg]);
    }
    __syncthreads();
    {   f32x16 w1 = zero16(), w2 = zero16();
#pragma unroll
        for (int ks = 0; ks < 4; ++ks) { const int k0 = 16 * ks + 8 * hh; const bf16x8 tq = ldsfrag(S7, 32 * q + r, k0);
            w1 = MFMA32(ldsfrag(S4, 32 * p + r, k0), tq, w1); w2 = MFMA32(ldsfrag(S2, 32 * p + r, k0), tq, w2); }
        __syncthreads();
        st_rows(S0, p, q, w1, r, hh); st_rows(S1, p, q, w2, r, hh);
    }
    __syncthreads();
    {   f32x16 qf = zero16(), dl = zero16(), pv = zero16(), kf = zero16();
#pragma unroll
        for (int ks = 0; ks < 4; ++ks) { const int k0 = 16 * ks + 8 * hh;
            const bf16x8 w1p = ldsfrag(S0, 32 * p + r, k0), w1q = ldsfrag(S0, 32 * q + r, k0), w2p = ldsfrag(S1, 32 * p + r, k0), w2q = ldsfrag(S1, 32 * q + r, k0), nrq = ldsfrag(S3, 32 * q + r, k0), bep = ldsfrag(S5, 32 * p + r, k0);
            qf = MFMA32(w1p, nrq, qf); dl = MFMA32(bep, w1q, dl); pv = MFMA32(w2p, nrq, pv); kf = MFMA32(bep, w2q, kf); }
        bf16* qo = (bf16*)(a.ws + WS_PR) + row * NPR + hc + 32 * p + 4 * hh;
        if (!dry)
#pragma unroll
        for (int g = 0; g < 4; ++g) { v2u w; w.x = cvtpk(RqT[4 * g] - qf[4 * g], RqT[4 * g + 1] - qf[4 * g + 1]); w.y = cvtpk(RqT[4 * g + 2] - qf[4 * g + 2], RqT[4 * g + 3] - qf[4 * g + 3]); *(v2u*)(qo + 8 * g) = w; }
        bf16* dlo = (bf16*)((unsigned char*)a.out + DO_DLRT) + (size_t)ritem * 4096 + (32 * p + 4 * hh) * 64 + 32 * q + r;
#pragma unroll
        for (int reg = 0; reg < 16; ++reg) { if (!dry) dlo[((reg & 3) + 8 * (reg >> 2)) * 64] = (bf16)f2bf(-dl[reg]); pv[reg] = NrkT[reg] - pv[reg]; kf[reg] = KeT[reg] - kf[reg]; }
        st_cols(S2, p, q, pv, r, hh);
        st_rows(S4, p, q, kf, r, hh);
    }
    __syncthreads();
    {   f32x16 yl = zero16(), ds = zero16();
#pragma unroll
        for (int ks = 0; ks < 4; ++ks) { const int k0 = 16 * ks + 8 * hh; const bf16x8 vp = ldsfrag(S6, 32 * p + r, k0);
            yl = MFMA32(vp, ldsfrag(S2, 32 * q + r, k0), yl); ds = MFMA32(vp, ldsfrag(S4, 32 * q + r, k0), ds); }
        bf16* yo = (bf16*)(a.ws + WS_PR) + row * NPR + 512 + hc + 32 * p + 4 * hh;
        if (!dry)
#pragma unroll
        for (int g = 0; g < 4; ++g) { v2u w; w.x = cvtpk(yl[4 * g], yl[4 * g + 1]); w.y = cvtpk(yl[4 * g + 2], yl[4 * g + 3]); *(v2u*)(yo + 8 * g) = w; }
        bf16* dso = (bf16*)((unsigned char*)a.out + DO_DS) + (size_t)ritem * 4096 + (32 * p + 4 * hh) * 64 + 32 * q + r;
#pragma unroll
        for (int reg = 0; reg < 16; ++reg) if (!dry) dso[((reg & 3) + 8 * (reg >> 2)) * 64] = (bf16)f2bf(ds[reg]);
    }
    __syncthreads();
}

typedef float f32x4v __attribute__((ext_vector_type(4)));
__device__ __forceinline__ void rwkv_scan_task(const Args& a, int bh, int vq, int lane) {
    const int lc = lane & 15, g = lane >> 4, v = 16 * vq + lc;
    f32x4v ST[4];
#pragma unroll
    for (int ib = 0; ib < 4; ++ib) ST[ib] = (f32x4v){0.f, 0.f, 0.f, 0.f};
    const bf16* DL0 = (const bf16*)((const unsigned char*)a.out + DO_DLRT) + (size_t)bh * 32 * 4096 + (size_t)lc * 64 + 4 * g;
    const bf16* DS0 = (const bf16*)((const unsigned char*)a.out + DO_DS) + (size_t)bh * 32 * 4096 + (size_t)v * 64 + 4 * g;
    const float* GL0 = (const float*)(a.ws + WS_GL) + (size_t)bh * 32 * 64 + 4 * g; bf16* SP0 = (bf16*)(a.ws + WS_SPREV) + (size_t)bh * 32 * 4096 + v * 64 + 4 * g;
    v2u dl[4][2][2], ds[4]; f32x4 gl[4];
#define R2_LOAD(c_) do { const bf16* DL = DL0 + (size_t)(c_) * 4096; \
        _Pragma("unroll") for (int ib = 0; ib < 4; ++ib) { _Pragma("unroll") for (int s = 0; s < 2; ++s) { dl[ib][s][0] = *(const v2u*)(DL + (16 * ib) * 64 + 32 * s); dl[ib][s][1] = *(const v2u*)(DL + (16 * ib) * 64 + 32 * s + 16); } \
            ds[ib] = *(const v2u*)(DS0 + (size_t)(c_) * 4096 + 16 * ib); gl[ib] = *(const f32x4*)(GL0 + (size_t)(c_) * 64 + 16 * ib); } } while (0)
    R2_LOAD(0);
    for (int c = 0; c < 32; ++c) {
        bf16* SP = SP0 + (size_t)c * 4096;
        unsigned hi[4][2], lo[4][2];
#pragma unroll
        for (int ib = 0; ib < 4; ++ib) { hi[ib][0] = cvtpk(ST[ib][0], ST[ib][1]); hi[ib][1] = cvtpk(ST[ib][2], ST[ib][3]);
            v2u w; w.x = hi[ib][0]; w.y = hi[ib][1]; *(v2u*)(SP + 16 * ib) = w;
            lo[ib][0] = cvtpk(ST[ib][0] - bflo(hi[ib][0]), ST[ib][1] - bfhi(hi[ib][0])); lo[ib][1] = cvtpk(ST[ib][2] - bflo(hi[ib][1]), ST[ib][3] - bfhi(hi[ib][1])); }
        bf16x8 Bh[2], Bl[2];
#pragma unroll
        for (int s = 0; s < 2; ++s) { v4u t; t.x = hi[2 * s][0]; t.y = hi[2 * s][1]; t.z = hi[2 * s + 1][0]; t.w = hi[2 * s + 1][1]; Bh[s] = __builtin_bit_cast(bf16x8, t);
            v4u u2; u2.x = lo[2 * s][0]; u2.y = lo[2 * s][1]; u2.z = lo[2 * s + 1][0]; u2.w = lo[2 * s + 1][1]; Bl[s] = __builtin_bit_cast(bf16x8, u2); }
        f32x4v nw[4]; bf16x8 Af[4][2];
#pragma unroll
        for (int ib = 0; ib < 4; ++ib) {
            nw[ib] = (f32x4v){bflo(ds[ib].x) + gl[ib].x * ST[ib][0], bfhi(ds[ib].x) + gl[ib].y * ST[ib][1], bflo(ds[ib].y) + gl[ib].z * ST[ib][2], bfhi(ds[ib].y) + gl[ib].w * ST[ib][3]};
#pragma unroll
            for (int s = 0; s < 2; ++s) { v4u t; t.x = dl[ib][s][0].x; t.y = dl[ib][s][0].y; t.z = dl[ib][s][1].x; t.w = dl[ib][s][1].y; Af[ib][s] = __builtin_bit_cast(bf16x8, t); } }
        if (c + 1 < 32) R2_LOAD(c + 1);
#pragma unroll
        for (int s = 0; s < 2; ++s)
#pragma unroll
            for (int ib = 0; ib < 4; ++ib) { nw[ib] = __builtin_amdgcn_mfma_f32_16x16x32_bf16(Af[ib][s], Bh[s], nw[ib], 0, 0, 0); nw[ib] = __builtin_amdgcn_mfma_f32_16x16x32_bf16(Af[ib][s], Bl[s], nw[ib], 0, 0, 0); }
#pragma unroll
        for (int ib = 0; ib < 4; ++ib) ST[ib] = nw[ib];
    }
#undef R2_LOAD
    float* So = a.out + O_PWKV + (size_t)bh * 4096 + v * 64 + 4 * g;
#pragma unroll
    for (int ib = 0; ib < 4; ++ib) *(f32x4*)(So + 16 * ib) = (f32x4){ST[ib][0], ST[ib][1], ST[ib][2], ST[ib][3]};
}

__device__ __forceinline__ void rwkv_out_task(const Args& a, int ritem, int tb, int lane_, bool dry = false) {
    int lane = lane_; asm volatile("" : "+v"(lane));
    const int r = lane & 31, hh = lane >> 5, bh = ritem >> 5, c = ritem & 31, b = bh >> 3, h = bh & 7, hc = h * 64, row0 = b * SEQ, t0 = c * 64, tl = 32 * tb + r;
    const size_t row = (size_t)(row0 + t0 + tl);
    bf16* PRw = (bf16*)(a.ws + WS_PR); const bf16* cur = PRw + row * NPR; const bf16* prv = (t0 + tl) > 0 ? cur - NPR : nullptr;
    const bf16* SP = (const bf16*)(a.ws + WS_SPREV) + (size_t)ritem * 4096; const float* mu = a.in[10];
    f32x16 Y[2] = {zero16(), zero16()};
#pragma unroll
    for (int ks = 0; ks < 4; ++ks) { const int k0 = 16 * ks + 8 * hh; const bf16x8 B = ld16(cur + hc + k0);
        Y[0] = MFMA32(ld16(SP + (size_t)r * 64 + k0), B, Y[0]); Y[1] = MFMA32(ld16(SP + (size_t)(32 + r) * 64 + k0), B, Y[1]); }
    __builtin_amdgcn_sched_barrier(0);
    f32x16 G[2] = {zero16(), zero16()};
    {   const bf16* G2T = (const bf16*)(a.ws + WS_LG2T) + (size_t)(hc + r) * 128;
#pragma unroll
        for (int ks = 0; ks < 8; ++ks) { const int k0 = 16 * ks + 8 * hh; float m[8];
            mix8(*(const v4u*)(cur + 1664 + k0), prv ? *(const v4u*)(prv + 1664 + k0) : (v4u){0u, 0u, 0u, 0u}, mu + 1664 + k0, m);
            const bf16x8 B = pack8(sigmoidf_(m[0]), sigmoidf_(m[1]), sigmoidf_(m[2]), sigmoidf_(m[3]), sigmoidf_(m[4]), sigmoidf_(m[5]), sigmoidf_(m[6]), sigmoidf_(m[7]));
            G[0] = MFMA32(ld16(G2T + k0), B, G[0]); G[1] = MFMA32(ld16(G2T + 32 * 128 + k0), B, G[1]); }
    }
    __builtin_amdgcn_sched_barrier(0);
    float s1 = 0.f;
#pragma unroll
    for (int vb = 0; vb < 2; ++vb)
#pragma unroll
        for (int g = 0; g < 4; ++g) { const v2u y4 = *(const v2u*)(cur + 512 + hc + 32 * vb + 8 * g + 4 * hh);
            Y[vb][4 * g] += bflo(y4.x); Y[vb][4 * g + 1] += bfhi(y4.x); Y[vb][4 * g + 2] += bflo(y4.y); Y[vb][4 * g + 3] += bfhi(y4.y);
            s1 += (Y[vb][4 * g] + Y[vb][4 * g + 1]) + (Y[vb][4 * g + 2] + Y[vb][4 * g + 3]); }
    s1 += __shfl_xor(s1, 32); const float mean = s1 * (1.0f / 64.0f); float s2 = 0.f;
#pragma unroll
    for (int vb = 0; vb < 2; ++vb)
#pragma unroll
        for (int i = 0; i < 16; ++i) { const float d = Y[vb][i] - mean; s2 += d * d; }
    s2 += __shfl_xor(s2, 32); const float rs = rsqrtf(s2 * (1.0f / 64.0f) + R_GN_EPS);
    const float bon = ((const float*)(a.ws + WS_BON))[row * 8 + h];
    bf16* yo = (bf16*)(a.ws + WS_YRM) + row * 1024 + hc;
#pragma unroll
    for (int vb = 0; vb < 2; ++vb)
#pragma unroll
        for (int g = 0; g < 4; ++g) { const int ch = hc + 32 * vb + 8 * g + 4 * hh; float mv[4];
            mix4(*(const v2u*)(cur + 1024 + ch), prv ? *(const v2u*)(prv + 1024 + ch) : (v2u){0u, 0u}, mu + 1024 + ch, mv);
            const f32x4 gw = *(const f32x4*)(a.in[19] + ch), gb = *(const f32x4*)(a.in[20] + ch); float o[4];
#pragma unroll
            for (int i = 0; i < 4; ++i) o[i] = ((Y[vb][4 * g + i] - mean) * rs * gw[i] + gb[i] + bon * mv[i]) * G[vb][4 * g + i];
            v2u w; w.x = cvtpk(o[0], o[1]); w.y = cvtpk(o[2], o[3]); if (!dry) *(v2u*)(yo + 32 * vb + 8 * g + 4 * hh) = w; }
}


__device__ __forceinline__ void rwkv_sample_task(const Args& a, int sb, int h, int lane) {
    const int hc = h * 64, j = lane;
    bf16* PRw = (bf16*)(a.ws + WS_PR); const bf16* cur = PRw + (size_t)(MP + sb) * NPR; const bf16* prv = PRw + (size_t)(MTOK + sb) * NPR; const float* mu = a.in[10];
#define RS_MIX(col) (bf2f(cur[col]) + (bf2f(prv[col]) - bf2f(cur[col])) * mu[col])
    const float r = RS_MIX(hc + j), k = RS_MIX(512 + hc + j), v = RS_MIX(1024 + hc + j);
    const float tw = tanh_fast(RS_MIX(1536 + j)), xa = RS_MIX(1600 + j), g0 = sigmoidf_(RS_MIX(1664 + j)), g1 = sigmoidf_(RS_MIX(1728 + j));
#undef RS_MIX
    float wl = a.in[11][hc + j], al = a.in[13][hc + j], gl = 0.f;
    const float* w2 = a.in[12] + hc + j; const float* a2 = a.in[14] + hc + j; const float* g2 = a.in[15] + hc + j;
#pragma unroll 8
    for (int i = 0; i < 64; ++i) { wl += __shfl(tw, i) * w2[(size_t)i * 512]; al += __shfl(xa, i) * a2[(size_t)i * 512]; gl += __shfl(g0, i) * g2[(size_t)i * 512] + __shfl(g1, i) * g2[(size_t)(64 + i) * 512]; }
    const float dec = expf(-0.6065306597126334f / (1.0f + expf(-wl))), aa = 1.0f / (1.0f + expf(-al));
    const float kkr = k * a.in[16][hc + j]; const float kk = kkr / fmaxf(sqrtf(wave_sum(kkr * kkr)), 1e-12f);
    const float k2 = k * (1.0f + (aa - 1.0f) * a.in[17][hc + j]), bb = kk * aa; const float bon = wave_sum(r * k2 * a.in[18][hc + j]);
    const float* S0 = a.in[3] + (size_t)(sb * 8 + h) * 4096 + j * 64; float* So = a.out + O_SWKV + (size_t)(sb * 8 + h) * 4096 + j * 64;
    float S[64];
#pragma unroll
    for (int i = 0; i < 16; ++i) { const f32x4 t = *(const f32x4*)(S0 + 4 * i); S[4 * i] = t.x; S[4 * i + 1] = t.y; S[4 * i + 2] = t.z; S[4 * i + 3] = t.w; }
    float p = 0.f;
#pragma unroll
    for (int i = 0; i < 64; ++i) p += S[i] * __shfl(kk, i);
    float y = 0.f;
#pragma unroll
    for (int i = 0; i < 64; ++i) { S[i] = S[i] * __shfl(dec, i) - p * __shfl(bb, i) + v * __shfl(k2, i); y += S[i] * __shfl(r, i); }
#pragma unroll
    for (int i = 0; i < 16; ++i) *(f32x4*)(So + 4 * i) = (f32x4){S[4 * i], S[4 * i + 1], S[4 * i + 2], S[4 * i + 3]};
    const float mean = wave_sum(y) * (1.0f / 64.0f), d = y - mean; const float rs = rsqrtf(wave_sum(d * d) * (1.0f / 64.0f) + R_GN_EPS);
    const float o = (d * rs * a.in[19][hc + j] + a.in[20][hc + j] + bon * v) * gl;
    PRw[(size_t)(MP + sb) * NPR + hc + j] = (bf16)f2bf(o);
}

typedef float f32x4m __attribute__((ext_vector_type(4)));
constexpr size_t WS_MERGED_S = 255 * MiB;
#define MFMA16(a, b, c) __builtin_amdgcn_mfma_f32_16x16x32_bf16((a), (b), (c), 0, 0, 0)
template <int KSTEPS>
__device__ __forceinline__ f32x4m skinny_acc(const bf16* ap, const bf16* bp, f32x4m acc) {
#pragma unroll 8
    for (int ks = 0; ks < KSTEPS; ++ks) acc = MFMA16(ld16(ap + 32 * ks), ld16(bp + 32 * ks), acc);
    return acc;
}
__device__ __forceinline__ void sample_up_task(const Args& a, int j, int wave, int lane) {
    const int lc = lane & 15, g = lane >> 4, rowa = MP + 16 * wave + lc, col = 16 * j + lc;
    unsigned char* ws = a.ws;
    f32x4m a1 = {0.f, 0.f, 0.f, 0.f}, a2 = {0.f, 0.f, 0.f, 0.f};
    a1 = skinny_acc<16>((const bf16*)(ws + WS_PR) + (size_t)rowa * NPR + 8 * g, (const bf16*)(ws + WS_UPRT) + (size_t)col * 1024 + 8 * g, a1);
    a2 = skinny_acc<16>((const bf16*)(ws + WS_YMS) + (size_t)(rowa - MP) * 512 + 8 * g, (const bf16*)(ws + WS_UPRT) + (size_t)col * 1024 + 512 + 8 * g, a2);
    const bf16* PG = (const bf16*)(ws + WS_PG); bf16* MG = (bf16*)(ws + WS_MERGED_S) - (size_t)MP * 1024;
#pragma unroll
    for (int rr = 0; rr < 4; ++rr) { const size_t row = (size_t)(MP + 16 * wave + 4 * g + rr);
        MG[row * 1024 + col] = (bf16)f2bf(bf2f(PG[row * 2048 + col]) * a1[rr] + bf2f(PG[row * 2048 + 1024 + col]) * a2[rr]); }
}
__device__ __forceinline__ void sample_out_task(const Args& a, int j, int wave, int lane) {
    const int lc = lane & 15, g = lane >> 4, rowa = MP + 16 * wave + lc, col = 16 * j + lc;
    unsigned char* ws = a.ws;
    f32x4m acc = {0.f, 0.f, 0.f, 0.f};
    acc = skinny_acc<32>((const bf16*)(ws + WS_MERGED_S) + (size_t)(rowa - MP) * 1024 + 8 * g, (const bf16*)(ws + WS_WOUTT) + (size_t)col * 1024 + 8 * g, acc);
    const float gf = a.in[33][col]; bf16* X2B = (bf16*)(ws + WS_X2B); float* ssq = (float*)(ws + WS_SSQ1);
#pragma unroll
    for (int rr = 0; rr < 4; ++rr) { const int rs = 16 * wave + 4 * g + rr; const size_t row = (size_t)(MP + rs);
        const float x2 = a.in[1][(size_t)rs * 1024 + col] + acc[rr];
        a.out[row * 1024 + col] = x2; X2B[row * 1024 + col] = (bf16)f2bf(x2 * gf);
        float sq = x2 * x2; sq += __shfl_xor(sq, 1); sq += __shfl_xor(sq, 2); sq += __shfl_xor(sq, 4); sq += __shfl_xor(sq, 8);
        if (lc == 0) atomicAdd(ssq + row, sq); }
}
__device__ __forceinline__ void sample_ffn1_task(const Args& a, int j, int wave, int lane) {
    const int lc = lane & 15, g = lane >> 4, rowa = MP + 16 * wave + lc, col = 16 * j + lc;
    unsigned char* ws = a.ws;
    f32x4m acc = {0.f, 0.f, 0.f, 0.f};
    acc = skinny_acc<32>((const bf16*)(ws + WS_X2B) + (size_t)rowa * 1024 + 8 * g, (const bf16*)(ws + WS_W1T) + (size_t)col * 1024 + 8 * g, acc);
    const float* ssq = (const float*)(ws + WS_SSQ1); bf16* H = (bf16*)(ws + WS_H);
#pragma unroll
    for (int rr = 0; rr < 4; ++rr) { const size_t row = (size_t)(MP + 16 * wave + 4 * g + rr); const float rs = rsqrtf(ssq[row] * (1.0f / 1024.0f) + RMS_EPS);
        const float v = fmaxf(acc[rr] * rs, 0.f); H[row * 4096 + col] = (bf16)f2bf(v * v); }
}
__device__ __forceinline__ void sample_ffn2_task(const Args& a, int t, int wave, int lane) {
    const int lc = lane & 15, g = lane >> 4, rowa = MP + 16 * wave + lc, j = t >> 2, kq = t & 3, col = 16 * j + lc;
    unsigned char* ws = a.ws;
    f32x4m acc = {0.f, 0.f, 0.f, 0.f};
    acc = skinny_acc<32>((const bf16*)(ws + WS_H) + (size_t)rowa * 4096 + 1024 * kq + 8 * g, (const bf16*)(ws + WS_W2T) + (size_t)col * 4096 + 1024 * kq + 8 * g, acc);
#pragma unroll
    for (int rr = 0; rr < 4; ++rr) atomicAdd(a.out + (size_t)(MP + 16 * wave + 4 * g + rr) * 1024 + col, acc[rr]);
}

__device__ __forceinline__ unsigned long long rt() { return __builtin_amdgcn_s_memrealtime(); }
#define XB_TMO      128
#define XB_XCNT(j)  (256  + 64 * (j))
#define XB_XSUB(j)  (1280 + 64 * (j))
#define XB_XGEN(j)  (2304 + 64 * (j))
#define XB_TOP      3328
#define XB_TOPGEN   3392
#define XCD_BAR_WORDS 3456
#define XB_SPIN_CAP (1u << 18)

__device__ __forceinline__ unsigned xb_ld(unsigned* p)              { return __hip_atomic_load(p, __ATOMIC_RELAXED, __HIP_MEMORY_SCOPE_AGENT); }
__device__ __forceinline__ unsigned xb_add(unsigned* p, unsigned v) { return __hip_atomic_fetch_add(p, v, __ATOMIC_RELAXED, __HIP_MEMORY_SCOPE_AGENT); }
__device__ __forceinline__ unsigned xb_xcc_id() { return (unsigned)__builtin_amdgcn_s_getreg((3 << 11) | 20) & 0xFu; }
#define XB_SPIN(cond, bar) do { unsigned _sp = 0; while (cond) { __builtin_amdgcn_s_sleep(1); \
    if ((++_sp & 255u) == 0u) { if (xb_ld(&(bar)[XB_TMO])) break; if (_sp > XB_SPIN_CAP) { atomicAdd(&(bar)[XB_TMO], 1u); break; } } } } while (0)

struct XcdBarrier {
    unsigned* bar; unsigned x;
    volatile LAS unsigned* st;
};

__device__ __forceinline__ XcdBarrier xcd_barrier_post(unsigned* bar, volatile LAS unsigned* st) {
    XcdBarrier b; b.bar = bar; b.x = xb_xcc_id(); b.st = st;
    if (threadIdx.x == 0) (void)xb_add(&bar[XB_XCNT(b.x)], 1u);
    return b;
}
__device__ __forceinline__ void xcd_barrier_complete(unsigned* bar, unsigned x, unsigned& nloc, unsigned& nx) {
    const unsigned G = gridDim.x * gridDim.y * gridDim.z;
    unsigned sum, cnt, mine, sp = 0u;
    for (;;) {
        sum = 0u; cnt = 0u; mine = 0u;
#pragma unroll
        for (unsigned j = 0; j < 16; ++j) { const unsigned c = xb_ld(&bar[XB_XCNT(j)]); sum += c; cnt += (c > 0u) ? 1u : 0u; mine = (j == x) ? c : mine; }
        if (sum == G) break;
        __builtin_amdgcn_s_sleep(1);
        if ((++sp & 255u) == 0u) { if (xb_ld(&bar[XB_TMO])) break; if (sp > XB_SPIN_CAP) { atomicAdd(&bar[XB_TMO], 1u); break; } }
    }
    nloc = mine > 0u ? mine : 1u; nx = cnt > 0u ? cnt : 1u;
}

__device__ __forceinline__ void xcd_barrier(const XcdBarrier& b) {
    asm volatile("s_waitcnt vmcnt(0)" ::: "memory");
    __syncthreads();
    if (threadIdx.x == 0) {
        unsigned* bar = b.bar;
        __builtin_amdgcn_s_waitcnt(0);
        unsigned nloc = b.st[0], nx = b.st[1];
        if (nloc == 0u) { xcd_barrier_complete(bar, b.x, nloc, nx); b.st[0] = nloc; b.st[1] = nx; }
        const unsigned old = xb_add(&bar[XB_XSUB(b.x)], 1u);
        const unsigned gen = old / nloc;
        if (old + 1u == (gen + 1u) * nloc) {
            __builtin_amdgcn_fence(__ATOMIC_RELEASE, "agent");
            asm volatile("s_waitcnt vmcnt(0)" ::: "memory");
            const unsigned og = xb_add(&bar[XB_TOP], 1u);
            const unsigned tg = og / nx;
            if (og + 1u == (tg + 1u) * nx) xb_add(&bar[XB_TOPGEN], 1u);
            else XB_SPIN(xb_ld(&bar[XB_TOPGEN]) == tg, bar);
            __builtin_amdgcn_fence(__ATOMIC_ACQUIRE, "agent");
            xb_add(&bar[XB_XGEN(b.x)], 1u);
            asm volatile("s_waitcnt vmcnt(0)" ::: "memory");
        } else {
            XB_SPIN(xb_ld(&bar[XB_XGEN(b.x)]) == gen, bar);
            __builtin_amdgcn_fence(__ATOMIC_ACQUIRE, "agent");
            asm volatile("s_waitcnt vmcnt(0)" ::: "memory");
        }
    }
    __syncthreads();
}


constexpr size_t WS_BAR = 512 * 1024;
constexpr int MISC_OFF = 159744, MEGA_LDS = 160000;
static_assert(2 * RWKV_LDS <= MISC_OFF && MLSTM_LDS <= MISC_OFF && P0_LDS <= MISC_OFF && 2 * R1_ITEM_LDS <= MISC_OFF && GEMM_LDS <= MISC_OFF, "LDS map");

__global__ void __launch_bounds__(NTHR, 2) mega_fwd(Args a) {
    extern __shared__ __attribute__((aligned(16))) unsigned char lds_raw[];
    LAS unsigned char* lds = (LAS unsigned char*)lds_raw;
    volatile LAS unsigned* MISC = (volatile LAS unsigned*)(lds + MISC_OFF);
    const int tid = threadIdx.x, lane = tid & 63, wave = __builtin_amdgcn_readfirstlane(tid >> 6);
    const int G = gridDim.x, bx = blockIdx.x;
    unsigned char* ws = a.ws;
    if (tid < 64) MISC[tid] = 0u;
    __syncthreads();
    XcdBarrier bar = xcd_barrier_post((unsigned*)(ws + WS_BAR), MISC + 8);

    p0_prologue(a, lds, bx * NWAVES + wave, G * NWAVES, lane, wave);
    xcd_barrier(bar);
    { pg8::StaticOrder S; pg8::Gemm g{(const bf16*)(ws + WS_XN), (const bf16*)(ws + WS_WINT), MT, NPROJ, 1024, 1024, 1024, 0}; S.init(MT, NPROJ, G, bx);
      pg8::EpiProj E{(bf16*)(ws + WS_PR), (bf16*)(ws + WS_PM), (bf16*)(ws + WS_PG), a.in[31], (bf16*)(ws + WS_BND)}; pg8::gemm_phase<pg8::EpiProj, pg8::StaticOrder, true, true>(lds, g, S, E); }
    xcd_barrier(bar);
    {
        for (int pr = bx; pr < 1024; pr += G) rwkv_prep_pair(a, lds, 2 * pr);
        for (int item = bx; item < 1024; item += G) { mlstm_prep_stage(a, lds, item, tid); __syncthreads(); mlstm_prep_xc(lds, tid); __syncthreads(); mlstm_prep_task(a, item, wave, lds, lane); __syncthreads(); }
    }
    xcd_barrier(bar);
    {
        if (wave == 0) rwkv_scan_task(a, bx >> 2, bx & 3, lane);
        else if (wave == 1 && bx < 160) mlstm_scan_task(a, bx / 5, bx % 5, (LAS float*)lds, lane);
        else if (wave >= 2) { const int tq = bx * 6 + (wave - 2); if (tq < MS * RH) rwkv_sample_task(a, tq >> 3, tq & 7, lane);
            ffn_weights_convert(a, bx * 6 + (wave - 2), G * 6, (LAS float*)(lds + 4096) + (wave - 2) * (64 * 33), lane); }
    }
    xcd_barrier(bar);
    {
        for (int s = bx; s < 512; s += G) { mlstm_seq_item(a, lds, 32 + s); __syncthreads(); }
        mlstm_out_stage(a, lds, bx & 3, tid); mlstm_out_stage_xm(a, lds, bx & 3, (bx >> 2) * NWAVES, tid);
        __syncthreads();
        { const int tq = (bx >> 2) * NWAVES + wave, hq = bx & 3; const int item = ((tq >> 6) * 4 + hq) * 32 + ((tq >> 1) & 31); mlstm_out_task(a, item, tq & 1, lds, wave, lane); }
        for (int task = bx * NWAVES + wave; task < 4096; task += G * NWAVES) rwkv_out_task(a, task >> 1, task & 1, lane);
    }
    xcd_barrier(bar);
    if (bx < 64) sample_up_task(a, bx, wave, lane);
    { pg8::PairOrder S; pg8::Gemm g{(const bf16*)(ws + WS_YRM), (const bf16*)(ws + WS_UPRT), MP, 1024, 512, 1024, 1024, 512}; S.init(MP, 1024, G, bx);
      pg8::EpiUpZ E{a.out, (const bf16*)(ws + WS_PG), (bf16*)(ws + WS_MERGED)}; pg8::gemm_phase<pg8::EpiUpZ, pg8::PairOrder, true, true>(lds, g, S, E); }
    xcd_barrier(bar);
    if (bx < 64) sample_out_task(a, bx, wave, lane);
    { pg8::StaticOrder S; pg8::Gemm g{(const bf16*)(ws + WS_MERGED), (const bf16*)(ws + WS_WOUTT), MP, 1024, 1024, 1024, 1024, 0}; S.init(MP, 1024, G, bx);
      pg8::EpiOut E{a.in[0], a.in[1], a.out, (bf16*)(ws + WS_X2B), a.in[33], (float*)(ws + WS_SSQ1)}; pg8::gemm_phase<pg8::EpiOut, pg8::StaticOrder, true, true>(lds, g, S, E); }
    xcd_barrier(bar);
    sample_ffn1_task(a, bx, wave, lane);
    { pg8::StaticOrder S; pg8::Gemm g{(const bf16*)(ws + WS_X2B), (const bf16*)(ws + WS_W1T), MP, FF, 1024, 1024, 1024, 0}; S.init(MP, FF, G, bx);
      pg8::EpiFfn1 E{(bf16*)(ws + WS_H), (const float*)(ws + WS_SSQ1)}; pg8::gemm_phase<pg8::EpiFfn1, pg8::StaticOrder, true, true>(lds, g, S, E); }
    xcd_barrier(bar);
    sample_ffn2_task(a, bx, wave, lane);
    { pg8::StaticOrder S; pg8::Gemm g{(const bf16*)(ws + WS_H), (const bf16*)(ws + WS_W2T), MP, 1024, FF, FF, FF, 0}; S.init(MP, 1024, G, bx);
      pg8::EpiFfn2 E{a.out, nullptr}; pg8::gemm_phase<pg8::EpiFfn2, pg8::StaticOrder, true, true>(lds, g, S, E); }
    xcd_barrier(bar);
    final_norm_rows(a, bx * NWAVES + wave, G * NWAVES, lane);
}

extern "C" void kernel_launch(void* const* d_in, const int* in_sizes, int n_in, void* d_out, int out_size, void* d_ws, size_t ws_size, hipStream_t stream) {
    static int grid = 0;
    if (grid == 0) {
        if (n_in != 37 || (size_t)out_size != O_END || ws_size < WS_NEED) { fprintf(stderr, "kernel_launch: unexpected problem: n_in %d out %d ws %zu\n", n_in, out_size, ws_size); grid = -1; return; }
        int dev = 0, cus = 0, per_cu = 0;
        if (hipGetDevice(&dev) != hipSuccess || hipDeviceGetAttribute(&cus, hipDeviceAttributeMultiprocessorCount, dev) != hipSuccess) { fprintf(stderr, "kernel_launch: device query failed\n"); grid = -1; return; }
        if (hipFuncSetAttribute((const void*)mega_fwd, hipFuncAttributeMaxDynamicSharedMemorySize, MEGA_LDS) != hipSuccess) { fprintf(stderr, "kernel_launch: hipFuncSetAttribute failed\n"); grid = -1; return; }
        if (hipOccupancyMaxActiveBlocksPerMultiprocessor(&per_cu, (const void*)mega_fwd, NTHR, MEGA_LDS) != hipSuccess || per_cu < 1) { fprintf(stderr, "kernel_launch: occupancy query reports %d workgroups per CU\n", per_cu); (void)hipGetLastError(); per_cu = 1; }
        if (cus != 256) fprintf(stderr, "kernel_launch: built for a 256-CU device (one workgroup per CU); found %d CUs\n", cus);
        grid = 256;
    }
    if (grid < 0) return;
    if (hipMemsetAsync((char*)d_ws + WS_BAR, 0, 16384, stream) != hipSuccess) { fprintf(stderr, "kernel_launch: memset failed\n"); return; }
    Args a{};
    for (int i = 0; i < 37; ++i) a.in[i] = (const float*)d_in[i];
    a.out = (float*)d_out; a.ws = (unsigned char*)d_ws;
    void* args[] = {&a};
    hipError_t e = hipLaunchCooperativeKernel((const void*)mega_fwd, dim3(grid), dim3(NTHR), args, MEGA_LDS, stream);
    if (e != hipSuccess) fprintf(stderr, "kernel_launch: cooperative launch failed: %s (grid %d)\n", hipGetErrorString(e), grid);
}
```

```cpp
#include <hip/hip_runtime.h>
#include <cstdio>
#include <cstdint>

constexpr int DM = 1024, MP = 16384, MS = 128, MTOK = MP + MS, MT = 16640;
constexpr int SEQ = 2048, NB = 8;
constexpr int NPR = 1792, NPM = 1536, NPG = 2048, NPROJ = NPR + NPM + NPG, INCOLS = 5384, GCOL0 = 3328;
constexpr int RH = 8, RN = 64, RW = 512, MH = 4, MD = 128, MW = 512, FF = 4096;
constexpr float RMS_EPS = 1e-6f, R_GN_EPS = 64e-5f, M_GN_EPS = 1e-5f;

constexpr size_t O_Y = 0;
constexpr size_t O_PSHIFT = (size_t)MTOK * DM;
constexpr size_t O_PWKV = O_PSHIFT + (size_t)NB * DM;
constexpr size_t O_PC = O_PWKV + (size_t)NB * RH * RN * RN;
constexpr size_t O_PN = O_PC + (size_t)NB * MH * MD * MD;
constexpr size_t O_PMM = O_PN + (size_t)NB * MH * MD;
constexpr size_t O_PCONV = O_PMM + (size_t)NB * MH;
constexpr size_t O_SSHIFT = O_PCONV + (size_t)NB * 3 * MW;
constexpr size_t O_SWKV = O_SSHIFT + (size_t)MS * DM;
constexpr size_t O_SC = O_SWKV + (size_t)MS * RH * RN * RN;
constexpr size_t O_SN = O_SC + (size_t)MS * MH * MD * MD;
constexpr size_t O_SMM = O_SN + (size_t)MS * MH * MD;
constexpr size_t O_SCONV = O_SMM + (size_t)MS * MH;
constexpr size_t O_END = O_SCONV + (size_t)MS * 3 * MW;
static_assert(O_END == 30695968, "output size");

constexpr size_t MiB = 1u << 20;
constexpr size_t WS_CTL = 0;
constexpr size_t WS_SSQ1 = 0, WS_SSQ2 = 128 * 1024;
constexpr size_t WS_WINT = 1 * MiB, WS_UPRT = 12 * MiB, WS_UPMT = 13 * MiB, WS_WOUTT = 14 * MiB, WS_W1T = 16 * MiB, WS_W2T = 24 * MiB;
constexpr size_t WS_GATES = 32 * MiB;
constexpr size_t WS_WQT = 32 * MiB + 576 * 1024, WS_WKT = 32 * MiB + 704 * 1024;
constexpr size_t WS_LW2T = 576 * 1024, WS_LA2T = 640 * 1024, WS_LG2T = 704 * 1024;
constexpr size_t WS_XN = 33 * MiB;
constexpr size_t WS_YM = 33 * MiB, WS_X2B = 33 * MiB;
constexpr size_t WS_YRM = 33 * MiB;
constexpr size_t WS_YMS = 255 * MiB + 512 * 1024;
constexpr size_t WS_PR = 66 * MiB;
constexpr size_t WS_PM = 123 * MiB;
constexpr size_t WS_PG = 172 * MiB;
constexpr size_t WS_YR = 237 * MiB;
constexpr size_t WS_MERGED = 66 * MiB;
constexpr size_t WS_UPSCR = 100 * MiB;
constexpr size_t WS_H = 66 * MiB;
constexpr size_t WS_NEED = 256 * MiB;
static_assert(WS_YR + (size_t)MT * 512 * 2 <= WS_NEED && WS_H + (size_t)MT * FF * 2 <= WS_NEED && WS_PG + (size_t)MT * NPG * 2 <= WS_YR && WS_UPSCR + (size_t)MT * DM * 4 <= WS_PG, "ws map");

#define GAS __attribute__((address_space(1)))
#define LAS __attribute__((address_space(3)))
typedef unsigned short bf16;
typedef unsigned v4u __attribute__((ext_vector_type(4)));
typedef unsigned v2u __attribute__((ext_vector_type(2)));
typedef float f32x4 __attribute__((ext_vector_type(4)));
typedef float f32x2 __attribute__((ext_vector_type(2)));
__device__ __forceinline__ unsigned f2bf(float f) { unsigned u = __builtin_bit_cast(unsigned, f); return (u + 0x7fffu + ((u >> 16) & 1u)) >> 16; }
__device__ __forceinline__ unsigned pk2(float lo, float hi) { return f2bf(lo) | (f2bf(hi) << 16); }
__device__ __forceinline__ float bf2f(unsigned b) { return __builtin_bit_cast(float, b << 16); }
__device__ __forceinline__ float bflo(unsigned w) { return __builtin_bit_cast(float, w << 16); }
__device__ __forceinline__ float bfhi(unsigned w) { return __builtin_bit_cast(float, w & 0xffff0000u); }
__device__ __forceinline__ float sigmoidf_(float x) { return __builtin_amdgcn_rcpf(1.0f + __expf(-x)); }
__device__ __forceinline__ float wave_sum(float v) {
#pragma unroll
    for (int o = 1; o < 64; o <<= 1) v += __shfl_xor(v, o);
    return v;
}

namespace pg8 {
#define PG8_LAS __attribute__((address_space(3)))
typedef unsigned short bf16_t;
typedef short bf16x8 __attribute__((ext_vector_type(8)));
typedef float f32x4 __attribute__((ext_vector_type(4)));
typedef unsigned u32x4 __attribute__((ext_vector_type(4)));
constexpr int BM = 256, BK = 64, HALF = 128, HTB = HALF * BK * 2  , STAGE_BYTES = 8 * HTB, NXCD = 8, WGM = 8;

__host__ __device__ __forceinline__ int lds_byte(int r, int c) { const int st = (r >> 4) * 2 + (c >> 5), rr = r & 15, cc = c & 31, ob = rr * 64 + cc * 2; return st * 1024 + (ob ^ (((ob >> 9) & 1) << 5)); }
__host__ __device__ __forceinline__ void stage_rc(int b, int& R, int& C) { const int st = b / 1024, sb = b % 1024, swz = sb ^ (((sb >> 9) & 1) << 5); R = (st >> 1) * 16 + swz / 64; C = (st & 1) * 32 + (swz % 64) / 2; }
__host__ __device__ __forceinline__ int perm32(int rho) { const int n = rho >> 4, i = rho & 15; return 8 * (i >> 2) + 4 * n + (i & 3); }

struct Unit { int pm, pn, z; };
struct Gemm { const bf16_t* A; const bf16_t* Bt; int M, N, K, lda, ldb, zoff; };

struct StaticOrder {
    int nM, nN, nwg, G, c;
    __host__ __device__ void init(int M, int N, int G_, int c_) { nM = M / BM; nN = N / BM; nwg = nM * nN; G = G_; c = c_; }
    __host__ __device__ bool next(int i, Unit& u) const {
        const long L = (long)i * G + c; if (L >= nwg) return false;
        int wgid = (int)L; { const int q = nwg / NXCD, r = nwg % NXCD, xcd = wgid % NXCD, off = wgid / NXCD; wgid = (xcd < r ? xcd * (q + 1) : r * (q + 1) + (xcd - r) * q) + off; }
        const int nig = WGM * nN, gid = wgid / nig, fm = gid * WGM, gsz = (nM - fm) < WGM ? (nM - fm) : WGM;
        u.pm = fm + ((wgid % nig) % gsz); u.pn = (wgid % nig) / gsz; u.z = 0; return true;
    }
    __device__ __forceinline__ void a_ready(const Unit&) const {}
    __device__ __forceinline__ void done(const Unit&) const {}
};

struct PairOrder : StaticOrder {
    __host__ __device__ bool next(int i, Unit& u) const { if (i >= 2) return false; const bool ok = StaticOrder::next(0, u); u.z = i; return ok; }
};
__device__ __forceinline__ unsigned cvt_pk_bf16(float lo, float hi) { unsigned r; asm volatile("v_cvt_pk_bf16_f32 %0, %1, %2" : "=v"(r) : "v"(lo), "v"(hi)); return r; }
typedef unsigned u32x2 __attribute__((ext_vector_type(2)));
__device__ __forceinline__ float sigm(float x) { return __builtin_amdgcn_rcpf(1.0f + __expf(-x)); }
__device__ __forceinline__ float bf_lo(unsigned w) { return __builtin_bit_cast(float, w << 16); }
__device__ __forceinline__ float bf_hi(unsigned w) { return __builtin_bit_cast(float, w & 0xffff0000u); }

struct EpiProj {
    static constexpr bool PERM = true, AFTER_DRAIN = false; static constexpr int MIDK = 0; static constexpr bool KEEP_ACC = false;
    bf16_t *PR, *PM, *PG; const float* gate_b; bf16_t* BND;
    __device__ __forceinline__ void operator()(const f32x4 (&acc)[2][2][4][2], const Unit& u, int wr, int wc, int fr, int fq) const {
        int colt = u.pn * BM; bf16_t* base; int ldc; bool gate = false;
        if (colt < 1792) { base = PR; ldc = 1792; } else if (colt < 3328) { base = PM; ldc = 1536; colt -= 1792; } else { base = PG; ldc = 2048; colt -= 3328; gate = true; }
        const int row0 = u.pm * BM + wr * 64 + fr, col0 = colt + wc * 32 + 8 * fq;
        f32x4 bv[2][2];
#pragma unroll
        for (int bj = 0; bj < 2; ++bj)
#pragma unroll
            for (int n = 0; n < 2; ++n) bv[bj][n] = gate ? *(const f32x4*)(gate_b + col0 + bj * HALF + 4 * n) : (f32x4){0.f, 0.f, 0.f, 0.f};
#pragma unroll
        for (int ai = 0; ai < 2; ++ai)
#pragma unroll
            for (int m = 0; m < 4; ++m) { bf16_t* rowp = base + (size_t)(row0 + ai * HALF + m * 16) * ldc + col0;
#pragma unroll
                for (int bj = 0; bj < 2; ++bj) { f32x4 v0 = acc[ai][bj][m][0] + bv[bj][0], v1 = acc[ai][bj][m][1] + bv[bj][1];
                    if (gate) {
#pragma unroll
                        for (int j = 0; j < 4; ++j) { v0[j] = sigm(v0[j]); v1[j] = sigm(v1[j]); } }
                    u32x4 w; w.x = cvt_pk_bf16(v0[0], v0[1]); w.y = cvt_pk_bf16(v0[2], v0[3]); w.z = cvt_pk_bf16(v1[0], v1[1]); w.w = cvt_pk_bf16(v1[2], v1[3]);
                    *(u32x4*)(rowp + bj * HALF) = w;
                    if (m == 3 && fr == 15 && base == PR && u.pm < 64) *(u32x4*)(BND + (size_t)((row0 + ai * HALF + m * 16) >> 6) * 1792 + col0 + bj * HALF) = w; } }
    }
};
struct EpiUp1 {
    static constexpr bool PERM = false, AFTER_DRAIN = false; static constexpr int MIDK = 0; static constexpr bool KEEP_ACC = false;
    float* SCR; const bf16_t* PG;
    __device__ __forceinline__ void operator()(const f32x4 (&acc)[2][2][4][2], const Unit& u, int wr, int wc, int fr, int fq) const {
        const int row0 = u.pm * BM + wr * 64 + fr, col0 = u.pn * BM + wc * 32 + 4 * fq;
#pragma unroll
        for (int ai = 0; ai < 2; ++ai) {
            if (u.pm * BM + ai * HALF >= 16512) continue;
#pragma unroll
            for (int m = 0; m < 4; ++m) { const size_t row = (size_t)(row0 + ai * HALF + m * 16);
#pragma unroll
                for (int bj = 0; bj < 2; ++bj)
#pragma unroll
                    for (int n = 0; n < 2; ++n) { const int c = col0 + bj * HALF + n * 16; const u32x2 g = *(const u32x2*)(PG + row * 2048 + c);
                        f32x4 v = acc[ai][bj][m][n]; v[0] *= bf_lo(g.x); v[1] *= bf_hi(g.x); v[2] *= bf_lo(g.y); v[3] *= bf_hi(g.y);
                        *(f32x4*)(SCR + row * 1024 + c) = v; } } }
    }
};
struct EpiUp2 {
    static constexpr bool PERM = false, AFTER_DRAIN = false; static constexpr int MIDK = 0; static constexpr bool KEEP_ACC = false;
    const float* SCR; const bf16_t* PG; bf16_t* MG;
    __device__ __forceinline__ void operator()(const f32x4 (&acc)[2][2][4][2], const Unit& u, int wr, int wc, int fr, int fq) const {
        const int row0 = u.pm * BM + wr * 64 + fr, col0 = u.pn * BM + wc * 32 + 4 * fq;
#pragma unroll
        for (int ai = 0; ai < 2; ++ai) {
            if (u.pm * BM + ai * HALF >= 16512) continue;
#pragma unroll
            for (int m = 0; m < 4; ++m) { const size_t row = (size_t)(row0 + ai * HALF + m * 16);
#pragma unroll
                for (int bj = 0; bj < 2; ++bj)
#pragma unroll
                    for (int n = 0; n < 2; ++n) { const int c = col0 + bj * HALF + n * 16; const u32x2 g = *(const u32x2*)(PG + row * 2048 + 1024 + c);
                        const f32x4 s = *(const f32x4*)(SCR + row * 1024 + c); f32x4 v = acc[ai][bj][m][n];
                        v[0] = s[0] + v[0] * bf_lo(g.x); v[1] = s[1] + v[1] * bf_hi(g.x); v[2] = s[2] + v[2] * bf_lo(g.y); v[3] = s[3] + v[3] * bf_hi(g.y);
                        u32x2 w; w.x = cvt_pk_bf16(v[0], v[1]); w.y = cvt_pk_bf16(v[2], v[3]); *(u32x2*)(MG + row * 1024 + c) = w; } } }
    }
};
struct EpiUpZ {
    static constexpr bool PERM = false, AFTER_DRAIN = false; static constexpr int MIDK = 0; static constexpr bool KEEP_ACC = true;
    const bf16_t* PG; bf16_t* MG;
    __device__ __forceinline__ void operator()(const f32x4 (&acc_)[2][2][4][2], const Unit& u, int wr, int wc, int fr, int fq) const {
        f32x4 (&acc)[2][2][4][2] = const_cast<f32x4 (&)[2][2][4][2]>(acc_);
        const int row0 = u.pm * BM + wr * 64 + fr, col0 = u.pn * BM + wc * 32 + 4 * fq;
#pragma unroll
        for (int ai = 0; ai < 2; ++ai)
#pragma unroll
            for (int m = 0; m < 4; ++m) { const size_t row = (size_t)(row0 + ai * HALF + m * 16);
#pragma unroll
                for (int bj = 0; bj < 2; ++bj)
#pragma unroll
                    for (int n = 0; n < 2; ++n) { const int c = col0 + bj * HALF + n * 16; const u32x2 gm = *(const u32x2*)(PG + row * 2048 + 1024 + c); f32x4& v = acc[ai][bj][m][n];
                        if (u.z == 0) { const u32x2 gr = *(const u32x2*)(PG + row * 2048 + c);
                            v[0] *= bf_lo(gr.x) * __builtin_amdgcn_rcpf(bf_lo(gm.x)); v[1] *= bf_hi(gr.x) * __builtin_amdgcn_rcpf(bf_hi(gm.x));
                            v[2] *= bf_lo(gr.y) * __builtin_amdgcn_rcpf(bf_lo(gm.y)); v[3] *= bf_hi(gr.y) * __builtin_amdgcn_rcpf(bf_hi(gm.y)); }
                        else { u32x2 w; w.x = cvt_pk_bf16(v[0] * bf_lo(gm.x), v[1] * bf_hi(gm.x)); w.y = cvt_pk_bf16(v[2] * bf_lo(gm.y), v[3] * bf_hi(gm.y)); *(u32x2*)(MG + row * 1024 + c) = w; } }
                asm volatile("" ::: "memory"); }
    }
};
struct EpiOut {
    static constexpr bool PERM = false, AFTER_DRAIN = false; static constexpr int MIDK = 0; static constexpr bool KEEP_ACC = false;
    const float *xp, *xs; float* OUT; bf16_t* X2B; const float* gffn; float* ssq;
    __device__ __forceinline__ void operator()(const f32x4 (&acc)[2][2][4][2], const Unit& u, int wr, int wc, int fr, int fq) const {
        const int row0 = u.pm * BM + wr * 64 + fr, col0 = u.pn * BM + wc * 32 + 4 * fq;
        f32x4 gv[2][2];
#pragma unroll
        for (int bj = 0; bj < 2; ++bj)
#pragma unroll
            for (int n = 0; n < 2; ++n) gv[bj][n] = *(const f32x4*)(gffn + col0 + bj * HALF + n * 16);
#pragma unroll
        for (int ai = 0; ai < 2; ++ai) {
            if (u.pm * BM + ai * HALF >= 16512) continue;
#pragma unroll
            for (int m = 0; m < 4; ++m) { const int row = row0 + ai * HALF + m * 16;
                const float* xin = row < 16384 ? xp + (size_t)row * 1024 : xs + (size_t)(row - 16384) * 1024; float sq = 0.f;
#pragma unroll
                for (int bj = 0; bj < 2; ++bj)
#pragma unroll
                    for (int n = 0; n < 2; ++n) { const int c = col0 + bj * HALF + n * 16; const f32x4 v = *(const f32x4*)(xin + c) + acc[ai][bj][m][n];
                        *(f32x4*)(OUT + (size_t)row * 1024 + c) = v; sq += (v[0] * v[0] + v[1] * v[1]) + (v[2] * v[2] + v[3] * v[3]);
                        const f32x4 h = v * gv[bj][n]; u32x2 w; w.x = cvt_pk_bf16(h[0], h[1]); w.y = cvt_pk_bf16(h[2], h[3]); *(u32x2*)(X2B + (size_t)row * 1024 + c) = w; }
                sq += __shfl_xor(sq, 16); sq += __shfl_xor(sq, 32);
                if (fq == 0) atomicAdd(ssq + row, sq); }
        }
    }
};
struct EpiFfn1 {
    static constexpr bool PERM = true, AFTER_DRAIN = false; static constexpr int MIDK = 0; static constexpr bool KEEP_ACC = false;
    bf16_t* H; const float* ssq;
    __device__ __forceinline__ void operator()(const f32x4 (&acc)[2][2][4][2], const Unit& u, int wr, int wc, int fr, int fq) const {
        const int row0 = u.pm * BM + wr * 64 + fr, col0 = u.pn * BM + wc * 32 + 8 * fq;
#pragma unroll
        for (int ai = 0; ai < 2; ++ai)
#pragma unroll
            for (int m = 0; m < 4; ++m) { const int row = row0 + ai * HALF + m * 16; const float rs = rsqrtf(ssq[row] * (1.0f / 1024.0f) + 1e-6f);
                bf16_t* rowp = H + (size_t)row * 4096 + col0;
#pragma unroll
                for (int bj = 0; bj < 2; ++bj) { f32x4 v0 = acc[ai][bj][m][0] * rs, v1 = acc[ai][bj][m][1] * rs;
#pragma unroll
                    for (int j = 0; j < 4; ++j) { const float a = fmaxf(v0[j], 0.f), b = fmaxf(v1[j], 0.f); v0[j] = a * a; v1[j] = b * b; }
                    u32x4 w; w.x = cvt_pk_bf16(v0[0], v0[1]); w.y = cvt_pk_bf16(v0[2], v0[3]); w.z = cvt_pk_bf16(v1[0], v1[1]); w.w = cvt_pk_bf16(v1[2], v1[3]);
                    *(u32x4*)(rowp + bj * HALF) = w; } }
    }
};
struct EpiFfn2 {
    static constexpr bool PERM = false, AFTER_DRAIN = false; static constexpr int MIDK = 0; static constexpr bool KEEP_ACC = false;
    float* OUT; float* ssq;
    __device__ __forceinline__ void operator()(const f32x4 (&acc)[2][2][4][2], const Unit& u, int wr, int wc, int fr, int fq) const {
        const int row0 = u.pm * BM + wr * 64 + fr, col0 = u.pn * BM + wc * 32 + 4 * fq;
#pragma unroll
        for (int ai = 0; ai < 2; ++ai) {
            if (u.pm * BM + ai * HALF >= 16512) continue;
#pragma unroll
            for (int m = 0; m < 4; ++m) { const int row = row0 + ai * HALF + m * 16; float sq = 0.f;
#pragma unroll
                for (int bj = 0; bj < 2; ++bj)
#pragma unroll
                    for (int n = 0; n < 2; ++n) { float* p = OUT + (size_t)row * 1024 + col0 + bj * HALF + n * 16; const f32x4 v = *(const f32x4*)p + acc[ai][bj][m][n];
                        *(f32x4*)p = v; }
                (void)sq; }
        }
    }
};

template <class Epi, class Sched, bool ALIGN_EPI = false, bool SP2 = false>
__device__ __forceinline__ void gemm_phase(PG8_LAS unsigned char* lds, const Gemm g, const Sched& S, const Epi& E) {
    int tid_ = threadIdx.x; asm volatile("" : "+v"(tid_));
    const int tid = tid_, wid = __builtin_amdgcn_readfirstlane(tid >> 6), lane = tid & 63, wr = wid >> 2, wc = wid & 3, fr = lane & 15, fq = lane >> 4;
    const int K = g.K, nt = K / BK;
    unsigned voffA[2], voffB[2];
#pragma unroll
    for (int i = 0; i < 2; ++i) { int R, C; stage_rc(tid * 16 + i * 8192, R, C); const int Rb = Epi::PERM ? ((R & ~31) + perm32(R & 31)) : R;
        voffA[i] = (unsigned)(R * g.lda + C) * 2u; voffB[i] = (unsigned)(Rb * g.ldb + C) * 2u; }
    const size_t kstep = (size_t)(BK * 2);
    const size_t hstep = (size_t)HALF * g.ldb * 2;
    const size_t tstep = 2 * hstep;
    const size_t hstepA = (size_t)HALF * g.lda * 2, tstepA = 2 * hstepA;
    const unsigned ldsw = (unsigned)wid * 1024u;
    const int aoff = lds_byte(wr * 64 + fr, fq * 8), boff = lds_byte(wc * 32 + fr, fq * 8);
#define PG8_SA(b, h) (((b) * 2 + (h)) * HTB)
#define PG8_SB(b, h) ((4 + (b) * 2 + (h)) * HTB)
#define PG8_STAGE(bufoff, gbase, voff) do { _Pragma("unroll") for (int _i = 0; _i < 2; ++_i) \
        __builtin_amdgcn_global_load_lds((const unsigned*)((const char*)(gbase) + (voff)[_i]), (PG8_LAS unsigned*)(lds + (bufoff) + ldsw + _i * 8192), 16, 0, 0); } while (0)
#define PG8_LDA(dst, b, h) do { _Pragma("unroll") for (int m = 0; m < 4; ++m) _Pragma("unroll") for (int k = 0; k < 2; ++k) dst[m][k] = *(const PG8_LAS bf16x8*)(lds + PG8_SA(b, h) + aoff + m * 2048 + k * 1024); } while (0)
#define PG8_LDB(dst, b, h) do { _Pragma("unroll") for (int n = 0; n < 2; ++n) _Pragma("unroll") for (int k = 0; k < 2; ++k) dst[n][k] = *(const PG8_LAS bf16x8*)(lds + PG8_SB(b, h) + boff + n * 2048 + k * 1024); } while (0)
#define PG8_MMA(ai, bj, At, Bt) do { __builtin_amdgcn_s_setprio(1); _Pragma("unroll") for (int m = 0; m < 4; ++m) _Pragma("unroll") for (int n = 0; n < 2; ++n) _Pragma("unroll") for (int k = 0; k < 2; ++k) \
        acc[ai][bj][m][n] = __builtin_amdgcn_mfma_f32_16x16x32_bf16(Bt[n][k], At[m][k], acc[ai][bj][m][n], 0, 0, 0); __builtin_amdgcn_s_setprio(0); } while (0)
#define PG8_WAIT_V(n) asm volatile("s_waitcnt vmcnt(" #n ")" ::: "memory")
#define PG8_WAIT_L(n) asm volatile("s_waitcnt lgkmcnt(" #n ")" ::: "memory")
#define PG8_BAR __builtin_amdgcn_s_barrier()
#define PG8_SCHED __builtin_amdgcn_sched_barrier(0)
    Unit cur, nxt; int ui = 0;
    if (!S.next(0, cur)) return;
    f32x4 acc[2][2][4][2];
#pragma unroll
    for (int a = 0; a < 2; ++a)
#pragma unroll
        for (int b = 0; b < 2; ++b)
#pragma unroll
            for (int m = 0; m < 4; ++m)
#pragma unroll
                for (int n = 0; n < 2; ++n) acc[a][b][m][n] = (f32x4){0.f, 0.f, 0.f, 0.f};
    bf16x8 At[4][2], B0[2][2], B1[2][2];
    const size_t zb = (size_t)g.zoff * 2;
    const char* cA = (const char*)g.A + (size_t)cur.pm * tstepA + cur.z * zb; const char* cB = (const char*)g.Bt + (size_t)cur.pn * tstep + cur.z * zb;
    S.a_ready(cur);
    if constexpr (SP2) {
        PG8_STAGE(PG8_SB(0, 0), cB, voffB); PG8_STAGE(PG8_SB(0, 1), cB + hstep, voffB); PG8_STAGE(PG8_SA(0, 0), cA, voffA); PG8_STAGE(PG8_SA(0, 1), cA + hstepA, voffA);
        if (wr == 1) PG8_BAR;
        PG8_WAIT_V(2); PG8_BAR;
        PG8_STAGE(PG8_SB(1, 0), cB + kstep, voffB); PG8_STAGE(PG8_SA(1, 0), cA + kstep, voffA); PG8_STAGE(PG8_SB(1, 1), cB + hstep + kstep, voffB);
        PG8_WAIT_V(6); PG8_BAR;
    } else {
        PG8_STAGE(PG8_SB(0, 0), cB, voffB); PG8_STAGE(PG8_SA(0, 0), cA, voffA); PG8_STAGE(PG8_SB(0, 1), cB + hstep, voffB); PG8_STAGE(PG8_SA(0, 1), cA + hstepA, voffA);
        if (wr == 1) PG8_BAR;
        PG8_WAIT_V(4); PG8_BAR;
        PG8_STAGE(PG8_SB(1, 0), cB + kstep, voffB); PG8_STAGE(PG8_SA(1, 0), cA + kstep, voffA); PG8_STAGE(PG8_SB(1, 1), cB + hstep + kstep, voffB);
        PG8_WAIT_V(6); PG8_BAR;
    }
    for (;;) {
        const bool has_next = S.next(ui + 1, nxt);
        const char* nA = has_next ? (const char*)g.A + (size_t)nxt.pm * tstepA + nxt.z * zb : cA; const char* nB = has_next ? (const char*)g.Bt + (size_t)nxt.pn * tstep + nxt.z * zb : cB;
        for (int t = 0; t < nt; t += 2) {
            const bool last = (t == nt - 2);
            const char* a1 = cA + (size_t)(t + 1) * kstep;
            const char* a2 = last ? nA : cA + (size_t)(t + 2) * kstep; const char* b2 = last ? nB : cB + (size_t)(t + 2) * kstep;
            const char* a3 = a2 + kstep; const char* b3 = b2 + kstep;
            if (last && has_next) S.a_ready(nxt);
            if constexpr (SP2) {
            PG8_LDB(B0, 0, 0); PG8_LDB(B1, 0, 1); PG8_SCHED; PG8_LDA(At, 0, 0); PG8_STAGE(PG8_SA(1, 1), a1 + hstepA, voffA);
            PG8_WAIT_V(8); PG8_WAIT_L(0); PG8_BAR; PG8_MMA(0, 0, At, B0); PG8_MMA(0, 1, At, B1); PG8_BAR; PG8_SCHED;
            PG8_LDA(At, 0, 1); PG8_STAGE(PG8_SB(0, 0), b2, voffB); PG8_STAGE(PG8_SB(0, 1), b2 + hstep, voffB); PG8_STAGE(PG8_SA(0, 0), a2, voffA);
            PG8_WAIT_V(8); PG8_WAIT_L(0); PG8_BAR; PG8_MMA(1, 0, At, B0); PG8_MMA(1, 1, At, B1); PG8_BAR; PG8_SCHED;
            PG8_LDB(B0, 1, 0); PG8_LDB(B1, 1, 1); PG8_SCHED; PG8_LDA(At, 1, 0); PG8_STAGE(PG8_SA(0, 1), a2 + hstepA, voffA);
            PG8_WAIT_V(8); PG8_WAIT_L(0); PG8_BAR; PG8_MMA(0, 0, At, B0); PG8_MMA(0, 1, At, B1); PG8_BAR; PG8_SCHED;
            PG8_LDA(At, 1, 1); PG8_STAGE(PG8_SB(1, 0), b3, voffB); PG8_STAGE(PG8_SB(1, 1), b3 + hstep, voffB); PG8_STAGE(PG8_SA(1, 0), a3, voffA);
            PG8_WAIT_V(8); PG8_WAIT_L(0); PG8_BAR; PG8_MMA(1, 0, At, B0); PG8_MMA(1, 1, At, B1); PG8_BAR; PG8_SCHED;
            } else {
            PG8_LDB(B0, 0, 0); PG8_SCHED; PG8_LDA(At, 0, 0); PG8_STAGE(PG8_SA(1, 1), a1 + hstepA, voffA);
            PG8_WAIT_L(8); PG8_BAR; PG8_WAIT_L(0); PG8_MMA(0, 0, At, B0); PG8_BAR; PG8_SCHED;
            PG8_LDB(B1, 0, 1); PG8_STAGE(PG8_SB(0, 0), b2, voffB);
            PG8_BAR; PG8_WAIT_L(0); PG8_MMA(0, 1, At, B1); PG8_BAR;
            PG8_LDA(At, 0, 1); PG8_STAGE(PG8_SA(0, 0), a2, voffA);
            PG8_BAR; PG8_WAIT_L(0); PG8_MMA(1, 0, At, B0); PG8_BAR; PG8_SCHED;
            PG8_STAGE(PG8_SB(0, 1), b2 + hstep, voffB);
            PG8_WAIT_V(6); PG8_BAR; PG8_MMA(1, 1, At, B1); PG8_BAR;
            PG8_LDB(B0, 1, 0); PG8_SCHED; PG8_LDA(At, 1, 0); PG8_STAGE(PG8_SA(0, 1), a2 + hstepA, voffA);
            PG8_WAIT_L(8); PG8_BAR; PG8_WAIT_L(0); PG8_MMA(0, 0, At, B0); PG8_BAR; PG8_SCHED;
            PG8_LDB(B1, 1, 1); PG8_STAGE(PG8_SB(1, 0), b3, voffB);
            PG8_BAR; PG8_WAIT_L(0); PG8_MMA(0, 1, At, B1); PG8_BAR;
            PG8_LDA(At, 1, 1); PG8_STAGE(PG8_SA(1, 0), a3, voffA);
            PG8_BAR; PG8_WAIT_L(0); PG8_MMA(1, 0, At, B0); PG8_BAR; PG8_SCHED;
            PG8_STAGE(PG8_SB(1, 1), b3 + hstep, voffB);
            PG8_WAIT_V(6); PG8_BAR; PG8_MMA(1, 1, At, B1); PG8_BAR;
            }
        }
        if constexpr (ALIGN_EPI) { if (wr == 0) PG8_BAR; }
        if constexpr (!Epi::AFTER_DRAIN) { E(acc, cur, wr, wc, fr, fq); S.done(cur); }
        if (!has_next) break;
        if (!(Epi::KEEP_ACC && nxt.z != 0))
#pragma unroll
        for (int a = 0; a < 2; ++a)
#pragma unroll
            for (int b = 0; b < 2; ++b)
#pragma unroll
                for (int m = 0; m < 4; ++m)
#pragma unroll
                    for (int n = 0; n < 2; ++n) acc[a][b][m][n] = (f32x4){0.f, 0.f, 0.f, 0.f};
        cur = nxt; cA = nA; cB = nB; ++ui;
        if constexpr (ALIGN_EPI) { if (wr == 1) PG8_BAR; }
    }
    PG8_WAIT_V(0);
    if constexpr (!ALIGN_EPI) { if (wr == 0) PG8_BAR; }
    PG8_BAR;
    if constexpr (Epi::AFTER_DRAIN) { E.fused(acc, cur, wr, wc, fr, fq, lds, wid, lane); S.done(cur); }
#undef PG8_SA
#undef PG8_SB
#undef PG8_STAGE
#undef PG8_LDA
#undef PG8_LDB
#undef PG8_MMA
#undef PG8_WAIT_V
#undef PG8_WAIT_L
#undef PG8_BAR
#undef PG8_SCHED
}
}

struct Args {
    const float* in[37];
    float* out; unsigned char* ws;
};
constexpr int NWAVES = 8, NTHR = 512;
constexpr int GEMM_LDS = 131072;

#define LDS_WAIT() asm volatile("s_waitcnt lgkmcnt(0)" ::: "memory")

__device__ __forceinline__ void transpose_item(const float* W, int ldw, int nblk, bf16* WT, int ldt, int item, LAS float* scr, int lane, float sc = 1.0f) {
    const int kb = item / nblk, nb = item % nblk, k0 = 64 * kb, n0 = 32 * nb;
#pragma unroll 8
    for (int i = 0; i < 32; ++i) { const int kk = 2 * i + (lane >> 5); scr[kk * 33 + (lane & 31)] = W[(size_t)(k0 + kk) * ldw + n0 + (lane & 31)]; }
    LDS_WAIT(); asm volatile("" ::: "memory");
    const int c = lane & 7;
#pragma unroll
    for (int j = 0; j < 4; ++j) { const int n = (lane >> 3) + 8 * j; const LAS float* s = scr + (8 * c) * 33 + n;
        v4u o; o.x = pk2(s[0 * 33] * sc, s[1 * 33] * sc); o.y = pk2(s[2 * 33] * sc, s[3 * 33] * sc); o.z = pk2(s[4 * 33] * sc, s[5 * 33] * sc); o.w = pk2(s[6 * 33] * sc, s[7 * 33] * sc);
        *(v4u*)(WT + (size_t)(n0 + n) * ldt + k0 + 8 * c) = o; }
    LDS_WAIT(); asm volatile("" ::: "memory");
}

__device__ __forceinline__ void ffn_weights_convert(const Args& a, int wi, int nw, LAS float* scr, int lane) {
    for (int it = wi; it < 4096; it += nw) {
        if (it < 2048) transpose_item(a.in[34], 4096, 128, (bf16*)(a.ws + WS_W1T), 1024, it, scr, lane);
        else transpose_item(a.in[35], 1024, 32, (bf16*)(a.ws + WS_W2T), 4096, it - 2048, scr, lane); }
}
constexpr int P0_LDS = 8 * 64 * 33 * 4 + 8 * 1024 * 4;
__device__ __forceinline__ void p0_prologue(const Args& a, LAS unsigned char* lds, int gw, int NGW, int lane, int wave) {
    unsigned char* ws = a.ws;
    LAS float* scr = (LAS float*)(lds) + wave * (64 * 33);
    LAS float* wg = (LAS float*)(lds + 8 * 64 * 33 * 4);
    const float* w_in = a.in[9];
    for (int i = threadIdx.x; i < 8 * 1024; i += NTHR) { const int k = i >> 3, c = i & 7; wg[c * 1024 + k] = w_in[(size_t)k * INCOLS + GCOL0 + c]; }
    { float* z = (float*)(ws + WS_CTL); for (int i = gw * 64 + lane; i < 65536; i += NGW * 64) z[i] = 0.f; }
    constexpr int I_IN1 = 16 * (3328 / 32), I_IN2 = 16 * (2048 / 32), I_UP = 8 * 32, I_OUT = 16 * 32, I_F1 = 16 * 128, I_F2 = 64 * 32;
    constexpr int I_QK = 8 * 8;
    constexpr int I_LW = 16, I_LG = 32;
    constexpr int NITEMS = I_IN1 + I_IN2 + 2 * I_UP + I_OUT + I_F1 + I_F2 + I_QK + 2 * I_LW + I_LG;
    for (int it = gw; it < NITEMS; it += NGW) {
        int r = it;
        if (r < I_IN1) { transpose_item(w_in, INCOLS, 3328 / 32, (bf16*)(ws + WS_WINT), 1024, r, scr, lane); continue; } r -= I_IN1;
        if (r < I_IN2) { transpose_item(w_in + 3336, INCOLS, 2048 / 32, (bf16*)(ws + WS_WINT) + (size_t)3328 * 1024, 1024, r, scr, lane); continue; } r -= I_IN2;
        if (r < I_UP) { transpose_item(a.in[21], 1024, 32, (bf16*)(ws + WS_UPRT), 1024, r, scr, lane); continue; } r -= I_UP;
        if (r < I_UP) { transpose_item(a.in[30], 1024, 32, (bf16*)(ws + WS_UPRT) + 512, 1024, r, scr, lane); continue; } r -= I_UP;
        if (r < I_OUT) { transpose_item(a.in[32], 1024, 32, (bf16*)(ws + WS_WOUTT), 1024, r, scr, lane); continue; } r -= I_OUT;
        if (r < I_F1 + I_F2) continue;
        r -= I_F1 + I_F2;
        if (r >= I_QK) { r -= I_QK;
            if (r < I_LW) { transpose_item(a.in[12], 512, 16, (bf16*)(ws + WS_LW2T), 64, r, scr, lane); continue; } r -= I_LW;
            if (r < I_LW) { transpose_item(a.in[14], 512, 16, (bf16*)(ws + WS_LA2T), 64, r, scr, lane); continue; } r -= I_LW;
            transpose_item(a.in[15], 512, 16, (bf16*)(ws + WS_LG2T), 128, r, scr, lane); continue; }
        { const int mat = r >> 3, hq = mat & 3, isk = mat >> 2;
          transpose_item((isk ? a.in[25] : a.in[24]) + (size_t)hq * 16384, 128, 4, (bf16*)(ws + (isk ? WS_WKT : WS_WQT)) + (size_t)hq * 16384, 128, r & 7, scr, lane, isk ? 1.0f : 0.08838834764831845f); }
    }
    __syncthreads();
    const float* gmix = a.in[8];
    f32x4 gv[4];
#pragma unroll
    for (int j = 0; j < 4; ++j) gv[j] = ((const f32x4*)gmix)[lane + 64 * j];
    bf16* XN = (bf16*)(ws + WS_XN); float* GATES = (float*)(ws + WS_GATES);
    for (int row = gw; row < MT; row += NGW) {
        unsigned long long* o8 = (unsigned long long*)(XN + (size_t)row * 1024) + lane;
        if (row >= MTOK) {
            const f32x4* xr = (const f32x4*)(a.in[2] + (size_t)(row - MTOK) * 1024) + lane;
#pragma unroll
            for (int j = 0; j < 4; ++j) { const f32x4 v = xr[64 * j]; o8[64 * j] = (unsigned long long)pk2(v.x, v.y) | ((unsigned long long)pk2(v.z, v.w) << 32); }
            continue;
        }
        const f32x4* xr = (const f32x4*)(row < MP ? a.in[0] + (size_t)row * 1024 : a.in[1] + (size_t)(row - MP) * 1024) + lane;
        f32x4 v[4]; float s = 0.f;
#pragma unroll
        for (int j = 0; j < 4; ++j) { v[j] = xr[64 * j]; s += (v[j].x * v[j].x + v[j].y * v[j].y) + (v[j].z * v[j].z + v[j].w * v[j].w); }
        const float rstd = rsqrtf(wave_sum(s) * (1.f / 1024.f) + RMS_EPS);
#pragma unroll
        for (int j = 0; j < 4; ++j) { v[j] = v[j] * rstd * gv[j]; o8[64 * j] = (unsigned long long)pk2(v[j].x, v[j].y) | ((unsigned long long)pk2(v[j].z, v[j].w) << 32); }
        float gsum[8];
#pragma unroll
        for (int c = 0; c < 8; ++c) { float p = 0.f;
#pragma unroll
            for (int j = 0; j < 4; ++j) { const f32x4 w = *(const LAS f32x4*)(wg + c * 1024 + 4 * (lane + 64 * j)); p += (v[j].x * w.x + v[j].y * w.y) + (v[j].z * w.z + v[j].w * w.w); }
            gsum[c] = wave_sum(p); }
        if (lane < 8) { float g = gsum[0];
#pragma unroll
            for (int c = 1; c < 8; ++c) g = (lane == c) ? gsum[c] : g;
            GATES[(size_t)row * 8 + lane] = g; }
        float* so = nullptr;
        if (row >= MP) so = a.out + O_SSHIFT + (size_t)(row - MP) * 1024;
        else if ((row & (SEQ - 1)) == SEQ - 1) so = a.out + O_PSHIFT + (size_t)(row >> 11) * 1024;
        if (so) {
#pragma unroll
            for (int j = 0; j < 4; ++j) ((f32x4*)so)[lane + 64 * j] = v[j]; }
    }
}

constexpr int RCH = 16;
constexpr int RWKV_LDS = (RCH * 256 + 8 * RCH * 64 + RCH) * 4;
__device__ __forceinline__ void rwkv_seq_item(const Args& a, LAS unsigned char* ldsb0, int item0) {
    const int tid = threadIdx.x & 255, lane = tid & 63, wv = tid >> 6; const int item = item0 + (threadIdx.x >> 8);
    LAS unsigned char* ldsb = ldsb0 + (threadIdx.x >> 8) * RWKV_LDS;
    const bf16* PR = (const bf16*)(a.ws + WS_PR); bf16* YR = (bf16*)(a.ws + WS_PR);
    const float *mu = a.in[10], *w0 = a.in[11], *w2 = a.in[12], *a0 = a.in[13], *a2 = a.in[14], *g2 = a.in[15], *rkk = a.in[16], *rka = a.in[17], *rrk = a.in[18], *gnw = a.in[19], *gnb = a.in[20];
    int T, row0, h, prevrow0; const float* S0 = nullptr; float* Sout;
    if (item < 64) { const int b = item >> 3; h = item & 7; T = SEQ; row0 = b * SEQ; prevrow0 = -1; Sout = a.out + O_PWKV + (size_t)item * 4096; }
    else { const int sb = (item - 64) >> 3; h = (item - 64) & 7; T = 1; row0 = MP + sb; prevrow0 = MTOK + sb; S0 = a.in[3] + (size_t)(item - 64) * 4096; Sout = a.out + O_SWKV + (size_t)(item - 64) * 4096; }
    const int hc = h * 64;
    LAS float* MIXW = (LAS float*)ldsb;
    LAS float* MIXA = MIXW + RCH * 64;
    LAS float* MIXG = MIXA + RCH * 64;
    LAS float* Rb = MIXG + RCH * 128;
    LAS float* Kb = Rb + RCH * 64;
    LAS float* Vb = Kb + RCH * 64;
    LAS float* Wb = Vb + RCH * 64;
    LAS float* KKb = Wb + RCH * 64;
    LAS float* Bb = KKb + RCH * 64;
    LAS float* Gb = Bb + RCH * 64;
    LAS float* Yb = Gb + RCH * 64;
    LAS float* BON = Yb + RCH * 64;
    const int sv = tid >> 2, kq = tid & 3;
    float S[16];
    if (S0) {
#pragma unroll
        for (int i = 0; i < 4; ++i) { const f32x4 t = *(const f32x4*)(S0 + sv * 64 + 16 * kq + 4 * i); S[4 * i] = t.x; S[4 * i + 1] = t.y; S[4 * i + 2] = t.z; S[4 * i + 3] = t.w; }
    } else {
#pragma unroll
        for (int i = 0; i < 16; ++i) S[i] = 0.f;
    }
    const int j = lane;
    const float w0j = w0[hc + j], a0j = a0[hc + j], rkkj = rkk[hc + j], rkaj = rka[hc + j], rrkj = rrk[hc + j], gnwj = gnw[hc + j], gnbj = gnb[hc + j];
    for (int t0 = 0; t0 < T; t0 += RCH) {
        const int nt = (T - t0) < RCH ? (T - t0) : RCH;
        for (int it = tid; it < nt * 56; it += 256) {
            const int t = it / 56, g = it % 56;
            int col; LAS float* dst; int kind;
            if (g < 8) { col = hc + 8 * g; dst = Rb + t * 64 + 8 * g; kind = 0; }
            else if (g < 16) { col = 512 + hc + 8 * (g - 8); dst = Kb + t * 64 + 8 * (g - 8); kind = 0; }
            else if (g < 24) { col = 1024 + hc + 8 * (g - 16); dst = Vb + t * 64 + 8 * (g - 16); kind = 0; }
            else if (g < 32) { col = 1536 + 8 * (g - 24); dst = MIXW + t * 64 + 8 * (g - 24); kind = 1; }
            else if (g < 40) { col = 1600 + 8 * (g - 32); dst = MIXA + t * 64 + 8 * (g - 32); kind = 0; }
            else { col = 1664 + 8 * (g - 40); dst = MIXG + t * 128 + 8 * (g - 40); kind = 2; }
            const int tg = t0 + t;
            const v4u cur = *(const v4u*)(PR + (size_t)(row0 + tg) * NPR + col);
            v4u prv = (v4u){0u, 0u, 0u, 0u};
            if (tg > 0) prv = *(const v4u*)(PR + (size_t)(row0 + tg - 1) * NPR + col);
            else if (prevrow0 >= 0) prv = *(const v4u*)(PR + (size_t)prevrow0 * NPR + col);
            const f32x4 m0 = *(const f32x4*)(mu + col), m1 = *(const f32x4*)(mu + col + 4);
            float c[8], p[8], mm[8] = {m0.x, m0.y, m0.z, m0.w, m1.x, m1.y, m1.z, m1.w};
            c[0] = bflo(cur.x); c[1] = bfhi(cur.x); c[2] = bflo(cur.y); c[3] = bfhi(cur.y); c[4] = bflo(cur.z); c[5] = bfhi(cur.z); c[6] = bflo(cur.w); c[7] = bfhi(cur.w);
            p[0] = bflo(prv.x); p[1] = bfhi(prv.x); p[2] = bflo(prv.y); p[3] = bfhi(prv.y); p[4] = bflo(prv.z); p[5] = bfhi(prv.z); p[6] = bflo(prv.w); p[7] = bfhi(prv.w);
#pragma unroll
            for (int i = 0; i < 8; ++i) { float m = c[i] + (p[i] - c[i]) * mm[i]; if (kind == 1) m = tanhf(m); else if (kind == 2) m = sigmoidf_(m); dst[i] = m; }
        }
        __syncthreads();
        float accw[RCH / 4], acca[RCH / 4], accg[RCH / 4];
#pragma unroll
        for (int i = 0; i < RCH / 4; ++i) { accw[i] = 0.f; acca[i] = 0.f; accg[i] = 0.f; }
        for (int i4 = 0; i4 < 16; ++i4) {
            float wv4[4], av4[4];
#pragma unroll
            for (int q = 0; q < 4; ++q) { wv4[q] = w2[(size_t)(4 * i4 + q) * 512 + hc + j]; av4[q] = a2[(size_t)(4 * i4 + q) * 512 + hc + j]; }
#pragma unroll
            for (int tt = 0; tt < RCH / 4; ++tt) { const int t = wv + 4 * tt; if (t < nt) {
                const f32x4 xw = *(const LAS f32x4*)(MIXW + t * 64 + 4 * i4), xa = *(const LAS f32x4*)(MIXA + t * 64 + 4 * i4);
                accw[tt] += (xw.x * wv4[0] + xw.y * wv4[1]) + (xw.z * wv4[2] + xw.w * wv4[3]);
                acca[tt] += (xa.x * av4[0] + xa.y * av4[1]) + (xa.z * av4[2] + xa.w * av4[3]); } }
        }
        for (int i4 = 0; i4 < 32; ++i4) {
            float gv4[4];
#pragma unroll
            for (int q = 0; q < 4; ++q) gv4[q] = g2[(size_t)(4 * i4 + q) * 512 + hc + j];
#pragma unroll
            for (int tt = 0; tt < RCH / 4; ++tt) { const int t = wv + 4 * tt; if (t < nt) {
                const f32x4 xg = *(const LAS f32x4*)(MIXG + t * 128 + 4 * i4);
                accg[tt] += (xg.x * gv4[0] + xg.y * gv4[1]) + (xg.z * gv4[2] + xg.w * gv4[3]); } }
        }
#pragma unroll
        for (int tt = 0; tt < RCH / 4; ++tt) { const int t = wv + 4 * tt; if (t < nt) {
            const float wl = w0j + accw[tt]; const float sg = 1.0f / (1.0f + expf(-wl));
            const float dec = expf(-0.6065306597126334f * sg);
            const float aa = 1.0f / (1.0f + expf(-(a0j + acca[tt])));
            const float kraw = Kb[t * 64 + j]; const float kkr = kraw * rkkj;
            const float ss = wave_sum(kkr * kkr); const float kk = kkr / fmaxf(sqrtf(ss), 1e-12f);
            const float k2 = kraw * (1.0f + (aa - 1.0f) * rkaj);
            const float bon = wave_sum(Rb[t * 64 + j] * k2 * rrkj);
            Wb[t * 64 + j] = dec; KKb[t * 64 + j] = kk; Bb[t * 64 + j] = kk * aa; Kb[t * 64 + j] = k2; Gb[t * 64 + j] = accg[tt];
            if (j == 0) BON[t] = bon; } }
        __syncthreads();
        for (int t = 0; t < nt; ++t) {
            float kk[16], p = 0.f;
#pragma unroll
            for (int i = 0; i < 4; ++i) { const f32x4 x = *(const LAS f32x4*)(KKb + t * 64 + 16 * kq + 4 * i); kk[4 * i] = x.x; kk[4 * i + 1] = x.y; kk[4 * i + 2] = x.z; kk[4 * i + 3] = x.w; }
#pragma unroll
            for (int i = 0; i < 16; ++i) p += S[i] * kk[i];
            p += __shfl_xor(p, 1); p += __shfl_xor(p, 2);
            const float vv = Vb[t * 64 + sv]; float y = 0.f;
#pragma unroll
            for (int i = 0; i < 4; ++i) {
                const f32x4 w = *(const LAS f32x4*)(Wb + t * 64 + 16 * kq + 4 * i), bb = *(const LAS f32x4*)(Bb + t * 64 + 16 * kq + 4 * i), k2 = *(const LAS f32x4*)(Kb + t * 64 + 16 * kq + 4 * i), r = *(const LAS f32x4*)(Rb + t * 64 + 16 * kq + 4 * i);
                S[4 * i + 0] = S[4 * i + 0] * w.x - p * bb.x + vv * k2.x; y += S[4 * i + 0] * r.x;
                S[4 * i + 1] = S[4 * i + 1] * w.y - p * bb.y + vv * k2.y; y += S[4 * i + 1] * r.y;
                S[4 * i + 2] = S[4 * i + 2] * w.z - p * bb.z + vv * k2.z; y += S[4 * i + 2] * r.z;
                S[4 * i + 3] = S[4 * i + 3] * w.w - p * bb.w + vv * k2.w; y += S[4 * i + 3] * r.w;
            }
            y += __shfl_xor(y, 1); y += __shfl_xor(y, 2);
            if (kq == 0) Yb[t * 64 + sv] = y;
        }
        __syncthreads();
#pragma unroll
        for (int tt = 0; tt < RCH / 4; ++tt) { const int t = wv + 4 * tt; if (t < nt) {
            const float y = Yb[t * 64 + j]; const float mean = wave_sum(y) * (1.0f / 64.0f); const float d = y - mean; const float var = wave_sum(d * d) * (1.0f / 64.0f);
            float o = d * rsqrtf(var + R_GN_EPS) * gnwj + gnbj; o += BON[t] * Vb[t * 64 + j]; o *= Gb[t * 64 + j];
            YR[(size_t)(row0 + t0 + t) * NPR + hc + j] = (bf16)f2bf(o); } }
        __syncthreads();
    }
#pragma unroll
    for (int i = 0; i < 4; ++i) *(f32x4*)(Sout + sv * 64 + 16 * kq + 4 * i) = (f32x4){S[4 * i], S[4 * i + 1], S[4 * i + 2], S[4 * i + 3]};
}

constexpr int MCH = 16;
constexpr int MLSTM_LDS = ((MCH + 3) * 128 + 5 * MCH * 128 + MCH * 4 * 128 + 8 * MCH) * 4;
__device__ __forceinline__ void mlstm_seq_item(const Args& a, LAS unsigned char* ldsb, int item) {
    const int tid = threadIdx.x, lane = tid & 63, wv = tid >> 6;
    const bf16* PM = (const bf16*)(a.ws + WS_PM); bf16* YM = item < 32 ? (bf16*)(a.ws + WS_YM) : (bf16*)(a.ws + WS_YMS) - (size_t)MP * 512; const float* GATES = (const float*)(a.ws + WS_GATES);
    const float *convw = a.in[22], *convb = a.in[23], *wq = a.in[24], *wk = a.in[25], *ib = a.in[26], *fb = a.in[27], *gnw = a.in[28], *skip = a.in[29];
    int T, row0, h, sb = -1; float *Cout, *nout, *mout, *convout;
    if (item < 32) { const int b = item >> 2; h = item & 3; T = SEQ; row0 = b * SEQ; Cout = a.out + O_PC + (size_t)item * 16384; nout = a.out + O_PN + (size_t)item * 128; mout = a.out + O_PMM + item; convout = a.out + O_PCONV + (size_t)b * 3 * 512 + h * 128; }
    else { const int it2 = item - 32; sb = it2 >> 2; h = it2 & 3; T = 1; row0 = MP + sb; Cout = a.out + O_SC + (size_t)it2 * 16384; nout = a.out + O_SN + (size_t)it2 * 128; mout = a.out + O_SMM + it2; convout = a.out + O_SCONV + (size_t)sb * 3 * 512 + h * 128; }
    const int hc = h * 128;
    LAS float* XMW = (LAS float*)ldsb;
    LAS float* XC = XMW + (MCH + 3) * 128;
    LAS float* Qb = XC + MCH * 128;
    LAS float* Kb = Qb + MCH * 128;
    LAS float* Vb = Kb + MCH * 128;
    LAS float* Ob = Vb + MCH * 128;
    LAS float* HP = Ob + MCH * 128;
    LAS float* FS = HP + MCH * 512;
    LAS float* IS = FS + MCH;
    LAS float* EM = IS + MCH;
    LAS float* DEN = EM + MCH;
    LAS float* MST = DEN + 2 * MCH;
    const int e = tid & 127, dq = tid >> 7;
    float C[32]; float nreg = 0.f;
    if (sb >= 0) {
        const float* C0 = a.in[4] + (size_t)(item - 32) * 16384;
#pragma unroll
        for (int i = 0; i < 32; ++i) C[i] = C0[(size_t)(32 * dq + i) * 128 + e];
        if (tid < 128) nreg = a.in[5][(size_t)(item - 32) * 128 + tid];
        if (tid == 0) MST[0] = a.in[6][item - 32];
        if (tid < 384) XMW[tid] = a.in[7][(size_t)sb * 3 * 512 + (tid >> 7) * 512 + hc + (tid & 127)];
    } else {
#pragma unroll
        for (int i = 0; i < 32; ++i) C[i] = 0.f;
        if (tid == 0) MST[0] = 0.f;
        if (tid < 384) XMW[tid] = 0.f;
    }
    const float cw0 = convw[0 * 512 + hc + e], cw1 = convw[1 * 512 + hc + e], cw2 = convw[2 * 512 + hc + e], cw3 = convw[3 * 512 + hc + e], cbe = convb[hc + e];
    const float ibh = ib[h], fbh = fb[h];
    __syncthreads();
    for (int t0 = 0; t0 < T; t0 += MCH) {
        const int nt = (T - t0) < MCH ? (T - t0) : MCH;
        for (int t = dq; t < nt; t += 4) { const size_t r = (size_t)(row0 + t0 + t) * NPM;
            XMW[(t + 3) * 128 + e] = bf2f(PM[r + hc + e]); Vb[t * 128 + e] = bf2f(PM[r + 512 + hc + e]); Ob[t * 128 + e] = sigmoidf_(bf2f(PM[r + 1024 + hc + e])); }
        __syncthreads();
        for (int t = dq; t < nt; t += 4) { const float x = cbe + XMW[t * 128 + e] * cw0 + XMW[(t + 1) * 128 + e] * cw1 + XMW[(t + 2) * 128 + e] * cw2 + XMW[(t + 3) * 128 + e] * cw3;
            XC[t * 128 + e] = x / (1.0f + expf(-x)); }
        if (tid == 0) { float m = MST[0];
            for (int t = 0; t < nt; ++t) { const float* g = GATES + (size_t)(row0 + t0 + t) * 8;
                const float li = g[h] + ibh, fr = g[4 + h] + fbh; const float lf = fminf(fr, 0.f) - log1pf(expf(-fabsf(fr)));
                const float mn = fmaxf(lf + m, li); FS[t] = expf(lf + m - mn); IS[t] = expf(li - mn); EM[t] = expf(-mn); m = mn; }
            MST[0] = m; }
        __syncthreads();
        { float aq[MCH / 4], ak[MCH / 4];
#pragma unroll
          for (int i = 0; i < MCH / 4; ++i) { aq[i] = 0.f; ak[i] = 0.f; }
          for (int d4 = 0; d4 < 32; ++d4) {
              float q4[4], k4[4];
#pragma unroll
              for (int q = 0; q < 4; ++q) { q4[q] = wq[(size_t)(hc + 4 * d4 + q) * 128 + e]; k4[q] = wk[(size_t)(hc + 4 * d4 + q) * 128 + e]; }
#pragma unroll
              for (int tt = 0; tt < MCH / 4; ++tt) { const int t = dq + 4 * tt; if (t < nt) { const f32x4 x = *(const LAS f32x4*)(XC + t * 128 + 4 * d4);
                  aq[tt] += (x.x * q4[0] + x.y * q4[1]) + (x.z * q4[2] + x.w * q4[3]); ak[tt] += (x.x * k4[0] + x.y * k4[1]) + (x.z * k4[2] + x.w * k4[3]); } }
          }
#pragma unroll
          for (int tt = 0; tt < MCH / 4; ++tt) { const int t = dq + 4 * tt; if (t < nt) { Qb[t * 128 + e] = aq[tt] * 0.08838834764831845f; Kb[t * 128 + e] = ak[tt]; } }
        }
        __syncthreads();
        for (int t = 0; t < nt; ++t) {
            const float fs = FS[t], is = IS[t]; const float ve = Vb[t * 128 + e] * is; float hp = 0.f;
#pragma unroll
            for (int i = 0; i < 8; ++i) { const f32x4 k = *(const LAS f32x4*)(Kb + t * 128 + 32 * dq + 4 * i), q = *(const LAS f32x4*)(Qb + t * 128 + 32 * dq + 4 * i);
                C[4 * i + 0] = fs * C[4 * i + 0] + k.x * ve; hp += q.x * C[4 * i + 0];
                C[4 * i + 1] = fs * C[4 * i + 1] + k.y * ve; hp += q.y * C[4 * i + 1];
                C[4 * i + 2] = fs * C[4 * i + 2] + k.z * ve; hp += q.z * C[4 * i + 2];
                C[4 * i + 3] = fs * C[4 * i + 3] + k.w * ve; hp += q.w * C[4 * i + 3]; }
            HP[t * 512 + dq * 128 + e] = hp;
            if (tid < 128) { nreg = fs * nreg + is * Kb[t * 128 + tid]; const float dn = wave_sum(Qb[t * 128 + tid] * nreg); if (lane == 0) DEN[t * 2 + wv] = dn; }
        }
        __syncthreads();
        for (int t = wv; t < nt; t += 8) {
            const float den = DEN[t * 2] + DEN[t * 2 + 1]; const float dd = fmaxf(fabsf(den), EM[t]);
            float hv[2];
#pragma unroll
            for (int q = 0; q < 2; ++q) { const int ee = lane + 64 * q; hv[q] = (HP[t * 512 + ee] + HP[t * 512 + 128 + ee] + HP[t * 512 + 256 + ee] + HP[t * 512 + 384 + ee]) / dd; }
            const float mean = wave_sum(hv[0] + hv[1]) * (1.0f / 128.0f); const float d0 = hv[0] - mean, d1 = hv[1] - mean;
            const float var = wave_sum(d0 * d0 + d1 * d1) * (1.0f / 128.0f); const float rs = rsqrtf(var + M_GN_EPS);
#pragma unroll
            for (int q = 0; q < 2; ++q) { const int ee = lane + 64 * q; float o = (q ? d1 : d0) * rs * gnw[hc + ee] + skip[hc + ee] * XC[t * 128 + ee]; o *= Ob[t * 128 + ee];
                YM[(size_t)(row0 + t0 + t) * 512 + hc + ee] = (bf16)f2bf(o); }
        }
        __syncthreads();
        float keep = 0.f; if (tid < 384) keep = XMW[(nt + (tid >> 7)) * 128 + (tid & 127)];
        __syncthreads();
        if (tid < 384) XMW[tid] = keep;
        __syncthreads();
    }
#pragma unroll
    for (int i = 0; i < 32; ++i) Cout[(size_t)(32 * dq + i) * 128 + e] = C[i];
    if (tid < 128) nout[tid] = nreg;
    if (tid == 0) mout[0] = MST[0];
    if (tid < 384) convout[(tid >> 7) * 512 + (tid & 127)] = XMW[tid];
}

__device__ __forceinline__ void final_norm_rows(const Args& a, int gw, int NGW, int lane) {
    const float* gf = a.in[36];
    f32x4 gv[4];
#pragma unroll
    for (int j = 0; j < 4; ++j) gv[j] = ((const f32x4*)gf)[lane + 64 * j];
    for (int row = gw; row < MTOK; row += NGW) { f32x4* p = (f32x4*)(a.out + (size_t)row * 1024) + lane; f32x4 v[4]; float s = 0.f;
#pragma unroll
        for (int j = 0; j < 4; ++j) { v[j] = p[64 * j]; s += (v[j].x * v[j].x + v[j].y * v[j].y) + (v[j].z * v[j].z + v[j].w * v[j].w); }
        const float rs = rsqrtf(wave_sum(s) * (1.0f / 1024.0f) + RMS_EPS);
#pragma unroll
        for (int j = 0; j < 4; ++j) p[64 * j] = v[j] * rs * gv[j]; }
}


typedef short bf16x8 __attribute__((ext_vector_type(8)));
typedef float f32x16 __attribute__((ext_vector_type(16)));
__device__ __forceinline__ int perm16(int x) { return (x & ~15) | (((x >> 2) & 1) << 3) | (((x >> 3) & 1) << 2) | (x & 3); }
constexpr size_t WS_KT = 49 * MiB + 512 * 1024;
constexpr size_t DO_CTP = 0;
constexpr size_t DO_VT = 40 * MiB;
constexpr size_t DO_UU = 60 * MiB, DO_BCUM = DO_UU + 256 * 1024, DO_PPFX = DO_BCUM + 256 * 1024;
constexpr size_t DO_BL = DO_PPFX + 256 * 1024, DO_PMX = DO_BL + 4096, DO_MPREV = DO_PMX + 4096;
static_assert(DO_MPREV + 4096 <= (size_t)MTOK * DM * 4, "d_out scratch");

typedef float f32x2_t __attribute__((ext_vector_type(2))); typedef __bf16 bf16x2_t __attribute__((ext_vector_type(2)));
__device__ __forceinline__ unsigned cvtpk(float lo, float hi) { f32x2_t v = {lo, hi}; bf16x2_t b = __builtin_convertvector(v, bf16x2_t); return __builtin_bit_cast(unsigned, b); }
__device__ __forceinline__ bf16x8 pack8(float a0, float a1, float a2, float a3, float a4, float a5, float a6, float a7) {
    v4u w; w.x = cvtpk(a0, a1); w.y = cvtpk(a2, a3); w.z = cvtpk(a4, a5); w.w = cvtpk(a6, a7); return __builtin_bit_cast(bf16x8, w); }
__device__ __forceinline__ bf16x8 acc_frag(const f32x16& x, int s2) { return s2 == 0 ? pack8(x[0], x[1], x[2], x[3], x[4], x[5], x[6], x[7]) : pack8(x[8], x[9], x[10], x[11], x[12], x[13], x[14], x[15]); }
__device__ __forceinline__ bf16x8 ld16(const bf16* p) { return __builtin_bit_cast(bf16x8, *(const v4u*)p); }
__device__ __forceinline__ bf16x8 ld8x2(const bf16* p0, const bf16* p1) { const v2u a = *(const v2u*)p0, b = *(const v2u*)p1; v4u w; w.x = a.x; w.y = a.y; w.z = b.x; w.w = b.y; return __builtin_bit_cast(bf16x8, w); }
#define MFMA32(a, b, c) __builtin_amdgcn_mfma_f32_32x32x16_bf16((a), (b), (c), 0, 0, 0)

__device__ __forceinline__ void stage_conv_head(const Args& a, LAS float* CW, int h, int tid, int nthr) {
    for (int i = tid; i < 640; i += nthr) CW[i] = i < 512 ? a.in[22][(size_t)(i >> 7) * 512 + h * 128 + (i & 127)] : a.in[23][h * 128 + (i - 512)];
}
__device__ __forceinline__ void xc8(const bf16* xmcol, int t, int d0, const LAS float* CW, float (&x)[8]) {
    const f32x4 b0 = *(const LAS f32x4*)(CW + 512 + d0), b1 = *(const LAS f32x4*)(CW + 512 + d0 + 4);
    x[0] = b0.x; x[1] = b0.y; x[2] = b0.z; x[3] = b0.w; x[4] = b1.x; x[5] = b1.y; x[6] = b1.z; x[7] = b1.w;
#pragma unroll
    for (int tap = 0; tap < 4; ++tap) { const int tt = t - 3 + tap;
        if (tt >= 0) { const v4u v = *(const v4u*)(xmcol + (size_t)tt * NPM + d0);
            const f32x4 w0 = *(const LAS f32x4*)(CW + tap * 128 + d0), w1 = *(const LAS f32x4*)(CW + tap * 128 + d0 + 4);
            x[0] += bflo(v.x) * w0.x; x[1] += bfhi(v.x) * w0.y; x[2] += bflo(v.y) * w0.z; x[3] += bfhi(v.y) * w0.w;
            x[4] += bflo(v.z) * w1.x; x[5] += bfhi(v.z) * w1.y; x[6] += bflo(v.w) * w1.z; x[7] += bfhi(v.w) * w1.w; } }
#pragma unroll
    for (int i = 0; i < 8; ++i) x[i] = x[i] * __builtin_amdgcn_rcpf(1.0f + __expf(-x[i]));
}
__device__ __forceinline__ bf16x8 xc_frag(const bf16* xmcol, int t, int d0, const LAS float* CW) { float x[8]; xc8(xmcol, t, d0, CW, x); return pack8(x[0], x[1], x[2], x[3], x[4], x[5], x[6], x[7]); }

constexpr int M1_XSTR = 272;
constexpr int M1_XM = 0, M1_XC = 67 * M1_XSTR + 208, M1_CW = M1_XC + 64 * M1_XSTR, M1_LDS = M1_CW + 2560;
static_assert(M1_XC % 16 == 0 && M1_CW % 16 == 0, "M1 LDS alignment");
__device__ __forceinline__ void mlstm_prep_stage(const Args& a, LAS unsigned char* L, int item, int tid) {
    const int bh = item >> 5, c = item & 31, b = bh >> 2, h = bh & 3, hc = h * 128, row0 = b * SEQ, t0 = c * 64;
    const bf16* PM = (const bf16*)(a.ws + WS_PM);
    stage_conv_head(a, (LAS float*)(L + M1_CW), h, tid, NTHR);
    for (int i = tid; i < 67 * 16; i += NTHR) { const int rw = i >> 4, ch = i & 15, tt = t0 - 3 + rw;
        *(LAS v4u*)(L + M1_XM + rw * M1_XSTR + ch * 16) = tt >= 0 ? *(const v4u*)(PM + (size_t)(row0 + tt) * NPM + hc + 8 * ch) : (v4u){0u, 0u, 0u, 0u}; }
}
__device__ __forceinline__ void mlstm_prep_xc(LAS unsigned char* L, int tid) {
    const int t = tid >> 3, d0 = (tid & 7) * 16; const LAS float* CW = (const LAS float*)(L + M1_CW);
#pragma unroll
    for (int hf = 0; hf < 2; ++hf) { const int d = d0 + 8 * hf;
        const f32x4 b0 = *(const LAS f32x4*)(CW + 512 + d), b1 = *(const LAS f32x4*)(CW + 512 + d + 4); float x[8] = {b0.x, b0.y, b0.z, b0.w, b1.x, b1.y, b1.z, b1.w};
#pragma unroll
        for (int tap = 0; tap < 4; ++tap) { const v4u v = *(const LAS v4u*)(L + M1_XM + (t + tap) * M1_XSTR + d * 2);
            const f32x4 w0 = *(const LAS f32x4*)(CW + tap * 128 + d), w1 = *(const LAS f32x4*)(CW + tap * 128 + d + 4);
            x[0] += bflo(v.x) * w0.x; x[1] += bfhi(v.x) * w0.y; x[2] += bflo(v.y) * w0.z; x[3] += bfhi(v.y) * w0.w; x[4] += bflo(v.z) * w1.x; x[5] += bfhi(v.z) * w1.y; x[6] += bflo(v.w) * w1.z; x[7] += bfhi(v.w) * w1.w; }
#pragma unroll
        for (int i = 0; i < 8; ++i) x[i] = x[i] * __builtin_amdgcn_rcpf(1.0f + __expf(-x[i]));
        *(LAS bf16x8*)(L + M1_XC + t * M1_XSTR + d * 2) = pack8(x[0], x[1], x[2], x[3], x[4], x[5], x[6], x[7]); }
}
__device__ __forceinline__ void mlstm_prep_task(const Args& a, int item, int blk, const LAS unsigned char* L, int lane_) {
    int lane = lane_; asm volatile("" : "+v"(lane));
    const int r = lane & 31, hh = lane >> 5, bh = item >> 5, c = item & 31, b = bh >> 2, h = bh & 3, hc = h * 128, row0 = b * SEQ, t0 = c * 64, db = blk & 3, sb = blk >> 2;
    const bf16* PM = (const bf16*)(a.ws + WS_PM); const bf16* xmcol = PM + (size_t)row0 * NPM + hc;
    const bf16* WKT = (const bf16*)(a.ws + WS_WKT) + (size_t)h * 16384;
    bf16* KT = (bf16*)(a.ws + WS_KT) + (size_t)item * 8192; bf16* VT = (bf16*)((unsigned char*)a.out + DO_VT) + (size_t)item * 10240;
    f32x16 acc;
#pragma unroll
    for (int i = 0; i < 16; ++i) acc[i] = 0.f;
#pragma unroll
    for (int ks = 0; ks < 8; ++ks) acc = MFMA32(ld16(WKT + (size_t)(32 * db + r) * 128 + 16 * ks + 8 * hh), *(const LAS bf16x8*)(L + M1_XC + (32 * sb + r) * M1_XSTR + (16 * ks + 8 * hh) * 2), acc);
#pragma unroll
    for (int reg = 0; reg < 16; reg += 2) { const unsigned w = cvtpk(acc[reg], acc[reg + 1]); bf16* kp = KT + (size_t)(32 * db + 4 * hh) * 64 + perm16(32 * sb + r);
        kp[((reg & 3) + 8 * (reg >> 2)) * 64] = (bf16)(w & 0xffffu); kp[(((reg + 1) & 3) + 8 * ((reg + 1) >> 2)) * 64] = (bf16)(w >> 16); }
    { const bf16* vp = PM + (size_t)(row0 + t0 + 32 * sb + r) * NPM + 512 + hc + 32 * db + 16 * hh; const v4u v0 = *(const v4u*)vp, v1 = *(const v4u*)(vp + 8);
      const unsigned w[8] = {v0.x, v0.y, v0.z, v0.w, v1.x, v1.y, v1.z, v1.w}; bf16* o = VT + (size_t)(32 * db + 16 * hh) * 64 + perm16(32 * sb + r);
#pragma unroll
      for (int i = 0; i < 8; ++i) { o[(size_t)(2 * i) * 64] = (bf16)(w[i] & 0xffffu); o[(size_t)(2 * i + 1) * 64] = (bf16)(w[i] >> 16); } }
#pragma unroll
    for (int i = 0; i < 4; ++i) VT[(size_t)(128 + 4 * blk + i) * 64 + lane] = (blk == 0 && i == 0) ? (bf16)0x3f80u : (bf16)0u;
    if (blk == 1 && c == 31) {
        float* co = a.out + O_PCONV + (size_t)b * 3 * 512 + hc;
        for (int i = lane; i < 384; i += 64) co[(i >> 7) * 512 + (i & 127)] = bf2f(xmcol[(size_t)(SEQ - 3 + (i >> 7)) * NPM + (i & 127)]);
    }
    if (blk == 0) {
        const float* g = (const float*)(a.ws + WS_GATES) + (size_t)(row0 + t0 + lane) * 8;
        const float li = g[h] + a.in[26][h], fr = g[4 + h] + a.in[27][h]; const float lf = fminf(fr, 0.f) - log1pf(expf(-fabsf(fr)));
        float bc = lf;
#pragma unroll
        for (int o = 1; o < 64; o <<= 1) { const float t = __shfl_up(bc, o); if (lane >= o) bc += t; }
        const float u = li - bc; float p = u;
#pragma unroll
        for (int o = 1; o < 64; o <<= 1) { const float t = __shfl_up(p, o); if (lane >= o) p = fmaxf(p, t); }
        float* dof = (float*)a.out; const size_t ti = (size_t)bh * 2048 + t0 + lane;
        dof[DO_UU / 4 + ti] = u; dof[DO_BCUM / 4 + ti] = bc; dof[DO_PPFX / 4 + ti] = p;
        if (lane == 63) { dof[DO_BL / 4 + item] = bc; dof[DO_PMX / 4 + item] = p; }
    }
}

__device__ __forceinline__ void mlstm_scan_task(const Args& a, int bh, int eb, int dh, LAS float* WE, int lane) {
    const int r = lane & 31, hh = lane >> 5;
    const float* dof = (const float*)a.out;
    f32x16 CT[2];
#pragma unroll
    for (int cb = 0; cb < 2; ++cb)
#pragma unroll
        for (int i = 0; i < 16; ++i) CT[cb][i] = 0.f;
    float m = 0.f;
    const bf16* KT0 = (const bf16*)(a.ws + WS_KT) + (size_t)bh * 32 * 8192 + (size_t)(64 * dh + r) * 64 + 8 * hh;
    const bf16* VT0 = (const bf16*)((const unsigned char*)a.out + DO_VT) + (size_t)bh * 32 * 10240 + (size_t)(32 * eb + r) * 64 + 8 * hh;
    bf16* CTP0 = (bf16*)((unsigned char*)a.out + DO_CTP) + (size_t)bh * 32 * 20480 + (size_t)(32 * eb + 4 * hh) * 128 + 64 * dh + perm16(r);
    v4u Ar[4], Bf[4][2];
#pragma unroll
    for (int ks = 0; ks < 4; ++ks) { Ar[ks] = *(const v4u*)(VT0 + 16 * ks);
#pragma unroll
        for (int cb = 0; cb < 2; ++cb) Bf[ks][cb] = *(const v4u*)(KT0 + (size_t)(32 * cb) * 64 + 16 * ks); }
    float u = dof[DO_UU / 4 + (size_t)bh * 2048 + lane], pmx = dof[DO_PMX / 4 + bh * 32], bl = dof[DO_BL / 4 + bh * 32];
    for (int c = 0; c < 32; ++c) {
        const int item = bh * 32 + c;
        const float Mx = fmaxf(m, pmx); const float ge = __expf(m - Mx);
        WE[perm16(lane)] = __expf(u - Mx);
        const float mnext = bl + Mx;
        if (c + 1 < 32) { u = dof[DO_UU / 4 + (size_t)bh * 2048 + 64 * (c + 1) + lane]; pmx = dof[DO_PMX / 4 + item + 1]; bl = dof[DO_BL / 4 + item + 1]; }
        bf16* CTP = CTP0 + (size_t)c * 20480;
#pragma unroll
        for (int cb = 0; cb < 2; ++cb)
#pragma unroll
            for (int reg = 0; reg < 16; reg += 2) { const unsigned w = cvtpk(CT[cb][reg], CT[cb][reg + 1]);
                CTP[((reg & 3) + 8 * (reg >> 2)) * 128 + 32 * cb] = (bf16)(w & 0xffffu); CTP[(((reg + 1) & 3) + 8 * ((reg + 1) >> 2)) * 128 + 32 * cb] = (bf16)(w >> 16);
                CT[cb][reg] *= ge; CT[cb][reg + 1] *= ge; }
        if (eb == 0 && dh == 0 && lane == 0) ((float*)a.out)[DO_MPREV / 4 + item] = m;
        LDS_WAIT(); asm volatile("" ::: "memory");
        const size_t nx = (c + 1 < 32) ? (size_t)(c + 1) : (size_t)c;
#pragma unroll
        for (int ks = 0; ks < 4; ++ks) {
            const v4u av = Ar[ks];
            const f32x4 w0 = *(const LAS f32x4*)(WE + 16 * ks + 8 * hh), w1 = *(const LAS f32x4*)(WE + 16 * ks + 8 * hh + 4);
            const bf16x8 A = pack8(bflo(av.x) * w0.x, bfhi(av.x) * w0.y, bflo(av.y) * w0.z, bfhi(av.y) * w0.w, bflo(av.z) * w1.x, bfhi(av.z) * w1.y, bflo(av.w) * w1.z, bfhi(av.w) * w1.w);
#pragma unroll
            for (int cb = 0; cb < 2; ++cb) CT[cb] = MFMA32(A, __builtin_bit_cast(bf16x8, Bf[ks][cb]), CT[cb]);
            Ar[ks] = *(const v4u*)(VT0 + nx * 10240 + 16 * ks);
#pragma unroll
            for (int cb = 0; cb < 2; ++cb) Bf[ks][cb] = *(const v4u*)(KT0 + nx * 8192 + (size_t)(32 * cb) * 64 + 16 * ks);
        }
        m = mnext;
        LDS_WAIT(); asm volatile("" ::: "memory");
    }
    if (eb < 4) { float* Co = a.out + O_PC + (size_t)bh * 16384 + (size_t)(64 * dh) * 128;
#pragma unroll
        for (int cb = 0; cb < 2; ++cb)
#pragma unroll
            for (int reg = 0; reg < 16; ++reg) Co[(size_t)(32 * cb + r) * 128 + 32 * eb + (reg & 3) + 8 * (reg >> 2) + 4 * hh] = CT[cb][reg];
    } else if (hh == 0) {
#pragma unroll
        for (int cb = 0; cb < 2; ++cb) a.out[O_PN + (size_t)bh * 128 + 64 * dh + 32 * cb + r] = CT[cb][0];
    }
    if (eb == 0 && dh == 0 && lane == 0) a.out[O_PMM + bh] = m;
}

constexpr int M3_WSTR = 272;
constexpr int M3_XMT = 18432;
constexpr int M3_WQ = 0, M3_WK = 128 * M3_WSTR, M3_CW = 2 * 128 * M3_WSTR, M3_GN = M3_CW + 2560, M3_SK = M3_GN + 512, M3_XM = M3_SK + 512, M3_LDS = M3_XM + 4 * M3_XMT;
static_assert(M3_LDS <= 159744 && M3_XM % 16 == 0, "M3 LDS");
__device__ __forceinline__ void mlstm_out_stage(const Args& a, LAS unsigned char* L, int h, int tid) {
    const bf16* WQT = (const bf16*)(a.ws + WS_WQT) + (size_t)h * 16384; const bf16* WKT = (const bf16*)(a.ws + WS_WKT) + (size_t)h * 16384;
    for (int i = tid; i < 2048; i += NTHR) { const int row = i >> 4, ch = i & 15;
        *(LAS v4u*)(L + M3_WQ + row * M3_WSTR + ch * 16) = *(const v4u*)(WQT + row * 128 + ch * 8);
        *(LAS v4u*)(L + M3_WK + row * M3_WSTR + ch * 16) = *(const v4u*)(WKT + row * 128 + ch * 8); }
    stage_conv_head(a, (LAS float*)(L + M3_CW), h, tid, NTHR);
    for (int i = tid; i < 128; i += NTHR) { ((LAS float*)(L + M3_GN))[i] = a.in[28][h * 128 + i]; ((LAS float*)(L + M3_SK))[i] = a.in[29][h * 128 + i]; }
}
__device__ __forceinline__ void mlstm_out_stage_xm(const Args& a, LAS unsigned char* L, int h, int tq0, int tid) {
    const bf16* PM = (const bf16*)(a.ws + WS_PM);
    for (int id = tid; id < 4 * 67 * 16; id += NTHR) { const int ti = id / (67 * 16), rem = id - ti * (67 * 16), rw = rem >> 4, ch = rem & 15;
        const int tq = tq0 + 2 * ti, b = tq >> 6, c = (tq >> 1) & 31, tt = 64 * c - 3 + rw;
        *(LAS v4u*)(L + M3_XM + ti * M3_XMT + rw * M1_XSTR + ch * 16) = tt >= 0 ? *(const v4u*)(PM + (size_t)(b * SEQ + tt) * NPM + h * 128 + 8 * ch) : (v4u){0u, 0u, 0u, 0u}; }
}
__device__ __forceinline__ bf16x8 xc_frag_lds(const LAS unsigned char* XM, int tloc, int d0, const LAS float* CW) {
    const f32x4 b0 = *(const LAS f32x4*)(CW + 512 + d0), b1 = *(const LAS f32x4*)(CW + 512 + d0 + 4); float x[8] = {b0.x, b0.y, b0.z, b0.w, b1.x, b1.y, b1.z, b1.w};
#pragma unroll
    for (int tap = 0; tap < 4; ++tap) { const v4u v = *(const LAS v4u*)(XM + (tloc + tap) * M1_XSTR + d0 * 2);
        const f32x4 w0 = *(const LAS f32x4*)(CW + tap * 128 + d0), w1 = *(const LAS f32x4*)(CW + tap * 128 + d0 + 4);
        x[0] += bflo(v.x) * w0.x; x[1] += bfhi(v.x) * w0.y; x[2] += bflo(v.y) * w0.z; x[3] += bfhi(v.y) * w0.w; x[4] += bflo(v.z) * w1.x; x[5] += bfhi(v.z) * w1.y; x[6] += bflo(v.w) * w1.z; x[7] += bfhi(v.w) * w1.w; }
#pragma unroll
    for (int i = 0; i < 8; ++i) x[i] = x[i] * __builtin_amdgcn_rcpf(1.0f + __expf(-x[i]));
    return pack8(x[0], x[1], x[2], x[3], x[4], x[5], x[6], x[7]);
}
__device__ __forceinline__ bf16x8 m3_wfrag(const LAS unsigned char* W, int row, int k0) { return *(const LAS bf16x8*)(W + row * M3_WSTR + k0 * 2); }
__device__ __forceinline__ void mlstm_st_tile(int sb, int tb, const bf16x8 (&XB)[8], const bf16x8 (&QTb)[4][2], const LAS unsigned char* WK, const LAS unsigned char* XM, const LAS float* CW, const float* uu, int t0, int tl, float Mt, int r, int hh, bf16x8& o0, bf16x8& o1) {
    f32x16 st;
#pragma unroll
    for (int i = 0; i < 16; ++i) st[i] = 0.f;
    bf16x8 XS[8];
#pragma unroll
    for (int ks = 0; ks < 8; ++ks) XS[ks] = (sb == tb) ? XB[ks] : xc_frag_lds(XM, 32 * sb + r, 16 * ks + 8 * hh, CW);
#pragma unroll
    for (int db = 0; db < 4; ++db) { f32x16 k;
#pragma unroll
        for (int i = 0; i < 16; ++i) k[i] = 0.f;
#pragma unroll
        for (int ks = 0; ks < 8; ++ks) k = MFMA32(m3_wfrag(WK, 32 * db + r, 16 * ks + 8 * hh), XS[ks], k);
        st = MFMA32(acc_frag(k, 0), QTb[db][0], st); st = MFMA32(acc_frag(k, 1), QTb[db][1], st); __builtin_amdgcn_sched_barrier(0); }
#pragma unroll
    for (int g = 0; g < 4; ++g) { const f32x4 u4 = *(const f32x4*)(uu + 32 * sb + 8 * g + 4 * hh);
#pragma unroll
        for (int i = 0; i < 4; ++i) { const int sidx = 32 * sb + 8 * g + 4 * hh + i; st[4 * g + i] = (sidx <= tl) ? st[4 * g + i] * __expf(u4[i] - Mt) : 0.f; } }
    o0 = acc_frag(st, 0); o1 = acc_frag(st, 1);
}

__device__ __forceinline__ void mlstm_out_task(const Args& a, int item, int tb, LAS unsigned char* L, int wave, int lane_) {
    int lane = lane_; asm volatile("" : "+v"(lane));
    LAS unsigned char* XM = L + M3_XM + (wave >> 1) * M3_XMT;
    const int r = lane & 31, hh = lane >> 5, bh = item >> 5, c = item & 31, b = bh >> 2, h = bh & 3, hc = h * 128, row0 = b * SEQ, t0 = c * 64;
    const bf16* PM = (const bf16*)(a.ws + WS_PM); const bf16* xmcol = PM + (size_t)row0 * NPM + hc; const LAS float* CW = (const LAS float*)(L + M3_CW);
    const LAS unsigned char* WQ = L + M3_WQ; const LAS unsigned char* WK = L + M3_WK;
    const bf16* VT = (const bf16*)((const unsigned char*)a.out + DO_VT) + (size_t)item * 10240; const bf16* CTP = (const bf16*)((const unsigned char*)a.out + DO_CTP) + (size_t)item * 20480;
    const float* dof = (const float*)a.out;
    const int tl = 32 * tb + r, t = t0 + tl;
    bf16x8 XB[8];
#pragma unroll
    for (int ks = 0; ks < 8; ++ks) { XB[ks] = xc_frag_lds(XM, tl, 16 * ks + 8 * hh, CW); if (ks & 1) __builtin_amdgcn_sched_barrier(0); }
    bf16x8 QTb[4][2];
#pragma unroll
    for (int eb = 0; eb < 4; ++eb) { f32x16 q;
#pragma unroll
        for (int i = 0; i < 16; ++i) q[i] = 0.f;
#pragma unroll
        for (int ks = 0; ks < 8; ++ks) q = MFMA32(m3_wfrag(WQ, 32 * eb + r, 16 * ks + 8 * hh), XB[ks], q);
        QTb[eb][0] = acc_frag(q, 0); QTb[eb][1] = acc_frag(q, 1); __builtin_amdgcn_sched_barrier(0); }
    const float mprev = dof[DO_MPREV / 4 + item], pp = dof[DO_PPFX / 4 + (size_t)bh * 2048 + t], bc = dof[DO_BCUM / 4 + (size_t)bh * 2048 + t];
    const float Mt = fmaxf(mprev, pp), wst = expf(mprev - Mt), em = expf(-bc - Mt);
    bf16x8 STb[2][2];
    mlstm_st_tile(0, tb, XB, QTb, WK, XM, CW, dof + DO_UU / 4 + (size_t)bh * 2048 + t0, t0, tl, Mt, r, hh, STb[0][0], STb[0][1]);
    if (tb == 1) mlstm_st_tile(1, tb, XB, QTb, WK, XM, CW, dof + DO_UU / 4 + (size_t)bh * 2048 + t0, t0, tl, Mt, r, hh, STb[1][0], STb[1][1]);
    else { STb[1][0] = (bf16x8){0, 0, 0, 0, 0, 0, 0, 0}; STb[1][1] = STb[1][0]; }
    __syncthreads();
    LAS unsigned char* xbp = XM + (wave & 1) * 8192 + lane * 16;
#pragma unroll
    for (int ks = 0; ks < 8; ++ks) *(LAS bf16x8*)(xbp + ks * 1024) = XB[ks];
    __builtin_amdgcn_sched_barrier(0);
    auto num_block = [&](int eb, f32x16& nt) {
#pragma unroll
        for (int i = 0; i < 16; ++i) nt[i] = 0.f;
        const bf16* crow = CTP + (size_t)(32 * eb + r) * 128 + 8 * hh;
#pragma unroll
        for (int rb = 0; rb < 4; ++rb) {
#pragma unroll
            for (int s2 = 0; s2 < 2; ++s2) nt = MFMA32(ld16(crow + 32 * rb + 16 * s2), QTb[rb][s2], nt);
            if (rb == 1) __builtin_amdgcn_sched_barrier(0); }
#pragma unroll
        for (int i = 0; i < 16; ++i) nt[i] *= wst;
        __builtin_amdgcn_sched_barrier(0);
        const bf16* vrow = VT + (size_t)(32 * eb + r) * 64 + 8 * hh;
#pragma unroll
        for (int s2 = 0; s2 < 2; ++s2) nt = MFMA32(ld16(vrow + 16 * s2), STb[0][s2], nt);
        if (tb == 1) {
#pragma unroll
            for (int s2 = 0; s2 < 2; ++s2) nt = MFMA32(ld16(vrow + 32 + 16 * s2), STb[1][s2], nt); }
        __builtin_amdgcn_sched_barrier(0);
    };
    float inv;
    { f32x16 nd; num_block(4, nd); const float den = __shfl(nd[0], r); inv = 1.0f / fmaxf(fabsf(den), em); }
    f32x16 NT[4];
#pragma unroll
    for (int eb = 0; eb < 4; ++eb) num_block(eb, NT[eb]);
    float s1 = 0.f;
#pragma unroll
    for (int eb = 0; eb < 4; ++eb)
#pragma unroll
        for (int i = 0; i < 16; ++i) { NT[eb][i] *= inv; s1 += NT[eb][i]; }
    s1 += __shfl_xor(s1, 32); const float mean = s1 * (1.0f / 128.0f); float s2v = 0.f;
#pragma unroll
    for (int eb = 0; eb < 4; ++eb)
#pragma unroll
        for (int i = 0; i < 16; ++i) { const float d = NT[eb][i] - mean; s2v += d * d; }
    s2v += __shfl_xor(s2v, 32); const float rs = rsqrtf(s2v * (1.0f / 128.0f) + M_GN_EPS);
    bf16* YM = (bf16*)(a.ws + WS_YRM) + (size_t)(row0 + t) * 1024 + 512 + hc; const bf16* orow = PM + (size_t)(row0 + t) * NPM + 1024 + hc;
    const LAS float* gnw = (const LAS float*)(L + M3_GN); const LAS float* skp = (const LAS float*)(L + M3_SK);
    bf16x8 idf[2];
#pragma unroll
    for (int ksl = 0; ksl < 2; ++ksl) { v4u id; const int kb0 = 16 * ksl + 8 * hh;
        id.x = (r == kb0 ? 0x3f80u : 0u) | (r == kb0 + 1 ? 0x3f800000u : 0u); id.y = (r == kb0 + 2 ? 0x3f80u : 0u) | (r == kb0 + 3 ? 0x3f800000u : 0u);
        id.z = (r == kb0 + 4 ? 0x3f80u : 0u) | (r == kb0 + 5 ? 0x3f800000u : 0u); id.w = (r == kb0 + 6 ? 0x3f80u : 0u) | (r == kb0 + 7 ? 0x3f800000u : 0u);
        idf[ksl] = __builtin_bit_cast(bf16x8, id); }
#pragma unroll
    for (int eb = 0; eb < 4; ++eb) { f32x16 xt;
#pragma unroll
        for (int i = 0; i < 16; ++i) xt[i] = 0.f;
        xt = MFMA32(idf[0], *(const LAS bf16x8*)(xbp + (2 * eb) * 1024), xt); xt = MFMA32(idf[1], *(const LAS bf16x8*)(xbp + (2 * eb + 1) * 1024), xt);
#pragma unroll
        for (int g = 0; g < 4; ++g) { const int e0 = 32 * eb + 8 * g + 4 * hh;
            const v2u ov = *(const v2u*)(orow + e0); const float og[4] = {bflo(ov.x), bfhi(ov.x), bflo(ov.y), bfhi(ov.y)};
            const f32x4 gw = *(const LAS f32x4*)(gnw + e0), sk = *(const LAS f32x4*)(skp + e0); float o[4];
#pragma unroll
            for (int i = 0; i < 4; ++i) o[i] = ((NT[eb][4 * g + i] - mean) * rs * gw[i] + sk[i] * xt[4 * g + i]) * sigmoidf_(og[i]);
            v2u w; w.x = cvtpk(o[0], o[1]); w.y = cvtpk(o[2], o[3]); *(v2u*)(YM + e0) = w; }
        __builtin_amdgcn_sched_barrier(0); }
}

constexpr size_t WS_SPREV = 237 * MiB;
constexpr size_t WS_GL = 253 * MiB, WS_BON = 253 * MiB + 512 * 1024, WS_BND = 254 * MiB;
constexpr size_t DO_DLRT = O_SC * 4, DO_DS = O_SC * 4 + 16 * MiB;
constexpr int RSTR = 144, RSLOT = 64 * RSTR;
constexpr int R1_MISC = 8 * RSLOT, R1_ITEM_LDS = 8 * RSLOT + 6144;
static_assert(2 * R1_ITEM_LDS == 159744, "R1 LDS");

__device__ __forceinline__ int rowidx(int reg, int hh) { return (reg & 3) + 8 * (reg >> 2) + 4 * hh; }
__device__ __forceinline__ bf16x8 ldsfrag(const LAS unsigned char* slot, int row, int k0) { return *(const LAS bf16x8*)(slot + row * RSTR + k0 * 2); }
__device__ __forceinline__ void st_rows(LAS unsigned char* slot, int rb, int cb, const f32x16& x, int r, int hh) {
    LAS unsigned char* bp = slot + (32 * rb + 4 * hh) * RSTR + (32 * cb + r) * 2;
#pragma unroll
    for (int reg = 0; reg < 16; reg += 2) { const unsigned w = cvtpk(x[reg], x[reg + 1]);
        *(LAS bf16*)(bp + ((reg & 3) + 8 * (reg >> 2)) * RSTR) = (bf16)(w & 0xffffu); *(LAS bf16*)(bp + (((reg + 1) & 3) + 8 * ((reg + 1) >> 2)) * RSTR) = (bf16)(w >> 16); }
}
__device__ __forceinline__ void st_cols(LAS unsigned char* slot, int rb, int cb, const f32x16& x, int r, int hh) {
    LAS unsigned char* bp = slot + (32 * cb + r) * RSTR + (32 * rb + 4 * hh) * 2;
#pragma unroll
    for (int g = 0; g < 4; ++g) { v2u w; w.x = cvtpk(x[4 * g], x[4 * g + 1]); w.y = cvtpk(x[4 * g + 2], x[4 * g + 3]); *(LAS v2u*)(bp + 16 * g) = w; }
}
__device__ __forceinline__ f32x16 zero16() { f32x16 z;
#pragma unroll
    for (int i = 0; i < 16; ++i) z[i] = 0.f;
    return z; }
__device__ __forceinline__ void mix8(const v4u cur, const v4u prv, const float* mu, float (&m)[8]) {
    const f32x4 m0 = *(const f32x4*)mu, m1 = *(const f32x4*)(mu + 4);
    const float c[8] = {bflo(cur.x), bfhi(cur.x), bflo(cur.y), bfhi(cur.y), bflo(cur.z), bfhi(cur.z), bflo(cur.w), bfhi(cur.w)};
    const float p[8] = {bflo(prv.x), bfhi(prv.x), bflo(prv.y), bfhi(prv.y), bflo(prv.z), bfhi(prv.z), bflo(prv.w), bfhi(prv.w)};
    const float mm[8] = {m0.x, m0.y, m0.z, m0.w, m1.x, m1.y, m1.z, m1.w};
#pragma unroll
    for (int i = 0; i < 8; ++i) m[i] = c[i] + (p[i] - c[i]) * mm[i];
}
__device__ __forceinline__ void mix8l(const v4u cur, const v4u prv, const LAS float* mu, float (&m)[8]) {
    const f32x4 m0 = *(const LAS f32x4*)mu, m1 = *(const LAS f32x4*)(mu + 4);
    const float c[8] = {bflo(cur.x), bfhi(cur.x), bflo(cur.y), bfhi(cur.y), bflo(cur.z), bfhi(cur.z), bflo(cur.w), bfhi(cur.w)};
    const float p[8] = {bflo(prv.x), bfhi(prv.x), bflo(prv.y), bfhi(prv.y), bflo(prv.z), bfhi(prv.z), bflo(prv.w), bfhi(prv.w)};
    const float mm[8] = {m0.x, m0.y, m0.z, m0.w, m1.x, m1.y, m1.z, m1.w};
#pragma unroll
    for (int i = 0; i < 8; ++i) m[i] = c[i] + (p[i] - c[i]) * mm[i];
}
__device__ __forceinline__ void mix4l(const v2u cur, const v2u prv, const LAS float* mu, float (&m)[4]) {
    const f32x4 m0 = *(const LAS f32x4*)mu;
    const float c[4] = {bflo(cur.x), bfhi(cur.x), bflo(cur.y), bfhi(cur.y)}, p[4] = {bflo(prv.x), bfhi(prv.x), bflo(prv.y), bfhi(prv.y)}, mm[4] = {m0.x, m0.y, m0.z, m0.w};
#pragma unroll
    for (int i = 0; i < 4; ++i) m[i] = c[i] + (p[i] - c[i]) * mm[i];
}
__device__ __forceinline__ void mix4(const v2u cur, const v2u prv, const float* mu, float (&m)[4]) {
    const f32x4 m0 = *(const f32x4*)mu;
    const float c[4] = {bflo(cur.x), bfhi(cur.x), bflo(cur.y), bfhi(cur.y)}, p[4] = {bflo(prv.x), bfhi(prv.x), bflo(prv.y), bfhi(prv.y)}, mm[4] = {m0.x, m0.y, m0.z, m0.w};
#pragma unroll
    for (int i = 0; i < 4; ++i) m[i] = c[i] + (p[i] - c[i]) * mm[i];
}

__device__ __forceinline__ float tanh_fast(float x) { return 1.0f - 2.0f * __builtin_amdgcn_rcpf(__expf(2.0f * x) + 1.0f); }
__device__ __forceinline__ void rwkv_prep_pair(const Args& a, LAS unsigned char* lds0, int ritem0, bool dry = false) {
    int tid_ = threadIdx.x; asm volatile("" : "+v"(tid_));
    const int tid = tid_ & 255, lane = tid & 63, w4 = tid >> 6, r = lane & 31, hh = lane >> 5, half = tid_ >> 8;
    const int ritem = ritem0 + half, bh = ritem >> 5, c = ritem & 31, b = bh >> 3, h = bh & 7, hc = h * 64, row0 = b * SEQ, t0 = c * 64;
    const int p = w4 >> 1, q = w4 & 1;
    LAS unsigned char* L = lds0 + half * R1_ITEM_LDS;
    LAS unsigned char *S0 = L, *S1 = L + RSLOT, *S2 = L + 2 * RSLOT, *S3 = L + 3 * RSLOT, *S4 = L + 4 * RSLOT, *S5 = L + 5 * RSLOT, *S6 = L + 6 * RSLOT, *S7 = L + 7 * RSLOT;
    LAS float* SSX = (LAS float*)(L + R1_MISC);
    LAS float* BONX = SSX + 128;
    LAS float* CUMT = BONX + 128;
    LAS float* CUML = CUMT + 64;
    LAS float* CUMTp = CUMT + 32 * p + 4 * hh; LAS float* CUMLp = CUML + 32 * p + 4 * hh;
    LAS float* KC = CUML + 64;
    LAS unsigned char* T00T = L + R1_MISC;
    LAS unsigned char* G1T = L + R1_MISC + 2560;
    const bf16* PR = (const bf16*)(a.ws + WS_PR); const bf16* BND = (const bf16*)(a.ws + WS_BND);
    const float* mu = a.in[10];
    constexpr int RAWS = 656;
    bf16x8 w2f[4], a2f[4];
    {   const bf16* W2T = (const bf16*)(a.ws + WS_LW2T) + (size_t)(hc + 32 * p + r) * 64; const bf16* A2T = (const bf16*)(a.ws + WS_LA2T) + (size_t)(hc + 32 * p + r) * 64;
#pragma unroll
        for (int ks = 0; ks < 4; ++ks) { w2f[ks] = ld16(W2T + 16 * ks + 8 * hh); a2f[ks] = ld16(A2T + 16 * ks + 8 * hh); } }
    for (int i = tid; i < 640; i += 256) { const int which = i >> 6, j = i & 63;
        KC[i] = which == 0 ? a.in[11][hc + j] : which == 1 ? a.in[13][hc + j] : which == 2 ? a.in[16][hc + j] : which == 3 ? a.in[17][hc + j] : which == 4 ? a.in[18][hc + j]
              : which == 5 ? mu[hc + j] : which == 6 ? mu[512 + hc + j] : which == 7 ? mu[1024 + hc + j] : which == 8 ? mu[1536 + j] : mu[1600 + j]; }
    {   const int segcol[5] = {hc, 512 + hc, 1024 + hc, 1536, 1600};
        for (int ci = tid; ci < 65 * 40; ci += 256) { const int trow = ci / 40, sc = ci - trow * 40, seg = sc >> 3, part = sc & 7;
            v4u v = (v4u){0u, 0u, 0u, 0u};
            const int col = (seg == 0 ? hc : seg == 1 ? 512 + hc : seg == 2 ? 1024 + hc : seg == 3 ? 1536 : 1600) + part * 8;
            if (trow > 0) v = *(const v4u*)(PR + (size_t)(row0 + t0 + trow - 1) * NPR + col);
            else if (c > 0) v = *(const v4u*)(BND + (size_t)(b * 32 + c - 1) * NPR + col);
            *(LAS v4u*)(L + trow * RAWS + seg * 128 + part * 16) = v; }
        (void)segcol;
    }
    __syncthreads();
    const int tl = 32 * q + r; const size_t row = (size_t)(row0 + t0 + tl);
    const LAS unsigned char* rcur = L + (tl + 1) * RAWS; const LAS unsigned char* rprv = L + tl * RAWS;
    f32x16 wl = zero16(), al = zero16();
    {
#pragma unroll
        for (int ks = 0; ks < 4; ++ks) { const int k0 = 16 * ks + 8 * hh; float m[8];
            mix8l(*(const LAS v4u*)(rcur + 384 + k0 * 2), *(const LAS v4u*)(rprv + 384 + k0 * 2), KC + 8 * 64 + k0, m);
            wl = MFMA32(w2f[ks], pack8(tanh_fast(m[0]), tanh_fast(m[1]), tanh_fast(m[2]), tanh_fast(m[3]), tanh_fast(m[4]), tanh_fast(m[5]), tanh_fast(m[6]), tanh_fast(m[7])), wl);
            mix8l(*(const LAS v4u*)(rcur + 512 + k0 * 2), *(const LAS v4u*)(rprv + 512 + k0 * 2), KC + 9 * 64 + k0, m);
            al = MFMA32(a2f[ks], pack8(m[0], m[1], m[2], m[3], m[4], m[5], m[6], m[7]), al); }
    }
    f32x16 lw, aa, kx, rx, vx;
    float ssp = 0.f, bonp = 0.f;
#pragma unroll
    for (int g = 0; g < 4; ++g) { const int ch = hc + 32 * p + 8 * g + 4 * hh; const int cl = (32 * p + 8 * g + 4 * hh) * 2;
        const int cj = 32 * p + 8 * g + 4 * hh;
        const f32x4 w04 = *(const LAS f32x4*)(KC + cj), a04 = *(const LAS f32x4*)(KC + 64 + cj), kk4 = *(const LAS f32x4*)(KC + 128 + cj), ka4 = *(const LAS f32x4*)(KC + 192 + cj), rk4 = *(const LAS f32x4*)(KC + 256 + cj);
        float mr[4], mk[4], mv[4];
        mix4l(*(const LAS v2u*)(rcur + cl), *(const LAS v2u*)(rprv + cl), KC + 320 + cj, mr);
        mix4l(*(const LAS v2u*)(rcur + 128 + cl), *(const LAS v2u*)(rprv + 128 + cl), KC + 384 + cj, mk);
        mix4l(*(const LAS v2u*)(rcur + 256 + cl), *(const LAS v2u*)(rprv + 256 + cl), KC + 448 + cj, mv);
#pragma unroll
        for (int i = 0; i < 4; ++i) { const int reg = 4 * g + i;
            lw[reg] = -0.6065306597126334f * __builtin_amdgcn_rcpf(1.0f + __expf(-(w04[i] + wl[reg])));
            const float av = __builtin_amdgcn_rcpf(1.0f + __expf(-(a04[i] + al[reg]))); aa[reg] = av;
            const float kkr = mk[i] * kk4[i]; ssp += kkr * kkr; wl[reg] = kkr;
            const float k2 = mk[i] * (1.0f + (av - 1.0f) * ka4[i]); kx[reg] = k2; rx[reg] = mr[i]; vx[reg] = mv[i];
            bonp += mr[i] * k2 * rk4[i]; } }
    ssp += __shfl_xor(ssp, 32); bonp += __shfl_xor(bonp, 32);
    if (hh == 0) { SSX[tl * 2 + p] = ssp; BONX[tl * 2 + p] = bonp; }
    st_rows(S6, p, q, vx, r, hh);
    __builtin_amdgcn_sched_barrier(0);
    f32x16 cum = lw;
#pragma unroll
    for (int reg = 0; reg < 16; ++reg) {
        float x = cum[reg];
        x += __builtin_bit_cast(float, __builtin_amdgcn_update_dpp(0, __builtin_bit_cast(int, x), 0x111, 0xf, 0xf, true));
        x += __builtin_bit_cast(float, __builtin_amdgcn_update_dpp(0, __builtin_bit_cast(int, x), 0x112, 0xf, 0xf, true));
        x += __builtin_bit_cast(float, __builtin_amdgcn_update_dpp(0, __builtin_bit_cast(int, x), 0x114, 0xf, 0xf, true));
        x += __builtin_bit_cast(float, __builtin_amdgcn_update_dpp(0, __builtin_bit_cast(int, x), 0x118, 0xf, 0xf, true));
        x += __builtin_bit_cast(float, __builtin_amdgcn_update_dpp(0, __builtin_bit_cast(int, x), 0x142, 0xa, 0xf, false));
        cum[reg] = x; }
    if (q == 0 && r == 31) {
#pragma unroll
        for (int reg = 0; reg < 16; ++reg) CUMTp[(reg & 3) + 8 * (reg >> 2)] = cum[reg]; }
    __syncthreads();
    if (q == 1) {
#pragma unroll
        for (int reg = 0; reg < 16; ++reg) cum[reg] += CUMTp[(reg & 3) + 8 * (reg >> 2)];
        if (r == 31) {
#pragma unroll
            for (int reg = 0; reg < 16; ++reg) CUMLp[(reg & 3) + 8 * (reg >> 2)] = cum[reg]; } }
    const float rinv = 1.0f / fmaxf(sqrtf(SSX[tl * 2] + SSX[tl * 2 + 1]), 1e-12f);
    if (p == 0 && hh == 0 && !dry) ((float*)(a.ws + WS_BON))[row * 8 + h] = BONX[tl * 2] + BONX[tl * 2 + 1];
    f32x16 KeT, RqT;
#pragma unroll
    for (int reg = 0; reg < 16; ++reg) { RqT[reg] = rx[reg] * __expf(cum[reg]); lw[reg] = cum[reg] - lw[reg]; wl[reg] *= rinv; }
    st_cols(S3, p, q, RqT, r, hh);
    __syncthreads();
    __builtin_amdgcn_sched_barrier(0);
    {   f32x16 tmp;
#pragma unroll
        for (int reg = 0; reg < 16; ++reg) tmp[reg] = wl[reg] * __expf(lw[reg]);
        st_cols(S0, p, q, tmp, r, hh); st_rows(S4, p, q, tmp, r, hh);
        __builtin_amdgcn_sched_barrier(0);
#pragma unroll
        for (int reg = 0; reg < 16; ++reg) tmp[reg] = wl[reg] * aa[reg] * __expf(-cum[reg]);
        st_cols(S1, p, q, tmp, r, hh);
        __builtin_amdgcn_sched_barrier(0);
#pragma unroll
        for (int reg = 0; reg < 16; ++reg) tmp[reg] = kx[reg] * __expf(-cum[reg]);
        st_cols(S2, p, q, tmp, r, hh);
        __builtin_amdgcn_sched_barrier(0);
#pragma unroll
        for (int reg = 0; reg < 16; ++reg) { const float e4 = __expf(CUMLp[(reg & 3) + 8 * (reg >> 2)] - cum[reg]); tmp[reg] = wl[reg] * aa[reg] * e4; KeT[reg] = kx[reg] * e4; }
        st_rows(S5, p, q, tmp, r, hh);
        if (q == 0 && r == 0 && !dry) { float* glp = (float*)(a.ws + WS_GL) + (size_t)ritem * 64 + 32 * p + 4 * hh;
#pragma unroll
            for (int reg = 0; reg < 16; ++reg) glp[(reg & 3) + 8 * (reg >> 2)] = __expf(CUMLp[(reg & 3) + 8 * (reg >> 2)]); }
    }
    __syncthreads();
    __builtin_amdgcn_sched_barrier(0);
    f32x16 NrkT;
    {   f32x16 mkb = zero16(), mkk = zero16(), nrb = zero16(); NrkT = zero16();
        if (!(p == 0 && q == 1)) {
#pragma unroll
            for (int ks = 0; ks < 4; ++ks) { const int k0 = 16 * ks + 8 * hh;
                const bf16x8 kqp = ldsfrag(S0, 32 * p + r, k0), rqp = ldsfrag(S3, 32 * p + r, k0), bdq = ldsfrag(S1, 32 * q + r, k0), kdq = ldsfrag(S2, 32 * q + r, k0);
                mkb = MFMA32(kqp, bdq, mkb); mkk = MFMA32(kqp, kdq, mkk); nrb = MFMA32(rqp, bdq, nrb); }
        }
        if (!(p == 1 && q == 0)) {
#pragma unroll
            for (int ks = 0; ks < 4; ++ks) { const int k0 = 16 * ks + 8 * hh; NrkT = MFMA32(ldsfrag(S2, 32 * p + r, k0), ldsfrag(S3, 32 * q + r, k0), NrkT); }
        }
#pragma unroll
        for (int reg = 0; reg < 16; ++reg) { const int i = 32 * p + rowidx(reg, hh), j = 32 * q + r;
            if (!(j < i)) { mkb[reg] = 0.f; mkk[reg] = 0.f; } if (!(j <= i)) nrb[reg] = 0.f;
            if (!(i <= j)) NrkT[reg] = 0.f; }
        __syncthreads();
#pragma unroll
        for (int reg = 0; reg < 16; ++reg) *(LAS float*)(S0 + ((32 * p + 4 * hh) * 68 + 32 * q + r) * 4 + ((reg & 3) + 8 * (reg >> 2)) * 272) = mkb[reg];
        st_cols(S2, p, q, mkk, r, hh); st_rows(S3, p, q, nrb, r, hh);
    }
    __syncthreads();
    if (w4 < 2) {
        if (lane < 32) { const int i0 = 32 * w4; float tc[32];
#pragma unroll
            for (int i = 0; i < 32; ++i) { float acc = (i == lane) ? 1.0f : 0.0f;
#pragma unroll
                for (int j4 = 0; j4 < (i + 3) / 4; ++j4) { const f32x4 m4 = *(const LAS f32x4*)(S0 + ((i0 + i) * 68 + i0 + 4 * j4) * 4);
                    if (4 * j4 + 0 < i) acc -= m4.x * tc[4 * j4 + 0]; if (4 * j4 + 1 < i) acc -= m4.y * tc[4 * j4 + 1]; if (4 * j4 + 2 < i) acc -= m4.z * tc[4 * j4 + 2]; if (4 * j4 + 3 < i) acc -= m4.w * tc[4 * j4 + 3]; }
                tc[i] = acc; }
#pragma unroll
            for (int i = 0; i < 32; ++i) *(LAS bf16*)(S7 + (i0 + i) * RSTR + (i0 + lane) * 2) = (bf16)f2bf(tc[i]);
            if (w4 == 0) {
#pragma unroll
                for (int i8 = 0; i8 < 4; ++i8) *(LAS bf16x8*)(T00T + lane * 80 + i8 * 16) = pack8(tc[8 * i8], tc[8 * i8 + 1], tc[8 * i8 + 2], tc[8 * i8 + 3], tc[8 * i8 + 4], tc[8 * i8 + 5], tc[8 * i8 + 6], tc[8 * i8 + 7]); }
        }
    } else if (w4 == 2) {
#pragma unroll
        for (int i = 0; i < 16; ++i) *(LAS bf16*)(S7 + (2 * i + hh) * RSTR + (32 + r) * 2) = (bf16)0;
    }
    __syncthreads();
    if (w4 == 1) {
        f32x16 g1 = zero16();
#pragma unroll
        for (int ks = 0; ks < 2; ++ks) { const int k0 = 16 * ks + 8 * hh; const LAS float* mp = (const LAS float*)(S0 + ((32 + r) * 68 + k0) * 4); const f32x4 x0 = *(const LAS f32x4*)mp, x1 = *(const LAS f32x4*)(mp + 4);
            g1 = MFMA32(pack8(x0.x, x0.y, x0.z, x0.w, x1.x, x1.y, x1.z, x1.w), *(const LAS bf16x8*)(T00T + r * 80 + k0 * 2), g1); }
#pragma unroll
        for (int g = 0; g < 4; ++g) { v2u w; w.x = cvtpk(g1[4 * g], g1[4 * g + 1]); w.y = cvtpk(g1[4 * g + 2], g1[4 * g + 3]); *(LAS v2u*)(G1T + r * 80 + (8 * g + 4 * hh) * 2) = w; }
        LDS_WAIT(); asm volatile("" ::: "memory");
        f32x16 t10 = zero16();
#pragma unroll
        for (int ks = 0; ks < 2; ++ks) { const int k0 = 16 * ks + 8 * hh; t10 = MFMA32(ldsfrag(S7, 32 + r, 32 + k0), *(const LAS bf16x8*)(G1T + r * 80 + k0 * 2), t10); }
#pragma unroll
        for (int reg = 0; reg < 16; ++reg) *(LAS bf16*)(S7 + (32 + 4 * hh) * RSTR + r * 2 + ((reg & 3) + 8 * (reg >> 2)) * RSTR) = (bf16)f2bf(-t10[reg]);
    }
    __syncthreads();
    {   f32x16 w1 = zero16(), w2 = zero16();
#pragma unroll
        for (int ks = 0; ks < 4; ++ks) { const int k0 = 16 * ks + 8 * hh; const bf16x8 tq = ldsfrag(S7, 32 * q + r, k0);
            w1 = MFMA32(ldsfrag(S4, 32 * p + r, k0), tq, w1); w2 = MFMA32(ldsfrag(S2, 32 * p + r, k0), tq, w2); }
        __syncthreads();
        st_rows(S0, p, q, w1, r, hh); st_rows(S1, p, q, w2, r, hh);
    }
    __syncthreads();
    {   f32x16 qf = zero16(), dl = zero16(), pv = zero16(), kf = zero16();
#pragma unroll
        for (int ks = 0; ks < 4; ++ks) { const int k0 = 16 * ks + 8 * hh;
            const bf16x8 w1p = ldsfrag(S0, 32 * p + r, k0), w1q = ldsfrag(S0, 32 * q + r, k0), w2p = ldsfrag(S1, 32 * p + r, k0), w2q = ldsfrag(S1, 32 * q + r, k0), nrq = ldsfrag(S3, 32 * q + r, k0), bep = ldsfrag(S5, 32 * p + r, k0);
            qf = MFMA32(w1p, nrq, qf); dl = MFMA32(bep, w1q, dl); pv = MFMA32(w2p, nrq, pv); kf = MFMA32(bep, w2q, kf); }
        bf16* qo = (bf16*)(a.ws + WS_PR) + row * NPR + hc + 32 * p + 4 * hh;
        if (!dry)
#pragma unroll
        for (int g = 0; g < 4; ++g) { v2u w; w.x = cvtpk(RqT[4 * g] - qf[4 * g], RqT[4 * g + 1] - qf[4 * g + 1]); w.y = cvtpk(RqT[4 * g + 2] - qf[4 * g + 2], RqT[4 * g + 3] - qf[4 * g + 3]); *(v2u*)(qo + 8 * g) = w; }
        bf16* dlo = (bf16*)((unsigned char*)a.out + DO_DLRT) + (size_t)ritem * 4096 + (32 * p + 4 * hh) * 64 + 32 * q + r;
#pragma unroll
        for (int reg = 0; reg < 16; ++reg) { if (!dry) dlo[((reg & 3) + 8 * (reg >> 2)) * 64] = (bf16)f2bf(-dl[reg]); pv[reg] = NrkT[reg] - pv[reg]; kf[reg] = KeT[reg] - kf[reg]; }
        st_cols(S2, p, q, pv, r, hh);
        st_rows(S4, p, q, kf, r, hh);
    }
    __syncthreads();
    {   f32x16 yl = zero16(), ds = zero16();
#pragma unroll
        for (int ks = 0; ks < 4; ++ks) { const int k0 = 16 * ks + 8 * hh; const bf16x8 vp = ldsfrag(S6, 32 * p + r, k0);
            yl = MFMA32(vp, ldsfrag(S2, 32 * q + r, k0), yl); ds = MFMA32(vp, ldsfrag(S4, 32 * q + r, k0), ds); }
        bf16* yo = (bf16*)(a.ws + WS_PR) + row * NPR + 512 + hc + 32 * p + 4 * hh;
        if (!dry)
#pragma unroll
        for (int g = 0; g < 4; ++g) { v2u w; w.x = cvtpk(yl[4 * g], yl[4 * g + 1]); w.y = cvtpk(yl[4 * g + 2], yl[4 * g + 3]); *(v2u*)(yo + 8 * g) = w; }
        bf16* dso = (bf16*)((unsigned char*)a.out + DO_DS) + (size_t)ritem * 4096 + (32 * p + 4 * hh) * 64 + 32 * q + r;
#pragma unroll
        for (int reg = 0; reg < 16; ++reg) if (!dry) dso[((reg & 3) + 8 * (reg >> 2)) * 64] = (bf16)f2bf(ds[reg]);
    }
    __syncthreads();
}

typedef float f32x4v __attribute__((ext_vector_type(4)));
__device__ __forceinline__ void rwkv_scan_task(const Args& a, int bh, int vq, int lane) {
    const int lc = lane & 15, g = lane >> 4, v = 16 * vq + lc;
    f32x4v ST[4];
#pragma unroll
    for (int ib = 0; ib < 4; ++ib) ST[ib] = (f32x4v){0.f, 0.f, 0.f, 0.f};
    const bf16* DL0 = (const bf16*)((const unsigned char*)a.out + DO_DLRT) + (size_t)bh * 32 * 4096 + (size_t)lc * 64 + 4 * g;
    const bf16* DS0 = (const bf16*)((const unsigned char*)a.out + DO_DS) + (size_t)bh * 32 * 4096 + (size_t)v * 64 + 4 * g;
    const float* GL0 = (const float*)(a.ws + WS_GL) + (size_t)bh * 32 * 64 + 4 * g; bf16* SP0 = (bf16*)(a.ws + WS_SPREV) + (size_t)bh * 32 * 4096 + v * 64 + 4 * g;
    v2u dl[4][2][2], ds[4]; f32x4 gl[4];
#define R2_LOAD(c_) do { const bf16* DL = DL0 + (size_t)(c_) * 4096; \
        _Pragma("unroll") for (int ib = 0; ib < 4; ++ib) { _Pragma("unroll") for (int s = 0; s < 2; ++s) { dl[ib][s][0] = *(const v2u*)(DL + (16 * ib) * 64 + 32 * s); dl[ib][s][1] = *(const v2u*)(DL + (16 * ib) * 64 + 32 * s + 16); } \
            ds[ib] = *(const v2u*)(DS0 + (size_t)(c_) * 4096 + 16 * ib); gl[ib] = *(const f32x4*)(GL0 + (size_t)(c_) * 64 + 16 * ib); } } while (0)
    R2_LOAD(0);
    for (int c = 0; c < 32; ++c) {
        bf16* SP = SP0 + (size_t)c * 4096;
        unsigned hi[4][2], lo[4][2];
#pragma unroll
        for (int ib = 0; ib < 4; ++ib) { hi[ib][0] = cvtpk(ST[ib][0], ST[ib][1]); hi[ib][1] = cvtpk(ST[ib][2], ST[ib][3]);
            v2u w; w.x = hi[ib][0]; w.y = hi[ib][1]; *(v2u*)(SP + 16 * ib) = w;
            lo[ib][0] = cvtpk(ST[ib][0] - bflo(hi[ib][0]), ST[ib][1] - bfhi(hi[ib][0])); lo[ib][1] = cvtpk(ST[ib][2] - bflo(hi[ib][1]), ST[ib][3] - bfhi(hi[ib][1])); }
        bf16x8 Bh[2], Bl[2];
#pragma unroll
        for (int s = 0; s < 2; ++s) { v4u t; t.x = hi[2 * s][0]; t.y = hi[2 * s][1]; t.z = hi[2 * s + 1][0]; t.w = hi[2 * s + 1][1]; Bh[s] = __builtin_bit_cast(bf16x8, t);
            v4u u2; u2.x = lo[2 * s][0]; u2.y = lo[2 * s][1]; u2.z = lo[2 * s + 1][0]; u2.w = lo[2 * s + 1][1]; Bl[s] = __builtin_bit_cast(bf16x8, u2); }
        f32x4v nw[4]; bf16x8 Af[4][2];
#pragma unroll
        for (int ib = 0; ib < 4; ++ib) {
            nw[ib] = (f32x4v){bflo(ds[ib].x) + gl[ib].x * ST[ib][0], bfhi(ds[ib].x) + gl[ib].y * ST[ib][1], bflo(ds[ib].y) + gl[ib].z * ST[ib][2], bfhi(ds[ib].y) + gl[ib].w * ST[ib][3]};
#pragma unroll
            for (int s = 0; s < 2; ++s) { v4u t; t.x = dl[ib][s][0].x; t.y = dl[ib][s][0].y; t.z = dl[ib][s][1].x; t.w = dl[ib][s][1].y; Af[ib][s] = __builtin_bit_cast(bf16x8, t); } }
        if (c + 1 < 32) R2_LOAD(c + 1);
#pragma unroll
        for (int s = 0; s < 2; ++s)
#pragma unroll
            for (int ib = 0; ib < 4; ++ib) { nw[ib] = __builtin_amdgcn_mfma_f32_16x16x32_bf16(Af[ib][s], Bh[s], nw[ib], 0, 0, 0); nw[ib] = __builtin_amdgcn_mfma_f32_16x16x32_bf16(Af[ib][s], Bl[s], nw[ib], 0, 0, 0); }
#pragma unroll
        for (int ib = 0; ib < 4; ++ib) ST[ib] = nw[ib];
    }
#undef R2_LOAD
    float* So = a.out + O_PWKV + (size_t)bh * 4096 + v * 64 + 4 * g;
#pragma unroll
    for (int ib = 0; ib < 4; ++ib) *(f32x4*)(So + 16 * ib) = (f32x4){ST[ib][0], ST[ib][1], ST[ib][2], ST[ib][3]};
}

__device__ __forceinline__ void rwkv_out_task(const Args& a, int ritem, int tb, int lane_, bool dry = false) {
    int lane = lane_; asm volatile("" : "+v"(lane));
    const int r = lane & 31, hh = lane >> 5, bh = ritem >> 5, c = ritem & 31, b = bh >> 3, h = bh & 7, hc = h * 64, row0 = b * SEQ, t0 = c * 64, tl = 32 * tb + r;
    const size_t row = (size_t)(row0 + t0 + tl);
    bf16* PRw = (bf16*)(a.ws + WS_PR); const bf16* cur = PRw + row * NPR; const bf16* prv = (t0 + tl) > 0 ? cur - NPR : nullptr;
    const bf16* SP = (const bf16*)(a.ws + WS_SPREV) + (size_t)ritem * 4096; const float* mu = a.in[10];
    f32x16 Y[2] = {zero16(), zero16()};
#pragma unroll
    for (int ks = 0; ks < 4; ++ks) { const int k0 = 16 * ks + 8 * hh; const bf16x8 B = ld16(cur + hc + k0);
        Y[0] = MFMA32(ld16(SP + (size_t)r * 64 + k0), B, Y[0]); Y[1] = MFMA32(ld16(SP + (size_t)(32 + r) * 64 + k0), B, Y[1]); }
    __builtin_amdgcn_sched_barrier(0);
    f32x16 G[2] = {zero16(), zero16()};
    {   const bf16* G2T = (const bf16*)(a.ws + WS_LG2T) + (size_t)(hc + r) * 128;
#pragma unroll
        for (int ks = 0; ks < 8; ++ks) { const int k0 = 16 * ks + 8 * hh; float m[8];
            mix8(*(const v4u*)(cur + 1664 + k0), prv ? *(const v4u*)(prv + 1664 + k0) : (v4u){0u, 0u, 0u, 0u}, mu + 1664 + k0, m);
            const bf16x8 B = pack8(sigmoidf_(m[0]), sigmoidf_(m[1]), sigmoidf_(m[2]), sigmoidf_(m[3]), sigmoidf_(m[4]), sigmoidf_(m[5]), sigmoidf_(m[6]), sigmoidf_(m[7]));
            G[0] = MFMA32(ld16(G2T + k0), B, G[0]); G[1] = MFMA32(ld16(G2T + 32 * 128 + k0), B, G[1]); }
    }
    __builtin_amdgcn_sched_barrier(0);
    float s1 = 0.f;
#pragma unroll
    for (int vb = 0; vb < 2; ++vb)
#pragma unroll
        for (int g = 0; g < 4; ++g) { const v2u y4 = *(const v2u*)(cur + 512 + hc + 32 * vb + 8 * g + 4 * hh);
            Y[vb][4 * g] += bflo(y4.x); Y[vb][4 * g + 1] += bfhi(y4.x); Y[vb][4 * g + 2] += bflo(y4.y); Y[vb][4 * g + 3] += bfhi(y4.y);
            s1 += (Y[vb][4 * g] + Y[vb][4 * g + 1]) + (Y[vb][4 * g + 2] + Y[vb][4 * g + 3]); }
    s1 += __shfl_xor(s1, 32); const float mean = s1 * (1.0f / 64.0f); float s2 = 0.f;
#pragma unroll
    for (int vb = 0; vb < 2; ++vb)
#pragma unroll
        for (int i = 0; i < 16; ++i) { const float d = Y[vb][i] - mean; s2 += d * d; }
    s2 += __shfl_xor(s2, 32); const float rs = rsqrtf(s2 * (1.0f / 64.0f) + R_GN_EPS);
    const float bon = ((const float*)(a.ws + WS_BON))[row * 8 + h];
    bf16* yo = (bf16*)(a.ws + WS_YRM) + row * 1024 + hc;
#pragma unroll
    for (int vb = 0; vb < 2; ++vb)
#pragma unroll
        for (int g = 0; g < 4; ++g) { const int ch = hc + 32 * vb + 8 * g + 4 * hh; float mv[4];
            mix4(*(const v2u*)(cur + 1024 + ch), prv ? *(const v2u*)(prv + 1024 + ch) : (v2u){0u, 0u}, mu + 1024 + ch, mv);
            const f32x4 gw = *(const f32x4*)(a.in[19] + ch), gb = *(const f32x4*)(a.in[20] + ch); float o[4];
#pragma unroll
            for (int i = 0; i < 4; ++i) o[i] = ((Y[vb][4 * g + i] - mean) * rs * gw[i] + gb[i] + bon * mv[i]) * G[vb][4 * g + i];
            v2u w; w.x = cvtpk(o[0], o[1]); w.y = cvtpk(o[2], o[3]); if (!dry) *(v2u*)(yo + 32 * vb + 8 * g + 4 * hh) = w; }
}


__device__ __forceinline__ void rwkv_sample_task(const Args& a, int sb, int h, int lane) {
    const int hc = h * 64, j = lane;
    bf16* PRw = (bf16*)(a.ws + WS_PR); const bf16* cur = PRw + (size_t)(MP + sb) * NPR; const bf16* prv = PRw + (size_t)(MTOK + sb) * NPR; const float* mu = a.in[10];
#define RS_MIX(col) (bf2f(cur[col]) + (bf2f(prv[col]) - bf2f(cur[col])) * mu[col])
    const float r = RS_MIX(hc + j), k = RS_MIX(512 + hc + j), v = RS_MIX(1024 + hc + j);
    const float tw = tanh_fast(RS_MIX(1536 + j)), xa = RS_MIX(1600 + j), g0 = sigmoidf_(RS_MIX(1664 + j)), g1 = sigmoidf_(RS_MIX(1728 + j));
#undef RS_MIX
    float wl = a.in[11][hc + j], al = a.in[13][hc + j], gl = 0.f;
    const float* w2 = a.in[12] + hc + j; const float* a2 = a.in[14] + hc + j; const float* g2 = a.in[15] + hc + j;
#pragma unroll 8
    for (int i = 0; i < 64; ++i) { wl += __shfl(tw, i) * w2[(size_t)i * 512]; al += __shfl(xa, i) * a2[(size_t)i * 512]; gl += __shfl(g0, i) * g2[(size_t)i * 512] + __shfl(g1, i) * g2[(size_t)(64 + i) * 512]; }
    const float dec = expf(-0.6065306597126334f / (1.0f + expf(-wl))), aa = 1.0f / (1.0f + expf(-al));
    const float kkr = k * a.in[16][hc + j]; const float kk = kkr / fmaxf(sqrtf(wave_sum(kkr * kkr)), 1e-12f);
    const float k2 = k * (1.0f + (aa - 1.0f) * a.in[17][hc + j]), bb = kk * aa; const float bon = wave_sum(r * k2 * a.in[18][hc + j]);
    const float* S0 = a.in[3] + (size_t)(sb * 8 + h) * 4096 + j * 64; float* So = a.out + O_SWKV + (size_t)(sb * 8 + h) * 4096 + j * 64;
    float S[64];
#pragma unroll
    for (int i = 0; i < 16; ++i) { const f32x4 t = *(const f32x4*)(S0 + 4 * i); S[4 * i] = t.x; S[4 * i + 1] = t.y; S[4 * i + 2] = t.z; S[4 * i + 3] = t.w; }
    float p = 0.f;
#pragma unroll
    for (int i = 0; i < 64; ++i) p += S[i] * __shfl(kk, i);
    float y = 0.f;
#pragma unroll
    for (int i = 0; i < 64; ++i) { S[i] = S[i] * __shfl(dec, i) - p * __shfl(bb, i) + v * __shfl(k2, i); y += S[i] * __shfl(r, i); }
#pragma unroll
    for (int i = 0; i < 16; ++i) *(f32x4*)(So + 4 * i) = (f32x4){S[4 * i], S[4 * i + 1], S[4 * i + 2], S[4 * i + 3]};
    const float mean = wave_sum(y) * (1.0f / 64.0f), d = y - mean; const float rs = rsqrtf(wave_sum(d * d) * (1.0f / 64.0f) + R_GN_EPS);
    const float o = (d * rs * a.in[19][hc + j] + a.in[20][hc + j] + bon * v) * gl;
    PRw[(size_t)(MP + sb) * NPR + hc + j] = (bf16)f2bf(o);
}

typedef float f32x4m __attribute__((ext_vector_type(4)));
constexpr size_t WS_MERGED_S = 255 * MiB;
#define MFMA16(a, b, c) __builtin_amdgcn_mfma_f32_16x16x32_bf16((a), (b), (c), 0, 0, 0)
template <int KSTEPS>
__device__ __forceinline__ f32x4m skinny_acc(const bf16* ap, const bf16* bp, f32x4m acc) {
#pragma unroll 16
    for (int ks = 0; ks < KSTEPS; ++ks) acc = MFMA16(ld16(ap + 32 * ks), ld16(bp + 32 * ks), acc);
    return acc;
}
__device__ __forceinline__ void sample_up_task(const Args& a, int j, int wave, int lane) {
    const int lc = lane & 15, g = lane >> 4, rowa = MP + 16 * wave + lc, col = 16 * j + lc;
    unsigned char* ws = a.ws;
    f32x4m a1 = {0.f, 0.f, 0.f, 0.f}, a2 = {0.f, 0.f, 0.f, 0.f};
    a1 = skinny_acc<16>((const bf16*)(ws + WS_PR) + (size_t)rowa * NPR + 8 * g, (const bf16*)(ws + WS_UPRT) + (size_t)col * 1024 + 8 * g, a1);
    a2 = skinny_acc<16>((const bf16*)(ws + WS_YMS) + (size_t)(rowa - MP) * 512 + 8 * g, (const bf16*)(ws + WS_UPRT) + (size_t)col * 1024 + 512 + 8 * g, a2);
    const bf16* PG = (const bf16*)(ws + WS_PG); bf16* MG = (bf16*)(ws + WS_MERGED_S) - (size_t)MP * 1024;
#pragma unroll
    for (int rr = 0; rr < 4; ++rr) { const size_t row = (size_t)(MP + 16 * wave + 4 * g + rr);
        MG[row * 1024 + col] = (bf16)f2bf(bf2f(PG[row * 2048 + col]) * a1[rr] + bf2f(PG[row * 2048 + 1024 + col]) * a2[rr]); }
}
__device__ __forceinline__ void sample_out_task(const Args& a, int j, int wave, int lane) {
    const int lc = lane & 15, g = lane >> 4, rowa = MP + 16 * wave + lc, col = 16 * j + lc;
    unsigned char* ws = a.ws;
    f32x4m acc = {0.f, 0.f, 0.f, 0.f};
    acc = skinny_acc<32>((const bf16*)(ws + WS_MERGED_S) + (size_t)(rowa - MP) * 1024 + 8 * g, (const bf16*)(ws + WS_WOUTT) + (size_t)col * 1024 + 8 * g, acc);
    const float gf = a.in[33][col]; bf16* X2B = (bf16*)(ws + WS_X2B); float* ssq = (float*)(ws + WS_SSQ1);
#pragma unroll
    for (int rr = 0; rr < 4; ++rr) { const int rs = 16 * wave + 4 * g + rr; const size_t row = (size_t)(MP + rs);
        const float x2 = a.in[1][(size_t)rs * 1024 + col] + acc[rr];
        a.out[row * 1024 + col] = x2; X2B[row * 1024 + col] = (bf16)f2bf(x2 * gf);
        float sq = x2 * x2; sq += __shfl_xor(sq, 1); sq += __shfl_xor(sq, 2); sq += __shfl_xor(sq, 4); sq += __shfl_xor(sq, 8);
        if (lc == 0) atomicAdd(ssq + row, sq); }
}
__device__ __forceinline__ void sample_ffn1_task(const Args& a, int j, int wave, int lane) {
    const int lc = lane & 15, g = lane >> 4, rowa = MP + 16 * wave + lc, col = 16 * j + lc;
    unsigned char* ws = a.ws;
    f32x4m acc = {0.f, 0.f, 0.f, 0.f};
    acc = skinny_acc<32>((const bf16*)(ws + WS_X2B) + (size_t)rowa * 1024 + 8 * g, (const bf16*)(ws + WS_W1T) + (size_t)col * 1024 + 8 * g, acc);
    const float* ssq = (const float*)(ws + WS_SSQ1); bf16* H = (bf16*)(ws + WS_H);
#pragma unroll
    for (int rr = 0; rr < 4; ++rr) { const size_t row = (size_t)(MP + 16 * wave + 4 * g + rr); const float rs = rsqrtf(ssq[row] * (1.0f / 1024.0f) + RMS_EPS);
        const float v = fmaxf(acc[rr] * rs, 0.f); H[row * 4096 + col] = (bf16)f2bf(v * v); }
}
__device__ __forceinline__ void sample_ffn2_task(const Args& a, int t, int wave, int lane) {
    const int lc = lane & 15, g = lane >> 4, rowa = MP + 16 * wave + lc, j = t >> 2, kq = t & 3, col = 16 * j + lc;
    unsigned char* ws = a.ws;
    f32x4m acc = {0.f, 0.f, 0.f, 0.f};
    acc = skinny_acc<32>((const bf16*)(ws + WS_H) + (size_t)rowa * 4096 + 1024 * kq + 8 * g, (const bf16*)(ws + WS_W2T) + (size_t)col * 4096 + 1024 * kq + 8 * g, acc);
#pragma unroll
    for (int rr = 0; rr < 4; ++rr) atomicAdd(a.out + (size_t)(MP + 16 * wave + 4 * g + rr) * 1024 + col, acc[rr]);
}

__device__ __forceinline__ unsigned long long rt() { return __builtin_amdgcn_s_memrealtime(); }
#define XB_TMO      128
#define XB_XCNT(j)  (256  + 64 * (j))
#define XB_XSUB(j)  (1280 + 64 * (j))
#define XB_XGEN(j)  (2304 + 64 * (j))
#define XB_TOP      3328
#define XB_TOPGEN   3392
#define XCD_BAR_WORDS 3456
#define XB_SPIN_CAP (1u << 18)

__device__ __forceinline__ unsigned xb_ld(unsigned* p)              { return __hip_atomic_load(p, __ATOMIC_RELAXED, __HIP_MEMORY_SCOPE_AGENT); }
__device__ __forceinline__ unsigned xb_add(unsigned* p, unsigned v) { return __hip_atomic_fetch_add(p, v, __ATOMIC_RELAXED, __HIP_MEMORY_SCOPE_AGENT); }
__device__ __forceinline__ unsigned xb_xcc_id() { return (unsigned)__builtin_amdgcn_s_getreg((3 << 11) | 20) & 0xFu; }
#define XB_SPIN(cond, bar) do { unsigned _sp = 0; while (cond) { __builtin_amdgcn_s_sleep(1); \
    if ((++_sp & 255u) == 0u) { if (xb_ld(&(bar)[XB_TMO])) break; if (_sp > XB_SPIN_CAP) { atomicAdd(&(bar)[XB_TMO], 1u); break; } } } } while (0)

struct XcdBarrier {
    unsigned* bar; unsigned x;
    volatile LAS unsigned* st;
};

__device__ __forceinline__ XcdBarrier xcd_barrier_post(unsigned* bar, volatile LAS unsigned* st) {
    XcdBarrier b; b.bar = bar; b.x = xb_xcc_id(); b.st = st;
    if (threadIdx.x == 0) (void)xb_add(&bar[XB_XCNT(b.x)], 1u);
    return b;
}
__device__ __forceinline__ void xcd_barrier_complete(unsigned* bar, unsigned x, unsigned& nloc, unsigned& nx) {
    const unsigned G = gridDim.x * gridDim.y * gridDim.z;
    unsigned sum, cnt, mine, sp = 0u;
    for (;;) {
        sum = 0u; cnt = 0u; mine = 0u;
#pragma unroll
        for (unsigned j = 0; j < 16; ++j) { const unsigned c = xb_ld(&bar[XB_XCNT(j)]); sum += c; cnt += (c > 0u) ? 1u : 0u; mine = (j == x) ? c : mine; }
        if (sum == G) break;
        __builtin_amdgcn_s_sleep(1);
        if ((++sp & 255u) == 0u) { if (xb_ld(&bar[XB_TMO])) break; if (sp > XB_SPIN_CAP) { atomicAdd(&bar[XB_TMO], 1u); break; } }
    }
    nloc = mine > 0u ? mine : 1u; nx = cnt > 0u ? cnt : 1u;
}

__device__ __forceinline__ void xcd_barrier(const XcdBarrier& b) {
    asm volatile("s_waitcnt vmcnt(0)" ::: "memory");
    __syncthreads();
    if (threadIdx.x == 0) {
        unsigned* bar = b.bar;
        __builtin_amdgcn_s_waitcnt(0);
        unsigned nloc = b.st[0], nx = b.st[1];
        if (nloc == 0u) { xcd_barrier_complete(bar, b.x, nloc, nx); b.st[0] = nloc; b.st[1] = nx; }
        const unsigned old = xb_add(&bar[XB_XSUB(b.x)], 1u);
        const unsigned gen = old / nloc;
        if (old + 1u == (gen + 1u) * nloc) {
            __builtin_amdgcn_fence(__ATOMIC_RELEASE, "agent");
            asm volatile("s_waitcnt vmcnt(0)" ::: "memory");
            const unsigned og = xb_add(&bar[XB_TOP], 1u);
            const unsigned tg = og / nx;
            if (og + 1u == (tg + 1u) * nx) xb_add(&bar[XB_TOPGEN], 1u);
            else XB_SPIN(xb_ld(&bar[XB_TOPGEN]) == tg, bar);
            __builtin_amdgcn_fence(__ATOMIC_ACQUIRE, "agent");
            xb_add(&bar[XB_XGEN(b.x)], 1u);
            asm volatile("s_waitcnt vmcnt(0)" ::: "memory");
        } else {
            XB_SPIN(xb_ld(&bar[XB_XGEN(b.x)]) == gen, bar);
            __builtin_amdgcn_fence(__ATOMIC_ACQUIRE, "agent");
            asm volatile("s_waitcnt vmcnt(0)" ::: "memory");
        }
    }
    __syncthreads();
}


constexpr size_t WS_BAR = 512 * 1024;
constexpr int MISC_OFF = 159744, MEGA_LDS = 160000;
static_assert(2 * RWKV_LDS <= MISC_OFF && MLSTM_LDS <= MISC_OFF && P0_LDS <= MISC_OFF && 2 * R1_ITEM_LDS <= MISC_OFF && GEMM_LDS <= MISC_OFF, "LDS map");

__global__ void __launch_bounds__(NTHR, 2) mega_fwd(Args a) {
    extern __shared__ __attribute__((aligned(16))) unsigned char lds_raw[];
    LAS unsigned char* lds = (LAS unsigned char*)lds_raw;
    volatile LAS unsigned* MISC = (volatile LAS unsigned*)(lds + MISC_OFF);
    const int tid = threadIdx.x, lane = tid & 63, wave = __builtin_amdgcn_readfirstlane(tid >> 6);
    const int G = gridDim.x, bx = blockIdx.x;
    unsigned char* ws = a.ws;
    if (tid < 64) MISC[tid] = 0u;
    __syncthreads();
    XcdBarrier bar = xcd_barrier_post((unsigned*)(ws + WS_BAR), MISC + 8);

    p0_prologue(a, lds, bx * NWAVES + wave, G * NWAVES, lane, wave);
    xcd_barrier(bar);
    { pg8::StaticOrder S; pg8::Gemm g{(const bf16*)(ws + WS_XN), (const bf16*)(ws + WS_WINT), MT, NPROJ, 1024, 1024, 1024, 0}; S.init(MT, NPROJ, G, bx);
      pg8::EpiProj E{(bf16*)(ws + WS_PR), (bf16*)(ws + WS_PM), (bf16*)(ws + WS_PG), a.in[31], (bf16*)(ws + WS_BND)}; pg8::gemm_phase<pg8::EpiProj, pg8::StaticOrder, true, true>(lds, g, S, E); }
    xcd_barrier(bar);
    {
        for (int pr = bx; pr < 1024; pr += G) rwkv_prep_pair(a, lds, 2 * pr);
        for (int item = bx; item < 1024; item += G) { mlstm_prep_stage(a, lds, item, tid); __syncthreads(); mlstm_prep_xc(lds, tid); __syncthreads(); mlstm_prep_task(a, item, wave, lds, lane); __syncthreads(); }
    }
    xcd_barrier(bar);
    {
        if (wave == 0) rwkv_scan_task(a, bx >> 2, bx & 3, lane);
        else if ((wave == 1 || wave == 2) && bx < 160) mlstm_scan_task(a, bx / 5, bx % 5, wave - 1, (LAS float*)lds + (wave - 1) * 64, lane);
        else if (wave >= 2) { const int sidx = bx < 160 ? bx * 5 + (wave - 3) : 800 + (bx - 160) * 6 + (wave - 2);
            if (sidx < MS * RH) rwkv_sample_task(a, sidx >> 3, sidx & 7, lane);
            ffn_weights_convert(a, sidx, 1376, (LAS float*)(lds + 4096) + (wave - 2) * (64 * 33), lane); }
    }
    xcd_barrier(bar);
    {
        for (int s = bx; s < 512; s += G) { mlstm_seq_item(a, lds, 32 + s); __syncthreads(); }
        mlstm_out_stage(a, lds, bx & 3, tid); mlstm_out_stage_xm(a, lds, bx & 3, (bx >> 2) * NWAVES, tid);
        __syncthreads();
        { const int tq = (bx >> 2) * NWAVES + wave, hq = bx & 3; const int item = ((tq >> 6) * 4 + hq) * 32 + ((tq >> 1) & 31); mlstm_out_task(a, item, tq & 1, lds, wave, lane); }
        for (int task = bx * NWAVES + wave; task < 4096; task += G * NWAVES) rwkv_out_task(a, task >> 1, task & 1, lane);
    }
    xcd_barrier(bar);
    if (bx < 64) sample_up_task(a, bx, wave, lane);
    { pg8::PairOrder S; pg8::Gemm g{(const bf16*)(ws + WS_YRM), (const bf16*)(ws + WS_UPRT), MP, 1024, 512, 1024, 1024, 512}; S.init(MP, 1024, G, bx);
      pg8::EpiUpZ E{(const bf16*)(ws + WS_PG), (bf16*)(ws + WS_MERGED)}; pg8::gemm_phase<pg8::EpiUpZ, pg8::PairOrder, true, true>(lds, g, S, E); }
    xcd_barrier(bar);
    if (bx < 64) sample_out_task(a, bx, wave, lane);
    { pg8::StaticOrder S; pg8::Gemm g{(const bf16*)(ws + WS_MERGED), (const bf16*)(ws + WS_WOUTT), MP, 1024, 1024, 1024, 1024, 0}; S.init(MP, 1024, G, bx);
      pg8::EpiOut E{a.in[0], a.in[1], a.out, (bf16*)(ws + WS_X2B), a.in[33], (float*)(ws + WS_SSQ1)}; pg8::gemm_phase<pg8::EpiOut, pg8::StaticOrder, true, true>(lds, g, S, E); }
    xcd_barrier(bar);
    sample_ffn1_task(a, bx, wave, lane);
    { pg8::StaticOrder S; pg8::Gemm g{(const bf16*)(ws + WS_X2B), (const bf16*)(ws + WS_W1T), MP, FF, 1024, 1024, 1024, 0}; S.init(MP, FF, G, bx);
      pg8::EpiFfn1 E{(bf16*)(ws + WS_H), (const float*)(ws + WS_SSQ1)}; pg8::gemm_phase<pg8::EpiFfn1, pg8::StaticOrder, true, true>(lds, g, S, E); }
    xcd_barrier(bar);
    sample_ffn2_task(a, bx, wave, lane);
    { pg8::StaticOrder S; pg8::Gemm g{(const bf16*)(ws + WS_H), (const bf16*)(ws + WS_W2T), MP, 1024, FF, FF, FF, 0}; S.init(MP, 1024, G, bx);
      pg8::EpiFfn2 E{a.out, nullptr}; pg8::gemm_phase<pg8::EpiFfn2, pg8::StaticOrder, true, true>(lds, g, S, E); }
    xcd_barrier(bar);
    final_norm_rows(a, bx * NWAVES + wave, G * NWAVES, lane);
}

extern "C" void kernel_launch(void* const* d_in, const int* in_sizes, int n_in, void* d_out, int out_size, void* d_ws, size_t ws_size, hipStream_t stream) {
    static int grid = 0;
    if (grid == 0) {
        if (n_in != 37 || (size_t)out_size != O_END || ws_size < WS_NEED) { fprintf(stderr, "kernel_launch: unexpected problem: n_in %d out %d ws %zu\n", n_in, out_size, ws_size); grid = -1; return; }
        int dev = 0, cus = 0, per_cu = 0;
        if (hipGetDevice(&dev) != hipSuccess || hipDeviceGetAttribute(&cus, hipDeviceAttributeMultiprocessorCount, dev) != hipSuccess) { fprintf(stderr, "kernel_launch: device query failed\n"); grid = -1; return; }
        if (hipFuncSetAttribute((const void*)mega_fwd, hipFuncAttributeMaxDynamicSharedMemorySize, MEGA_LDS) != hipSuccess) { fprintf(stderr, "kernel_launch: hipFuncSetAttribute failed\n"); grid = -1; return; }
        if (hipOccupancyMaxActiveBlocksPerMultiprocessor(&per_cu, (const void*)mega_fwd, NTHR, MEGA_LDS) != hipSuccess || per_cu < 1) { fprintf(stderr, "kernel_launch: occupancy query reports %d workgroups per CU\n", per_cu); (void)hipGetLastError(); per_cu = 1; }
        if (cus != 256) fprintf(stderr, "kernel_launch: built for a 256-CU device (one workgroup per CU); found %d CUs\n", cus);
        grid = 256;
    }
    if (grid < 0) return;
    if (hipMemsetAsync((char*)d_ws + WS_BAR, 0, 16384, stream) != hipSuccess) { fprintf(stderr, "kernel_launch: memset failed\n"); return; }
    Args a{};
    for (int i = 0; i < 37; ++i) a.in[i] = (const float*)d_in[i];
    a.out = (float*)d_out; a.ws = (unsigned char*)d_ws;
    void* args[] = {&a};
    hipError_t e = hipLaunchCooperativeKernel((const void*)mega_fwd, dim3(grid), dim3(NTHR), args, MEGA_LDS, stream);
    if (e != hipSuccess) fprintf(stderr, "kernel_launch: cooperative launch failed: %s (grid %d)\n", hipGetErrorString(e), grid);
}
```
